# Optimizing an MI355X kernel written in HIP

```python
import math
import jax, jax.numpy as jnp
from jax import lax
import numpy as np

D_MODEL = 1024
BATCH = 16
SEQ = 2048
DEPTH = 4

N_A_LAYERS = DEPTH // 2
N_B_LAYERS = DEPTH - N_A_LAYERS

H_A = 16
QK_NOPE = 128
QK_ROPE = 64
QK_HEAD = QK_NOPE + QK_ROPE
V_HEAD = 128
Q_LORA = 256
KV_LORA = 128

DILATED_GROUPS = ((128, 1), (512, 4), (2048, 16))
N_GROUPS = len(DILATED_GROUPS)
H_B = 8
HEAD_DIM_B = 128

D_FF = 4 * D_MODEL

ROPE_THETA = 10000.0
Q_BLOCK = 128
NORM_EPS = 1e-6
NEG_INF = -1e30

kernel_name = "yoco_mla_dilated_window_hybrid"


def _rms_norm(x, g):
    xf = x.astype(jnp.float32)
    y = xf * lax.rsqrt(jnp.mean(xf * xf, axis=-1, keepdims=True) + NORM_EPS)
    return (y * g.astype(jnp.float32)).astype(x.dtype)


def _rope(x, positions):
    r = x.shape[-1]
    inv_freq = ROPE_THETA ** (-jnp.arange(0, r, 2, dtype=jnp.float32) / r)
    ang = positions.astype(jnp.float32)[..., None] * inv_freq
    cos = jnp.cos(ang)[:, :, None, :]
    sin = jnp.sin(ang)[:, :, None, :]
    x1, x2 = jnp.split(x.astype(jnp.float32), 2, axis=-1)
    out = jnp.concatenate([x1 * cos - x2 * sin, x2 * cos + x1 * sin], axis=-1)
    return out.astype(x.dtype)


def _causal_block_attention(q, k, v, scale):
    S = q.shape[1]
    outs = []
    for i in range(S // Q_BLOCK):
        lo, hi = i * Q_BLOCK, (i + 1) * Q_BLOCK
        s = jnp.einsum('bqhd,bkhd->bhqk', q[:, lo:hi], k[:, :hi]).astype(jnp.float32) * scale
        mask = np.arange(lo, hi)[:, None] >= np.arange(hi)[None, :]
        s = jnp.where(mask, s, NEG_INF)
        p = jax.nn.softmax(s, axis=-1).astype(v.dtype)
        outs.append(jnp.einsum('bhqk,bkhd->bqhd', p, v[:, :hi]))
    return jnp.concatenate(outs, axis=1)


def _mla(xn, positions, w_in, qa_norm, kva_norm, w_qb, w_kvb, q_norm, k_norm, w_o):
    B, S, _ = xn.shape
    lat = xn @ w_in
    c_q, c_kv, k_pe = jnp.split(lat, [Q_LORA, Q_LORA + KV_LORA], axis=-1)
    q = (_rms_norm(c_q, qa_norm) @ w_qb).reshape(B, S, H_A, QK_HEAD)
    kv = (_rms_norm(c_kv, kva_norm) @ w_kvb).reshape(B, S, H_A, QK_NOPE + V_HEAD)
    k_nope, v = jnp.split(kv, [QK_NOPE], axis=-1)
    k_pe = jnp.broadcast_to(k_pe[:, :, None, :], (B, S, H_A, QK_ROPE))
    k = jnp.concatenate([k_nope, k_pe], axis=-1)
    q = _rms_norm(q, q_norm)
    k = _rms_norm(k, k_norm)
    q = jnp.concatenate([q[..., :QK_NOPE], _rope(q[..., QK_NOPE:], positions)], axis=-1)
    k = jnp.concatenate([k[..., :QK_NOPE], _rope(k[..., QK_NOPE:], positions)], axis=-1)
    o = _causal_block_attention(q, k, v, QK_HEAD ** -0.5)
    return o.reshape(B, S, H_A * V_HEAD) @ w_o


def _sliding_window_attention(q, k, v, steps):
    N, L, H, D = q.shape
    bq = math.gcd(L, Q_BLOCK)
    nb = L // bq
    pad = ((0, 0), (steps, 0), (0, 0), (0, 0))
    kp = jnp.pad(k, pad)
    vp = jnp.pad(v, pad)
    idx = np.arange(nb)[:, None] * bq + np.arange(bq + steps)[None, :]
    kb = kp[:, idx]
    vb = vp[:, idx]
    qb = q.reshape(N, nb, bq, H, D)
    s = jnp.einsum('nbqhd,nbkhd->nbhqk', qb, kb).astype(jnp.float32) * (D ** -0.5)
    rel = steps + np.arange(bq)[:, None] - np.arange(bq + steps)[None, :]
    band = (rel >= 0) & (rel <= steps)
    valid = band[None, :, :] & (idx[:, None, :] >= steps)
    s = jnp.where(valid[None, :, None], s, NEG_INF)
    m = jnp.max(s, axis=-1, keepdims=True)
    p = jnp.exp(s - m)
    denom = jnp.sum(p, axis=-1)
    out = jnp.einsum('nbhqk,nbkhd->nbqhd', p, vb.astype(jnp.float32))
    out = out / jnp.swapaxes(denom, 2, 3)[..., None]
    lse = jnp.swapaxes(m[..., 0] + jnp.log(denom), 2, 3)
    return out.reshape(N, L, H, D), lse.reshape(N, L, H)


def _dilated_group(q, k, v, dilation, steps):
    B, S, H, D = q.shape
    L = S // dilation

    def to_res(t):
        return t.reshape(B, L, dilation, H, D).transpose(0, 2, 1, 3, 4).reshape(B * dilation, L, H, D)

    out, lse = _sliding_window_attention(to_res(q), to_res(k), to_res(v), steps)
    out = out.reshape(B, dilation, L, H, D).transpose(0, 2, 1, 3, 4).reshape(B, S, H, D)
    lse = lse.reshape(B, dilation, L, H).transpose(0, 2, 1, 3).reshape(B, S, H)
    return out, lse


def _shared_kv(x, positions, kv_norm, w_kv, k_norm_b):
    B, S, _ = x.shape
    kv = (_rms_norm(x, kv_norm) @ w_kv).reshape(B, S, 2, N_GROUPS, H_B, HEAD_DIM_B)
    k, v = kv[:, :, 0], kv[:, :, 1]
    k = _rms_norm(k, k_norm_b[:, None, :])
    k = _rope(k.reshape(B, S, N_GROUPS * H_B, HEAD_DIM_B), positions).reshape(B, S, N_GROUPS, H_B, HEAD_DIM_B)
    return k, v


def _dilated_mixture(xn, positions, k, v, w_q, q_norm, w_o):
    B, S, _ = xn.shape
    q = (xn @ w_q).reshape(B, S, N_GROUPS, H_B, HEAD_DIM_B)
    q = _rms_norm(q, q_norm[:, None, :])
    q = _rope(q.reshape(B, S, N_GROUPS * H_B, HEAD_DIM_B), positions).reshape(B, S, N_GROUPS, H_B, HEAD_DIM_B)
    outs, lses = [], []
    for g, (window, dilation) in enumerate(DILATED_GROUPS):
        o, lse = _dilated_group(q[:, :, g], k[:, :, g], v[:, :, g], dilation, window // dilation)
        outs.append(o)
        lses.append(lse)
    wts = jax.nn.softmax(jnp.stack(lses, axis=0), axis=0)
    o = jnp.sum(wts[..., None] * jnp.stack(outs, axis=0), axis=0).astype(xn.dtype)
    return o.reshape(B, S, H_B * HEAD_DIM_B) @ w_o


def _sq_relu_mlp(xn, w1, w2):
    h = jax.nn.relu(xn @ w1)
    return (h * h) @ w2


def setup_inputs(seed: int = 0) -> dict:
    key = jax.random.key(seed)
    ks = jax.random.split(key, 24)
    f32 = jnp.float32

    def w(k, shape, fan_in):
        return jax.random.normal(k, shape, f32) * fan_in ** -0.5

    def gain(k, shape):
        return 1.0 + 0.02 * jax.random.normal(k, shape, f32)

    x = jax.random.normal(ks[0], (BATCH, SEQ, D_MODEL), f32)
    start = jax.random.randint(ks[1], (BATCH, 1), 0, 1024, dtype=jnp.int32)
    positions = start + jnp.arange(SEQ, dtype=jnp.int32)[None, :]
    qkv_b = N_GROUPS * H_B * HEAD_DIM_B
    return {
        "x": x,
        "positions": positions,
        "attn_norm": gain(ks[2], (DEPTH, D_MODEL)),
        "mlp_norm": gain(ks[3], (DEPTH, D_MODEL)),
        "mla_w_in": w(ks[4], (N_A_LAYERS, D_MODEL, Q_LORA + KV_LORA + QK_ROPE), D_MODEL),
        "mla_qa_norm": gain(ks[5], (N_A_LAYERS, Q_LORA)),
        "mla_kva_norm": gain(ks[6], (N_A_LAYERS, KV_LORA)),
        "mla_w_qb": w(ks[7], (N_A_LAYERS, Q_LORA, H_A * QK_HEAD), Q_LORA),
        "mla_w_kvb": w(ks[8], (N_A_LAYERS, KV_LORA, H_A * (QK_NOPE + V_HEAD)), KV_LORA),
        "mla_q_norm": gain(ks[9], (N_A_LAYERS, QK_HEAD)),
        "mla_k_norm": gain(ks[10], (N_A_LAYERS, QK_HEAD)),
        "mla_w_o": w(ks[11], (N_A_LAYERS, H_A * V_HEAD, D_MODEL), H_A * V_HEAD),
        "kv_norm": gain(ks[12], (D_MODEL,)),
        "w_kv": w(ks[13], (D_MODEL, 2 * qkv_b), D_MODEL),
        "k_norm_b": gain(ks[14], (N_GROUPS, HEAD_DIM_B)),
        "w_q_b": w(ks[15], (N_B_LAYERS, D_MODEL, qkv_b), D_MODEL),
        "q_norm_b": gain(ks[16], (N_B_LAYERS, N_GROUPS, HEAD_DIM_B)),
        "w_o_b": w(ks[17], (N_B_LAYERS, H_B * HEAD_DIM_B, D_MODEL), H_B * HEAD_DIM_B),
        "mlp_w1": w(ks[18], (DEPTH, D_MODEL, D_FF), D_MODEL),
        "mlp_w2": w(ks[19], (DEPTH, D_FF, D_MODEL), D_FF),
    }


def reference(x, positions, attn_norm, mlp_norm, mla_w_in, mla_qa_norm, mla_kva_norm, mla_w_qb,
              mla_w_kvb, mla_q_norm, mla_k_norm, mla_w_o, kv_norm, w_kv, k_norm_b, w_q_b, q_norm_b,
              w_o_b, mlp_w1, mlp_w2):
    shared_k, shared_v = None, None
    for layer in range(DEPTH):
        if layer == N_A_LAYERS:
            shared_k, shared_v = _shared_kv(x, positions, kv_norm, w_kv, k_norm_b)
        xn = _rms_norm(x, attn_norm[layer])
        if layer < N_A_LAYERS:
            a = layer
            h = _mla(xn, positions, mla_w_in[a], mla_qa_norm[a], mla_kva_norm[a], mla_w_qb[a],
                     mla_w_kvb[a], mla_q_norm[a], mla_k_norm[a], mla_w_o[a])
        else:
            b = layer - N_A_LAYERS
            h = _dilated_mixture(xn, positions, shared_k, shared_v, w_q_b[b], q_norm_b[b], w_o_b[b])
        x = x + h
        x = x + _sq_relu_mlp(_rms_norm(x, mlp_norm[layer]), mlp_w1[layer], mlp_w2[layer])
    return x
```

```cpp
#include <hip/hip_runtime.h>
#include <hip/hip_cooperative_groups.h>
#include <cstdio>
#include <cstdint>
namespace cg = cooperative_groups;

#ifndef ONE_LAUNCH
#define ONE_LAUNCH 1
#endif

__device__ __forceinline__ int opaque_tid() { int t = (int)threadIdx.x; asm volatile("" : "+v"(t)); return t; }
__device__ __forceinline__ int opaque_bid() { int b = (int)blockIdx.x; asm volatile("" : "+s"(b)); return b; }
namespace pg8 {
#define PG8_LAS __attribute__((address_space(3)))
typedef unsigned short bf16_t;
typedef short bf16x8 __attribute__((ext_vector_type(8)));
typedef float f32x4 __attribute__((ext_vector_type(4)));
typedef unsigned u32x4 __attribute__((ext_vector_type(4)));
constexpr int BM = 256, BK = 64, HALF = 128, HTB = HALF * BK * 2  , STAGE_BYTES = 8 * HTB, NXCD = 8, WGM = 8;

__host__ __device__ __forceinline__ int lds_byte(int r, int c) { const int st = (r >> 4) * 2 + (c >> 5), rr = r & 15, cc = c & 31, ob = rr * 64 + cc * 2; return st * 1024 + (ob ^ (((ob >> 9) & 1) << 5)); }
__host__ __device__ __forceinline__ void stage_rc(int b, int& R, int& C) { const int st = b / 1024, sb = b % 1024, swz = sb ^ (((sb >> 9) & 1) << 5); R = (st >> 1) * 16 + swz / 64; C = (st & 1) * 32 + (swz % 64) / 2; }
__host__ __device__ __forceinline__ int perm32(int rho) { const int n = rho >> 4, i = rho & 15; return 8 * (i >> 2) + 4 * n + (i & 3); }
struct Unit { int pm, pn; };
struct Gemm { const bf16_t* A; const bf16_t* Bt; int M, N, K, lda; };
struct StaticOrder {
    int nM, nN, nwg, G, c;
    __host__ __device__ void init(int M, int N, int G_, int c_) { nM = M / BM; nN = N / BM; nwg = nM * nN; G = G_; c = c_; }
    __host__ __device__ bool next(int i, Unit& u) const {
        const long L = (long)i * G + c; if (L >= nwg) return false;
        int wgid = (int)L; { const int q = nwg / NXCD, r = nwg % NXCD, xcd = wgid % NXCD, off = wgid / NXCD; wgid = (xcd < r ? xcd * (q + 1) : r * (q + 1) + (xcd - r) * q) + off; }
        const int nig = WGM * nN, gid = wgid / nig, fm = gid * WGM, gsz = (nM - fm) < WGM ? (nM - fm) : WGM;
        u.pm = fm + ((wgid % nig) % gsz); u.pn = (wgid % nig) / gsz; return true;
    }
    __device__ __forceinline__ void a_ready(const Unit&) const {}
    __device__ __forceinline__ void done(const Unit&) const {}
};
__device__ __forceinline__ unsigned cvt_pk_bf16(float lo, float hi) { unsigned r; asm volatile("v_cvt_pk_bf16_f32 %0, %1, %2" : "=v"(r) : "v"(lo), "v"(hi)); return r; }
template <class Epi, class Sched>
__device__ __forceinline__ void gemm_phase(PG8_LAS unsigned char* lds, const Gemm g, const Sched& S, const Epi& E) {
    const int tid = opaque_tid(), wid = __builtin_amdgcn_readfirstlane(tid >> 6), lane = tid & 63, wr = wid >> 2, wc = wid & 3, fr = lane & 15, fq = lane >> 4;
    const int K = g.K, nt = K / BK;
    unsigned voffA[2], voffB[2];
#pragma unroll
    for (int i = 0; i < 2; ++i) { int R, C; stage_rc(tid * 16 + i * 8192, R, C); const int Rb = Epi::PERM ? ((R & ~31) + perm32(R & 31)) : R;
        voffA[i] = (unsigned)(R * g.lda + C) * 2u; voffB[i] = (unsigned)(Rb * K + C) * 2u; }
    const size_t kstep = (size_t)(BK * 2);
    const size_t hstep = (size_t)HALF * K * 2, hstepA = (size_t)HALF * g.lda * 2;
    const size_t tstep = 2 * hstep, tstepA = 2 * hstepA;
    const unsigned ldsw = (unsigned)wid * 1024u;
    const int aoff = lds_byte(wr * 64 + fr, fq * 8), boff = lds_byte(wc * 32 + fr, fq * 8);
#define PG8_SA(b, h) (((b) * 2 + (h)) * HTB)
#define PG8_SB(b, h) ((4 + (b) * 2 + (h)) * HTB)
#define PG8_STAGE(bufoff, gbase, voff) do { _Pragma("unroll") for (int _i = 0; _i < 2; ++_i) \
        __builtin_amdgcn_global_load_lds((const unsigned*)((const char*)(gbase) + (voff)[_i]), (PG8_LAS unsigned*)(lds + (bufoff) + ldsw + _i * 8192), 16, 0, 0); } while (0)
#define PG8_LDA(dst, b, h) do { _Pragma("unroll") for (int m = 0; m < 4; ++m) _Pragma("unroll") for (int k = 0; k < 2; ++k) dst[m][k] = *(const PG8_LAS bf16x8*)(lds + PG8_SA(b, h) + aoff + m * 2048 + k * 1024); } while (0)
#define PG8_LDB(dst, b, h) do { _Pragma("unroll") for (int n = 0; n < 2; ++n) _Pragma("unroll") for (int k = 0; k < 2; ++k) dst[n][k] = *(const PG8_LAS bf16x8*)(lds + PG8_SB(b, h) + boff + n * 2048 + k * 1024); } while (0)
#define PG8_MMA(ai, bj, At, Bt) do { __builtin_amdgcn_s_setprio(1); _Pragma("unroll") for (int m = 0; m < 4; ++m) _Pragma("unroll") for (int n = 0; n < 2; ++n) _Pragma("unroll") for (int k = 0; k < 2; ++k) \
        acc[ai][bj][m][n] = __builtin_amdgcn_mfma_f32_16x16x32_bf16(Bt[n][k], At[m][k], acc[ai][bj][m][n], 0, 0, 0); __builtin_amdgcn_s_setprio(0); } while (0)
#define PG8_WAIT_V(n) asm volatile("s_waitcnt vmcnt(" #n ")" ::: "memory")
#define PG8_WAIT_L(n) asm volatile("s_waitcnt lgkmcnt(" #n ")" ::: "memory")
#define PG8_BAR __builtin_amdgcn_s_barrier()
#define PG8_SCHED __builtin_amdgcn_sched_barrier(0)
    Unit cur, nxt; int ui = 0;
    if (!S.next(0, cur)) return;
    f32x4 acc[2][2][4][2];
#pragma unroll
    for (int a = 0; a < 2; ++a)
#pragma unroll
        for (int b = 0; b < 2; ++b)
#pragma unroll
            for (int m = 0; m < 4; ++m)
#pragma unroll
                for (int n = 0; n < 2; ++n) acc[a][b][m][n] = (f32x4){0.f, 0.f, 0.f, 0.f};
    bf16x8 At[4][2], B0[2][2], B1[2][2];
    const char* cA = (const char*)g.A + (size_t)cur.pm * tstepA; const char* cB = (const char*)g.Bt + (size_t)cur.pn * tstep;
    S.a_ready(cur);
    PG8_STAGE(PG8_SB(0, 0), cB, voffB); PG8_STAGE(PG8_SA(0, 0), cA, voffA); PG8_STAGE(PG8_SB(0, 1), cB + hstep, voffB); PG8_STAGE(PG8_SA(0, 1), cA + hstepA, voffA);
    if (wr == 1) PG8_BAR;
    PG8_WAIT_V(4); PG8_BAR;
    PG8_STAGE(PG8_SB(1, 0), cB + kstep, voffB); PG8_STAGE(PG8_SA(1, 0), cA + kstep, voffA); PG8_STAGE(PG8_SB(1, 1), cB + hstep + kstep, voffB);
    PG8_WAIT_V(6); PG8_BAR;
    for (;;) {
        const bool has_next = S.next(ui + 1, nxt);
        const char* nA = has_next ? (const char*)g.A + (size_t)nxt.pm * tstepA : cA; const char* nB = has_next ? (const char*)g.Bt + (size_t)nxt.pn * tstep : cB;
        for (int t = 0; t < nt; t += 2) {
            const bool last = (t == nt - 2);
            const char* a1 = cA + (size_t)(t + 1) * kstep;
            const char* a2 = last ? nA : cA + (size_t)(t + 2) * kstep; const char* b2 = last ? nB : cB + (size_t)(t + 2) * kstep;
            const char* a3 = a2 + kstep; const char* b3 = b2 + kstep;
            if (last && has_next) S.a_ready(nxt);
            PG8_LDB(B0, 0, 0); PG8_SCHED; PG8_LDA(At, 0, 0); PG8_STAGE(PG8_SA(1, 1), a1 + hstepA, voffA);
            PG8_WAIT_L(8); PG8_BAR; PG8_WAIT_L(0); PG8_MMA(0, 0, At, B0); PG8_BAR; PG8_SCHED;
            PG8_LDB(B1, 0, 1); PG8_STAGE(PG8_SB(0, 0), b2, voffB);
            PG8_BAR; PG8_WAIT_L(0); PG8_MMA(0, 1, At, B1); PG8_BAR;
            PG8_LDA(At, 0, 1); PG8_STAGE(PG8_SA(0, 0), a2, voffA);
            PG8_BAR; PG8_WAIT_L(0); PG8_MMA(1, 0, At, B0); PG8_BAR; PG8_SCHED;
            PG8_STAGE(PG8_SB(0, 1), b2 + hstep, voffB);
            PG8_WAIT_V(6); PG8_BAR; PG8_MMA(1, 1, At, B1); PG8_BAR;
            PG8_LDB(B0, 1, 0); PG8_SCHED; PG8_LDA(At, 1, 0); PG8_STAGE(PG8_SA(0, 1), a2 + hstepA, voffA);
            PG8_WAIT_L(8); PG8_BAR; PG8_WAIT_L(0); PG8_MMA(0, 0, At, B0); PG8_BAR; PG8_SCHED;
            PG8_LDB(B1, 1, 1); PG8_STAGE(PG8_SB(1, 0), b3, voffB);
            PG8_BAR; PG8_WAIT_L(0); PG8_MMA(0, 1, At, B1); PG8_BAR;
            PG8_LDA(At, 1, 1); PG8_STAGE(PG8_SA(1, 0), a3, voffA);
            PG8_BAR; PG8_WAIT_L(0); PG8_MMA(1, 0, At, B0); PG8_BAR; PG8_SCHED;
            PG8_STAGE(PG8_SB(1, 1), b3 + hstep, voffB);
            PG8_WAIT_V(6); PG8_BAR; PG8_MMA(1, 1, At, B1); PG8_BAR;
        }
        if constexpr (!Epi::AFTER_DRAIN) { E(acc, cur, wr, wc, fr, fq); S.done(cur); }
        if (!has_next) break;
#pragma unroll
        for (int a = 0; a < 2; ++a)
#pragma unroll
            for (int b = 0; b < 2; ++b)
#pragma unroll
                for (int m = 0; m < 4; ++m)
#pragma unroll
                    for (int n = 0; n < 2; ++n) acc[a][b][m][n] = (f32x4){0.f, 0.f, 0.f, 0.f};
        cur = nxt; cA = nA; cB = nB; ++ui;
    }
    PG8_WAIT_V(0);
    if (wr == 0) PG8_BAR;
    PG8_BAR;
    if constexpr (Epi::AFTER_DRAIN) { E.fused(acc, cur, wr, wc, fr, fq, lds, wid, lane); S.done(cur); }
#undef PG8_SA
#undef PG8_SB
#undef PG8_STAGE
#undef PG8_LDA
#undef PG8_LDB
#undef PG8_MMA
#undef PG8_WAIT_V
#undef PG8_WAIT_L
#undef PG8_BAR
#undef PG8_SCHED
}
}
using pg8::bf16_t; using pg8::bf16x8; using pg8::f32x4; using pg8::u32x4;
#define LAS __attribute__((address_space(3)))
typedef short s16x4 __attribute__((ext_vector_type(4)));
typedef float f32x16 __attribute__((ext_vector_type(16)));
typedef unsigned u32x2 __attribute__((ext_vector_type(2)));

constexpr int SEQ = 2048, DM = 1024, NBATCH = 16, TT = NBATCH * SEQ, TH = TT / 2, BH = NBATCH / 2, DFF = 4096;
constexpr float EPS = 1e-6f, LOG2E = 1.4426950408889634f, LOG2_THETA = 13.287712379549449f;
constexpr int NTHR = 512;
constexpr int LDS_BYTES = 131072 + 4096;
constexpr size_t MiB = (size_t)1 << 20;
constexpr size_t WS_WIN = 0, WS_WQB = WS_WIN + 2 * MiB, WS_WKVB = WS_WQB + 3 * MiB, WS_WO = WS_WKVB + 4 * MiB, WS_WKVQ = WS_WO + 8 * MiB, WS_WQ1 = WS_WKVQ + 18 * MiB,
                 WS_WOB = WS_WQ1 + 6 * MiB, WS_W1 = WS_WOB + 4 * MiB, WS_W2 = WS_W1 + 32 * MiB, WS_XB = WS_W2 + 32 * MiB, WS_SS = WS_XB + 32 * MiB, WS_LSE = WS_SS + 1 * MiB,
                 WS_BIG = WS_LSE + 1 * MiB;
constexpr size_t WS_LAT = WS_BIG, WS_Q = WS_LAT + 16 * MiB, WS_KV = WS_Q + 96 * MiB, WS_KPE = WS_KV + 128 * MiB, WS_AO = WS_KPE + 32 * MiB;
constexpr size_t WS_KVB = WS_BIG, WS_QB = WS_BIG + 192 * MiB, WS_OB = WS_BIG + 288 * MiB;
constexpr size_t WS_H = WS_BIG + 192 * MiB;
constexpr size_t WS_END = WS_BIG + 336 * MiB;

struct Params { const void* in[20]; float* out; unsigned char* ws; int ph_lo, ph_hi; };

__device__ __forceinline__ unsigned cvtpk(float lo, float hi) { unsigned r; asm volatile("v_cvt_pk_bf16_f32 %0, %1, %2" : "=v"(r) : "v"(lo), "v"(hi)); return r; }
__device__ __forceinline__ float bf_lo(unsigned w) { return __uint_as_float(w << 16); }
__device__ __forceinline__ float bf_hi(unsigned w) { return __uint_as_float(w & 0xffff0000u); }
#define UNPACK8(W_, V_) do { const u32x4 t_ = (W_); V_[0] = bf_lo(t_[0]); V_[1] = bf_hi(t_[0]); V_[2] = bf_lo(t_[1]); V_[3] = bf_hi(t_[1]); V_[4] = bf_lo(t_[2]); V_[5] = bf_hi(t_[2]); V_[6] = bf_lo(t_[3]); V_[7] = bf_hi(t_[3]); } while (0)
#define PACK8(V_) ((u32x4){cvtpk(V_[0], V_[1]), cvtpk(V_[2], V_[3]), cvtpk(V_[4], V_[5]), cvtpk(V_[6], V_[7])})
__device__ __forceinline__ void sincos_rev(float pos, float invf_rev, float& s, float& c) {
    float rev = pos * invf_rev; rev = rev - floorf(rev);
    s = __builtin_amdgcn_sinf(rev); c = __builtin_amdgcn_cosf(rev);
}

__device__ __forceinline__ void cvt_job(const float* __restrict__ W, int K, int N, const float* __restrict__ gain, bf16_t* __restrict__ dst, int ldo, int& base, LAS float* tile) {
    const int tk = K / 64, tn = N / 64, nt = tk * tn, G = (int)gridDim.x, tid = opaque_tid();
    int start = (opaque_bid() - (base % G)); if (start < 0) start += G;
    for (int t = start; t < nt; t += G) {
        const int kt = t / tn, ntile = t - kt * tn;
        __syncthreads();
#pragma unroll
        for (int i = 0; i < 2; ++i) {
            const int k = (tid >> 4) + 32 * i, n4 = (tid & 15) * 4;
            const f32x4 v = *(const f32x4*)(W + (size_t)(kt * 64 + k) * N + ntile * 64 + n4);
            const float g = gain ? gain[kt * 64 + k] : 1.0f;
            tile[(n4 + 0) * 65 + k] = v.x * g; tile[(n4 + 1) * 65 + k] = v.y * g; tile[(n4 + 2) * 65 + k] = v.z * g; tile[(n4 + 3) * 65 + k] = v.w * g;
        }
        __syncthreads();
        const int n = tid >> 3, k8 = (tid & 7) * 8;
        const LAS float* tp = tile + n * 65 + k8;
        u32x4 w; w.x = cvtpk(tp[0], tp[1]); w.y = cvtpk(tp[2], tp[3]); w.z = cvtpk(tp[4], tp[5]); w.w = cvtpk(tp[6], tp[7]);
        *(u32x4*)(dst + (size_t)(ntile * 64 + n) * ldo + kt * 64 + k8) = w;
    }
    base += nt;
}
__device__ __forceinline__ void zero_fill(bf16_t* dst, int rows, int cols8, int ld) {
    const size_t n = (size_t)rows * cols8;
    for (size_t i = (size_t)opaque_bid() * NTHR + opaque_tid(); i < n; i += (size_t)gridDim.x * NTHR) { const size_t r = i / cols8, c = i - r * cols8; *(u32x4*)(dst + r * ld + c * 8) = (u32x4){0u, 0u, 0u, 0u}; }
}
__device__ void prep_weights(const Params& p, LAS unsigned char* lds) {
    LAS float* tile = (LAS float*)lds;
    unsigned char* ws = p.ws;
    const float* attn_norm = (const float*)p.in[2]; const float* mlp_norm = (const float*)p.in[3];
    int base = 0;
    for (int a = 0; a < 2; ++a) {
        cvt_job((const float*)p.in[4] + (size_t)a * 1024 * 448, 1024, 448, attn_norm + a * 1024, (bf16_t*)(ws + WS_WIN) + (size_t)a * 512 * 1024, 1024, base, tile);
        cvt_job((const float*)p.in[7] + (size_t)a * 256 * 3072, 256, 3072, (const float*)p.in[5] + a * 256, (bf16_t*)(ws + WS_WQB) + (size_t)a * 3072 * 256, 256, base, tile);
        cvt_job((const float*)p.in[8] + (size_t)a * 128 * 4096, 128, 4096, (const float*)p.in[6] + a * 128, (bf16_t*)(ws + WS_WKVB) + (size_t)a * 4096 * 256, 256, base, tile);
        cvt_job((const float*)p.in[11] + (size_t)a * 2048 * 1024, 2048, 1024, nullptr, (bf16_t*)(ws + WS_WO) + (size_t)a * 1024 * 2048, 2048, base, tile);
        cvt_job((const float*)p.in[17] + (size_t)a * 1024 * 1024, 1024, 1024, nullptr, (bf16_t*)(ws + WS_WOB) + (size_t)a * 1024 * 1024, 1024, base, tile);
        zero_fill((bf16_t*)(ws + WS_WIN) + (size_t)a * 512 * 1024 + (size_t)448 * 1024, 64, 128, 1024);
        zero_fill((bf16_t*)(ws + WS_WKVB) + (size_t)a * 4096 * 256 + 128, 4096, 16, 256);
    }
    cvt_job((const float*)p.in[13], 1024, 6144, (const float*)p.in[12], (bf16_t*)(ws + WS_WKVQ), 1024, base, tile);
    cvt_job((const float*)p.in[15], 1024, 3072, attn_norm + 2 * 1024, (bf16_t*)(ws + WS_WKVQ) + (size_t)6144 * 1024, 1024, base, tile);
    cvt_job((const float*)p.in[15] + (size_t)1024 * 3072, 1024, 3072, attn_norm + 3 * 1024, (bf16_t*)(ws + WS_WQ1), 1024, base, tile);
    for (int l = 0; l < 4; ++l) {
        cvt_job((const float*)p.in[18] + (size_t)l * 1024 * 4096, 1024, 4096, mlp_norm + l * 1024, (bf16_t*)(ws + WS_W1) + (size_t)l * 4096 * 1024, 1024, base, tile);
        cvt_job((const float*)p.in[19] + (size_t)l * 4096 * 1024, 4096, 1024, nullptr, (bf16_t*)(ws + WS_W2) + (size_t)l * 1024 * 4096, 4096, base, tile);
    }
    __syncthreads();
}
__device__ void prep_x(const float* __restrict__ x, bf16_t* __restrict__ xb, float* __restrict__ ss) {
    const int tid_ = opaque_tid(), lane = tid_ & 63, gw = opaque_bid() * 8 + (tid_ >> 6), nw = gridDim.x * 8;
    for (int r = gw; r < TH; r += nw) {
        const float* xr = x + (size_t)r * 1024; bf16_t* br = xb + (size_t)r * 1024; float s = 0.f;
#pragma unroll
        for (int i = 0; i < 4; ++i) { const f32x4 v = *(const f32x4*)(xr + i * 256 + lane * 4); s += v.x * v.x + v.y * v.y + v.z * v.z + v.w * v.w;
            *(u32x2*)(br + i * 256 + lane * 4) = (u32x2){cvtpk(v.x, v.y), cvtpk(v.z, v.w)}; }
#pragma unroll
        for (int o = 1; o < 64; o <<= 1) s += __shfl_xor(s, o);
        if (lane < 16) ss[(size_t)r * 16 + lane] = lane == 0 ? s : 0.f;
    }
}

struct EpiBf16S {
    static constexpr bool PERM = true, AFTER_DRAIN = false;
    bf16_t* O; int ldc; bf16_t* O2; int ldc2; int split; const float* ss; int act;
    __device__ __forceinline__ void operator()(const f32x4 (&acc)[2][2][4][2], const pg8::Unit& u, int wr, int wc, int fr, int fq) const {
        const int row0 = u.pm * 256 + wr * 64 + fr; int colt = u.pn * 256; bf16_t* base = O; int ld = ldc;
        if (colt >= split) { base = O2; colt -= split; ld = ldc2; }
        const int col0 = colt + wc * 32 + 8 * fq;
#pragma unroll
        for (int ai = 0; ai < 2; ++ai)
#pragma unroll
            for (int m = 0; m < 4; ++m) { const int row = row0 + ai * 128 + m * 16; float sc = 1.0f;
                if (ss) { const f32x4* sp = (const f32x4*)(ss + (size_t)row * 16); const f32x4 a = (sp[0] + sp[1]) + (sp[2] + sp[3]); sc = rsqrtf(((a.x + a.y) + (a.z + a.w)) * (1.0f / 1024.0f) + EPS); }
                bf16_t* rowp = base + (size_t)row * ld + col0;
#pragma unroll
                for (int bj = 0; bj < 2; ++bj) { f32x4 v0 = acc[ai][bj][m][0] * sc, v1 = acc[ai][bj][m][1] * sc;
                    if (act) {
#pragma unroll
                        for (int j = 0; j < 4; ++j) { const float a0 = fmaxf(v0[j], 0.f), a1 = fmaxf(v1[j], 0.f); v0[j] = a0 * a0; v1[j] = a1 * a1; } }
                    u32x4 w; w.x = cvtpk(v0[0], v0[1]); w.y = cvtpk(v0[2], v0[3]); w.z = cvtpk(v1[0], v1[1]); w.w = cvtpk(v1[2], v1[3]);
                    *(u32x4*)(rowp + bj * 128) = w; } }
    }
};
struct EpiRes {
    static constexpr bool PERM = false, AFTER_DRAIN = false;
    const float* xin; float* xout; bf16_t* xb; float* ss;
    __device__ __forceinline__ void operator()(const f32x4 (&acc)[2][2][4][2], const pg8::Unit& u, int wr, int wc, int fr, int fq) const {
        const int row0 = u.pm * 256 + wr * 64 + fr, col0 = u.pn * 256 + wc * 32 + 4 * fq;
#pragma unroll
        for (int ai = 0; ai < 2; ++ai)
#pragma unroll
            for (int m = 0; m < 4; ++m) { const int row = row0 + ai * 128 + m * 16; const size_t off = (size_t)row * 1024 + col0; float s = 0.f;
#pragma unroll
                for (int bj = 0; bj < 2; ++bj)
#pragma unroll
                    for (int n = 0; n < 2; ++n) { const int c = bj * 128 + n * 16; const f32x4 o = *(const f32x4*)(xin + off + c) + acc[ai][bj][m][n];
                        *(f32x4*)(xout + off + c) = o; s += (o.x * o.x + o.y * o.y) + (o.z * o.z + o.w * o.w);
                        *(u32x2*)(xb + off + c) = (u32x2){cvtpk(o.x, o.y), cvtpk(o.z, o.w)}; }
                s += __shfl_xor(s, 16); s += __shfl_xor(s, 32);
                if (fq == 0) ss[(size_t)row * 16 + u.pn * 4 + wc] = s; }
    }
};
template <class Epi> __device__ __forceinline__ void run_gemm(LAS unsigned char* lds, const bf16_t* A, int lda, const bf16_t* Bt, int N, int K, const Epi& E) {
    pg8::Gemm g{A, Bt, TH, N, K, lda}; pg8::StaticOrder S; S.init(TH, N, (int)gridDim.x, opaque_bid());
    pg8::gemm_phase<Epi, pg8::StaticOrder>(lds, g, S, E);
}

__device__ void lat_prep(bf16_t* lat) {
    const int tid_ = opaque_tid(), lane = tid_ & 63, gw = opaque_bid() * 8 + (tid_ >> 6), nw = gridDim.x * 8;
    for (int t = gw; t < TH; t += nw) {
        bf16_t* p = lat + (size_t)t * 512 + lane * 8; const u32x4 w = *(const u32x4*)p; float v[8]; UNPACK8(w, v);
        float s = 0.f;
#pragma unroll
        for (int e = 0; e < 8; ++e) s += v[e] * v[e];
        s += __shfl_xor(s, 1); s += __shfl_xor(s, 2); s += __shfl_xor(s, 4); s += __shfl_xor(s, 8);
        const float s32 = s + __shfl_xor(s, 16);
        const float rstd = lane < 32 ? rsqrtf(s32 * (1.0f / 256.0f) + EPS) : rsqrtf(s * (1.0f / 128.0f) + EPS);
        if (lane < 48) {
#pragma unroll
            for (int e = 0; e < 8; ++e) v[e] *= rstd;
            *(u32x4*)p = PACK8(v); }
    }
}
__device__ void mla_qk_prep(bf16_t* q, bf16_t* kv, const bf16_t* lat, bf16_t* kpe, const int* pos, const float* gq, const float* gk) {
    const int tid_ = opaque_tid(), lane = tid_ & 63, gw = opaque_bid() * 8 + (tid_ >> 6), nw = gridDim.x * 8;
    const float qscale = 0.07216878364870322f * LOG2E;
    float invf[8];
#pragma unroll
    for (int e = 0; e < 8; ++e) invf[e] = exp2f(-(float)((lane & 3) * 8 + e) * (LOG2_THETA / 32.0f)) * 0.15915494309189535f;
    for (int t = gw; t < TH; t += nw) {
        const float posf = (float)pos[t];
        float cs[8], sn[8];
#pragma unroll
        for (int e = 0; e < 8; ++e) sincos_rev(posf, invf[e], sn[e], cs[e]);
        float kr[8]; float ss_pe;
        { u32x4 w = (u32x4){0u, 0u, 0u, 0u}; if (lane < 8) w = *(const u32x4*)(lat + (size_t)t * 512 + 384 + lane * 8);
          float v[8]; UNPACK8(w, v); float s = 0.f;
#pragma unroll
          for (int e = 0; e < 8; ++e) s += v[e] * v[e];
          s += __shfl_xor(s, 1); s += __shfl_xor(s, 2); s += __shfl_xor(s, 4); ss_pe = __shfl(s, 0);
#pragma unroll
          for (int e = 0; e < 8; ++e) { const float g = gk[128 + (lane & 7) * 8 + e]; const float y = v[e] * g; const float pr = __shfl_xor(y, 4);
              const float r = (lane & 4) ? y * cs[e] + pr * sn[e] : y * cs[e] - pr * sn[e]; kr[e] = __shfl(r, lane & 7); } }
#pragma unroll 1
        for (int itr = 0; itr < 4; ++itr) { const int h = itr * 4 + (lane >> 4), c16 = lane & 15;
            bf16_t* p = kv + (size_t)t * 4096 + h * 256 + c16 * 8; const u32x4 w = *(const u32x4*)p; float v[8]; UNPACK8(w, v); float s = 0.f;
#pragma unroll
            for (int e = 0; e < 8; ++e) s += v[e] * v[e];
            s += __shfl_xor(s, 1); s += __shfl_xor(s, 2); s += __shfl_xor(s, 4); s += __shfl_xor(s, 8);
            const float rstd = rsqrtf((s + ss_pe) * (1.0f / 192.0f) + EPS);
#pragma unroll
            for (int e = 0; e < 8; ++e) v[e] = v[e] * rstd * gk[c16 * 8 + e];
            *(u32x4*)p = PACK8(v);
            if (c16 < 8) { float o[8];
#pragma unroll
                for (int e = 0; e < 8; ++e) o[e] = kr[e] * rstd;
                *(u32x4*)(kpe + ((size_t)t * 16 + h) * 64 + c16 * 8) = PACK8(o); } }
#pragma unroll 1
        for (int itr = 0; itr < 8; ++itr) { const int h = itr * 2 + (lane >> 5), c = lane & 31; const bool act = c < 24;
            bf16_t* p = q + (size_t)t * 3072 + h * 192 + c * 8; u32x4 w = (u32x4){0u, 0u, 0u, 0u}; if (act) w = *(const u32x4*)p; float v[8]; UNPACK8(w, v); float s = 0.f;
#pragma unroll
            for (int e = 0; e < 8; ++e) s += v[e] * v[e];
            s += __shfl_xor(s, 1); s += __shfl_xor(s, 2); s += __shfl_xor(s, 4); s += __shfl_xor(s, 8); s += __shfl_xor(s, 16);
            const float rstd = rsqrtf(s * (1.0f / 192.0f) + EPS) ;
#pragma unroll
            for (int e = 0; e < 8; ++e) { float y = v[e] * rstd * (act ? gq[c * 8 + e] : 0.f); const float pr = __shfl_xor(y, 4);
                if (c >= 16) y = (c & 4) ? y * cs[e] + pr * sn[e] : y * cs[e] - pr * sn[e];
                v[e] = y * qscale; }
            if (act) *(u32x4*)p = PACK8(v); }
    }
}
__device__ void head_prep(bf16_t* kbuf  , bf16_t* qbuf, const int* pos, const float* gk, const float* gq) {
    const int tid_ = opaque_tid(), lane = tid_ & 63, gw = opaque_bid() * 8 + (tid_ >> 6), nw = gridDim.x * 8;
    const float qscale = 0.08838834764831845f * LOG2E;
    const int c16 = lane & 15;
    float invf[8];
#pragma unroll
    for (int e = 0; e < 8; ++e) invf[e] = exp2f(-(float)((c16 & 7) * 8 + e) * (LOG2_THETA / 64.0f)) * 0.15915494309189535f;
    for (int t = gw; t < TH; t += nw) {
        const float posf = (float)pos[t];
        float cs[8], sn[8];
#pragma unroll
        for (int e = 0; e < 8; ++e) sincos_rev(posf, invf[e], sn[e], cs[e]);
#pragma unroll 1
        for (int itr = 0; itr < 12; ++itr) { const bool isq = itr >= 6; if (!isq && !kbuf) continue;
            const int hh = (isq ? itr - 6 : itr) * 4 + (lane >> 4), g = hh >> 3;
            bf16_t* p = isq ? qbuf + (size_t)t * 3072 + hh * 128 + c16 * 8 : kbuf + (size_t)t * 6144 + hh * 128 + c16 * 8;
            const float* gn = (isq ? gq : gk) + g * 128 + c16 * 8;
            const u32x4 w = *(const u32x4*)p; float v[8]; UNPACK8(w, v); float s = 0.f;
#pragma unroll
            for (int e = 0; e < 8; ++e) s += v[e] * v[e];
            s += __shfl_xor(s, 1); s += __shfl_xor(s, 2); s += __shfl_xor(s, 4); s += __shfl_xor(s, 8);
            const float rstd = rsqrtf(s * (1.0f / 128.0f) + EPS), osc = isq ? qscale : 1.0f;
#pragma unroll
            for (int e = 0; e < 8; ++e) { const float y = v[e] * rstd * gn[e]; const float pr = __shfl_xor(y, 8);
                v[e] = ((c16 & 8) ? y * cs[e] + pr * sn[e] : y * cs[e] - pr * sn[e]) * osc; }
            *(u32x4*)p = PACK8(v); }
    }
}

struct AttnItem { const bf16_t* q; const bf16_t* k; const bf16_t* kpe; const bf16_t* v; bf16_t* o; float* lse; int q_ld, k_ld, kpe_ld, v_ld, o_ld, P0, ld, merge; };
__device__ __forceinline__ int v_st(int k, int c) { const int kk = (k & ~0xC) | ((k & 4) << 1) | ((k & 8) >> 1); return ((kk >> 3) * 4 + (c >> 5)) * 512 + ((kk & 7) * 32 + (c & 31)) * 2; }
__device__ __forceinline__ int v_rd_base(int lane) { return ((lane & 3) << 3) | (((lane >> 2) & 3) << 6) | (((lane >> 4) & 1) << 5) | (((lane >> 5) & 1) << 8); }
#define PK4(P, B_, OUT) do { unsigned a0_ = cvtpk(P[B_+0], P[B_+1]), a1_ = cvtpk(P[B_+2], P[B_+3]); unsigned b0_ = cvtpk(P[B_+4], P[B_+5]), b1_ = cvtpk(P[B_+6], P[B_+7]); \
        auto r0_ = __builtin_amdgcn_permlane32_swap(a0_, b0_, false, false); auto r1_ = __builtin_amdgcn_permlane32_swap(a1_, b1_, false, false); \
        u32x4 w_ = {r0_[0], r1_[0], r0_[1], r1_[1]}; OUT = w_; } while (0)
__device__ __forceinline__ bf16x8 as_bf(u32x4 w) { return *reinterpret_cast<bf16x8*>(&w); }

template <int DQK, int MODE>
__device__ __forceinline__ void attn_block(const AttnItem& it, LAS unsigned char* lds) {
    constexpr int RS = DQK * 2, SHM_K = 64 * RS, SHM_V = 16384, ND0 = DQK / 16, KCH = DQK / 8, NKC = (64 * KCH) / 512;
    const int tid = opaque_tid(), wid = __builtin_amdgcn_readfirstlane(tid >> 6), lane = tid & 63, r32 = lane & 31, hi = lane >> 5;
    const int ld = it.ld, Lm1 = (2048 >> ld) - 1, lsh = 11 - ld;
#define TOK(p) (MODE == 0 ? (p) : ((((p) & Lm1) << ld) | ((p) >> lsh)))
#define LOF(p) (MODE == 0 ? 0 : max((p) - 128, (p) & ~Lm1))
    const int q0 = it.P0 + wid * 32, qp = q0 + r32;
    const int span = qp - LOF(qp), lo_w = LOF(q0), lo_last = LOF(q0 + 31);
    LAS unsigned char* V_lds = lds; LAS unsigned char* K_lds = lds + 2 * SHM_V;
    bf16x8 qr[ND0];
    { const bf16_t* qrow = it.q + (size_t)TOK(qp) * it.q_ld + hi * 8;
#pragma unroll
      for (int d0 = 0; d0 < ND0; ++d0) qr[d0] = *(const bf16x8*)(qrow + d0 * 16); }
    const int j_lo = LOF(it.P0) >> 6, NT = (it.P0 >> 6) + 4 - j_lo;
    const int sr = tid >> 4, sc = (tid & 15) * 8, vst0 = v_st(sr, sc), vst1 = v_st(32 + sr, sc);
    bf16x8 sk[NKC], sv0, sv1;
    int offk[NKC], offv0 = sr * it.v_ld + sc, offv1 = (32 + sr) * it.v_ld + sc;
#pragma unroll
    for (int i_ = 0; i_ < NKC; ++i_) { const int c_ = tid + 512 * i_, row_ = c_ / KCH, cc_ = c_ - row_ * KCH; offk[i_] = (DQK == 192 && cc_ >= 16) ? row_ * it.kpe_ld + (cc_ - 16) * 8 : row_ * it.k_ld + cc_ * 8; }
#define SLOAD(kb_) do { if (MODE == 0) { const bf16_t* kt_ = it.k + (size_t)(kb_) * it.k_ld; const bf16_t* pt_ = it.kpe + (size_t)(kb_) * it.kpe_ld; const bf16_t* vt_ = it.v + (size_t)(kb_) * it.v_ld; \
            _Pragma("unroll") for (int i_ = 0; i_ < NKC; ++i_) { const int c_ = tid + 512 * i_, row_ = c_ / KCH, cc_ = c_ - row_ * KCH; sk[i_] = *(const bf16x8*)(((DQK == 192 && cc_ >= 16) ? pt_ : kt_) + offk[i_]); } \
            sv0 = *(const bf16x8*)(vt_ + offv0); sv1 = *(const bf16x8*)(vt_ + offv1); } else { \
        _Pragma("unroll") for (int i_ = 0; i_ < NKC; ++i_) { const int c_ = tid + 512 * i_, row_ = c_ / KCH, cc_ = c_ - row_ * KCH; const int tk_ = TOK((kb_) + row_); \
            sk[i_] = *(const bf16x8*)(it.k + (size_t)tk_ * it.k_ld + cc_ * 8); } \
        { const int t0_ = TOK((kb_) + sr), t1_ = TOK((kb_) + 32 + sr); sv0 = *(const bf16x8*)(it.v + (size_t)t0_ * it.v_ld + sc); sv1 = *(const bf16x8*)(it.v + (size_t)t1_ * it.v_ld + sc); } } } while (0)
#define SWRITE(bf_) do { _Pragma("unroll") for (int i_ = 0; i_ < NKC; ++i_) { const int c_ = tid + 512 * i_, row_ = c_ / KCH, cc_ = c_ - row_ * KCH; const int swz_ = (((DQK == 128) ? row_ : (row_ >> 1)) & 7) << 4; \
            *(LAS bf16x8*)(K_lds + (bf_) * SHM_K + row_ * RS + ((cc_ * 16) ^ swz_)) = sk[i_]; } \
        *(LAS bf16x8*)(V_lds + (bf_) * SHM_V + vst0) = sv0; *(LAS bf16x8*)(V_lds + (bf_) * SHM_V + vst1) = sv1; } while (0)
    float m_reg = -1e30f, l_reg = 0.f; f32x16 o[4];
#pragma unroll
    for (int d = 0; d < 4; ++d)
#pragma unroll
        for (int r = 0; r < 16; ++r) o[d][r] = 0.f;
    SLOAD(j_lo * 64); SWRITE(0); __syncthreads();
    const int swzr = (((DQK == 128) ? r32 : (r32 >> 1)) & 7) << 4;
    int kro[4];
#pragma unroll
    for (int dd = 0; dd < 4; ++dd) kro[dd] = r32 * RS + ((dd * 32 + hi * 16) ^ swzr);
    for (int t = 0; t < NT; ++t) {
        const int kb = (j_lo + t) * 64, buf = t & 1;
        if (t + 1 < NT) SLOAD(kb + 64);
#pragma unroll 1
        for (int hf = 0; hf < 2; ++hf) {
            const int kh = kb + 32 * hf;
            const bool act = (kh <= q0 + 31) && (kh + 31 >= lo_w);
            if (act) {
                f32x16 p0;
#pragma unroll
                for (int r = 0; r < 16; ++r) p0[r] = 0.f;
                { const LAS unsigned char* kbp = K_lds + buf * SHM_K + hf * (32 * RS);
#pragma unroll
                  for (int d0 = 0; d0 < ND0; ++d0) {
                      const bf16x8 b0 = *(const LAS bf16x8*)(kbp + kro[d0 & 3] + (d0 >> 2) * 128);
                      p0 = __builtin_amdgcn_mfma_f32_32x32x16_bf16(b0, qr[d0], p0, 0, 0, 0); } }
                if (!((kh + 31 <= q0) && (kh >= lo_last))) {
                    const int dq = qp - kh - 4 * hi; const float NEG = -__builtin_inff();
#pragma unroll
                    for (int r = 0; r < 16; ++r) { const int c = (r & 3) + 8 * (r >> 2); if ((unsigned)(dq - c) > (unsigned)span) p0[r] = NEG; } }
                float pmax = p0[0];
#pragma unroll
                for (int r = 1; r < 16; ++r) pmax = fmaxf(pmax, p0[r]);
                { auto rr = __builtin_amdgcn_permlane32_swap(__float_as_uint(pmax), __float_as_uint(pmax), false, false); pmax = fmaxf(__uint_as_float(rr[0]), __uint_as_float(rr[1])); }
                const float mn = fmaxf(m_reg, pmax), alpha = __builtin_amdgcn_exp2f(m_reg - mn); m_reg = mn;
                float ps = 0.f;
#pragma unroll
                for (int r = 0; r < 16; ++r) { p0[r] = __builtin_amdgcn_exp2f(p0[r] - mn); ps += p0[r]; }
                { auto rr = __builtin_amdgcn_permlane32_swap(__float_as_uint(ps), __float_as_uint(ps), false, false); ps = __uint_as_float(rr[0]) + __uint_as_float(rr[1]); }
                l_reg = l_reg * alpha + ps;
                u32x4 pa0, pa1; PK4(p0, 0, pa0); PK4(p0, 8, pa1);
                if (__any(alpha != 1.0f)) {
#pragma unroll
                    for (int d = 0; d < 4; ++d)
#pragma unroll
                        for (int r = 0; r < 16; ++r) o[d][r] *= alpha; }
                const unsigned vb = (unsigned)(uintptr_t)(V_lds + buf * SHM_V + hf * 8192) + (unsigned)v_rd_base(lane);
#define TRRD(dst, off) asm volatile("ds_read_b64_tr_b16 %0, %1 offset:%2" : "=&v"(dst) : "v"(vb), "i"(off) : "memory")
#define PV_D0(d0) do { s16x4 l0, l1, h0, h1; constexpr int b_ = (d0) * 512; \
                TRRD(l0, b_); TRRD(h0, b_ + 2048); TRRD(l1, b_ + 4096); TRRD(h1, b_ + 6144); \
                asm volatile("s_waitcnt lgkmcnt(0)" ::: "memory"); __builtin_amdgcn_sched_barrier(0); \
                o[d0] = __builtin_amdgcn_mfma_f32_32x32x16_bf16((bf16x8){l0[0], l0[1], l0[2], l0[3], h0[0], h0[1], h0[2], h0[3]}, as_bf(pa0), o[d0], 0, 0, 0); \
                o[d0] = __builtin_amdgcn_mfma_f32_32x32x16_bf16((bf16x8){l1[0], l1[1], l1[2], l1[3], h1[0], h1[1], h1[2], h1[3]}, as_bf(pa1), o[d0], 0, 0, 0); } while (0)
                PV_D0(0); PV_D0(1); PV_D0(2); PV_D0(3);
#undef PV_D0
#undef TRRD
            }
        }
        if (t + 1 < NT) SWRITE(buf ^ 1);
        __syncthreads();
    }
    const int tq = TOK(qp);
    float a_cur = 1.0f / l_reg, a_prev = 0.f;
    if (MODE == 1) {
        const float lse_cur = m_reg + __builtin_amdgcn_logf(l_reg); float lse_new = lse_cur;
        if (it.merge) { const float lse_prev = it.lse[(size_t)tq * 8]; const float mx = fmaxf(lse_prev, lse_cur);
            const float e0 = __builtin_amdgcn_exp2f(lse_prev - mx), e1 = __builtin_amdgcn_exp2f(lse_cur - mx); const float inv = 1.0f / (e0 + e1);
            lse_new = mx + __builtin_amdgcn_logf(e0 + e1); a_prev = e0 * inv; a_cur *= e1 * inv; }
        if (hi == 0) it.lse[(size_t)tq * 8] = lse_new;
    }
    bf16_t* orow = it.o + (size_t)tq * it.o_ld + hi * 8;
#pragma unroll
    for (int d0 = 0; d0 < 4; ++d0) {
#pragma unroll
        for (int r = 0; r < 16; ++r) o[d0][r] *= a_cur;
        u32x4 w0, w1; PK4(o[d0], 0, w0); PK4(o[d0], 8, w1);
        if (MODE == 1 && it.merge) {
            const u32x4 q0w = *(const u32x4*)(orow + d0 * 32), q1w = *(const u32x4*)(orow + d0 * 32 + 16);
            float a[8], b[8];
            UNPACK8(w0, a); UNPACK8(q0w, b);
#pragma unroll
            for (int e = 0; e < 8; ++e) a[e] += b[e] * a_prev;
            w0 = PACK8(a);
            UNPACK8(w1, a); UNPACK8(q1w, b);
#pragma unroll
            for (int e = 0; e < 8; ++e) a[e] += b[e] * a_prev;
            w1 = PACK8(a);
        }
        *(u32x4*)(orow + d0 * 32) = w0; *(u32x4*)(orow + d0 * 32 + 16) = w1;
    }
#undef SLOAD
#undef SWRITE
#undef TOK
#undef LOF
}

__device__ void mla_attn_phase(const Params& p, LAS unsigned char* lds) {
    unsigned char* ws = p.ws;
    for (int item = opaque_bid(); item < BH * 16 * 4; item += gridDim.x) {
        const int bh = item >> 2, pr = item & 3, b = bh >> 4, h = bh & 15; const size_t tb = (size_t)b * SEQ;
        AttnItem it; it.q = (const bf16_t*)(ws + WS_Q) + tb * 3072 + h * 192; it.q_ld = 3072;
        it.k = (const bf16_t*)(ws + WS_KV) + tb * 4096 + h * 256; it.k_ld = 4096; it.kpe = (const bf16_t*)(ws + WS_KPE) + tb * 1024 + h * 64; it.kpe_ld = 1024;
        it.v = (const bf16_t*)(ws + WS_KV) + tb * 4096 + h * 256 + 128; it.v_ld = 4096; it.o = (bf16_t*)(ws + WS_AO) + tb * 2048 + h * 128; it.o_ld = 2048;
        it.lse = nullptr; it.ld = 0; it.merge = 0;
#pragma unroll 1
        for (int k2 = 0; k2 < 2; ++k2) { it.P0 = (k2 == 0 ? 7 - pr : pr) * 256; attn_block<192, 0>(it, lds); }
    }
}
__device__ void dil_attn_phase(const Params& p, LAS unsigned char* lds, int g) {
    unsigned char* ws = p.ws;
    for (int item = opaque_bid(); item < BH * 8 * 8; item += gridDim.x) {
        const int bh = item >> 3, qb = item & 7, b = bh >> 3, h = bh & 7, hh = g * 8 + h; const size_t tb = (size_t)b * SEQ;
        AttnItem it; it.q = (const bf16_t*)(ws + WS_QB) + tb * 3072 + hh * 128; it.q_ld = 3072;
        it.k = (const bf16_t*)(ws + WS_KVB) + tb * 6144 + hh * 128; it.k_ld = 6144; it.kpe = nullptr; it.kpe_ld = 0;
        it.v = (const bf16_t*)(ws + WS_KVB) + tb * 6144 + 3072 + hh * 128; it.v_ld = 6144; it.o = (bf16_t*)(ws + WS_OB) + tb * 1024 + h * 128; it.o_ld = 1024;
        it.lse = (float*)(ws + WS_LSE) + tb * 8 + h; it.ld = 2 * g; it.merge = g > 0; it.P0 = qb * 256;
        attn_block<128, 1>(it, lds);
    }
}

#ifndef SKIP_MASK
#define SKIP_MASK 0
#endif
__global__ void __launch_bounds__(NTHR) mega(Params p) {
    extern __shared__ __attribute__((aligned(16))) unsigned char lds_raw[];
    LAS unsigned char* lds = (LAS unsigned char*)lds_raw;
    cg::grid_group grid = cg::this_grid();
    unsigned char* ws = p.ws;
    bf16_t* XB = (bf16_t*)(ws + WS_XB); float* SS = (float*)(ws + WS_SS); bf16_t* HB = (bf16_t*)(ws + WS_H);
    bf16_t* LAT = (bf16_t*)(ws + WS_LAT); bf16_t* Q = (bf16_t*)(ws + WS_Q); bf16_t* KV = (bf16_t*)(ws + WS_KV); bf16_t* KPE = (bf16_t*)(ws + WS_KPE); bf16_t* AO = (bf16_t*)(ws + WS_AO);
    bf16_t* KVB = (bf16_t*)(ws + WS_KVB); bf16_t* QB = (bf16_t*)(ws + WS_QB); bf16_t* OB = (bf16_t*)(ws + WS_OB);
#pragma unroll 1
    for (int ph = p.ph_lo; ph < p.ph_hi; ++ph) {
        const int hb = ph >= 33 ? 1 : 0, li = ph - hb * 33;
        const size_t toff = (size_t)hb * TH;
        const float* xin0 = (const float*)p.in[0] + toff * DM; float* xo = p.out + toff * DM; const int* pos = (const int*)p.in[1] + toff;
        const int lyr = li == 0 ? 0 : (li - 1) >> 3, j = li == 0 ? -1 : (li - 1) & 7;
        const bool mla = lyr < 2; const int ab = lyr & 1;
        int gk = 0;
        const bf16_t* A = nullptr; const bf16_t* Bt = nullptr; int lda = 0, N = 0, K = 0, nsub = 1;
        EpiBf16S E1{nullptr, 0, nullptr, 0, 1 << 30, nullptr, 0}; EpiRes E2{nullptr, nullptr, XB, SS};
        if (li > 0) {
            if (j == 6) { gk = 1; A = XB; lda = 1024; Bt = (const bf16_t*)(ws + WS_W1) + (size_t)lyr * 4096 * 1024; N = 4096; K = 1024; E1.O = HB; E1.ldc = 4096; E1.ss = SS; E1.act = 1; }
            else if (j == 7) { gk = 2; A = HB; lda = 4096; Bt = (const bf16_t*)(ws + WS_W2) + (size_t)lyr * 1024 * 4096; N = 1024; K = 4096; E2.xin = xo; E2.xout = xo; }
            else if (j == 5) { gk = 2; N = 1024; E2.xin = lyr == 0 ? xin0 : xo; E2.xout = xo;
                if (mla) { A = AO; lda = 2048; K = 2048; Bt = (const bf16_t*)(ws + WS_WO) + (size_t)ab * 1024 * 2048; }
                else { A = OB; lda = 1024; K = 1024; Bt = (const bf16_t*)(ws + WS_WOB) + (size_t)ab * 1024 * 1024; } }
            else if (j == 0) { gk = 1; A = XB; lda = 1024; K = 1024; E1.ss = SS;
                if (mla) { Bt = (const bf16_t*)(ws + WS_WIN) + (size_t)ab * 512 * 1024; N = 512; E1.O = LAT; E1.ldc = 512; }
                else if (ab == 0) { Bt = (const bf16_t*)(ws + WS_WKVQ); N = 9216; E1.O = KVB; E1.ldc = 6144; E1.O2 = QB; E1.ldc2 = 3072; E1.split = 6144; }
                else { Bt = (const bf16_t*)(ws + WS_WQ1); N = 3072; E1.O = QB; E1.ldc = 3072; } }
            else if (j == 2 && mla) { gk = 1; nsub = 2; A = LAT; lda = 512; K = 256; Bt = (const bf16_t*)(ws + WS_WQB) + (size_t)ab * 3072 * 256; N = 3072; E1.O = Q; E1.ldc = 3072; }
        }
        if (!(SKIP_MASK & 1) && gk == 1) {
#pragma unroll 1
            for (int sub = 0; sub < nsub; ++sub) {
                if (sub == 1) { A = LAT + 256; Bt = (const bf16_t*)(ws + WS_WKVB) + (size_t)ab * 4096 * 256; N = 4096; E1.O = KV; E1.ldc = 4096; }
                run_gemm(lds, A, lda, Bt, N, K, E1);
            }
        } else if (!(SKIP_MASK & 2) && gk == 2) {
            run_gemm(lds, A, lda, Bt, N, K, E2);
        } else if (li == 0) {
            if (!(SKIP_MASK & 4)) { if (hb == 0) prep_weights(p, lds); prep_x(xin0, XB, SS); }
        } else if (mla) {
            if (j == 1) { if (!(SKIP_MASK & 8)) lat_prep(LAT); }
            else if (j == 3) { if (!(SKIP_MASK & 16)) mla_qk_prep(Q, KV, LAT, KPE, pos, (const float*)p.in[9] + ab * 192, (const float*)p.in[10] + ab * 192); }
            else if (j == 4) { if (!(SKIP_MASK & 32)) mla_attn_phase(p, lds); }
        } else {
            if (j == 1) { if (!(SKIP_MASK & 64)) head_prep(ab == 0 ? KVB : nullptr, QB, pos, (const float*)p.in[14], (const float*)p.in[16] + ab * 384); }
            else if (j >= 2 && j <= 4) { if (!(SKIP_MASK & 128)) dil_attn_phase(p, lds, j - 2); }
        }
        if (ph + 1 < p.ph_hi) grid.sync();
    }
}
constexpr int N_PHASES = 2 * (1 + 2 * 8 + 2 * 8);

extern "C" void kernel_launch(void* const* d_in, const int* in_sizes, int n_in, void* d_out, int out_size, void* d_ws, size_t ws_size, hipStream_t stream) {
    static int grid_blocks = 0;
    if (!grid_blocks) {
        int dev = 0, cus = 0, per_cu = 0;
        (void)hipGetDevice(&dev);
        (void)hipDeviceGetAttribute(&cus, hipDeviceAttributeMultiprocessorCount, dev);
        (void)hipFuncSetAttribute((const void*)mega, hipFuncAttributeMaxDynamicSharedMemorySize, LDS_BYTES);
        (void)hipOccupancyMaxActiveBlocksPerMultiprocessor(&per_cu, (const void*)mega, NTHR, LDS_BYTES);
        (void)hipGetLastError();
        grid_blocks = cus > 0 ? cus : 256;
        if (ws_size < WS_END || n_in != 20) { fprintf(stderr, "kernel_launch: workspace %zu < %zu or n_in %d != 20\n", ws_size, (size_t)WS_END, n_in); }
    }
    Params p{};
    for (int i = 0; i < 20; ++i) p.in[i] = d_in[i];
    p.out = (float*)d_out; p.ws = (unsigned char*)d_ws;
#if ONE_LAUNCH
    p.ph_lo = 0; p.ph_hi = N_PHASES;
    void* args[] = {&p};
    hipError_t e = hipLaunchCooperativeKernel((const void*)mega, dim3(grid_blocks), dim3(NTHR), args, LDS_BYTES, stream);
    if (e != hipSuccess) fprintf(stderr, "cooperative launch failed: %s (grid %d)\n", hipGetErrorString(e), grid_blocks);
#else
    for (int ph = 0; ph < N_PHASES; ++ph) { p.ph_lo = ph; p.ph_hi = ph + 1; hipLaunchKernelGGL(mega, dim3(grid_blocks), dim3(NTHR), LDS_BYTES, stream, p); }
#endif
}
```

```cpp
#include <hip/hip_runtime.h>
#include <hip/hip_cooperative_groups.h>
#include <cstdio>
#include <cstdint>
namespace cg = cooperative_groups;

#ifndef ONE_LAUNCH
#define ONE_LAUNCH 1
#endif

__device__ __forceinline__ int opaque_tid() { int t = (int)threadIdx.x; asm volatile("" : "+v"(t)); return t; }
__device__ __forceinline__ int opaque_bid() { int b = (int)blockIdx.x; asm volatile("" : "+s"(b)); return b; }
namespace pg8 {
#define PG8_LAS __attribute__((address_space(3)))
typedef unsigned short bf16_t;
typedef short bf16x8 __attribute__((ext_vector_type(8)));
typedef float f32x4 __attribute__((ext_vector_type(4)));
typedef unsigned u32x4 __attribute__((ext_vector_type(4)));
constexpr int BM = 256, BK = 64, HALF = 128, HTB = HALF * BK * 2  , STAGE_BYTES = 8 * HTB, NXCD = 8, WGM = 8;

__host__ __device__ __forceinline__ int lds_byte(int r, int c) { const int st = (r >> 4) * 2 + (c >> 5), rr = r & 15, cc = c & 31, ob = rr * 64 + cc * 2; return st * 1024 + (ob ^ (((ob >> 9) & 1) << 5)); }
__host__ __device__ __forceinline__ void stage_rc(int b, int& R, int& C) { const int st = b / 1024, sb = b % 1024, swz = sb ^ (((sb >> 9) & 1) << 5); R = (st >> 1) * 16 + swz / 64; C = (st & 1) * 32 + (swz % 64) / 2; }
__host__ __device__ __forceinline__ int perm32(int rho) { const int n = rho >> 4, i = rho & 15; return 8 * (i >> 2) + 4 * n + (i & 3); }
struct Unit { int pm, pn; };
struct Gemm { const bf16_t* A; const bf16_t* Bt; int M, N, K, lda; };
struct StaticOrder {
    int nM, nN, nwg, G, c;
    __host__ __device__ void init(int M, int N, int G_, int c_) { nM = M / BM; nN = N / BM; nwg = nM * nN; G = G_; c = c_; }
    __host__ __device__ bool next(int i, Unit& u) const {
        const long L = (long)i * G + c; if (L >= nwg) return false;
        int wgid = (int)L; { const int q = nwg / NXCD, r = nwg % NXCD, xcd = wgid % NXCD, off = wgid / NXCD; wgid = (xcd < r ? xcd * (q + 1) : r * (q + 1) + (xcd - r) * q) + off; }
        const int nig = WGM * nN, gid = wgid / nig, fm = gid * WGM, gsz = (nM - fm) < WGM ? (nM - fm) : WGM;
        u.pm = fm + ((wgid % nig) % gsz); u.pn = (wgid % nig) / gsz; return true;
    }
    __device__ __forceinline__ void a_ready(const Unit&) const {}
    __device__ __forceinline__ void done(const Unit&) const {}
};
__device__ __forceinline__ unsigned cvt_pk_bf16(float lo, float hi) { unsigned r; asm volatile("v_cvt_pk_bf16_f32 %0, %1, %2" : "=v"(r) : "v"(lo), "v"(hi)); return r; }
template <class Epi, class Sched>
__device__ __forceinline__ void gemm_phase(PG8_LAS unsigned char* lds, const Gemm g, const Sched& S, const Epi& E) {
    const int tid = opaque_tid(), wid = __builtin_amdgcn_readfirstlane(tid >> 6), lane = tid & 63, wr = wid >> 2, wc = wid & 3, fr = lane & 15, fq = lane >> 4;
    const int K = g.K, nt = K / BK;
    unsigned voffA[2], voffB[2];
#pragma unroll
    for (int i = 0; i < 2; ++i) { int R, C; stage_rc(tid * 16 + i * 8192, R, C); const int Rb = Epi::PERM ? ((R & ~31) + perm32(R & 31)) : R;
        voffA[i] = (unsigned)(R * g.lda + C) * 2u; voffB[i] = (unsigned)(Rb * K + C) * 2u; }
    const size_t kstep = (size_t)(BK * 2);
    const size_t hstep = (size_t)HALF * K * 2, hstepA = (size_t)HALF * g.lda * 2;
    const size_t tstep = 2 * hstep, tstepA = 2 * hstepA;
    const unsigned ldsw = (unsigned)wid * 1024u;
    const int aoff = lds_byte(wr * 64 + fr, fq * 8), boff = lds_byte(wc * 32 + fr, fq * 8);
#define PG8_SA(b, h) (((b) * 2 + (h)) * HTB)
#define PG8_SB(b, h) ((4 + (b) * 2 + (h)) * HTB)
#define PG8_STAGE(bufoff, gbase, voff) do { _Pragma("unroll") for (int _i = 0; _i < 2; ++_i) \
        __builtin_amdgcn_global_load_lds((const unsigned*)((const char*)(gbase) + (voff)[_i]), (PG8_LAS unsigned*)(lds + (bufoff) + ldsw + _i * 8192), 16, 0, 0); } while (0)
#define PG8_LDA(dst, b, h) do { _Pragma("unroll") for (int m = 0; m < 4; ++m) _Pragma("unroll") for (int k = 0; k < 2; ++k) dst[m][k] = *(const PG8_LAS bf16x8*)(lds + PG8_SA(b, h) + aoff + m * 2048 + k * 1024); } while (0)
#define PG8_LDB(dst, b, h) do { _Pragma("unroll") for (int n = 0; n < 2; ++n) _Pragma("unroll") for (int k = 0; k < 2; ++k) dst[n][k] = *(const PG8_LAS bf16x8*)(lds + PG8_SB(b, h) + boff + n * 2048 + k * 1024); } while (0)
#define PG8_MMA(ai, bj, At, Bt) do { __builtin_amdgcn_s_setprio(1); _Pragma("unroll") for (int m = 0; m < 4; ++m) _Pragma("unroll") for (int n = 0; n < 2; ++n) _Pragma("unroll") for (int k = 0; k < 2; ++k) \
        acc[ai][bj][m][n] = __builtin_amdgcn_mfma_f32_16x16x32_bf16(Bt[n][k], At[m][k], acc[ai][bj][m][n], 0, 0, 0); __builtin_amdgcn_s_setprio(0); } while (0)
#define PG8_WAIT_V(n) asm volatile("s_waitcnt vmcnt(" #n ")" ::: "memory")
#define PG8_WAIT_L(n) asm volatile("s_waitcnt lgkmcnt(" #n ")" ::: "memory")
#define PG8_BAR __builtin_amdgcn_s_barrier()
#define PG8_SCHED __builtin_amdgcn_sched_barrier(0)
    Unit cur, nxt; int ui = 0;
    if (!S.next(0, cur)) return;
    f32x4 acc[2][2][4][2];
#pragma unroll
    for (int a = 0; a < 2; ++a)
#pragma unroll
        for (int b = 0; b < 2; ++b)
#pragma unroll
            for (int m = 0; m < 4; ++m)
#pragma unroll
                for (int n = 0; n < 2; ++n) acc[a][b][m][n] = (f32x4){0.f, 0.f, 0.f, 0.f};
    bf16x8 At[4][2], B0[2][2], B1[2][2];
    const char* cA = (const char*)g.A + (size_t)cur.pm * tstepA; const char* cB = (const char*)g.Bt + (size_t)cur.pn * tstep;
    S.a_ready(cur);
    PG8_STAGE(PG8_SB(0, 0), cB, voffB); PG8_STAGE(PG8_SA(0, 0), cA, voffA); PG8_STAGE(PG8_SB(0, 1), cB + hstep, voffB); PG8_STAGE(PG8_SA(0, 1), cA + hstepA, voffA);
    if (wr == 1) PG8_BAR;
    PG8_WAIT_V(4); PG8_BAR;
    PG8_STAGE(PG8_SB(1, 0), cB + kstep, voffB); PG8_STAGE(PG8_SA(1, 0), cA + kstep, voffA); PG8_STAGE(PG8_SB(1, 1), cB + hstep + kstep, voffB);
    PG8_WAIT_V(6); PG8_BAR;
    for (;;) {
        const bool has_next = S.next(ui + 1, nxt);
        const char* nA = has_next ? (const char*)g.A + (size_t)nxt.pm * tstepA : cA; const char* nB = has_next ? (const char*)g.Bt + (size_t)nxt.pn * tstep : cB;
        for (int t = 0; t < nt; t += 2) {
            const bool last = (t == nt - 2);
            const char* a1 = cA + (size_t)(t + 1) * kstep;
            const char* a2 = last ? nA : cA + (size_t)(t + 2) * kstep; const char* b2 = last ? nB : cB + (size_t)(t + 2) * kstep;
            const char* a3 = a2 + kstep; const char* b3 = b2 + kstep;
            if (last && has_next) S.a_ready(nxt);
            PG8_LDB(B0, 0, 0); PG8_SCHED; PG8_LDA(At, 0, 0); PG8_STAGE(PG8_SA(1, 1), a1 + hstepA, voffA);
            PG8_WAIT_L(8); PG8_BAR; PG8_WAIT_L(0); PG8_MMA(0, 0, At, B0); PG8_BAR; PG8_SCHED;
            PG8_LDB(B1, 0, 1); PG8_STAGE(PG8_SB(0, 0), b2, voffB);
            PG8_BAR; PG8_WAIT_L(0); PG8_MMA(0, 1, At, B1); PG8_BAR;
            PG8_LDA(At, 0, 1); PG8_STAGE(PG8_SA(0, 0), a2, voffA);
            PG8_BAR; PG8_WAIT_L(0); PG8_MMA(1, 0, At, B0); PG8_BAR; PG8_SCHED;
            PG8_STAGE(PG8_SB(0, 1), b2 + hstep, voffB);
            PG8_WAIT_V(6); PG8_BAR; PG8_MMA(1, 1, At, B1); PG8_BAR;
            PG8_LDB(B0, 1, 0); PG8_SCHED; PG8_LDA(At, 1, 0); PG8_STAGE(PG8_SA(0, 1), a2 + hstepA, voffA);
            PG8_WAIT_L(8); PG8_BAR; PG8_WAIT_L(0); PG8_MMA(0, 0, At, B0); PG8_BAR; PG8_SCHED;
            PG8_LDB(B1, 1, 1); PG8_STAGE(PG8_SB(1, 0), b3, voffB);
            PG8_BAR; PG8_WAIT_L(0); PG8_MMA(0, 1, At, B1); PG8_BAR;
            PG8_LDA(At, 1, 1); PG8_STAGE(PG8_SA(1, 0), a3, voffA);
            PG8_BAR; PG8_WAIT_L(0); PG8_MMA(1, 0, At, B0); PG8_BAR; PG8_SCHED;
            PG8_STAGE(PG8_SB(1, 1), b3 + hstep, voffB);
            PG8_WAIT_V(6); PG8_BAR; PG8_MMA(1, 1, At, B1); PG8_BAR;
        }
        if constexpr (!Epi::AFTER_DRAIN) { E(acc, cur, wr, wc, fr, fq); S.done(cur); }
        if (!has_next) break;
#pragma unroll
        for (int a = 0; a < 2; ++a)
#pragma unroll
            for (int b = 0; b < 2; ++b)
#pragma unroll
                for (int m = 0; m < 4; ++m)
#pragma unroll
                    for (int n = 0; n < 2; ++n) acc[a][b][m][n] = (f32x4){0.f, 0.f, 0.f, 0.f};
        cur = nxt; cA = nA; cB = nB; ++ui;
    }
    PG8_WAIT_V(0);
    if (wr == 0) PG8_BAR;
    PG8_BAR;
    if constexpr (Epi::AFTER_DRAIN) { E.fused(acc, cur, wr, wc, fr, fq, lds, wid, lane); S.done(cur); }
#undef PG8_SA
#undef PG8_SB
#undef PG8_STAGE
#undef PG8_LDA
#undef PG8_LDB
#undef PG8_MMA
#undef PG8_WAIT_V
#undef PG8_WAIT_L
#undef PG8_BAR
#undef PG8_SCHED
}
}
using pg8::bf16_t; using pg8::bf16x8; using pg8::f32x4; using pg8::u32x4;
#define LAS __attribute__((address_space(3)))
typedef short s16x4 __attribute__((ext_vector_type(4)));
typedef float f32x16 __attribute__((ext_vector_type(16)));
typedef unsigned u32x2 __attribute__((ext_vector_type(2)));

constexpr int SEQ = 2048, DM = 1024, NBATCH = 16, TT = NBATCH * SEQ, TH = TT / 2, BH = NBATCH / 2, DFF = 4096;
constexpr float EPS = 1e-6f, LOG2E = 1.4426950408889634f, LOG2_THETA = 13.287712379549449f;
constexpr int NTHR = 512;
constexpr int LDS_BYTES = 131072 + 4096;
constexpr size_t MiB = (size_t)1 << 20;
constexpr size_t WS_WIN = 0, WS_WQB = WS_WIN + 2 * MiB, WS_WKVB = WS_WQB + 3 * MiB, WS_WO = WS_WKVB + 4 * MiB, WS_WKVQ = WS_WO + 8 * MiB, WS_WQ1 = WS_WKVQ + 18 * MiB,
                 WS_WOB = WS_WQ1 + 6 * MiB, WS_W1 = WS_WOB + 4 * MiB, WS_W2 = WS_W1 + 32 * MiB, WS_XB = WS_W2 + 32 * MiB, WS_SS = WS_XB + 32 * MiB, WS_LSE = WS_SS + 1 * MiB,
                 WS_BAR = WS_LSE + 768 * 1024, WS_SSL = WS_LSE + 1 * MiB, WS_BIG = WS_SSL + 1 * MiB;
constexpr size_t WS_LAT = WS_BIG, WS_Q = WS_LAT + 16 * MiB, WS_KV = WS_Q + 96 * MiB, WS_KPE = WS_KV + 128 * MiB, WS_AO = WS_KPE + 32 * MiB;
constexpr size_t WS_KVB = WS_BIG, WS_QB = WS_BIG + 192 * MiB, WS_OB = WS_BIG + 288 * MiB;
constexpr size_t WS_H = WS_BIG + 192 * MiB;
constexpr size_t WS_END = WS_BIG + 336 * MiB;

struct Params { const void* in[20]; float* out; unsigned char* ws; int ph_lo, ph_hi; };

__device__ __forceinline__ unsigned cvtpk(float lo, float hi) { unsigned r; asm volatile("v_cvt_pk_bf16_f32 %0, %1, %2" : "=v"(r) : "v"(lo), "v"(hi)); return r; }
__device__ __forceinline__ float bf_lo(unsigned w) { return __uint_as_float(w << 16); }
__device__ __forceinline__ float bf_hi(unsigned w) { return __uint_as_float(w & 0xffff0000u); }
#define UNPACK8(W_, V_) do { const u32x4 t_ = (W_); V_[0] = bf_lo(t_[0]); V_[1] = bf_hi(t_[0]); V_[2] = bf_lo(t_[1]); V_[3] = bf_hi(t_[1]); V_[4] = bf_lo(t_[2]); V_[5] = bf_hi(t_[2]); V_[6] = bf_lo(t_[3]); V_[7] = bf_hi(t_[3]); } while (0)
#define PACK8(V_) ((u32x4){cvtpk(V_[0], V_[1]), cvtpk(V_[2], V_[3]), cvtpk(V_[4], V_[5]), cvtpk(V_[6], V_[7])})
__device__ __forceinline__ void sincos_rev(float pos, float invf_rev, float& s, float& c) {
    float rev = pos * invf_rev; rev = rev - floorf(rev);
    s = __builtin_amdgcn_sinf(rev); c = __builtin_amdgcn_cosf(rev);
}

__device__ __forceinline__ void cvt_job(const float* __restrict__ W, int K, int N, const float* __restrict__ gain, bf16_t* __restrict__ dst, int ldo, int& base, LAS float* tile) {
    const int tk = K / 64, tn = N / 64, nt = tk * tn, G = (int)gridDim.x, tid = opaque_tid();
    int start = (opaque_bid() - (base % G)); if (start < 0) start += G;
    for (int t = start; t < nt; t += G) {
        const int kt = t / tn, ntile = t - kt * tn;
        __syncthreads();
#pragma unroll
        for (int i = 0; i < 2; ++i) {
            const int k = (tid >> 4) + 32 * i, n4 = (tid & 15) * 4;
            const f32x4 v = *(const f32x4*)(W + (size_t)(kt * 64 + k) * N + ntile * 64 + n4);
            const float g = gain ? gain[kt * 64 + k] : 1.0f;
            tile[(n4 + 0) * 65 + k] = v.x * g; tile[(n4 + 1) * 65 + k] = v.y * g; tile[(n4 + 2) * 65 + k] = v.z * g; tile[(n4 + 3) * 65 + k] = v.w * g;
        }
        __syncthreads();
        const int n = tid >> 3, k8 = (tid & 7) * 8;
        const LAS float* tp = tile + n * 65 + k8;
        u32x4 w; w.x = cvtpk(tp[0], tp[1]); w.y = cvtpk(tp[2], tp[3]); w.z = cvtpk(tp[4], tp[5]); w.w = cvtpk(tp[6], tp[7]);
        *(u32x4*)(dst + (size_t)(ntile * 64 + n) * ldo + kt * 64 + k8) = w;
    }
    base += nt;
}
__device__ __forceinline__ void zero_fill(bf16_t* dst, int rows, int cols8, int ld) {
    const size_t n = (size_t)rows * cols8;
    for (size_t i = (size_t)opaque_bid() * NTHR + opaque_tid(); i < n; i += (size_t)gridDim.x * NTHR) { const size_t r = i / cols8, c = i - r * cols8; *(u32x4*)(dst + r * ld + c * 8) = (u32x4){0u, 0u, 0u, 0u}; }
}
__device__ void prep_weights(const Params& p, LAS unsigned char* lds) {
    LAS float* tile = (LAS float*)lds;
    unsigned char* ws = p.ws;
    const float* attn_norm = (const float*)p.in[2]; const float* mlp_norm = (const float*)p.in[3];
    int base = 0;
    for (int a = 0; a < 2; ++a) {
        cvt_job((const float*)p.in[4] + (size_t)a * 1024 * 448, 1024, 448, attn_norm + a * 1024, (bf16_t*)(ws + WS_WIN) + (size_t)a * 512 * 1024, 1024, base, tile);
        cvt_job((const float*)p.in[7] + (size_t)a * 256 * 3072, 256, 3072, (const float*)p.in[5] + a * 256, (bf16_t*)(ws + WS_WQB) + (size_t)a * 3072 * 256, 256, base, tile);
        cvt_job((const float*)p.in[8] + (size_t)a * 128 * 4096, 128, 4096, (const float*)p.in[6] + a * 128, (bf16_t*)(ws + WS_WKVB) + (size_t)a * 4096 * 256, 256, base, tile);
        cvt_job((const float*)p.in[11] + (size_t)a * 2048 * 1024, 2048, 1024, nullptr, (bf16_t*)(ws + WS_WO) + (size_t)a * 1024 * 2048, 2048, base, tile);
        cvt_job((const float*)p.in[17] + (size_t)a * 1024 * 1024, 1024, 1024, nullptr, (bf16_t*)(ws + WS_WOB) + (size_t)a * 1024 * 1024, 1024, base, tile);
        zero_fill((bf16_t*)(ws + WS_WIN) + (size_t)a * 512 * 1024 + (size_t)448 * 1024, 64, 128, 1024);
        zero_fill((bf16_t*)(ws + WS_WKVB) + (size_t)a * 4096 * 256 + 128, 4096, 16, 256);
    }
    cvt_job((const float*)p.in[13], 1024, 6144, (const float*)p.in[12], (bf16_t*)(ws + WS_WKVQ), 1024, base, tile);
    cvt_job((const float*)p.in[15], 1024, 3072, attn_norm + 2 * 1024, (bf16_t*)(ws + WS_WKVQ) + (size_t)6144 * 1024, 1024, base, tile);
    cvt_job((const float*)p.in[15] + (size_t)1024 * 3072, 1024, 3072, attn_norm + 3 * 1024, (bf16_t*)(ws + WS_WQ1), 1024, base, tile);
    for (int l = 0; l < 4; ++l) {
        cvt_job((const float*)p.in[18] + (size_t)l * 1024 * 4096, 1024, 4096, mlp_norm + l * 1024, (bf16_t*)(ws + WS_W1) + (size_t)l * 4096 * 1024, 1024, base, tile);
        cvt_job((const float*)p.in[19] + (size_t)l * 4096 * 1024, 4096, 1024, nullptr, (bf16_t*)(ws + WS_W2) + (size_t)l * 1024 * 4096, 4096, base, tile);
    }
    __syncthreads();
}
__device__ void prep_x(const float* __restrict__ x, bf16_t* __restrict__ xb, float* __restrict__ ss) {
    const int tid_ = opaque_tid(), lane = tid_ & 63, gw = opaque_bid() * 8 + (tid_ >> 6), nw = gridDim.x * 8;
    for (int r = gw; r < TH; r += nw) {
        const float* xr = x + (size_t)r * 1024; bf16_t* br = xb + (size_t)r * 1024; float s = 0.f;
#pragma unroll
        for (int i = 0; i < 4; ++i) { const f32x4 v = *(const f32x4*)(xr + i * 256 + lane * 4); s += v.x * v.x + v.y * v.y + v.z * v.z + v.w * v.w;
            *(u32x2*)(br + i * 256 + lane * 4) = (u32x2){cvtpk(v.x, v.y), cvtpk(v.z, v.w)}; }
#pragma unroll
        for (int o = 1; o < 64; o <<= 1) s += __shfl_xor(s, o);
        if (lane < 16) ss[(size_t)r * 16 + lane] = lane == 0 ? s : 0.f;
    }
}

struct EpiBf16S {
    static constexpr bool PERM = true, AFTER_DRAIN = false;
    bf16_t* O; int ldc; bf16_t* O2; int ldc2; int split; const float* ss; int nsl4; float inv_n; int act; float* ssl;
    __device__ __forceinline__ void operator()(const f32x4 (&acc)[2][2][4][2], const pg8::Unit& u, int wr, int wc, int fr, int fq) const {
        const int row0 = u.pm * 256 + wr * 64 + fr; int colt = u.pn * 256; bf16_t* base = O; int ld = ldc;
        if (colt >= split) { base = O2; colt -= split; ld = ldc2; }
        const int col0 = colt + wc * 32 + 8 * fq;
#pragma unroll
        for (int ai = 0; ai < 2; ++ai)
#pragma unroll
            for (int m = 0; m < 4; ++m) { const int row = row0 + ai * 128 + m * 16; float sc = 1.0f;
                if (ss) { const f32x4* sp = (const f32x4*)(ss + (size_t)row * 16); f32x4 a = sp[0]; if (nsl4 == 4) a = (a + sp[1]) + (sp[2] + sp[3]); sc = rsqrtf(((a.x + a.y) + (a.z + a.w)) * inv_n + EPS); }
                bf16_t* rowp = base + (size_t)row * ld + col0; float sa = 0.f, sb = 0.f;
#pragma unroll
                for (int bj = 0; bj < 2; ++bj) { f32x4 v0 = acc[ai][bj][m][0] * sc, v1 = acc[ai][bj][m][1] * sc;
                    if (act) {
#pragma unroll
                        for (int j = 0; j < 4; ++j) { const float a0 = fmaxf(v0[j], 0.f), a1 = fmaxf(v1[j], 0.f); v0[j] = a0 * a0; v1[j] = a1 * a1; } }
                    const float sq = ((v0[0] * v0[0] + v0[1] * v0[1]) + (v0[2] * v0[2] + v0[3] * v0[3])) + ((v1[0] * v1[0] + v1[1] * v1[1]) + (v1[2] * v1[2] + v1[3] * v1[3]));
                    if (bj == 0) sa = sq; else sb = sq;
                    u32x4 w; w.x = cvtpk(v0[0], v0[1]); w.y = cvtpk(v0[2], v0[3]); w.z = cvtpk(v1[0], v1[1]); w.w = cvtpk(v1[2], v1[3]);
                    *(u32x4*)(rowp + bj * 128) = w; }
                if (ssl) { sa += __shfl_xor(sa, 16); sa += __shfl_xor(sa, 32); sb += __shfl_xor(sb, 16); sb += __shfl_xor(sb, 32);
                    if (fq == 0) { float* sr_ = ssl + (size_t)row * 16; if (u.pn == 0) sr_[wc] = sa + sb; else { sr_[4 + wc] = sa; sr_[8 + wc] = sb; } } } }
    }
};
struct EpiRes {
    static constexpr bool PERM = false, AFTER_DRAIN = false;
    const float* xin; float* xout; bf16_t* xb; float* ss;
    __device__ __forceinline__ void operator()(const f32x4 (&acc)[2][2][4][2], const pg8::Unit& u, int wr, int wc, int fr, int fq) const {
        const int row0 = u.pm * 256 + wr * 64 + fr, col0 = u.pn * 256 + wc * 32 + 4 * fq;
#pragma unroll
        for (int ai = 0; ai < 2; ++ai)
#pragma unroll
            for (int m = 0; m < 4; ++m) { const int row = row0 + ai * 128 + m * 16; const size_t off = (size_t)row * 1024 + col0; float s = 0.f;
#pragma unroll
                for (int bj = 0; bj < 2; ++bj)
#pragma unroll
                    for (int n = 0; n < 2; ++n) { const int c = bj * 128 + n * 16; const f32x4 o = *(const f32x4*)(xin + off + c) + acc[ai][bj][m][n];
                        *(f32x4*)(xout + off + c) = o; s += (o.x * o.x + o.y * o.y) + (o.z * o.z + o.w * o.w);
                        *(u32x2*)(xb + off + c) = (u32x2){cvtpk(o.x, o.y), cvtpk(o.z, o.w)}; }
                s += __shfl_xor(s, 16); s += __shfl_xor(s, 32);
                if (fq == 0) ss[(size_t)row * 16 + u.pn * 4 + wc] = s; }
    }
};
template <class Epi> __device__ __forceinline__ void run_gemm(LAS unsigned char* lds, const bf16_t* A, int lda, const bf16_t* Bt, int N, int K, const Epi& E) {
    pg8::Gemm g{A, Bt, TH, N, K, lda}; pg8::StaticOrder S; S.init(TH, N, (int)gridDim.x, opaque_bid());
    pg8::gemm_phase<Epi, pg8::StaticOrder>(lds, g, S, E);
}

__device__ void lat_prep(bf16_t* lat) {
    const int tid_ = opaque_tid(), lane = tid_ & 63, gw = opaque_bid() * 8 + (tid_ >> 6), nw = gridDim.x * 8;
    for (int t = gw; t < TH; t += nw) {
        bf16_t* p = lat + (size_t)t * 512 + lane * 8; const u32x4 w = *(const u32x4*)p; float v[8]; UNPACK8(w, v);
        float s = 0.f;
#pragma unroll
        for (int e = 0; e < 8; ++e) s += v[e] * v[e];
        s += __shfl_xor(s, 1); s += __shfl_xor(s, 2); s += __shfl_xor(s, 4); s += __shfl_xor(s, 8);
        const float s32 = s + __shfl_xor(s, 16);
        const float rstd = lane < 32 ? rsqrtf(s32 * (1.0f / 256.0f) + EPS) : rsqrtf(s * (1.0f / 128.0f) + EPS);
        if (lane < 48) {
#pragma unroll
            for (int e = 0; e < 8; ++e) v[e] *= rstd;
            *(u32x4*)p = PACK8(v); }
    }
}
__device__ void mla_qk_prep(bf16_t* q, bf16_t* kv, const bf16_t* lat, bf16_t* kpe, const int* pos, const float* gq, const float* gk) {
    const int tid_ = opaque_tid(), lane = tid_ & 63, gw = opaque_bid() * 8 + (tid_ >> 6), nw = gridDim.x * 8;
    const float qscale = 0.07216878364870322f * LOG2E;
    float invf[8];
#pragma unroll
    for (int e = 0; e < 8; ++e) invf[e] = exp2f(-(float)((lane & 3) * 8 + e) * (LOG2_THETA / 32.0f)) * 0.15915494309189535f;
    for (int t = gw; t < TH; t += nw) {
        const float posf = (float)pos[t];
        float cs[8], sn[8];
#pragma unroll
        for (int e = 0; e < 8; ++e) sincos_rev(posf, invf[e], sn[e], cs[e]);
        float kr[8]; float ss_pe;
        { u32x4 w = (u32x4){0u, 0u, 0u, 0u}; if (lane < 8) w = *(const u32x4*)(lat + (size_t)t * 512 + 384 + lane * 8);
          float v[8]; UNPACK8(w, v); float s = 0.f;
#pragma unroll
          for (int e = 0; e < 8; ++e) s += v[e] * v[e];
          s += __shfl_xor(s, 1); s += __shfl_xor(s, 2); s += __shfl_xor(s, 4); ss_pe = __shfl(s, 0);
#pragma unroll
          for (int e = 0; e < 8; ++e) { const float g = gk[128 + (lane & 7) * 8 + e]; const float y = v[e] * g; const float pr = __shfl_xor(y, 4);
              const float r = (lane & 4) ? y * cs[e] + pr * sn[e] : y * cs[e] - pr * sn[e]; kr[e] = __shfl(r, lane & 7); } }
        const int c16 = lane & 15, c32 = lane & 31; const bool qact = c32 < 24;
        u32x4 wk[4], wq[8];
#pragma unroll
        for (int itr = 0; itr < 4; ++itr) wk[itr] = *(const u32x4*)(kv + (size_t)t * 4096 + (itr * 4 + (lane >> 4)) * 256 + c16 * 8);
#pragma unroll
        for (int itr = 0; itr < 8; ++itr) { wq[itr] = (u32x4){0u, 0u, 0u, 0u}; if (qact) wq[itr] = *(const u32x4*)(q + (size_t)t * 3072 + (itr * 2 + (lane >> 5)) * 192 + c32 * 8); }
        float gkn[8], gqn[8];
#pragma unroll
        for (int e = 0; e < 8; ++e) { gkn[e] = gk[c16 * 8 + e]; gqn[e] = qact ? gq[c32 * 8 + e] : 0.f; }
#pragma unroll
        for (int itr = 0; itr < 4; ++itr) { const int h = itr * 4 + (lane >> 4);
            bf16_t* p = kv + (size_t)t * 4096 + h * 256 + c16 * 8; float v[8]; UNPACK8(wk[itr], v); float s = 0.f;
#pragma unroll
            for (int e = 0; e < 8; ++e) s += v[e] * v[e];
            s += __shfl_xor(s, 1); s += __shfl_xor(s, 2); s += __shfl_xor(s, 4); s += __shfl_xor(s, 8);
            const float rstd = rsqrtf((s + ss_pe) * (1.0f / 192.0f) + EPS);
#pragma unroll
            for (int e = 0; e < 8; ++e) v[e] = v[e] * rstd * gkn[e];
            *(u32x4*)p = PACK8(v);
            if (c16 < 8) { float o[8];
#pragma unroll
                for (int e = 0; e < 8; ++e) o[e] = kr[e] * rstd;
                *(u32x4*)(kpe + ((size_t)t * 16 + h) * 64 + c16 * 8) = PACK8(o); } }
#pragma unroll
        for (int itr = 0; itr < 8; ++itr) { const int h = itr * 2 + (lane >> 5), c = c32;
            bf16_t* p = q + (size_t)t * 3072 + h * 192 + c * 8; float v[8]; UNPACK8(wq[itr], v); float s = 0.f;
#pragma unroll
            for (int e = 0; e < 8; ++e) s += v[e] * v[e];
            s += __shfl_xor(s, 1); s += __shfl_xor(s, 2); s += __shfl_xor(s, 4); s += __shfl_xor(s, 8); s += __shfl_xor(s, 16);
            const float rstd = rsqrtf(s * (1.0f / 192.0f) + EPS);
#pragma unroll
            for (int e = 0; e < 8; ++e) { float y = v[e] * rstd * gqn[e]; const float pr = __shfl_xor(y, 4);
                if (c >= 16) y = (c & 4) ? y * cs[e] + pr * sn[e] : y * cs[e] - pr * sn[e];
                v[e] = y * qscale; }
            if (qact) *(u32x4*)p = PACK8(v); }
    }
}
__device__ void head_prep(bf16_t* kbuf  , bf16_t* qbuf, const int* pos, const float* gk, const float* gq) {
    const int tid_ = opaque_tid(), lane = tid_ & 63, gw = opaque_bid() * 8 + (tid_ >> 6), nw = gridDim.x * 8;
    const float qscale = 0.08838834764831845f * LOG2E;
    const int c16 = lane & 15;
    float invf[8];
#pragma unroll
    for (int e = 0; e < 8; ++e) invf[e] = exp2f(-(float)((c16 & 7) * 8 + e) * (LOG2_THETA / 64.0f)) * 0.15915494309189535f;
    for (int t = gw; t < TH; t += nw) {
        const float posf = (float)pos[t];
        float cs[8], sn[8];
#pragma unroll
        for (int e = 0; e < 8; ++e) sincos_rev(posf, invf[e], sn[e], cs[e]);
        u32x4 wv[12];
#pragma unroll
        for (int itr = 0; itr < 12; ++itr) { const bool isq = itr >= 6; const int hh = (isq ? itr - 6 : itr) * 4 + (lane >> 4);
            wv[itr] = (u32x4){0u, 0u, 0u, 0u};
            if (isq) wv[itr] = *(const u32x4*)(qbuf + (size_t)t * 3072 + hh * 128 + c16 * 8); else if (kbuf) wv[itr] = *(const u32x4*)(kbuf + (size_t)t * 6144 + hh * 128 + c16 * 8); }
#pragma unroll
        for (int itr = 0; itr < 12; ++itr) { const bool isq = itr >= 6; if (!isq && !kbuf) continue;
            const int hh = (isq ? itr - 6 : itr) * 4 + (lane >> 4), g = hh >> 3;
            bf16_t* p = isq ? qbuf + (size_t)t * 3072 + hh * 128 + c16 * 8 : kbuf + (size_t)t * 6144 + hh * 128 + c16 * 8;
            const float* gn = (isq ? gq : gk) + g * 128 + c16 * 8;
            float v[8]; UNPACK8(wv[itr], v); float s = 0.f;
#pragma unroll
            for (int e = 0; e < 8; ++e) s += v[e] * v[e];
            s += __shfl_xor(s, 1); s += __shfl_xor(s, 2); s += __shfl_xor(s, 4); s += __shfl_xor(s, 8);
            const float rstd = rsqrtf(s * (1.0f / 128.0f) + EPS), osc = isq ? qscale : 1.0f;
#pragma unroll
            for (int e = 0; e < 8; ++e) { const float y = v[e] * rstd * gn[e]; const float pr = __shfl_xor(y, 8);
                v[e] = ((c16 & 8) ? y * cs[e] + pr * sn[e] : y * cs[e] - pr * sn[e]) * osc; }
            *(u32x4*)p = PACK8(v); }
    }
}

struct AttnItem { const bf16_t* q; const bf16_t* k; const bf16_t* kpe; const bf16_t* v; bf16_t* o; float* lse; int q_ld, k_ld, kpe_ld, v_ld, o_ld, P0, ld, merge; };
__device__ __forceinline__ int v_st(int k, int c) { const int kk = (k & ~0xC) | ((k & 4) << 1) | ((k & 8) >> 1); return ((kk >> 3) * 4 + (c >> 5)) * 512 + ((kk & 7) * 32 + (c & 31)) * 2; }
__device__ __forceinline__ int v_rd_base(int lane) { return ((lane & 3) << 3) | (((lane >> 2) & 3) << 6) | (((lane >> 4) & 1) << 5) | (((lane >> 5) & 1) << 8); }
#define PK4(P, B_, OUT) do { unsigned a0_ = cvtpk(P[B_+0], P[B_+1]), a1_ = cvtpk(P[B_+2], P[B_+3]); unsigned b0_ = cvtpk(P[B_+4], P[B_+5]), b1_ = cvtpk(P[B_+6], P[B_+7]); \
        auto r0_ = __builtin_amdgcn_permlane32_swap(a0_, b0_, false, false); auto r1_ = __builtin_amdgcn_permlane32_swap(a1_, b1_, false, false); \
        u32x4 w_ = {r0_[0], r1_[0], r0_[1], r1_[1]}; OUT = w_; } while (0)
__device__ __forceinline__ bf16x8 as_bf(u32x4 w) { return *reinterpret_cast<bf16x8*>(&w); }

template <int DQK, int MODE>
__device__ __forceinline__ void attn_block(const AttnItem& it, LAS unsigned char* lds) {
    constexpr int RS = DQK * 2, SHM_K = 64 * RS, SHM_V = 16384, ND0 = DQK / 16, KCH = DQK / 8, NKC = (64 * KCH) / 512;
    const int tid = opaque_tid(), wid = __builtin_amdgcn_readfirstlane(tid >> 6), lane = tid & 63, r32 = lane & 31, hi = lane >> 5;
    const int ld = it.ld, Lm1 = (2048 >> ld) - 1, lsh = 11 - ld;
#define TOK(p) (MODE == 0 ? (p) : ((((p) & Lm1) << ld) | ((p) >> lsh)))
#define LOF(p) (MODE == 0 ? 0 : max((p) - 128, (p) & ~Lm1))
    const int q0 = it.P0 + wid * 32, qp = q0 + r32;
    const int span = qp - LOF(qp), lo_w = LOF(q0), lo_last = LOF(q0 + 31);
    LAS unsigned char* V_lds = lds; LAS unsigned char* K_lds = lds + 2 * SHM_V;
    bf16x8 qr[ND0];
    { const bf16_t* qrow = it.q + (size_t)TOK(qp) * it.q_ld + hi * 8;
#pragma unroll
      for (int d0 = 0; d0 < ND0; ++d0) qr[d0] = *(const bf16x8*)(qrow + d0 * 16); }
    const int j_lo = LOF(it.P0) >> 6, NT = (it.P0 >> 6) + 4 - j_lo;
    const int sr = tid >> 4, sc = (tid & 15) * 8, vst0 = v_st(sr, sc), vst1 = v_st(32 + sr, sc);
    bf16x8 sk[NKC], sv0, sv1;
    int offk[NKC], offv0 = sr * it.v_ld + sc, offv1 = (32 + sr) * it.v_ld + sc;
#pragma unroll
    for (int i_ = 0; i_ < NKC; ++i_) { const int c_ = tid + 512 * i_, row_ = c_ / KCH, cc_ = c_ - row_ * KCH; offk[i_] = (DQK == 192 && cc_ >= 16) ? row_ * it.kpe_ld + (cc_ - 16) * 8 : row_ * it.k_ld + cc_ * 8; }
#define SLOAD(kb_) do { if (MODE == 0) { const bf16_t* kt_ = it.k + (size_t)(kb_) * it.k_ld; const bf16_t* pt_ = it.kpe + (size_t)(kb_) * it.kpe_ld; const bf16_t* vt_ = it.v + (size_t)(kb_) * it.v_ld; \
            _Pragma("unroll") for (int i_ = 0; i_ < NKC; ++i_) { const int c_ = tid + 512 * i_, row_ = c_ / KCH, cc_ = c_ - row_ * KCH; sk[i_] = *(const bf16x8*)(((DQK == 192 && cc_ >= 16) ? pt_ : kt_) + offk[i_]); } \
            sv0 = *(const bf16x8*)(vt_ + offv0); sv1 = *(const bf16x8*)(vt_ + offv1); } else { \
        _Pragma("unroll") for (int i_ = 0; i_ < NKC; ++i_) { const int c_ = tid + 512 * i_, row_ = c_ / KCH, cc_ = c_ - row_ * KCH; const int tk_ = TOK((kb_) + row_); \
            sk[i_] = *(const bf16x8*)(it.k + (size_t)tk_ * it.k_ld + cc_ * 8); } \
        { const int t0_ = TOK((kb_) + sr), t1_ = TOK((kb_) + 32 + sr); sv0 = *(const bf16x8*)(it.v + (size_t)t0_ * it.v_ld + sc); sv1 = *(const bf16x8*)(it.v + (size_t)t1_ * it.v_ld + sc); } } } while (0)
#define SWRITE(bf_) do { _Pragma("unroll") for (int i_ = 0; i_ < NKC; ++i_) { const int c_ = tid + 512 * i_, row_ = c_ / KCH, cc_ = c_ - row_ * KCH; const int swz_ = (((DQK == 128) ? row_ : (row_ >> 1)) & 7) << 4; \
            *(LAS bf16x8*)(K_lds + (bf_) * SHM_K + row_ * RS + ((cc_ * 16) ^ swz_)) = sk[i_]; } \
        *(LAS bf16x8*)(V_lds + (bf_) * SHM_V + vst0) = sv0; *(LAS bf16x8*)(V_lds + (bf_) * SHM_V + vst1) = sv1; } while (0)
    float m_reg = -1e30f, l_reg = 0.f; f32x16 o[4];
#pragma unroll
    for (int d = 0; d < 4; ++d)
#pragma unroll
        for (int r = 0; r < 16; ++r) o[d][r] = 0.f;
    SLOAD(j_lo * 64); SWRITE(0); __syncthreads();
    const int swzr = (((DQK == 128) ? r32 : (r32 >> 1)) & 7) << 4;
    int kro[4];
#pragma unroll
    for (int dd = 0; dd < 4; ++dd) kro[dd] = r32 * RS + ((dd * 32 + hi * 16) ^ swzr);
    for (int t = 0; t < NT; ++t) {
        const int kb = (j_lo + t) * 64, buf = t & 1;
        if (t + 1 < NT) SLOAD(kb + 64);
#pragma unroll 1
        for (int hf = 0; hf < 2; ++hf) {
            const int kh = kb + 32 * hf;
            const bool act = (kh <= q0 + 31) && (kh + 31 >= lo_w);
            if (act) {
                f32x16 p0;
#pragma unroll
                for (int r = 0; r < 16; ++r) p0[r] = 0.f;
                { const LAS unsigned char* kbp = K_lds + buf * SHM_K + hf * (32 * RS);
#pragma unroll
                  for (int d0 = 0; d0 < ND0; ++d0) {
                      const bf16x8 b0 = *(const LAS bf16x8*)(kbp + kro[d0 & 3] + (d0 >> 2) * 128);
                      p0 = __builtin_amdgcn_mfma_f32_32x32x16_bf16(b0, qr[d0], p0, 0, 0, 0); } }
                if (!((kh + 31 <= q0) && (kh >= lo_last))) {
                    const int dq = qp - kh - 4 * hi; const float NEG = -__builtin_inff();
#pragma unroll
                    for (int r = 0; r < 16; ++r) { const int c = (r & 3) + 8 * (r >> 2); if ((unsigned)(dq - c) > (unsigned)span) p0[r] = NEG; } }
                float pmax = p0[0];
#pragma unroll
                for (int r = 1; r < 16; ++r) pmax = fmaxf(pmax, p0[r]);
                { auto rr = __builtin_amdgcn_permlane32_swap(__float_as_uint(pmax), __float_as_uint(pmax), false, false); pmax = fmaxf(__uint_as_float(rr[0]), __uint_as_float(rr[1])); }
                const float mn = fmaxf(m_reg, pmax), alpha = __builtin_amdgcn_exp2f(m_reg - mn); m_reg = mn;
                float ps = 0.f;
#pragma unroll
                for (int r = 0; r < 16; ++r) { p0[r] = __builtin_amdgcn_exp2f(p0[r] - mn); ps += p0[r]; }
                { auto rr = __builtin_amdgcn_permlane32_swap(__float_as_uint(ps), __float_as_uint(ps), false, false); ps = __uint_as_float(rr[0]) + __uint_as_float(rr[1]); }
                l_reg = l_reg * alpha + ps;
                u32x4 pa0, pa1; PK4(p0, 0, pa0); PK4(p0, 8, pa1);
                if (__any(alpha != 1.0f)) {
#pragma unroll
                    for (int d = 0; d < 4; ++d)
#pragma unroll
                        for (int r = 0; r < 16; ++r) o[d][r] *= alpha; }
                const unsigned vb = (unsigned)(uintptr_t)(V_lds + buf * SHM_V + hf * 8192) + (unsigned)v_rd_base(lane);
#define TRRD(dst, off) asm volatile("ds_read_b64_tr_b16 %0, %1 offset:%2" : "=&v"(dst) : "v"(vb), "i"(off) : "memory")
#define PV_D0(d0) do { s16x4 l0, l1, h0, h1; constexpr int b_ = (d0) * 512; \
                TRRD(l0, b_); TRRD(h0, b_ + 2048); TRRD(l1, b_ + 4096); TRRD(h1, b_ + 6144); \
                asm volatile("s_waitcnt lgkmcnt(0)" ::: "memory"); __builtin_amdgcn_sched_barrier(0); \
                o[d0] = __builtin_amdgcn_mfma_f32_32x32x16_bf16((bf16x8){l0[0], l0[1], l0[2], l0[3], h0[0], h0[1], h0[2], h0[3]}, as_bf(pa0), o[d0], 0, 0, 0); \
                o[d0] = __builtin_amdgcn_mfma_f32_32x32x16_bf16((bf16x8){l1[0], l1[1], l1[2], l1[3], h1[0], h1[1], h1[2], h1[3]}, as_bf(pa1), o[d0], 0, 0, 0); } while (0)
                PV_D0(0); PV_D0(1); PV_D0(2); PV_D0(3);
#undef PV_D0
#undef TRRD
            }
        }
        if (t + 1 < NT) SWRITE(buf ^ 1);
        __syncthreads();
    }
    const int tq = TOK(qp);
    float a_cur = 1.0f / l_reg, a_prev = 0.f;
    if (MODE == 1) {
        const float lse_cur = m_reg + __builtin_amdgcn_logf(l_reg); float lse_new = lse_cur;
        if (it.merge) { const float lse_prev = it.lse[(size_t)tq * 8]; const float mx = fmaxf(lse_prev, lse_cur);
            const float e0 = __builtin_amdgcn_exp2f(lse_prev - mx), e1 = __builtin_amdgcn_exp2f(lse_cur - mx); const float inv = 1.0f / (e0 + e1);
            lse_new = mx + __builtin_amdgcn_logf(e0 + e1); a_prev = e0 * inv; a_cur *= e1 * inv; }
        if (hi == 0) it.lse[(size_t)tq * 8] = lse_new;
    }
    bf16_t* orow = it.o + (size_t)tq * it.o_ld + hi * 8;
#pragma unroll
    for (int d0 = 0; d0 < 4; ++d0) {
#pragma unroll
        for (int r = 0; r < 16; ++r) o[d0][r] *= a_cur;
        u32x4 w0, w1; PK4(o[d0], 0, w0); PK4(o[d0], 8, w1);
        if (MODE == 1 && it.merge) {
            const u32x4 q0w = *(const u32x4*)(orow + d0 * 32), q1w = *(const u32x4*)(orow + d0 * 32 + 16);
            float a[8], b[8];
            UNPACK8(w0, a); UNPACK8(q0w, b);
#pragma unroll
            for (int e = 0; e < 8; ++e) a[e] += b[e] * a_prev;
            w0 = PACK8(a);
            UNPACK8(w1, a); UNPACK8(q1w, b);
#pragma unroll
            for (int e = 0; e < 8; ++e) a[e] += b[e] * a_prev;
            w1 = PACK8(a);
        }
        *(u32x4*)(orow + d0 * 32) = w0; *(u32x4*)(orow + d0 * 32 + 16) = w1;
    }
#undef SLOAD
#undef SWRITE
#undef TOK
#undef LOF
}

__device__ void mla_attn_phase(const Params& p, LAS unsigned char* lds) {
    unsigned char* ws = p.ws;
    for (int item = opaque_bid(); item < BH * 16 * 4; item += gridDim.x) {
        const int bh = item >> 2, pr = item & 3, b = bh >> 4, h = bh & 15; const size_t tb = (size_t)b * SEQ;
        AttnItem it; it.q = (const bf16_t*)(ws + WS_Q) + tb * 3072 + h * 192; it.q_ld = 3072;
        it.k = (const bf16_t*)(ws + WS_KV) + tb * 4096 + h * 256; it.k_ld = 4096; it.kpe = (const bf16_t*)(ws + WS_KPE) + tb * 1024 + h * 64; it.kpe_ld = 1024;
        it.v = (const bf16_t*)(ws + WS_KV) + tb * 4096 + h * 256 + 128; it.v_ld = 4096; it.o = (bf16_t*)(ws + WS_AO) + tb * 2048 + h * 128; it.o_ld = 2048;
        it.lse = nullptr; it.ld = 0; it.merge = 0;
#pragma unroll 1
        for (int k2 = 0; k2 < 2; ++k2) { it.P0 = (k2 == 0 ? 7 - pr : pr) * 256; attn_block<192, 0>(it, lds); }
    }
}
__device__ void dil_attn_phase(const Params& p, LAS unsigned char* lds, int g) {
    unsigned char* ws = p.ws;
    for (int item = opaque_bid(); item < BH * 8 * 8; item += gridDim.x) {
        const int bh = item >> 3, qb = item & 7, b = bh >> 3, h = bh & 7, hh = g * 8 + h; const size_t tb = (size_t)b * SEQ;
        AttnItem it; it.q = (const bf16_t*)(ws + WS_QB) + tb * 3072 + hh * 128; it.q_ld = 3072;
        it.k = (const bf16_t*)(ws + WS_KVB) + tb * 6144 + hh * 128; it.k_ld = 6144; it.kpe = nullptr; it.kpe_ld = 0;
        it.v = (const bf16_t*)(ws + WS_KVB) + tb * 6144 + 3072 + hh * 128; it.v_ld = 6144; it.o = (bf16_t*)(ws + WS_OB) + tb * 1024 + h * 128; it.o_ld = 1024;
        it.lse = (float*)(ws + WS_LSE) + tb * 8 + h; it.ld = 2 * g; it.merge = g > 0; it.P0 = qb * 256;
        attn_block<128, 1>(it, lds);
    }
}

#define XB_TMO      128
#define XB_XCNT(j)  (256  + 64 * (j))
#define XB_XSUB(j)  (1280 + 64 * (j))
#define XB_XGEN(j)  (2304 + 64 * (j))
#define XB_TOP      3328
#define XB_TOPGEN   3392
#define XCD_BAR_WORDS 3456
#define XB_SPIN_CAP (1u << 18)

__device__ __forceinline__ unsigned xb_ld(unsigned* p)              { return __hip_atomic_load(p, __ATOMIC_RELAXED, __HIP_MEMORY_SCOPE_AGENT); }
__device__ __forceinline__ unsigned xb_add(unsigned* p, unsigned v) { return __hip_atomic_fetch_add(p, v, __ATOMIC_RELAXED, __HIP_MEMORY_SCOPE_AGENT); }
__device__ __forceinline__ unsigned xb_xcc_id() { return (unsigned)__builtin_amdgcn_s_getreg((3 << 11) | 20) & 0xFu; }
#define XB_SPIN(cond, bar) do { unsigned _sp = 0; while (cond) { __builtin_amdgcn_s_sleep(1); \
    if ((++_sp & 255u) == 0u) { if (xb_ld(&(bar)[XB_TMO])) break; if (_sp > XB_SPIN_CAP) { atomicAdd(&(bar)[XB_TMO], 1u); break; } } } } while (0)

struct XcdBarrier {
    unsigned* bar; unsigned x;
    volatile LAS unsigned* st;
};

__device__ __forceinline__ XcdBarrier xcd_barrier_post(unsigned* bar, volatile LAS unsigned* st) {
    XcdBarrier b; b.bar = bar; b.x = xb_xcc_id(); b.st = st;
    if (threadIdx.x == 0) (void)xb_add(&bar[XB_XCNT(b.x)], 1u);
    return b;
}
__device__ __forceinline__ void xcd_barrier_complete(unsigned* bar, unsigned x, unsigned& nloc, unsigned& nx) {
    const unsigned G = gridDim.x * gridDim.y * gridDim.z;
    unsigned sum, cnt, mine, sp = 0u;
    for (;;) {
        sum = 0u; cnt = 0u; mine = 0u;
#pragma unroll
        for (unsigned j = 0; j < 16; ++j) { const unsigned c = xb_ld(&bar[XB_XCNT(j)]); sum += c; cnt += (c > 0u) ? 1u : 0u; mine = (j == x) ? c : mine; }
        if (sum == G) break;
        __builtin_amdgcn_s_sleep(1);
        if ((++sp & 255u) == 0u) { if (xb_ld(&bar[XB_TMO])) break; if (sp > XB_SPIN_CAP) { atomicAdd(&bar[XB_TMO], 1u); break; } }
    }
    nloc = mine > 0u ? mine : 1u; nx = cnt > 0u ? cnt : 1u;
}

__device__ __forceinline__ void xcd_barrier(const XcdBarrier& b) {
    asm volatile("s_waitcnt vmcnt(0)" ::: "memory");
    __syncthreads();
    if (threadIdx.x == 0) {
        unsigned* bar = b.bar;
        __builtin_amdgcn_s_waitcnt(0);
        unsigned nloc = b.st[0], nx = b.st[1];
        if (nloc == 0u) { xcd_barrier_complete(bar, b.x, nloc, nx); b.st[0] = nloc; b.st[1] = nx; }
        const unsigned old = xb_add(&bar[XB_XSUB(b.x)], 1u);
        const unsigned gen = old / nloc;
        if (old + 1u == (gen + 1u) * nloc) {
            __builtin_amdgcn_fence(__ATOMIC_RELEASE, "agent");
            asm volatile("s_waitcnt vmcnt(0)" ::: "memory");
            const unsigned og = xb_add(&bar[XB_TOP], 1u);
            const unsigned tg = og / nx;
            if (og + 1u == (tg + 1u) * nx) xb_add(&bar[XB_TOPGEN], 1u);
            else XB_SPIN(xb_ld(&bar[XB_TOPGEN]) == tg, bar);
            __builtin_amdgcn_fence(__ATOMIC_ACQUIRE, "agent");
            xb_add(&bar[XB_XGEN(b.x)], 1u);
            asm volatile("s_waitcnt vmcnt(0)" ::: "memory");
        } else {
            XB_SPIN(xb_ld(&bar[XB_XGEN(b.x)]) == gen, bar);
            __builtin_amdgcn_fence(__ATOMIC_ACQUIRE, "agent");
            asm volatile("s_waitcnt vmcnt(0)" ::: "memory");
        }
    }
    __syncthreads();
}

constexpr int NPH_HALF = 1 + 2 * 7 + 2 * 8;
#ifndef SKIP_MASK
#define SKIP_MASK 0
#endif
__global__ void __launch_bounds__(NTHR) mega(Params p) {
    extern __shared__ __attribute__((aligned(16))) unsigned char lds_raw[];
    LAS unsigned char* lds = (LAS unsigned char*)lds_raw;
    cg::grid_group grid = cg::this_grid();
    unsigned char* ws = p.ws;
    bf16_t* XB = (bf16_t*)(ws + WS_XB); float* SS = (float*)(ws + WS_SS); bf16_t* HB = (bf16_t*)(ws + WS_H);
    bf16_t* LAT = (bf16_t*)(ws + WS_LAT); bf16_t* Q = (bf16_t*)(ws + WS_Q); bf16_t* KV = (bf16_t*)(ws + WS_KV); bf16_t* KPE = (bf16_t*)(ws + WS_KPE); bf16_t* AO = (bf16_t*)(ws + WS_AO);
    bf16_t* KVB = (bf16_t*)(ws + WS_KVB); bf16_t* QB = (bf16_t*)(ws + WS_QB); bf16_t* OB = (bf16_t*)(ws + WS_OB);
#ifndef PROBE_MASK
#define PROBE_MASK 0
#endif
    unsigned long long probe_acc = 0ull;
    volatile LAS unsigned* bar_st = (volatile LAS unsigned*)(lds + 131072);
    if (threadIdx.x < 4) bar_st[threadIdx.x] = 0u;
    __syncthreads();
    XcdBarrier xbar = xcd_barrier_post((unsigned*)(ws + WS_BAR), bar_st);
#pragma unroll 1
    for (int ph = p.ph_lo; ph < p.ph_hi; ++ph) {
        const unsigned long long probe_t0 = PROBE_MASK ? __builtin_amdgcn_s_memrealtime() : 0ull;
        const int hb = ph >= NPH_HALF ? 1 : 0, li = ph - hb * NPH_HALF;
        const size_t toff = (size_t)hb * TH;
        const float* xin0 = (const float*)p.in[0] + toff * DM; float* xo = p.out + toff * DM; const int* pos = (const int*)p.in[1] + toff;
        int lyr = 0, j = -1;
        if (li >= 15) { lyr = 2 + ((li - 15) >> 3); j = (li - 15) & 7; }
        else if (li >= 1) { lyr = (li - 1) / 7; const int jm = (li - 1) - lyr * 7; j = jm == 0 ? 0 : jm + 1; }
        const bool mla = lyr < 2; const int ab = lyr & 1;
        int gk = 0;
        const bf16_t* A = nullptr; const bf16_t* Bt = nullptr; int lda = 0, N = 0, K = 0, nsub = 1;
        EpiBf16S E1{nullptr, 0, nullptr, 0, 1 << 30, nullptr, 4, 1.0f / 1024.0f, 0, nullptr}; EpiRes E2{nullptr, nullptr, XB, SS};
        float* SSL = (float*)(ws + WS_SSL);
        if (li > 0) {
            if (j == 6) { gk = 1; A = XB; lda = 1024; Bt = (const bf16_t*)(ws + WS_W1) + (size_t)lyr * 4096 * 1024; N = 4096; K = 1024; E1.O = HB; E1.ldc = 4096; E1.ss = SS; E1.act = 1; }
            else if (j == 7) { gk = 2; A = HB; lda = 4096; Bt = (const bf16_t*)(ws + WS_W2) + (size_t)lyr * 1024 * 4096; N = 1024; K = 4096; E2.xin = xo; E2.xout = xo; }
            else if (j == 5) { gk = 2; N = 1024; E2.xin = lyr == 0 ? xin0 : xo; E2.xout = xo;
                if (mla) { A = AO; lda = 2048; K = 2048; Bt = (const bf16_t*)(ws + WS_WO) + (size_t)ab * 1024 * 2048; }
                else { A = OB; lda = 1024; K = 1024; Bt = (const bf16_t*)(ws + WS_WOB) + (size_t)ab * 1024 * 1024; } }
            else if (j == 0) { gk = 1; A = XB; lda = 1024; K = 1024; E1.ss = SS;
                if (mla) { Bt = (const bf16_t*)(ws + WS_WIN) + (size_t)ab * 512 * 1024; N = 512; E1.O = LAT; E1.ldc = 512; E1.ssl = SSL; }
                else if (ab == 0) { Bt = (const bf16_t*)(ws + WS_WKVQ); N = 9216; E1.O = KVB; E1.ldc = 6144; E1.O2 = QB; E1.ldc2 = 3072; E1.split = 6144; }
                else { Bt = (const bf16_t*)(ws + WS_WQ1); N = 3072; E1.O = QB; E1.ldc = 3072; } }
            else if (j == 2 && mla) { gk = 1; nsub = 2; A = LAT; lda = 512; K = 256; Bt = (const bf16_t*)(ws + WS_WQB) + (size_t)ab * 3072 * 256; N = 3072; E1.O = Q; E1.ldc = 3072; E1.ss = SSL; E1.nsl4 = 1; E1.inv_n = 1.0f / 256.0f; }
        }
        if (!(SKIP_MASK & 1) && gk == 1) {
#pragma unroll 1
            for (int sub = 0; sub < nsub; ++sub) {
                if (sub == 1) { A = LAT + 256; Bt = (const bf16_t*)(ws + WS_WKVB) + (size_t)ab * 4096 * 256; N = 4096; E1.O = KV; E1.ldc = 4096; E1.ss = SSL + 4; E1.inv_n = 1.0f / 128.0f; }
                run_gemm(lds, A, lda, Bt, N, K, E1);
            }
        } else if (!(SKIP_MASK & 2) && gk == 2) {
            run_gemm(lds, A, lda, Bt, N, K, E2);
        } else if (li == 0) {
            if (!(SKIP_MASK & 4)) { if (hb == 0) prep_weights(p, lds); prep_x(xin0, XB, SS); }
        } else if (mla) {
            if (j == 3) { if (!(SKIP_MASK & 16)) mla_qk_prep(Q, KV, LAT, KPE, pos, (const float*)p.in[9] + ab * 192, (const float*)p.in[10] + ab * 192); }
            else if (j == 4) { if (!(SKIP_MASK & 32)) mla_attn_phase(p, lds); }
        } else {
            if (j == 1) { if (!(SKIP_MASK & 64)) head_prep(ab == 0 ? KVB : nullptr, QB, pos, (const float*)p.in[14], (const float*)p.in[16] + ab * 384); }
            else if (j >= 2 && j <= 4) { if (!(SKIP_MASK & 128)) dil_attn_phase(p, lds, j - 2); }
        }
        if (ph + 1 < p.ph_hi) { if (ph == p.ph_lo) grid.sync(); else xcd_barrier(xbar); }
        if (PROBE_MASK) { const int cat = gk == 1 ? 1 : gk == 2 ? 2 : li == 0 ? 3 : mla ? (j == 1 ? 4 : j == 3 ? 5 : 6) : (j == 1 ? 7 : 8);
            if ((PROBE_MASK >> cat) & 1) probe_acc += __builtin_amdgcn_s_memrealtime() - probe_t0; }
    }
    if (PROBE_MASK && blockIdx.x == 0) { const unsigned long long t1 = __builtin_amdgcn_s_memrealtime(); while (__builtin_amdgcn_s_memrealtime() - t1 < probe_acc) __builtin_amdgcn_s_sleep(16); }
}
constexpr int N_PHASES = 2 * NPH_HALF;

extern "C" void kernel_launch(void* const* d_in, const int* in_sizes, int n_in, void* d_out, int out_size, void* d_ws, size_t ws_size, hipStream_t stream) {
    static int grid_blocks = 0;
    if (!grid_blocks) {
        int dev = 0, cus = 0, per_cu = 0;
        (void)hipGetDevice(&dev);
        (void)hipDeviceGetAttribute(&cus, hipDeviceAttributeMultiprocessorCount, dev);
        (void)hipFuncSetAttribute((const void*)mega, hipFuncAttributeMaxDynamicSharedMemorySize, LDS_BYTES);
        (void)hipOccupancyMaxActiveBlocksPerMultiprocessor(&per_cu, (const void*)mega, NTHR, LDS_BYTES);
        (void)hipGetLastError();
        grid_blocks = cus > 0 ? cus : 256;
        if (ws_size < WS_END || n_in != 20) { fprintf(stderr, "kernel_launch: workspace %zu < %zu or n_in %d != 20\n", ws_size, (size_t)WS_END, n_in); }
    }
    (void)hipMemsetAsync((unsigned char*)d_ws + WS_BAR, 0, XCD_BAR_WORDS * sizeof(unsigned), stream);
    Params p{};
    for (int i = 0; i < 20; ++i) p.in[i] = d_in[i];
    p.out = (float*)d_out; p.ws = (unsigned char*)d_ws;
#if ONE_LAUNCH
    p.ph_lo = 0; p.ph_hi = N_PHASES;
    void* args[] = {&p};
    hipError_t e = hipLaunchCooperativeKernel((const void*)mega, dim3(grid_blocks), dim3(NTHR), args, LDS_BYTES, stream);
    if (e != hipSuccess) fprintf(stderr, "cooperative launch failed: %s (grid %d)\n", hipGetErrorString(e), grid_blocks);
#else
    for (int ph = 0; ph < N_PHASES; ++ph) { p.ph_lo = ph; p.ph_hi = ph + 1; hipLaunchKernelGGL(mega, dim3(grid_blocks), dim3(NTHR), LDS_BYTES, stream, p); }
#endif
}
```

```cpp
#include <hip/hip_runtime.h>
#include <hip/hip_cooperative_groups.h>
#include <cstdio>
#include <cstdint>
namespace cg = cooperative_groups;

#ifndef ONE_LAUNCH
#define ONE_LAUNCH 1
#endif

__device__ __forceinline__ int opaque_tid() { int t = (int)threadIdx.x; asm volatile("" : "+v"(t)); return t; }
__device__ __forceinline__ int opaque_bid() { int b = (int)blockIdx.x; asm volatile("" : "+s"(b)); return b; }
namespace pg8 {
#define PG8_LAS __attribute__((address_space(3)))
typedef unsigned short bf16_t;
typedef short bf16x8 __attribute__((ext_vector_type(8)));
typedef float f32x4 __attribute__((ext_vector_type(4)));
typedef unsigned u32x4 __attribute__((ext_vector_type(4)));
constexpr int BM = 256, BK = 64, HALF = 128, HTB = HALF * BK * 2  , STAGE_BYTES = 8 * HTB, NXCD = 8, WGM = 8;

__host__ __device__ __forceinline__ int lds_byte(int r, int c) { const int st = (r >> 4) * 2 + (c >> 5), rr = r & 15, cc = c & 31, ob = rr * 64 + cc * 2; return st * 1024 + (ob ^ (((ob >> 9) & 1) << 5)); }
__host__ __device__ __forceinline__ void stage_rc(int b, int& R, int& C) { const int st = b / 1024, sb = b % 1024, swz = sb ^ (((sb >> 9) & 1) << 5); R = (st >> 1) * 16 + swz / 64; C = (st & 1) * 32 + (swz % 64) / 2; }
__host__ __device__ __forceinline__ int perm32(int rho) { const int n = rho >> 4, i = rho & 15; return 8 * (i >> 2) + 4 * n + (i & 3); }
struct Unit { int pm, pn; };
struct Gemm { const bf16_t* A; const bf16_t* Bt; int M, N, K, lda; };
struct StaticOrder {
    int nM, nN, nwg, G, c;
    __host__ __device__ void init(int M, int N, int G_, int c_) { nM = M / BM; nN = N / BM; nwg = nM * nN; G = G_; c = c_; }
    __host__ __device__ bool next(int i, Unit& u) const {
        const long L = (long)i * G + c; if (L >= nwg) return false;
        int wgid = (int)L; { const int q = nwg / NXCD, r = nwg % NXCD, xcd = wgid % NXCD, off = wgid / NXCD; wgid = (xcd < r ? xcd * (q + 1) : r * (q + 1) + (xcd - r) * q) + off; }
        const int nig = WGM * nN, gid = wgid / nig, fm = gid * WGM, gsz = (nM - fm) < WGM ? (nM - fm) : WGM;
        u.pm = fm + ((wgid % nig) % gsz); u.pn = (wgid % nig) / gsz; return true;
    }
    __device__ __forceinline__ void a_ready(const Unit&) const {}
    __device__ __forceinline__ void done(const Unit&) const {}
};
__device__ __forceinline__ unsigned cvt_pk_bf16(float lo, float hi) { unsigned r; asm volatile("v_cvt_pk_bf16_f32 %0, %1, %2" : "=v"(r) : "v"(lo), "v"(hi)); return r; }
template <class Epi, class Sched>
__device__ __forceinline__ void gemm_phase(PG8_LAS unsigned char* lds, const Gemm g, const Sched& S, const Epi& E) {
    const int tid = opaque_tid(), wid = __builtin_amdgcn_readfirstlane(tid >> 6), lane = tid & 63, wr = wid >> 2, wc = wid & 3, fr = lane & 15, fq = lane >> 4;
    const int K = g.K, nt = K / BK;
    unsigned voffA[2], voffB[2];
#pragma unroll
    for (int i = 0; i < 2; ++i) { int R, C; stage_rc(tid * 16 + i * 8192, R, C); const int Rb = Epi::PERM ? ((R & ~31) + perm32(R & 31)) : R;
        voffA[i] = (unsigned)(R * g.lda + C) * 2u; voffB[i] = (unsigned)(Rb * K + C) * 2u; }
    const size_t kstep = (size_t)(BK * 2);
    const size_t hstep = (size_t)HALF * K * 2, hstepA = (size_t)HALF * g.lda * 2;
    const size_t tstep = 2 * hstep, tstepA = 2 * hstepA;
    const unsigned ldsw = (unsigned)wid * 1024u;
    const int aoff = lds_byte(wr * 64 + fr, fq * 8), boff = lds_byte(wc * 32 + fr, fq * 8);
#define PG8_SA(b, h) (((b) * 2 + (h)) * HTB)
#define PG8_SB(b, h) ((4 + (b) * 2 + (h)) * HTB)
#define PG8_STAGE(bufoff, gbase, voff) do { _Pragma("unroll") for (int _i = 0; _i < 2; ++_i) \
        __builtin_amdgcn_global_load_lds((const unsigned*)((const char*)(gbase) + (voff)[_i]), (PG8_LAS unsigned*)(lds + (bufoff) + ldsw + _i * 8192), 16, 0, 0); } while (0)
#define PG8_LDA(dst, b, h) do { _Pragma("unroll") for (int m = 0; m < 4; ++m) _Pragma("unroll") for (int k = 0; k < 2; ++k) dst[m][k] = *(const PG8_LAS bf16x8*)(lds + PG8_SA(b, h) + aoff + m * 2048 + k * 1024); } while (0)
#define PG8_LDB(dst, b, h) do { _Pragma("unroll") for (int n = 0; n < 2; ++n) _Pragma("unroll") for (int k = 0; k < 2; ++k) dst[n][k] = *(const PG8_LAS bf16x8*)(lds + PG8_SB(b, h) + boff + n * 2048 + k * 1024); } while (0)
#define PG8_MMA(ai, bj, At, Bt) do { __builtin_amdgcn_s_setprio(1); _Pragma("unroll") for (int m = 0; m < 4; ++m) _Pragma("unroll") for (int n = 0; n < 2; ++n) _Pragma("unroll") for (int k = 0; k < 2; ++k) \
        acc[ai][bj][m][n] = __builtin_amdgcn_mfma_f32_16x16x32_bf16(Bt[n][k], At[m][k], acc[ai][bj][m][n], 0, 0, 0); __builtin_amdgcn_s_setprio(0); } while (0)
#define PG8_WAIT_V(n) asm volatile("s_waitcnt vmcnt(" #n ")" ::: "memory")
#define PG8_WAIT_L(n) asm volatile("s_waitcnt lgkmcnt(" #n ")" ::: "memory")
#define PG8_BAR __builtin_amdgcn_s_barrier()
#define PG8_SCHED __builtin_amdgcn_sched_barrier(0)
    Unit cur, nxt; int ui = 0;
    if (!S.next(0, cur)) return;
    f32x4 acc[2][2][4][2];
#pragma unroll
    for (int a = 0; a < 2; ++a)
#pragma unroll
        for (int b = 0; b < 2; ++b)
#pragma unroll
            for (int m = 0; m < 4; ++m)
#pragma unroll
                for (int n = 0; n < 2; ++n) acc[a][b][m][n] = (f32x4){0.f, 0.f, 0.f, 0.f};
    bf16x8 At[4][2], B0[2][2], B1[2][2];
    const char* cA = (const char*)g.A + (size_t)cur.pm * tstepA; const char* cB = (const char*)g.Bt + (size_t)cur.pn * tstep;
    S.a_ready(cur);
    PG8_STAGE(PG8_SB(0, 0), cB, voffB); PG8_STAGE(PG8_SA(0, 0), cA, voffA); PG8_STAGE(PG8_SB(0, 1), cB + hstep, voffB); PG8_STAGE(PG8_SA(0, 1), cA + hstepA, voffA);
    if (wr == 1) PG8_BAR;
    PG8_WAIT_V(4); PG8_BAR;
    PG8_STAGE(PG8_SB(1, 0), cB + kstep, voffB); PG8_STAGE(PG8_SA(1, 0), cA + kstep, voffA); PG8_STAGE(PG8_SB(1, 1), cB + hstep + kstep, voffB);
    PG8_WAIT_V(6); PG8_BAR;
    for (;;) {
        const bool has_next = S.next(ui + 1, nxt);
        const char* nA = has_next ? (const char*)g.A + (size_t)nxt.pm * tstepA : cA; const char* nB = has_next ? (const char*)g.Bt + (size_t)nxt.pn * tstep : cB;
        for (int t = 0; t < nt; t += 2) {
            const bool last = (t == nt - 2);
            const char* a1 = cA + (size_t)(t + 1) * kstep;
            const char* a2 = last ? nA : cA + (size_t)(t + 2) * kstep; const char* b2 = last ? nB : cB + (size_t)(t + 2) * kstep;
            const char* a3 = a2 + kstep; const char* b3 = b2 + kstep;
            if (last && has_next) S.a_ready(nxt);
            PG8_LDB(B0, 0, 0); PG8_SCHED; PG8_LDA(At, 0, 0); PG8_STAGE(PG8_SA(1, 1), a1 + hstepA, voffA);
            PG8_WAIT_L(8); PG8_BAR; PG8_WAIT_L(0); PG8_MMA(0, 0, At, B0); PG8_BAR; PG8_SCHED;
            PG8_LDB(B1, 0, 1); PG8_STAGE(PG8_SB(0, 0), b2, voffB);
            PG8_BAR; PG8_WAIT_L(0); PG8_MMA(0, 1, At, B1); PG8_BAR;
            PG8_LDA(At, 0, 1); PG8_STAGE(PG8_SA(0, 0), a2, voffA);
            PG8_BAR; PG8_WAIT_L(0); PG8_MMA(1, 0, At, B0); PG8_BAR; PG8_SCHED;
            PG8_STAGE(PG8_SB(0, 1), b2 + hstep, voffB);
            PG8_WAIT_V(6); PG8_BAR; PG8_MMA(1, 1, At, B1); PG8_BAR;
            PG8_LDB(B0, 1, 0); PG8_SCHED; PG8_LDA(At, 1, 0); PG8_STAGE(PG8_SA(0, 1), a2 + hstepA, voffA);
            PG8_WAIT_L(8); PG8_BAR; PG8_WAIT_L(0); PG8_MMA(0, 0, At, B0); PG8_BAR; PG8_SCHED;
            PG8_LDB(B1, 1, 1); PG8_STAGE(PG8_SB(1, 0), b3, voffB);
            PG8_BAR; PG8_WAIT_L(0); PG8_MMA(0, 1, At, B1); PG8_BAR;
            PG8_LDA(At, 1, 1); PG8_STAGE(PG8_SA(1, 0), a3, voffA);
            PG8_BAR; PG8_WAIT_L(0); PG8_MMA(1, 0, At, B0); PG8_BAR; PG8_SCHED;
            PG8_STAGE(PG8_SB(1, 1), b3 + hstep, voffB);
            PG8_WAIT_V(6); PG8_BAR; PG8_MMA(1, 1, At, B1); PG8_BAR;
        }
        if constexpr (!Epi::AFTER_DRAIN) { E(acc, cur, wr, wc, fr, fq); S.done(cur); }
        if (!has_next) break;
#pragma unroll
        for (int a = 0; a < 2; ++a)
#pragma unroll
            for (int b = 0; b < 2; ++b)
#pragma unroll
                for (int m = 0; m < 4; ++m)
#pragma unroll
                    for (int n = 0; n < 2; ++n) acc[a][b][m][n] = (f32x4){0.f, 0.f, 0.f, 0.f};
        cur = nxt; cA = nA; cB = nB; ++ui;
    }
    PG8_WAIT_V(0);
    if (wr == 0) PG8_BAR;
    PG8_BAR;
    if constexpr (Epi::AFTER_DRAIN) { E.fused(acc, cur, wr, wc, fr, fq, lds, wid, lane); S.done(cur); }
#undef PG8_SA
#undef PG8_SB
#undef PG8_STAGE
#undef PG8_LDA
#undef PG8_LDB
#undef PG8_MMA
#undef PG8_WAIT_V
#undef PG8_WAIT_L
#undef PG8_BAR
#undef PG8_SCHED
}
}
using pg8::bf16_t; using pg8::bf16x8; using pg8::f32x4; using pg8::u32x4;
#define LAS __attribute__((address_space(3)))
typedef short s16x4 __attribute__((ext_vector_type(4)));
typedef float f32x16 __attribute__((ext_vector_type(16)));
typedef unsigned u32x2 __attribute__((ext_vector_type(2)));

constexpr int SEQ = 2048, DM = 1024, NBATCH = 16, TT = NBATCH * SEQ, TH = TT / 2, BH = NBATCH / 2, DFF = 4096;
constexpr float EPS = 1e-6f, LOG2E = 1.4426950408889634f, LOG2_THETA = 13.287712379549449f;
constexpr int NTHR = 512;
constexpr int LDS_BYTES = 131072 + 4096;
constexpr size_t MiB = (size_t)1 << 20;
constexpr size_t WS_WIN = 0, WS_WQB = WS_WIN + 2 * MiB, WS_WKVB = WS_WQB + 3 * MiB, WS_WO = WS_WKVB + 4 * MiB, WS_WKVQ = WS_WO + 8 * MiB, WS_WQ1 = WS_WKVQ + 18 * MiB,
                 WS_WOB = WS_WQ1 + 6 * MiB, WS_W1 = WS_WOB + 4 * MiB, WS_W2 = WS_W1 + 32 * MiB, WS_XB = WS_W2 + 32 * MiB, WS_SS = WS_XB + 32 * MiB, WS_LSE = WS_SS + 1 * MiB,
                 WS_BAR = WS_LSE + 768 * 1024, WS_SSL = WS_LSE + 1 * MiB, WS_BIG = WS_SSL + 1 * MiB;
constexpr size_t WS_LAT = WS_BIG, WS_Q = WS_LAT + 16 * MiB, WS_KV = WS_Q + 96 * MiB, WS_KPE = WS_KV + 128 * MiB, WS_AO = WS_KPE + 32 * MiB;
constexpr size_t WS_SSK = WS_KPE, WS_KPER = WS_KPE + 8 * MiB;
constexpr size_t WS_KVB = WS_BIG, WS_QB = WS_BIG + 192 * MiB, WS_OB = WS_BIG + 288 * MiB;
constexpr size_t WS_H = WS_BIG + 192 * MiB;
constexpr size_t WS_END = WS_BIG + 336 * MiB;

struct Params { const void* in[20]; float* out; unsigned char* ws; int ph_lo, ph_hi; };

__device__ __forceinline__ unsigned cvtpk(float lo, float hi) { unsigned r; asm volatile("v_cvt_pk_bf16_f32 %0, %1, %2" : "=v"(r) : "v"(lo), "v"(hi)); return r; }
__device__ __forceinline__ float bf_lo(unsigned w) { return __uint_as_float(w << 16); }
__device__ __forceinline__ float bf_hi(unsigned w) { return __uint_as_float(w & 0xffff0000u); }
#define UNPACK8(W_, V_) do { const u32x4 t_ = (W_); V_[0] = bf_lo(t_[0]); V_[1] = bf_hi(t_[0]); V_[2] = bf_lo(t_[1]); V_[3] = bf_hi(t_[1]); V_[4] = bf_lo(t_[2]); V_[5] = bf_hi(t_[2]); V_[6] = bf_lo(t_[3]); V_[7] = bf_hi(t_[3]); } while (0)
#define PACK8(V_) ((u32x4){cvtpk(V_[0], V_[1]), cvtpk(V_[2], V_[3]), cvtpk(V_[4], V_[5]), cvtpk(V_[6], V_[7])})
__device__ __forceinline__ void sincos_rev(float pos, float invf_rev, float& s, float& c) {
    float rev = pos * invf_rev; rev = rev - floorf(rev);
    s = __builtin_amdgcn_sinf(rev); c = __builtin_amdgcn_cosf(rev);
}

__device__ __forceinline__ void cvt_job(const float* __restrict__ W, int K, int N, const float* __restrict__ gain, bf16_t* __restrict__ dst, int ldo, int& base, LAS float* tile) {
    const int tk = K / 64, tn = N / 64, nt = tk * tn, G = (int)gridDim.x, tid = opaque_tid();
    int start = (opaque_bid() - (base % G)); if (start < 0) start += G;
    for (int t = start; t < nt; t += G) {
        const int kt = t / tn, ntile = t - kt * tn;
        __syncthreads();
#pragma unroll
        for (int i = 0; i < 2; ++i) {
            const int k = (tid >> 4) + 32 * i, n4 = (tid & 15) * 4;
            const f32x4 v = *(const f32x4*)(W + (size_t)(kt * 64 + k) * N + ntile * 64 + n4);
            const float g = gain ? gain[kt * 64 + k] : 1.0f;
            tile[(n4 + 0) * 65 + k] = v.x * g; tile[(n4 + 1) * 65 + k] = v.y * g; tile[(n4 + 2) * 65 + k] = v.z * g; tile[(n4 + 3) * 65 + k] = v.w * g;
        }
        __syncthreads();
        const int n = tid >> 3, k8 = (tid & 7) * 8;
        const LAS float* tp = tile + n * 65 + k8;
        u32x4 w; w.x = cvtpk(tp[0], tp[1]); w.y = cvtpk(tp[2], tp[3]); w.z = cvtpk(tp[4], tp[5]); w.w = cvtpk(tp[6], tp[7]);
        *(u32x4*)(dst + (size_t)(ntile * 64 + n) * ldo + kt * 64 + k8) = w;
    }
    base += nt;
}
__device__ __forceinline__ void zero_fill(bf16_t* dst, int rows, int cols8, int ld) {
    const size_t n = (size_t)rows * cols8;
    for (size_t i = (size_t)opaque_bid() * NTHR + opaque_tid(); i < n; i += (size_t)gridDim.x * NTHR) { const size_t r = i / cols8, c = i - r * cols8; *(u32x4*)(dst + r * ld + c * 8) = (u32x4){0u, 0u, 0u, 0u}; }
}
__device__ void prep_weights(const Params& p, LAS unsigned char* lds) {
    LAS float* tile = (LAS float*)lds;
    unsigned char* ws = p.ws;
    const float* attn_norm = (const float*)p.in[2]; const float* mlp_norm = (const float*)p.in[3];
    int base = 0;
    for (int a = 0; a < 2; ++a) {
        cvt_job((const float*)p.in[4] + (size_t)a * 1024 * 448, 1024, 448, attn_norm + a * 1024, (bf16_t*)(ws + WS_WIN) + (size_t)a * 512 * 1024, 1024, base, tile);
        cvt_job((const float*)p.in[7] + (size_t)a * 256 * 3072, 256, 3072, (const float*)p.in[5] + a * 256, (bf16_t*)(ws + WS_WQB) + (size_t)a * 3072 * 256, 256, base, tile);
        cvt_job((const float*)p.in[8] + (size_t)a * 128 * 4096, 128, 4096, (const float*)p.in[6] + a * 128, (bf16_t*)(ws + WS_WKVB) + (size_t)a * 4096 * 256, 256, base, tile);
        cvt_job((const float*)p.in[11] + (size_t)a * 2048 * 1024, 2048, 1024, nullptr, (bf16_t*)(ws + WS_WO) + (size_t)a * 1024 * 2048, 2048, base, tile);
        cvt_job((const float*)p.in[17] + (size_t)a * 1024 * 1024, 1024, 1024, nullptr, (bf16_t*)(ws + WS_WOB) + (size_t)a * 1024 * 1024, 1024, base, tile);
        zero_fill((bf16_t*)(ws + WS_WIN) + (size_t)a * 512 * 1024 + (size_t)448 * 1024, 64, 128, 1024);
        zero_fill((bf16_t*)(ws + WS_WKVB) + (size_t)a * 4096 * 256 + 128, 4096, 16, 256);
    }
    cvt_job((const float*)p.in[13], 1024, 6144, (const float*)p.in[12], (bf16_t*)(ws + WS_WKVQ), 1024, base, tile);
    cvt_job((const float*)p.in[15], 1024, 3072, attn_norm + 2 * 1024, (bf16_t*)(ws + WS_WKVQ) + (size_t)6144 * 1024, 1024, base, tile);
    cvt_job((const float*)p.in[15] + (size_t)1024 * 3072, 1024, 3072, attn_norm + 3 * 1024, (bf16_t*)(ws + WS_WQ1), 1024, base, tile);
    for (int l = 0; l < 4; ++l) {
        cvt_job((const float*)p.in[18] + (size_t)l * 1024 * 4096, 1024, 4096, mlp_norm + l * 1024, (bf16_t*)(ws + WS_W1) + (size_t)l * 4096 * 1024, 1024, base, tile);
        cvt_job((const float*)p.in[19] + (size_t)l * 4096 * 1024, 4096, 1024, nullptr, (bf16_t*)(ws + WS_W2) + (size_t)l * 1024 * 4096, 4096, base, tile);
    }
    __syncthreads();
}
__device__ void prep_x(const float* __restrict__ x, bf16_t* __restrict__ xb, float* __restrict__ ss) {
    const int tid_ = opaque_tid(), lane = tid_ & 63, gw = opaque_bid() * 8 + (tid_ >> 6), nw = gridDim.x * 8;
    for (int r = gw; r < TH; r += nw) {
        const float* xr = x + (size_t)r * 1024; bf16_t* br = xb + (size_t)r * 1024; float s = 0.f;
#pragma unroll
        for (int i = 0; i < 4; ++i) { const f32x4 v = *(const f32x4*)(xr + i * 256 + lane * 4); s += v.x * v.x + v.y * v.y + v.z * v.z + v.w * v.w;
            *(u32x2*)(br + i * 256 + lane * 4) = (u32x2){cvtpk(v.x, v.y), cvtpk(v.z, v.w)}; }
#pragma unroll
        for (int o = 1; o < 64; o <<= 1) s += __shfl_xor(s, o);
        if (lane < 16) ss[(size_t)r * 16 + lane] = lane == 0 ? s : 0.f;
    }
}

struct EpiBf16S {
    static constexpr bool PERM = true, AFTER_DRAIN = false;
    bf16_t* O; int ldc; bf16_t* O2; int ldc2; int split; const float* ss; int nsl4; float inv_n; int act; float* ssl; float* ssk;
    __device__ __forceinline__ void operator()(const f32x4 (&acc)[2][2][4][2], const pg8::Unit& u, int wr, int wc, int fr, int fq) const {
        const int row0 = u.pm * 256 + wr * 64 + fr; int colt = u.pn * 256; bf16_t* base = O; int ld = ldc;
        if (colt >= split) { base = O2; colt -= split; ld = ldc2; }
        const int col0 = colt + wc * 32 + 8 * fq;
#pragma unroll
        for (int ai = 0; ai < 2; ++ai)
#pragma unroll
            for (int m = 0; m < 4; ++m) { const int row = row0 + ai * 128 + m * 16; float sc = 1.0f;
                if (ss) { const f32x4* sp = (const f32x4*)(ss + (size_t)row * 16); f32x4 a = sp[0]; if (nsl4 == 4) a = (a + sp[1]) + (sp[2] + sp[3]); sc = rsqrtf(((a.x + a.y) + (a.z + a.w)) * inv_n + EPS); }
                bf16_t* rowp = base + (size_t)row * ld + col0; float sa = 0.f, sb = 0.f;
#pragma unroll
                for (int bj = 0; bj < 2; ++bj) { f32x4 v0 = acc[ai][bj][m][0] * sc, v1 = acc[ai][bj][m][1] * sc;
                    if (act) {
#pragma unroll
                        for (int j = 0; j < 4; ++j) { const float a0 = fmaxf(v0[j], 0.f), a1 = fmaxf(v1[j], 0.f); v0[j] = a0 * a0; v1[j] = a1 * a1; } }
                    const float sq = ((v0[0] * v0[0] + v0[1] * v0[1]) + (v0[2] * v0[2] + v0[3] * v0[3])) + ((v1[0] * v1[0] + v1[1] * v1[1]) + (v1[2] * v1[2] + v1[3] * v1[3]));
                    if (bj == 0) sa = sq; else sb = sq;
                    u32x4 w; w.x = cvtpk(v0[0], v0[1]); w.y = cvtpk(v0[2], v0[3]); w.z = cvtpk(v1[0], v1[1]); w.w = cvtpk(v1[2], v1[3]);
                    *(u32x4*)(rowp + bj * 128) = w; }
                if (ssk) { float sk_ = sa; sk_ += __shfl_xor(sk_, 16); sk_ += __shfl_xor(sk_, 32); if (fq == 0) ssk[((size_t)row * 16 + u.pn) * 4 + wc] = sk_; }
                if (ssl) { sa += __shfl_xor(sa, 16); sa += __shfl_xor(sa, 32); sb += __shfl_xor(sb, 16); sb += __shfl_xor(sb, 32);
                    if (fq == 0) { float* sr_ = ssl + (size_t)row * 16; if (u.pn == 0) sr_[wc] = sa + sb; else { sr_[4 + wc] = sa; sr_[8 + wc] = sb; } } } }
    }
};
struct EpiRes {
    static constexpr bool PERM = false, AFTER_DRAIN = false;
    const float* xin; float* xout; bf16_t* xb; float* ss;
    __device__ __forceinline__ void operator()(const f32x4 (&acc)[2][2][4][2], const pg8::Unit& u, int wr, int wc, int fr, int fq) const {
        const int row0 = u.pm * 256 + wr * 64 + fr, col0 = u.pn * 256 + wc * 32 + 4 * fq;
#pragma unroll
        for (int ai = 0; ai < 2; ++ai)
#pragma unroll
            for (int m = 0; m < 4; ++m) { const int row = row0 + ai * 128 + m * 16; const size_t off = (size_t)row * 1024 + col0; float s = 0.f;
#pragma unroll
                for (int bj = 0; bj < 2; ++bj)
#pragma unroll
                    for (int n = 0; n < 2; ++n) { const int c = bj * 128 + n * 16; const f32x4 o = *(const f32x4*)(xin + off + c) + acc[ai][bj][m][n];
                        *(f32x4*)(xout + off + c) = o; s += (o.x * o.x + o.y * o.y) + (o.z * o.z + o.w * o.w);
                        *(u32x2*)(xb + off + c) = (u32x2){cvtpk(o.x, o.y), cvtpk(o.z, o.w)}; }
                s += __shfl_xor(s, 16); s += __shfl_xor(s, 32);
                if (fq == 0) ss[(size_t)row * 16 + u.pn * 4 + wc] = s; }
    }
};
template <class Epi> __device__ __forceinline__ void run_gemm(LAS unsigned char* lds, const bf16_t* A, int lda, const bf16_t* Bt, int N, int K, const Epi& E) {
    pg8::Gemm g{A, Bt, TH, N, K, lda}; pg8::StaticOrder S; S.init(TH, N, (int)gridDim.x, opaque_bid());
    pg8::gemm_phase<Epi, pg8::StaticOrder>(lds, g, S, E);
}

__device__ void lat_prep(bf16_t* lat) {
    const int tid_ = opaque_tid(), lane = tid_ & 63, gw = opaque_bid() * 8 + (tid_ >> 6), nw = gridDim.x * 8;
    for (int t = gw; t < TH; t += nw) {
        bf16_t* p = lat + (size_t)t * 512 + lane * 8; const u32x4 w = *(const u32x4*)p; float v[8]; UNPACK8(w, v);
        float s = 0.f;
#pragma unroll
        for (int e = 0; e < 8; ++e) s += v[e] * v[e];
        s += __shfl_xor(s, 1); s += __shfl_xor(s, 2); s += __shfl_xor(s, 4); s += __shfl_xor(s, 8);
        const float s32 = s + __shfl_xor(s, 16);
        const float rstd = lane < 32 ? rsqrtf(s32 * (1.0f / 256.0f) + EPS) : rsqrtf(s * (1.0f / 128.0f) + EPS);
        if (lane < 48) {
#pragma unroll
            for (int e = 0; e < 8; ++e) v[e] *= rstd;
            *(u32x4*)p = PACK8(v); }
    }
}
__device__ void kpe_prep(const bf16_t* lat, const int* pos, const float* gk, bf16_t* kper) {
    const int tid = opaque_tid(), grp = tid >> 3, l8 = tid & 7;
    float invf[8], g[8];
#pragma unroll
    for (int e = 0; e < 8; ++e) { invf[e] = exp2f(-(float)((l8 & 3) * 8 + e) * (LOG2_THETA / 32.0f)) * 0.15915494309189535f; g[e] = gk[128 + l8 * 8 + e]; }
    for (int t = opaque_bid() * 64 + grp; t < TH; t += (int)gridDim.x * 64) {
        const float posf = (float)pos[t];
        const u32x4 w = *(const u32x4*)(lat + (size_t)t * 512 + 384 + l8 * 8); float v[8]; UNPACK8(w, v);
#pragma unroll
        for (int e = 0; e < 8; ++e) { const float y = v[e] * g[e]; const float pr = __shfl_xor(y, 4); float sn_, cs_; sincos_rev(posf, invf[e], sn_, cs_);
            v[e] = (l8 & 4) ? y * cs_ + pr * sn_ : y * cs_ - pr * sn_; }
        *(u32x4*)(kper + (size_t)t * 64 + l8 * 8) = PACK8(v);
    }
}
__device__ void head_prep(bf16_t* kbuf  , bf16_t* qbuf, const int* pos, const float* gk, const float* gq) {
    const int tid_ = opaque_tid(), lane = tid_ & 63, gw = opaque_bid() * 8 + (tid_ >> 6), nw = gridDim.x * 8;
    const float qscale = 0.08838834764831845f * LOG2E;
    const int c16 = lane & 15;
    float invf[8];
#pragma unroll
    for (int e = 0; e < 8; ++e) invf[e] = exp2f(-(float)((c16 & 7) * 8 + e) * (LOG2_THETA / 64.0f)) * 0.15915494309189535f;
    for (int t = gw; t < TH; t += nw) {
        const float posf = (float)pos[t];
        float cs[8], sn[8];
#pragma unroll
        for (int e = 0; e < 8; ++e) sincos_rev(posf, invf[e], sn[e], cs[e]);
        u32x4 wv[6];
#pragma unroll
        for (int itr = 0; itr < 6; ++itr) wv[itr] = *(const u32x4*)(kbuf + (size_t)t * 6144 + (itr * 4 + (lane >> 4)) * 128 + c16 * 8);
#pragma unroll
        for (int itr = 0; itr < 6; ++itr) { const bool isq = false;
            const int hh = (isq ? itr - 6 : itr) * 4 + (lane >> 4), g = hh >> 3;
            bf16_t* p = isq ? qbuf + (size_t)t * 3072 + hh * 128 + c16 * 8 : kbuf + (size_t)t * 6144 + hh * 128 + c16 * 8;
            const float* gn = (isq ? gq : gk) + g * 128 + c16 * 8;
            float v[8]; UNPACK8(wv[itr], v); float s = 0.f;
#pragma unroll
            for (int e = 0; e < 8; ++e) s += v[e] * v[e];
            s += __shfl_xor(s, 1); s += __shfl_xor(s, 2); s += __shfl_xor(s, 4); s += __shfl_xor(s, 8);
            const float rstd = rsqrtf(s * (1.0f / 128.0f) + EPS), osc = isq ? qscale : 1.0f;
#pragma unroll
            for (int e = 0; e < 8; ++e) { const float y = v[e] * rstd * gn[e]; const float pr = __shfl_xor(y, 8);
                v[e] = ((c16 & 8) ? y * cs[e] + pr * sn[e] : y * cs[e] - pr * sn[e]) * osc; }
            *(u32x4*)p = PACK8(v); }
    }
}

struct AttnItem { const bf16_t* q; const bf16_t* k; const bf16_t* kpe; const bf16_t* v; bf16_t* o; float* lse; const int* pos; const float* gq; const float* gk; const float* ssk; const float* ssl; int q_ld, k_ld, kpe_ld, v_ld, o_ld, P0, ld, merge; };
__device__ __forceinline__ int v_st(int k, int c) { const int kk = (k & ~0xC) | ((k & 4) << 1) | ((k & 8) >> 1); return ((kk >> 3) * 4 + (c >> 5)) * 512 + ((kk & 7) * 32 + (c & 31)) * 2; }
__device__ __forceinline__ int v_rd_base(int lane) { return ((lane & 3) << 3) | (((lane >> 2) & 3) << 6) | (((lane >> 4) & 1) << 5) | (((lane >> 5) & 1) << 8); }
#define PK4(P, B_, OUT) do { unsigned a0_ = cvtpk(P[B_+0], P[B_+1]), a1_ = cvtpk(P[B_+2], P[B_+3]); unsigned b0_ = cvtpk(P[B_+4], P[B_+5]), b1_ = cvtpk(P[B_+6], P[B_+7]); \
        auto r0_ = __builtin_amdgcn_permlane32_swap(a0_, b0_, false, false); auto r1_ = __builtin_amdgcn_permlane32_swap(a1_, b1_, false, false); \
        u32x4 w_ = {r0_[0], r1_[0], r0_[1], r1_[1]}; OUT = w_; } while (0)
__device__ __forceinline__ bf16x8 as_bf(u32x4 w) { return *reinterpret_cast<bf16x8*>(&w); }

template <int DQK, int MODE>
__device__ __forceinline__ void attn_block(const AttnItem& it, LAS unsigned char* lds) {
    constexpr int RS = DQK * 2, SHM_K = 64 * RS, SHM_V = 16384, ND0 = DQK / 16, KCH = DQK / 8, NKC = (64 * KCH) / 512;
    const int tid = opaque_tid(), wid = __builtin_amdgcn_readfirstlane(tid >> 6), lane = tid & 63, r32 = lane & 31, hi = lane >> 5;
    const int ld = it.ld, Lm1 = (2048 >> ld) - 1, lsh = 11 - ld;
#define TOK(p) (MODE == 0 ? (p) : ((((p) & Lm1) << ld) | ((p) >> lsh)))
#define LOF(p) (MODE == 0 ? 0 : max((p) - 128, (p) & ~Lm1))
    const int q0 = it.P0 + wid * 32, qp = q0 + r32;
    const int span = qp - LOF(qp), lo_w = LOF(q0), lo_last = LOF(q0 + 31);
    LAS unsigned char* V_lds = lds; LAS unsigned char* K_lds = lds + 2 * SHM_V;
    const int j_lo = LOF(it.P0) >> 6, NT = (it.P0 >> 6) + 4 - j_lo;
    const int sr = tid >> 4, sc = (tid & 15) * 8, vst0 = v_st(sr, sc), vst1 = v_st(32 + sr, sc);
    constexpr int NSET = (MODE == 1) ? 2 : 1;
    bf16x8 sk[NSET][NKC], sv0[NSET], sv1[NSET]; f32x4 s_k4 = {0.f, 0.f, 0.f, 0.f}, s_p4 = {0.f, 0.f, 0.f, 0.f};
    constexpr int KRS_OFF = 2 * SHM_V + 2 * SHM_K;
    int offk[NKC], offv0 = sr * it.v_ld + sc, offv1 = (32 + sr) * it.v_ld + sc;
#pragma unroll
    for (int i_ = 0; i_ < NKC; ++i_) { const int c_ = tid + 512 * i_, row_ = c_ / KCH, cc_ = c_ - row_ * KCH; offk[i_] = (DQK == 192 && cc_ >= 16) ? row_ * it.kpe_ld + (cc_ - 16) * 8 : row_ * it.k_ld + cc_ * 8; }
#define SLOAD(S_, kb_) do { if (MODE == 0) { const bf16_t* kt_ = it.k + (size_t)(kb_) * it.k_ld; const bf16_t* pt_ = it.kpe + (size_t)(kb_) * it.kpe_ld; const bf16_t* vt_ = it.v + (size_t)(kb_) * it.v_ld; \
            _Pragma("unroll") for (int i_ = 0; i_ < NKC; ++i_) { const int c_ = tid + 512 * i_, row_ = c_ / KCH, cc_ = c_ - row_ * KCH; sk[S_][i_] = *(const bf16x8*)(((DQK == 192 && cc_ >= 16) ? pt_ : kt_) + offk[i_]); } \
            sv0[S_] = *(const bf16x8*)(vt_ + offv0); sv1[S_] = *(const bf16x8*)(vt_ + offv1); \
            if (tid < 64) { s_k4 = *(const f32x4*)(it.ssk + (size_t)((kb_) + tid) * 64); s_p4 = *(const f32x4*)(it.ssl + (size_t)((kb_) + tid) * 16); } } else { \
        _Pragma("unroll") for (int i_ = 0; i_ < NKC; ++i_) { const int c_ = tid + 512 * i_, row_ = c_ / KCH, cc_ = c_ - row_ * KCH; const int tk_ = TOK((kb_) + row_); \
            sk[S_][i_] = *(const bf16x8*)(it.k + (size_t)tk_ * it.k_ld + cc_ * 8); } \
        { const int t0_ = TOK((kb_) + sr), t1_ = TOK((kb_) + 32 + sr); sv0[S_] = *(const bf16x8*)(it.v + (size_t)t0_ * it.v_ld + sc); sv1[S_] = *(const bf16x8*)(it.v + (size_t)t1_ * it.v_ld + sc); } } } while (0)
#define SWRITE(S_, bf_) do { _Pragma("unroll") for (int i_ = 0; i_ < NKC; ++i_) { const int c_ = tid + 512 * i_, row_ = c_ / KCH, cc_ = c_ - row_ * KCH; const int swz_ = (((DQK == 128) ? row_ : (row_ >> 1)) & 7) << 4; \
            *(LAS bf16x8*)(K_lds + (bf_) * SHM_K + row_ * RS + ((cc_ * 16) ^ swz_)) = sk[S_][i_]; } \
        *(LAS bf16x8*)(V_lds + (bf_) * SHM_V + vst0) = sv0[S_]; *(LAS bf16x8*)(V_lds + (bf_) * SHM_V + vst1) = sv1[S_]; \
        if (MODE == 0 && tid < 64) { const f32x4 a_ = s_k4 + s_p4; *(LAS float*)(lds + KRS_OFF + (bf_) * 256 + tid * 4) = rsqrtf(((a_.x + a_.y) + (a_.z + a_.w)) * (1.0f / 192.0f) + EPS); } } while (0)
    float m_reg = -1e30f, l_reg = 0.f; f32x16 o[4];
#pragma unroll
    for (int d = 0; d < 4; ++d)
#pragma unroll
        for (int r = 0; r < 16; ++r) o[d][r] = 0.f;
    SLOAD(0, j_lo * 64); if (MODE == 1) SLOAD(NSET - 1, j_lo * 64 + 64);
    bf16x8 qr[ND0];
    {
      constexpr int NR = (MODE == 0) ? 2 : 4;
      constexpr int R0 = (MODE == 0) ? 8 : 0;
      constexpr float QS = ((MODE == 0) ? 0.07216878364870322f : 0.08838834764831845f) * LOG2E;
      constexpr float FSTEP = LOG2_THETA / ((MODE == 0) ? 32.0f : 64.0f);
      const int tq_ = TOK(qp);
      const bf16_t* qrow = it.q + (size_t)tq_ * it.q_ld + hi * 8;
      u32x4 raw[ND0]; float ssq = 0.f;
#pragma unroll
      for (int d0 = 0; d0 < ND0; ++d0) raw[d0] = *(const u32x4*)(qrow + d0 * 16);
      const float posf = (float)it.pos[tq_];
#pragma unroll
      for (int d0 = 0; d0 < ND0; ++d0) { float v[8]; UNPACK8(raw[d0], v);
#pragma unroll
          for (int e = 0; e < 8; ++e) ssq += v[e] * v[e]; }
      { auto rr = __builtin_amdgcn_permlane32_swap(__float_as_uint(ssq), __float_as_uint(ssq), false, false); ssq = __uint_as_float(rr[0]) + __uint_as_float(rr[1]); }
      const float rq = rsqrtf(ssq * (1.0f / (float)DQK) + EPS) * QS;
      const float* gp = it.gq + hi * 8;
#pragma unroll
      for (int d0 = 0; d0 < ND0; ++d0) {
          if (d0 >= R0 + NR && d0 < R0 + 2 * NR) continue;
          f32x4 g0 = *(const f32x4*)(gp + d0 * 16), g1 = *(const f32x4*)(gp + d0 * 16 + 4);
          if (MODE == 0 && d0 < 8) { g0 *= *(const f32x4*)(it.gk + hi * 8 + d0 * 16); g1 *= *(const f32x4*)(it.gk + hi * 8 + d0 * 16 + 4); }
          float v[8]; UNPACK8(raw[d0], v);
#pragma unroll
          for (int e = 0; e < 8; ++e) v[e] *= rq * (e < 4 ? g0[e & 3] : g1[e & 3]);
          if (d0 >= R0 && d0 < R0 + NR) {
              const f32x4 h0 = *(const f32x4*)(gp + (d0 + NR) * 16), h1 = *(const f32x4*)(gp + (d0 + NR) * 16 + 4);
              float w[8]; UNPACK8(raw[d0 + NR], w);
#pragma unroll
              for (int e = 0; e < 8; ++e) { w[e] *= rq * (e < 4 ? h0[e & 3] : h1[e & 3]);
                  float sn_, cs_; sincos_rev(posf, exp2f(-(float)((d0 - R0) * 16 + hi * 8 + e) * FSTEP) * 0.15915494309189535f, sn_, cs_);
                  const float x1 = v[e], x2 = w[e]; v[e] = x1 * cs_ - x2 * sn_; w[e] = x2 * cs_ + x1 * sn_; }
              qr[d0 + NR] = as_bf(PACK8(w)); }
          qr[d0] = as_bf(PACK8(v)); } }
    SWRITE(0, 0); __syncthreads();
    const int swzr = (((DQK == 128) ? r32 : (r32 >> 1)) & 7) << 4;
    int kro[4];
#pragma unroll
    for (int dd = 0; dd < 4; ++dd) kro[dd] = r32 * RS + ((dd * 32 + hi * 16) ^ swzr);
#pragma unroll 1
    for (int t2 = 0; t2 < NT; t2 += NSET) {
#pragma unroll
      for (int us = 0; us < NSET; ++us) { const int t = t2 + us; if (t < NT) {
        const int kb = (j_lo + t) * 64, buf = t & 1;
        if (MODE == 1) { if (t + 2 < NT) SLOAD(us, kb + 128); } else { if (t + 1 < NT) SLOAD(0, kb + 64); }
#pragma unroll 1
        for (int hf = 0; hf < 2; ++hf) {
            const int kh = kb + 32 * hf;
            const bool act = (kh <= q0 + 31) && (kh + 31 >= lo_w);
            if (act) {
                f32x16 p0;
#pragma unroll
                for (int r = 0; r < 16; ++r) p0[r] = 0.f;
                { const LAS unsigned char* kbp = K_lds + buf * SHM_K + hf * (32 * RS);
#pragma unroll
                  for (int d0 = 0; d0 < ND0; ++d0) {
                      const bf16x8 b0 = *(const LAS bf16x8*)(kbp + kro[d0 & 3] + (d0 >> 2) * 128);
                      p0 = __builtin_amdgcn_mfma_f32_32x32x16_bf16(b0, qr[d0], p0, 0, 0, 0); } }
                if (MODE == 0) { const LAS float* kr_ = (const LAS float*)(lds + KRS_OFF + buf * 256) + 32 * hf + 4 * hi;
#pragma unroll
                    for (int j4 = 0; j4 < 4; ++j4) { const f32x4 s4 = *(const LAS f32x4*)(kr_ + 8 * j4);
#pragma unroll
                        for (int e = 0; e < 4; ++e) p0[4 * j4 + e] *= s4[e]; } }
                if (!((kh + 31 <= q0) && (kh >= lo_last))) {
                    const int dq = qp - kh - 4 * hi; const float NEG = -__builtin_inff();
#pragma unroll
                    for (int r = 0; r < 16; ++r) { const int c = (r & 3) + 8 * (r >> 2); if ((unsigned)(dq - c) > (unsigned)span) p0[r] = NEG; } }
                float pmax = p0[0];
#pragma unroll
                for (int r = 1; r < 16; ++r) pmax = fmaxf(pmax, p0[r]);
                { auto rr = __builtin_amdgcn_permlane32_swap(__float_as_uint(pmax), __float_as_uint(pmax), false, false); pmax = fmaxf(__uint_as_float(rr[0]), __uint_as_float(rr[1])); }
                const float mn = fmaxf(m_reg, pmax), alpha = __builtin_amdgcn_exp2f(m_reg - mn); m_reg = mn;
                float ps = 0.f;
#pragma unroll
                for (int r = 0; r < 16; ++r) { p0[r] = __builtin_amdgcn_exp2f(p0[r] - mn); ps += p0[r]; }
                { auto rr = __builtin_amdgcn_permlane32_swap(__float_as_uint(ps), __float_as_uint(ps), false, false); ps = __uint_as_float(rr[0]) + __uint_as_float(rr[1]); }
                l_reg = l_reg * alpha + ps;
                u32x4 pa0, pa1; PK4(p0, 0, pa0); PK4(p0, 8, pa1);
                if (__any(alpha != 1.0f)) {
#pragma unroll
                    for (int d = 0; d < 4; ++d)
#pragma unroll
                        for (int r = 0; r < 16; ++r) o[d][r] *= alpha; }
                const unsigned vb = (unsigned)(uintptr_t)(V_lds + buf * SHM_V + hf * 8192) + (unsigned)v_rd_base(lane);
#define TRRD(dst, off) asm volatile("ds_read_b64_tr_b16 %0, %1 offset:%2" : "=&v"(dst) : "v"(vb), "i"(off) : "memory")
#define PV_D0(d0) do { s16x4 l0, l1, h0, h1; constexpr int b_ = (d0) * 512; \
                TRRD(l0, b_); TRRD(h0, b_ + 2048); TRRD(l1, b_ + 4096); TRRD(h1, b_ + 6144); \
                asm volatile("s_waitcnt lgkmcnt(0)" ::: "memory"); __builtin_amdgcn_sched_barrier(0); \
                o[d0] = __builtin_amdgcn_mfma_f32_32x32x16_bf16((bf16x8){l0[0], l0[1], l0[2], l0[3], h0[0], h0[1], h0[2], h0[3]}, as_bf(pa0), o[d0], 0, 0, 0); \
                o[d0] = __builtin_amdgcn_mfma_f32_32x32x16_bf16((bf16x8){l1[0], l1[1], l1[2], l1[3], h1[0], h1[1], h1[2], h1[3]}, as_bf(pa1), o[d0], 0, 0, 0); } while (0)
                PV_D0(0); PV_D0(1); PV_D0(2); PV_D0(3);
#undef PV_D0
#undef TRRD
            }
        }
        if (t + 1 < NT) SWRITE((NSET - 1) - us, buf ^ 1);
        __syncthreads();
      } }
    }
    const int tq = TOK(qp);
    float a_cur = 1.0f / l_reg, a_prev = 0.f;
    if (MODE == 1) {
        const float lse_cur = m_reg + __builtin_amdgcn_logf(l_reg); float lse_new = lse_cur;
        if (it.merge) { const float lse_prev = it.lse[(size_t)tq * 8]; const float mx = fmaxf(lse_prev, lse_cur);
            const float e0 = __builtin_amdgcn_exp2f(lse_prev - mx), e1 = __builtin_amdgcn_exp2f(lse_cur - mx); const float inv = 1.0f / (e0 + e1);
            lse_new = mx + __builtin_amdgcn_logf(e0 + e1); a_prev = e0 * inv; a_cur *= e1 * inv; }
        if (hi == 0) it.lse[(size_t)tq * 8] = lse_new;
    }
    bf16_t* orow = it.o + (size_t)tq * it.o_ld + hi * 8;
#pragma unroll
    for (int d0 = 0; d0 < 4; ++d0) {
#pragma unroll
        for (int r = 0; r < 16; ++r) o[d0][r] *= a_cur;
        u32x4 w0, w1; PK4(o[d0], 0, w0); PK4(o[d0], 8, w1);
        if (MODE == 1 && it.merge) {
            const u32x4 q0w = *(const u32x4*)(orow + d0 * 32), q1w = *(const u32x4*)(orow + d0 * 32 + 16);
            float a[8], b[8];
            UNPACK8(w0, a); UNPACK8(q0w, b);
#pragma unroll
            for (int e = 0; e < 8; ++e) a[e] += b[e] * a_prev;
            w0 = PACK8(a);
            UNPACK8(w1, a); UNPACK8(q1w, b);
#pragma unroll
            for (int e = 0; e < 8; ++e) a[e] += b[e] * a_prev;
            w1 = PACK8(a);
        }
        *(u32x4*)(orow + d0 * 32) = w0; *(u32x4*)(orow + d0 * 32 + 16) = w1;
    }
#undef SLOAD
#undef SWRITE
#undef TOK
#undef LOF
}

__device__ void mla_attn_phase(const Params& p, LAS unsigned char* lds, const int* pos, const float* gq, const float* gk) {
    unsigned char* ws = p.ws;
    for (int item = opaque_bid(); item < BH * 16 * 4; item += gridDim.x) {
        const int bh = item >> 2, pr = item & 3, b = bh >> 4, h = bh & 15; const size_t tb = (size_t)b * SEQ;
        AttnItem it; it.q = (const bf16_t*)(ws + WS_Q) + tb * 3072 + h * 192; it.q_ld = 3072;
        it.k = (const bf16_t*)(ws + WS_KV) + tb * 4096 + h * 256; it.k_ld = 4096; it.kpe = (const bf16_t*)(ws + WS_KPER) + tb * 64; it.kpe_ld = 64; it.gk = gk; it.ssk = (const float*)(ws + WS_SSK) + (tb * 16 + h) * 4; it.ssl = (const float*)(ws + WS_SSL) + tb * 16 + 8;
        it.v = (const bf16_t*)(ws + WS_KV) + tb * 4096 + h * 256 + 128; it.v_ld = 4096; it.o = (bf16_t*)(ws + WS_AO) + tb * 2048 + h * 128; it.o_ld = 2048;
        it.lse = nullptr; it.ld = 0; it.merge = 0; it.pos = pos + tb; it.gq = gq;
#pragma unroll 1
        for (int k2 = 0; k2 < 2; ++k2) { it.P0 = (k2 == 0 ? 7 - pr : pr) * 256; attn_block<192, 0>(it, lds); }
    }
}
__device__ void dil_attn_phase(const Params& p, LAS unsigned char* lds, int g, const int* pos, const float* gq) {
    unsigned char* ws = p.ws;
    for (int item = opaque_bid(); item < BH * 8 * 8; item += gridDim.x) {
        const int bh = item >> 3, qb = item & 7, b = bh >> 3, h = bh & 7, hh = g * 8 + h; const size_t tb = (size_t)b * SEQ;
        AttnItem it; it.q = (const bf16_t*)(ws + WS_QB) + tb * 3072 + hh * 128; it.q_ld = 3072;
        it.k = (const bf16_t*)(ws + WS_KVB) + tb * 6144 + hh * 128; it.k_ld = 6144; it.kpe = nullptr; it.kpe_ld = 0; it.gk = nullptr; it.ssk = nullptr; it.ssl = nullptr;
        it.v = (const bf16_t*)(ws + WS_KVB) + tb * 6144 + 3072 + hh * 128; it.v_ld = 6144; it.o = (bf16_t*)(ws + WS_OB) + tb * 1024 + h * 128; it.o_ld = 1024;
        it.lse = (float*)(ws + WS_LSE) + tb * 8 + h; it.ld = 2 * g; it.merge = g > 0; it.P0 = qb * 256; it.pos = pos + tb; it.gq = gq + g * 128;
        attn_block<128, 1>(it, lds);
    }
}

#define XB_TMO      128
#define XB_XCNT(j)  (256  + 64 * (j))
#define XB_XSUB(j)  (1280 + 64 * (j))
#define XB_XGEN(j)  (2304 + 64 * (j))
#define XB_TOP      3328
#define XB_TOPGEN   3392
#define XCD_BAR_WORDS 3456
#define XB_SPIN_CAP (1u << 18)

__device__ __forceinline__ unsigned xb_ld(unsigned* p)              { return __hip_atomic_load(p, __ATOMIC_RELAXED, __HIP_MEMORY_SCOPE_AGENT); }
__device__ __forceinline__ unsigned xb_add(unsigned* p, unsigned v) { return __hip_atomic_fetch_add(p, v, __ATOMIC_RELAXED, __HIP_MEMORY_SCOPE_AGENT); }
__device__ __forceinline__ unsigned xb_xcc_id() { return (unsigned)__builtin_amdgcn_s_getreg((3 << 11) | 20) & 0xFu; }
#define XB_SPIN(cond, bar) do { unsigned _sp = 0; while (cond) { __builtin_amdgcn_s_sleep(1); \
    if ((++_sp & 255u) == 0u) { if (xb_ld(&(bar)[XB_TMO])) break; if (_sp > XB_SPIN_CAP) { atomicAdd(&(bar)[XB_TMO], 1u); break; } } } } while (0)

struct XcdBarrier {
    unsigned* bar; unsigned x;
    volatile LAS unsigned* st;
};

__device__ __forceinline__ XcdBarrier xcd_barrier_post(unsigned* bar, volatile LAS unsigned* st) {
    XcdBarrier b; b.bar = bar; b.x = xb_xcc_id(); b.st = st;
    if (threadIdx.x == 0) (void)xb_add(&bar[XB_XCNT(b.x)], 1u);
    return b;
}
__device__ __forceinline__ void xcd_barrier_complete(unsigned* bar, unsigned x, unsigned& nloc, unsigned& nx) {
    const unsigned G = gridDim.x * gridDim.y * gridDim.z;
    unsigned sum, cnt, mine, sp = 0u;
    for (;;) {
        sum = 0u; cnt = 0u; mine = 0u;
#pragma unroll
        for (unsigned j = 0; j < 16; ++j) { const unsigned c = xb_ld(&bar[XB_XCNT(j)]); sum += c; cnt += (c > 0u) ? 1u : 0u; mine = (j == x) ? c : mine; }
        if (sum == G) break;
        __builtin_amdgcn_s_sleep(1);
        if ((++sp & 255u) == 0u) { if (xb_ld(&bar[XB_TMO])) break; if (sp > XB_SPIN_CAP) { atomicAdd(&bar[XB_TMO], 1u); break; } }
    }
    nloc = mine > 0u ? mine : 1u; nx = cnt > 0u ? cnt : 1u;
}

__device__ __forceinline__ void xcd_barrier(const XcdBarrier& b) {
    asm volatile("s_waitcnt vmcnt(0)" ::: "memory");
    __syncthreads();
    if (threadIdx.x == 0) {
        unsigned* bar = b.bar;
        __builtin_amdgcn_s_waitcnt(0);
        unsigned nloc = b.st[0], nx = b.st[1];
        if (nloc == 0u) { xcd_barrier_complete(bar, b.x, nloc, nx); b.st[0] = nloc; b.st[1] = nx; }
        const unsigned old = xb_add(&bar[XB_XSUB(b.x)], 1u);
        const unsigned gen = old / nloc;
        if (old + 1u == (gen + 1u) * nloc) {
            __builtin_amdgcn_fence(__ATOMIC_RELEASE, "agent");
            asm volatile("s_waitcnt vmcnt(0)" ::: "memory");
            const unsigned og = xb_add(&bar[XB_TOP], 1u);
            const unsigned tg = og / nx;
            if (og + 1u == (tg + 1u) * nx) xb_add(&bar[XB_TOPGEN], 1u);
            else XB_SPIN(xb_ld(&bar[XB_TOPGEN]) == tg, bar);
            __builtin_amdgcn_fence(__ATOMIC_ACQUIRE, "agent");
            xb_add(&bar[XB_XGEN(b.x)], 1u);
            asm volatile("s_waitcnt vmcnt(0)" ::: "memory");
        } else {
            XB_SPIN(xb_ld(&bar[XB_XGEN(b.x)]) == gen, bar);
            __builtin_amdgcn_fence(__ATOMIC_ACQUIRE, "agent");
            asm volatile("s_waitcnt vmcnt(0)" ::: "memory");
        }
    }
    __syncthreads();
}

constexpr int NPH_HALF = 1 + 2 * 6 + 8 + 7;
#ifndef SKIP_MASK
#define SKIP_MASK 0
#endif
__global__ void __launch_bounds__(NTHR) mega(Params p) {
    extern __shared__ __attribute__((aligned(16))) unsigned char lds_raw[];
    LAS unsigned char* lds = (LAS unsigned char*)lds_raw;
    cg::grid_group grid = cg::this_grid();
    unsigned char* ws = p.ws;
    bf16_t* XB = (bf16_t*)(ws + WS_XB); float* SS = (float*)(ws + WS_SS); bf16_t* HB = (bf16_t*)(ws + WS_H);
    bf16_t* LAT = (bf16_t*)(ws + WS_LAT); bf16_t* Q = (bf16_t*)(ws + WS_Q); bf16_t* KV = (bf16_t*)(ws + WS_KV); bf16_t* KPE = (bf16_t*)(ws + WS_KPE); bf16_t* AO = (bf16_t*)(ws + WS_AO);
    bf16_t* KVB = (bf16_t*)(ws + WS_KVB); bf16_t* QB = (bf16_t*)(ws + WS_QB); bf16_t* OB = (bf16_t*)(ws + WS_OB);
#ifndef PROBE_MASK
#define PROBE_MASK 0
#endif
    unsigned long long probe_acc = 0ull;
    volatile LAS unsigned* bar_st = (volatile LAS unsigned*)(lds + 131072);
    if (threadIdx.x < 4) bar_st[threadIdx.x] = 0u;
    __syncthreads();
    XcdBarrier xbar = xcd_barrier_post((unsigned*)(ws + WS_BAR), bar_st);
#pragma unroll 1
    for (int ph = p.ph_lo; ph < p.ph_hi; ++ph) {
        const unsigned long long probe_t0 = PROBE_MASK ? __builtin_amdgcn_s_memrealtime() : 0ull;
        const int hb = ph >= NPH_HALF ? 1 : 0, li = ph - hb * NPH_HALF;
        const size_t toff = (size_t)hb * TH;
        const float* xin0 = (const float*)p.in[0] + toff * DM; float* xo = p.out + toff * DM; const int* pos = (const int*)p.in[1] + toff;
        int lyr = 0, j = -1;
        if (li >= 21) { lyr = 3; const int jm = li - 21; j = jm == 0 ? 0 : jm + 1; }
        else if (li >= 13) { lyr = 2; j = li - 13; }
        else if (li >= 1) { lyr = (li - 1) / 6; const int jm = (li - 1) - lyr * 6; j = jm == 0 ? 0 : jm == 1 ? 2 : jm + 2; }
        const bool mla = lyr < 2; const int ab = lyr & 1;
        int gk = 0;
        const bf16_t* A = nullptr; const bf16_t* Bt = nullptr; int lda = 0, N = 0, K = 0, nsub = 1;
        EpiBf16S E1{nullptr, 0, nullptr, 0, 1 << 30, nullptr, 4, 1.0f / 1024.0f, 0, nullptr, nullptr}; EpiRes E2{nullptr, nullptr, XB, SS};
        float* SSL = (float*)(ws + WS_SSL);
        if (li > 0) {
            if (j == 6) { gk = 1; A = XB; lda = 1024; Bt = (const bf16_t*)(ws + WS_W1) + (size_t)lyr * 4096 * 1024; N = 4096; K = 1024; E1.O = HB; E1.ldc = 4096; E1.ss = SS; E1.act = 1; }
            else if (j == 7) { gk = 2; A = HB; lda = 4096; Bt = (const bf16_t*)(ws + WS_W2) + (size_t)lyr * 1024 * 4096; N = 1024; K = 4096; E2.xin = xo; E2.xout = xo; }
            else if (j == 5) { gk = 2; N = 1024; E2.xin = lyr == 0 ? xin0 : xo; E2.xout = xo;
                if (mla) { A = AO; lda = 2048; K = 2048; Bt = (const bf16_t*)(ws + WS_WO) + (size_t)ab * 1024 * 2048; }
                else { A = OB; lda = 1024; K = 1024; Bt = (const bf16_t*)(ws + WS_WOB) + (size_t)ab * 1024 * 1024; } }
            else if (j == 0) { gk = 1; A = XB; lda = 1024; K = 1024; E1.ss = SS;
                if (mla) { Bt = (const bf16_t*)(ws + WS_WIN) + (size_t)ab * 512 * 1024; N = 512; E1.O = LAT; E1.ldc = 512; E1.ssl = SSL; }
                else if (ab == 0) { Bt = (const bf16_t*)(ws + WS_WKVQ); N = 9216; E1.O = KVB; E1.ldc = 6144; E1.O2 = QB; E1.ldc2 = 3072; E1.split = 6144; }
                else { Bt = (const bf16_t*)(ws + WS_WQ1); N = 3072; E1.O = QB; E1.ldc = 3072; } }
            else if (j == 2 && mla) { gk = 1; nsub = 2; A = LAT; lda = 512; K = 256; Bt = (const bf16_t*)(ws + WS_WQB) + (size_t)ab * 3072 * 256; N = 3072; E1.O = Q; E1.ldc = 3072; E1.ss = SSL; E1.nsl4 = 1; E1.inv_n = 1.0f / 256.0f; }
        }
        if (!(SKIP_MASK & 1) && gk == 1) {
            if (nsub == 2) kpe_prep(LAT, pos, (const float*)p.in[10] + ab * 192, (bf16_t*)(ws + WS_KPER));
#pragma unroll 1
            for (int sub = 0; sub < nsub; ++sub) {
                if (sub == 1) { A = LAT + 256; Bt = (const bf16_t*)(ws + WS_WKVB) + (size_t)ab * 4096 * 256; N = 4096; E1.O = KV; E1.ldc = 4096; E1.ss = SSL + 4; E1.inv_n = 1.0f / 128.0f; E1.ssk = (float*)(ws + WS_SSK); }
                run_gemm(lds, A, lda, Bt, N, K, E1);
            }
        } else if (!(SKIP_MASK & 2) && gk == 2) {
            run_gemm(lds, A, lda, Bt, N, K, E2);
        } else if (li == 0) {
            if (!(SKIP_MASK & 4)) { if (hb == 0) prep_weights(p, lds); prep_x(xin0, XB, SS); }
        } else if (mla) {
            if (j == 4) { if (!(SKIP_MASK & 32)) mla_attn_phase(p, lds, pos, (const float*)p.in[9] + ab * 192, (const float*)p.in[10] + ab * 192); }
        } else {
            if (j == 1) { if (!(SKIP_MASK & 64)) head_prep(ab == 0 ? KVB : nullptr, QB, pos, (const float*)p.in[14], (const float*)p.in[16] + ab * 384); }
            else if (j >= 2 && j <= 4) { if (!(SKIP_MASK & 128)) dil_attn_phase(p, lds, j - 2, pos, (const float*)p.in[16] + ab * 384); }
        }
        if (ph + 1 < p.ph_hi) { if (ph == p.ph_lo) grid.sync(); else xcd_barrier(xbar); }
        if (PROBE_MASK) { const int cat = gk == 1 ? 1 : gk == 2 ? 2 : li == 0 ? 3 : mla ? (j == 1 ? 4 : j == 3 ? 5 : 6) : (j == 1 ? 7 : 8);
            if ((PROBE_MASK >> cat) & 1) probe_acc += __builtin_amdgcn_s_memrealtime() - probe_t0; }
    }
    if (PROBE_MASK && blockIdx.x == 0) { const unsigned long long t1 = __builtin_amdgcn_s_memrealtime(); while (__builtin_amdgcn_s_memrealtime() - t1 < probe_acc) __builtin_amdgcn_s_sleep(16); }
}
constexpr int N_PHASES = 2 * NPH_HALF;

extern "C" void kernel_launch(void* const* d_in, const int* in_sizes, int n_in, void* d_out, int out_size, void* d_ws, size_t ws_size, hipStream_t stream) {
    static int grid_blocks = 0;
    if (!grid_blocks) {
        int dev = 0, cus = 0, per_cu = 0;
        (void)hipGetDevice(&dev);
        (void)hipDeviceGetAttribute(&cus, hipDeviceAttributeMultiprocessorCount, dev);
        (void)hipFuncSetAttribute((const void*)mega, hipFuncAttributeMaxDynamicSharedMemorySize, LDS_BYTES);
        (void)hipOccupancyMaxActiveBlocksPerMultiprocessor(&per_cu, (const void*)mega, NTHR, LDS_BYTES);
        (void)hipGetLastError();
        grid_blocks = cus > 0 ? cus : 256;
        if (ws_size < WS_END || n_in != 20) { fprintf(stderr, "kernel_launch: workspace %zu < %zu or n_in %d != 20\n", ws_size, (size_t)WS_END, n_in); }
    }
    (void)hipMemsetAsync((unsigned char*)d_ws + WS_BAR, 0, XCD_BAR_WORDS * sizeof(unsigned), stream);
    Params p{};
    for (int i = 0; i < 20; ++i) p.in[i] = d_in[i];
    p.out = (float*)d_out; p.ws = (unsigned char*)d_ws;
#if ONE_LAUNCH
    p.ph_lo = 0; p.ph_hi = N_PHASES;
    void* args[] = {&p};
    hipError_t e = hipLaunchCooperativeKernel((const void*)mega, dim3(grid_blocks), dim3(NTHR), args, LDS_BYTES, stream);
    if (e != hipSuccess) fprintf(stderr, "cooperative launch failed: %s (grid %d)\n", hipGetErrorString(e), grid_blocks);
#else
    for (int ph = 0; ph < N_PHASES; ++ph) { p.ph_lo = ph; p.ph_hi = ph + 1; hipLaunchKernelGGL(mega, dim3(grid_blocks), dim3(NTHR), LDS_BYTES, stream, p); }
#endif
}
```

```cpp
#include <hip/hip_runtime.h>
#include <hip/hip_cooperative_groups.h>
#include <cstdio>
#include <cstdint>
namespace cg = cooperative_groups;

#ifndef ONE_LAUNCH
#define ONE_LAUNCH 1
#endif

__device__ __forceinline__ int opaque_tid() { int t = (int)threadIdx.x; asm volatile("" : "+v"(t)); return t; }
__device__ __forceinline__ int opaque_bid() { int b = (int)blockIdx.x; asm volatile("" : "+s"(b)); return b; }
namespace pg8 {
#define PG8_LAS __attribute__((address_space(3)))
typedef unsigned short bf16_t;
typedef short bf16x8 __attribute__((ext_vector_type(8)));
typedef float f32x4 __attribute__((ext_vector_type(4)));
typedef unsigned u32x4 __attribute__((ext_vector_type(4)));
constexpr int BM = 256, BK = 64, HALF = 128, HTB = HALF * BK * 2  , STAGE_BYTES = 8 * HTB, NXCD = 8, WGM = 8;

__host__ __device__ __forceinline__ int lds_byte(int r, int c) { const int st = (r >> 4) * 2 + (c >> 5), rr = r & 15, cc = c & 31, ob = rr * 64 + cc * 2; return st * 1024 + (ob ^ (((ob >> 9) & 1) << 5)); }
__host__ __device__ __forceinline__ void stage_rc(int b, int& R, int& C) { const int st = b / 1024, sb = b % 1024, swz = sb ^ (((sb >> 9) & 1) << 5); R = (st >> 1) * 16 + swz / 64; C = (st & 1) * 32 + (swz % 64) / 2; }
__host__ __device__ __forceinline__ int perm32(int rho) { const int n = rho >> 4, i = rho & 15; return 8 * (i >> 2) + 4 * n + (i & 3); }
struct Unit { int pm, pn; };
struct Gemm { const bf16_t* A; const bf16_t* Bt; int M, N, K, lda; };
struct StaticOrder {
    int nM, nN, nwg, G, c;
    __host__ __device__ void init(int M, int N, int G_, int c_) { nM = M / BM; nN = N / BM; nwg = nM * nN; G = G_; c = c_; }
    __host__ __device__ bool next(int i, Unit& u) const {
        const long L = (long)i * G + c; if (L >= nwg) return false;
        int wgid = (int)L; { const int q = nwg / NXCD, r = nwg % NXCD, xcd = wgid % NXCD, off = wgid / NXCD; wgid = (xcd < r ? xcd * (q + 1) : r * (q + 1) + (xcd - r) * q) + off; }
        const int nig = WGM * nN, gid = wgid / nig, fm = gid * WGM, gsz = (nM - fm) < WGM ? (nM - fm) : WGM;
        u.pm = fm + ((wgid % nig) % gsz); u.pn = (wgid % nig) / gsz; return true;
    }
    __device__ __forceinline__ void a_ready(const Unit&) const {}
    __device__ __forceinline__ void done(const Unit&) const {}
};
__device__ __forceinline__ unsigned cvt_pk_bf16(float lo, float hi) { unsigned r; asm volatile("v_cvt_pk_bf16_f32 %0, %1, %2" : "=v"(r) : "v"(lo), "v"(hi)); return r; }
template <class Epi, class Sched>
__device__ __forceinline__ void gemm_phase(PG8_LAS unsigned char* lds, const Gemm g, const Sched& S, const Epi& E) {
    const int tid = opaque_tid(), wid = __builtin_amdgcn_readfirstlane(tid >> 6), lane = tid & 63, wr = wid >> 2, wc = wid & 3, fr = lane & 15, fq = lane >> 4;
    const int K = g.K, nt = K / BK;
    unsigned voffA[2], voffB[2];
#pragma unroll
    for (int i = 0; i < 2; ++i) { int R, C; stage_rc(tid * 16 + i * 8192, R, C); const int Rb = Epi::PERM ? ((R & ~31) + perm32(R & 31)) : R;
        voffA[i] = (unsigned)(R * g.lda + C) * 2u; voffB[i] = (unsigned)(Rb * K + C) * 2u; }
    const size_t kstep = (size_t)(BK * 2);
    const size_t hstep = (size_t)HALF * K * 2, hstepA = (size_t)HALF * g.lda * 2;
    const size_t tstep = 2 * hstep, tstepA = 2 * hstepA;
    const unsigned ldsw = (unsigned)wid * 1024u;
    const int aoff = lds_byte(wr * 64 + fr, fq * 8), boff = lds_byte(wc * 32 + fr, fq * 8);
#define PG8_SA(b, h) (((b) * 2 + (h)) * HTB)
#define PG8_SB(b, h) ((4 + (b) * 2 + (h)) * HTB)
#define PG8_STAGE(bufoff, gbase, voff) do { _Pragma("unroll") for (int _i = 0; _i < 2; ++_i) \
        __builtin_amdgcn_global_load_lds((const unsigned*)((const char*)(gbase) + (voff)[_i]), (PG8_LAS unsigned*)(lds + (bufoff) + ldsw + _i * 8192), 16, 0, 0); } while (0)
#define PG8_LDA(dst, b, h) do { _Pragma("unroll") for (int m = 0; m < 4; ++m) _Pragma("unroll") for (int k = 0; k < 2; ++k) dst[m][k] = *(const PG8_LAS bf16x8*)(lds + PG8_SA(b, h) + aoff + m * 2048 + k * 1024); } while (0)
#define PG8_LDB(dst, b, h) do { _Pragma("unroll") for (int n = 0; n < 2; ++n) _Pragma("unroll") for (int k = 0; k < 2; ++k) dst[n][k] = *(const PG8_LAS bf16x8*)(lds + PG8_SB(b, h) + boff + n * 2048 + k * 1024); } while (0)
#define PG8_MMA(ai, bj, At, Bt) do { __builtin_amdgcn_s_setprio(1); _Pragma("unroll") for (int m = 0; m < 4; ++m) _Pragma("unroll") for (int n = 0; n < 2; ++n) _Pragma("unroll") for (int k = 0; k < 2; ++k) \
        acc[ai][bj][m][n] = __builtin_amdgcn_mfma_f32_16x16x32_bf16(Bt[n][k], At[m][k], acc[ai][bj][m][n], 0, 0, 0); __builtin_amdgcn_s_setprio(0); } while (0)
#define PG8_WAIT_V(n) asm volatile("s_waitcnt vmcnt(" #n ")" ::: "memory")
#define PG8_WAIT_L(n) asm volatile("s_waitcnt lgkmcnt(" #n ")" ::: "memory")
#define PG8_BAR __builtin_amdgcn_s_barrier()
#define PG8_SCHED __builtin_amdgcn_sched_barrier(0)
    Unit cur, nxt; int ui = 0;
    if (!S.next(0, cur)) return;
    f32x4 acc[2][2][4][2];
#pragma unroll
    for (int a = 0; a < 2; ++a)
#pragma unroll
        for (int b = 0; b < 2; ++b)
#pragma unroll
            for (int m = 0; m < 4; ++m)
#pragma unroll
                for (int n = 0; n < 2; ++n) acc[a][b][m][n] = (f32x4){0.f, 0.f, 0.f, 0.f};
    bf16x8 At[4][2], B0[2][2], B1[2][2];
    const char* cA = (const char*)g.A + (size_t)cur.pm * tstepA; const char* cB = (const char*)g.Bt + (size_t)cur.pn * tstep;
    S.a_ready(cur);
    PG8_STAGE(PG8_SB(0, 0), cB, voffB); PG8_STAGE(PG8_SA(0, 0), cA, voffA); PG8_STAGE(PG8_SB(0, 1), cB + hstep, voffB); PG8_STAGE(PG8_SA(0, 1), cA + hstepA, voffA);
    if (wr == 1) PG8_BAR;
    PG8_WAIT_V(4); PG8_BAR;
    PG8_STAGE(PG8_SB(1, 0), cB + kstep, voffB); PG8_STAGE(PG8_SA(1, 0), cA + kstep, voffA); PG8_STAGE(PG8_SB(1, 1), cB + hstep + kstep, voffB);
    PG8_WAIT_V(6); PG8_BAR;
    for (;;) {
        const bool has_next = S.next(ui + 1, nxt);
        const char* nA = has_next ? (const char*)g.A + (size_t)nxt.pm * tstepA : cA; const char* nB = has_next ? (const char*)g.Bt + (size_t)nxt.pn * tstep : cB;
        for (int t = 0; t < nt; t += 2) {
            const bool last = (t == nt - 2);
            const char* a1 = cA + (size_t)(t + 1) * kstep;
            const char* a2 = last ? nA : cA + (size_t)(t + 2) * kstep; const char* b2 = last ? nB : cB + (size_t)(t + 2) * kstep;
            const char* a3 = a2 + kstep; const char* b3 = b2 + kstep;
            if (last && has_next) S.a_ready(nxt);
            PG8_LDB(B0, 0, 0); PG8_SCHED; PG8_LDA(At, 0, 0); PG8_STAGE(PG8_SA(1, 1), a1 + hstepA, voffA);
            PG8_WAIT_L(8); PG8_BAR; PG8_WAIT_L(0); PG8_MMA(0, 0, At, B0); PG8_BAR; PG8_SCHED;
            PG8_LDB(B1, 0, 1); PG8_STAGE(PG8_SB(0, 0), b2, voffB);
            PG8_BAR; PG8_WAIT_L(0); PG8_MMA(0, 1, At, B1); PG8_BAR;
            PG8_LDA(At, 0, 1); PG8_STAGE(PG8_SA(0, 0), a2, voffA);
            PG8_BAR; PG8_WAIT_L(0); PG8_MMA(1, 0, At, B0); PG8_BAR; PG8_SCHED;
            PG8_STAGE(PG8_SB(0, 1), b2 + hstep, voffB);
            PG8_WAIT_V(6); PG8_BAR; PG8_MMA(1, 1, At, B1); PG8_BAR;
            PG8_LDB(B0, 1, 0); PG8_SCHED; PG8_LDA(At, 1, 0); PG8_STAGE(PG8_SA(0, 1), a2 + hstepA, voffA);
            PG8_WAIT_L(8); PG8_BAR; PG8_WAIT_L(0); PG8_MMA(0, 0, At, B0); PG8_BAR; PG8_SCHED;
            PG8_LDB(B1, 1, 1); PG8_STAGE(PG8_SB(1, 0), b3, voffB);
            PG8_BAR; PG8_WAIT_L(0); PG8_MMA(0, 1, At, B1); PG8_BAR;
            PG8_LDA(At, 1, 1); PG8_STAGE(PG8_SA(1, 0), a3, voffA);
            PG8_BAR; PG8_WAIT_L(0); PG8_MMA(1, 0, At, B0); PG8_BAR; PG8_SCHED;
            PG8_STAGE(PG8_SB(1, 1), b3 + hstep, voffB);
            PG8_WAIT_V(6); PG8_BAR; PG8_MMA(1, 1, At, B1); PG8_BAR;
        }
        if constexpr (!Epi::AFTER_DRAIN) { E(acc, cur, wr, wc, fr, fq); S.done(cur); }
        if (!has_next) break;
#pragma unroll
        for (int a = 0; a < 2; ++a)
#pragma unroll
            for (int b = 0; b < 2; ++b)
#pragma unroll
                for (int m = 0; m < 4; ++m)
#pragma unroll
                    for (int n = 0; n < 2; ++n) acc[a][b][m][n] = (f32x4){0.f, 0.f, 0.f, 0.f};
        cur = nxt; cA = nA; cB = nB; ++ui;
    }
    PG8_WAIT_V(0);
    if (wr == 0) PG8_BAR;
    PG8_BAR;
    if constexpr (Epi::AFTER_DRAIN) { E.fused(acc, cur, wr, wc, fr, fq, lds, wid, lane); S.done(cur); }
#undef PG8_SA
#undef PG8_SB
#undef PG8_STAGE
#undef PG8_LDA
#undef PG8_LDB
#undef PG8_MMA
#undef PG8_WAIT_V
#undef PG8_WAIT_L
#undef PG8_BAR
#undef PG8_SCHED
}
}
using pg8::bf16_t; using pg8::bf16x8; using pg8::f32x4; using pg8::u32x4;
#define LAS __attribute__((address_space(3)))
typedef short s16x4 __attribute__((ext_vector_type(4)));
typedef float f32x16 __attribute__((ext_vector_type(16)));
typedef unsigned u32x2 __attribute__((ext_vector_type(2)));

constexpr int SEQ = 2048, DM = 1024, NBATCH = 16, TT = NBATCH * SEQ, TH = TT / 2, BH = NBATCH / 2, DFF = 4096;
constexpr float EPS = 1e-6f, LOG2E = 1.4426950408889634f, LOG2_THETA = 13.287712379549449f;
constexpr int NTHR = 512;
constexpr int LDS_BYTES = 131072 + 4096;
constexpr size_t MiB = (size_t)1 << 20;
constexpr size_t WS_WIN = 0, WS_WQB = WS_WIN + 2 * MiB, WS_WKVB = WS_WQB + 3 * MiB, WS_WO = WS_WKVB + 4 * MiB, WS_WKVQ = WS_WO + 8 * MiB, WS_WQ1 = WS_WKVQ + 18 * MiB,
                 WS_WOB = WS_WQ1 + 6 * MiB, WS_W1 = WS_WOB + 4 * MiB, WS_W2 = WS_W1 + 32 * MiB, WS_XB = WS_W2 + 32 * MiB, WS_SS = WS_XB + 32 * MiB, WS_LSE = WS_SS + 1 * MiB,
                 WS_BAR = WS_LSE + 768 * 1024, WS_SSL = WS_LSE + 1 * MiB, WS_BIG = WS_SSL + 1 * MiB;
constexpr size_t WS_LAT = WS_BIG, WS_Q = WS_LAT + 16 * MiB, WS_KV = WS_Q + 96 * MiB, WS_KPE = WS_KV + 128 * MiB, WS_AO = WS_KPE + 32 * MiB;
constexpr size_t WS_SSK = WS_KPE, WS_KPER = WS_KPE + 8 * MiB;
constexpr size_t WS_KVB = WS_BIG, WS_QB = WS_BIG + 192 * MiB, WS_OB = WS_BIG + 288 * MiB;
constexpr size_t WS_H = WS_BIG + 192 * MiB;
constexpr size_t WS_END = WS_BIG + 336 * MiB;

struct Params { const void* in[20]; float* out; unsigned char* ws; int ph_lo, ph_hi; };

__device__ __forceinline__ unsigned cvtpk(float lo, float hi) { unsigned r; asm volatile("v_cvt_pk_bf16_f32 %0, %1, %2" : "=v"(r) : "v"(lo), "v"(hi)); return r; }
__device__ __forceinline__ float bf_lo(unsigned w) { return __uint_as_float(w << 16); }
__device__ __forceinline__ float bf_hi(unsigned w) { return __uint_as_float(w & 0xffff0000u); }
#define UNPACK8(W_, V_) do { const u32x4 t_ = (W_); V_[0] = bf_lo(t_[0]); V_[1] = bf_hi(t_[0]); V_[2] = bf_lo(t_[1]); V_[3] = bf_hi(t_[1]); V_[4] = bf_lo(t_[2]); V_[5] = bf_hi(t_[2]); V_[6] = bf_lo(t_[3]); V_[7] = bf_hi(t_[3]); } while (0)
#define PACK8(V_) ((u32x4){cvtpk(V_[0], V_[1]), cvtpk(V_[2], V_[3]), cvtpk(V_[4], V_[5]), cvtpk(V_[6], V_[7])})
__device__ __forceinline__ void sincos_rev(float pos, float invf_rev, float& s, float& c) {
    float rev = pos * invf_rev; rev = rev - floorf(rev);
    s = __builtin_amdgcn_sinf(rev); c = __builtin_amdgcn_cosf(rev);
}

__device__ __forceinline__ void cvt_job(const float* __restrict__ W, int K, int N, const float* __restrict__ gain, bf16_t* __restrict__ dst, int ldo, int& base, LAS float* tile) {
    const int tk = K / 64, tn = N / 64, nt = tk * tn, G = (int)gridDim.x, tid = opaque_tid();
    int start = (opaque_bid() - (base % G)); if (start < 0) start += G;
    for (int t0 = start; t0 < nt; t0 += 4 * G) {
        f32x4 v[4][2]; float g[4][2];
#pragma unroll
        for (int q = 0; q < 4; ++q) { const int t = t0 + q * G; if (t < nt) { const int kt = t / tn, ntile = t - kt * tn;
#pragma unroll
            for (int i = 0; i < 2; ++i) { const int k = (tid >> 4) + 32 * i, n4 = (tid & 15) * 4;
                v[q][i] = *(const f32x4*)(W + (size_t)(kt * 64 + k) * N + ntile * 64 + n4); g[q][i] = gain ? gain[kt * 64 + k] : 1.0f; } } }
        __syncthreads();
#pragma unroll
        for (int q = 0; q < 4; ++q) { const int t = t0 + q * G; if (t < nt) { LAS float* tq = tile + q * (64 * 65);
#pragma unroll
            for (int i = 0; i < 2; ++i) { const int k = (tid >> 4) + 32 * i, n4 = (tid & 15) * 4;
                tq[(n4 + 0) * 65 + k] = v[q][i].x * g[q][i]; tq[(n4 + 1) * 65 + k] = v[q][i].y * g[q][i]; tq[(n4 + 2) * 65 + k] = v[q][i].z * g[q][i]; tq[(n4 + 3) * 65 + k] = v[q][i].w * g[q][i]; } } }
        __syncthreads();
#pragma unroll
        for (int q = 0; q < 4; ++q) { const int t = t0 + q * G; if (t < nt) { const int kt = t / tn, ntile = t - kt * tn; const int n = tid >> 3, k8 = (tid & 7) * 8;
            const LAS float* tp = tile + q * (64 * 65) + n * 65 + k8;
            u32x4 w; w.x = cvtpk(tp[0], tp[1]); w.y = cvtpk(tp[2], tp[3]); w.z = cvtpk(tp[4], tp[5]); w.w = cvtpk(tp[6], tp[7]);
            *(u32x4*)(dst + (size_t)(ntile * 64 + n) * ldo + kt * 64 + k8) = w; } }
    }
    base += nt;
}
__device__ __forceinline__ void zero_fill(bf16_t* dst, int rows, int cols8, int ld) {
    const size_t n = (size_t)rows * cols8;
    for (size_t i = (size_t)opaque_bid() * NTHR + opaque_tid(); i < n; i += (size_t)gridDim.x * NTHR) { const size_t r = i / cols8, c = i - r * cols8; *(u32x4*)(dst + r * ld + c * 8) = (u32x4){0u, 0u, 0u, 0u}; }
}
__device__ void prep_weights(const Params& p, LAS unsigned char* lds) {
    LAS float* tile = (LAS float*)lds;
    unsigned char* ws = p.ws;
    const float* attn_norm = (const float*)p.in[2]; const float* mlp_norm = (const float*)p.in[3];
    int base = 0;
    for (int a = 0; a < 2; ++a) {
        cvt_job((const float*)p.in[4] + (size_t)a * 1024 * 448, 1024, 448, attn_norm + a * 1024, (bf16_t*)(ws + WS_WIN) + (size_t)a * 512 * 1024, 1024, base, tile);
        cvt_job((const float*)p.in[7] + (size_t)a * 256 * 3072, 256, 3072, (const float*)p.in[5] + a * 256, (bf16_t*)(ws + WS_WQB) + (size_t)a * 3072 * 256, 256, base, tile);
        cvt_job((const float*)p.in[8] + (size_t)a * 128 * 4096, 128, 4096, (const float*)p.in[6] + a * 128, (bf16_t*)(ws + WS_WKVB) + (size_t)a * 4096 * 256, 256, base, tile);
        cvt_job((const float*)p.in[11] + (size_t)a * 2048 * 1024, 2048, 1024, nullptr, (bf16_t*)(ws + WS_WO) + (size_t)a * 1024 * 2048, 2048, base, tile);
        cvt_job((const float*)p.in[17] + (size_t)a * 1024 * 1024, 1024, 1024, nullptr, (bf16_t*)(ws + WS_WOB) + (size_t)a * 1024 * 1024, 1024, base, tile);
        zero_fill((bf16_t*)(ws + WS_WIN) + (size_t)a * 512 * 1024 + (size_t)448 * 1024, 64, 128, 1024);
        zero_fill((bf16_t*)(ws + WS_WKVB) + (size_t)a * 4096 * 256 + 128, 4096, 16, 256);
    }
    cvt_job((const float*)p.in[13], 1024, 6144, (const float*)p.in[12], (bf16_t*)(ws + WS_WKVQ), 1024, base, tile);
    cvt_job((const float*)p.in[15], 1024, 3072, attn_norm + 2 * 1024, (bf16_t*)(ws + WS_WKVQ) + (size_t)6144 * 1024, 1024, base, tile);
    cvt_job((const float*)p.in[15] + (size_t)1024 * 3072, 1024, 3072, attn_norm + 3 * 1024, (bf16_t*)(ws + WS_WQ1), 1024, base, tile);
    for (int l = 0; l < 4; ++l) {
        cvt_job((const float*)p.in[18] + (size_t)l * 1024 * 4096, 1024, 4096, mlp_norm + l * 1024, (bf16_t*)(ws + WS_W1) + (size_t)l * 4096 * 1024, 1024, base, tile);
        cvt_job((const float*)p.in[19] + (size_t)l * 4096 * 1024, 4096, 1024, nullptr, (bf16_t*)(ws + WS_W2) + (size_t)l * 1024 * 4096, 4096, base, tile);
    }
    __syncthreads();
}
__device__ void prep_x(const float* __restrict__ x, bf16_t* __restrict__ xb, float* __restrict__ ss) {
    const int tid_ = opaque_tid(), lane = tid_ & 63, gw = opaque_bid() * 8 + (tid_ >> 6), nw = gridDim.x * 8;
    for (int r = gw; r < TH; r += nw) {
        const float* xr = x + (size_t)r * 1024; bf16_t* br = xb + (size_t)r * 1024; float s = 0.f;
#pragma unroll
        for (int i = 0; i < 4; ++i) { const f32x4 v = *(const f32x4*)(xr + i * 256 + lane * 4); s += v.x * v.x + v.y * v.y + v.z * v.z + v.w * v.w;
            *(u32x2*)(br + i * 256 + lane * 4) = (u32x2){cvtpk(v.x, v.y), cvtpk(v.z, v.w)}; }
#pragma unroll
        for (int o = 1; o < 64; o <<= 1) s += __shfl_xor(s, o);
        if (lane < 16) ss[(size_t)r * 16 + lane] = lane == 0 ? s : 0.f;
    }
}

struct EpiBf16S {
    static constexpr bool PERM = true, AFTER_DRAIN = false;
    bf16_t* O; int ldc; bf16_t* O2; int ldc2; int split; const float* ss; int nsl4; float inv_n; int act; float* ssl; float* ssk;
    __device__ __forceinline__ void operator()(const f32x4 (&acc)[2][2][4][2], const pg8::Unit& u, int wr, int wc, int fr, int fq) const {
        const int row0 = u.pm * 256 + wr * 64 + fr; int colt = u.pn * 256; bf16_t* base = O; int ld = ldc;
        if (colt >= split) { base = O2; colt -= split; ld = ldc2; }
        const int col0 = colt + wc * 32 + 8 * fq;
#pragma unroll
        for (int ai = 0; ai < 2; ++ai)
#pragma unroll
            for (int m = 0; m < 4; ++m) { const int row = row0 + ai * 128 + m * 16; float sc = 1.0f;
                if (ss) { const f32x4* sp = (const f32x4*)(ss + (size_t)row * 16); f32x4 a = sp[0]; if (nsl4 == 4) a = (a + sp[1]) + (sp[2] + sp[3]); sc = rsqrtf(((a.x + a.y) + (a.z + a.w)) * inv_n + EPS); }
                bf16_t* rowp = base + (size_t)row * ld + col0; float sa = 0.f, sb = 0.f;
#pragma unroll
                for (int bj = 0; bj < 2; ++bj) { f32x4 v0 = acc[ai][bj][m][0] * sc, v1 = acc[ai][bj][m][1] * sc;
                    if (act) {
#pragma unroll
                        for (int j = 0; j < 4; ++j) { const float a0 = fmaxf(v0[j], 0.f), a1 = fmaxf(v1[j], 0.f); v0[j] = a0 * a0; v1[j] = a1 * a1; } }
                    const float sq = ((v0[0] * v0[0] + v0[1] * v0[1]) + (v0[2] * v0[2] + v0[3] * v0[3])) + ((v1[0] * v1[0] + v1[1] * v1[1]) + (v1[2] * v1[2] + v1[3] * v1[3]));
                    if (bj == 0) sa = sq; else sb = sq;
                    u32x4 w; w.x = cvtpk(v0[0], v0[1]); w.y = cvtpk(v0[2], v0[3]); w.z = cvtpk(v1[0], v1[1]); w.w = cvtpk(v1[2], v1[3]);
                    *(u32x4*)(rowp + bj * 128) = w; }
                if (ssk) { float sk_ = sa; sk_ += __shfl_xor(sk_, 16); sk_ += __shfl_xor(sk_, 32); if (fq == 0) ssk[((size_t)row * 16 + u.pn) * 4 + wc] = sk_; }
                if (ssl) { sa += __shfl_xor(sa, 16); sa += __shfl_xor(sa, 32); sb += __shfl_xor(sb, 16); sb += __shfl_xor(sb, 32);
                    if (fq == 0) { float* sr_ = ssl + (size_t)row * 16; if (u.pn == 0) sr_[wc] = sa + sb; else { sr_[4 + wc] = sa; sr_[8 + wc] = sb; } } } }
    }
};
struct EpiRes {
    static constexpr bool PERM = false, AFTER_DRAIN = false;
    const float* xin; float* xout; bf16_t* xb; float* ss;
    __device__ __forceinline__ void operator()(const f32x4 (&acc)[2][2][4][2], const pg8::Unit& u, int wr, int wc, int fr, int fq) const {
        const int row0 = u.pm * 256 + wr * 64 + fr, col0 = u.pn * 256 + wc * 32 + 4 * fq;
#pragma unroll
        for (int ai = 0; ai < 2; ++ai)
#pragma unroll
            for (int m = 0; m < 4; ++m) { const int row = row0 + ai * 128 + m * 16; const size_t off = (size_t)row * 1024 + col0; float s = 0.f;
#pragma unroll
                for (int bj = 0; bj < 2; ++bj)
#pragma unroll
                    for (int n = 0; n < 2; ++n) { const int c = bj * 128 + n * 16; const f32x4 o = *(const f32x4*)(xin + off + c) + acc[ai][bj][m][n];
                        *(f32x4*)(xout + off + c) = o; s += (o.x * o.x + o.y * o.y) + (o.z * o.z + o.w * o.w);
                        *(u32x2*)(xb + off + c) = (u32x2){cvtpk(o.x, o.y), cvtpk(o.z, o.w)}; }
                s += __shfl_xor(s, 16); s += __shfl_xor(s, 32);
                if (fq == 0) ss[(size_t)row * 16 + u.pn * 4 + wc] = s; }
    }
};
template <class Epi> __device__ __forceinline__ void run_gemm(LAS unsigned char* lds, const bf16_t* A, int lda, const bf16_t* Bt, int N, int K, const Epi& E) {
    pg8::Gemm g{A, Bt, TH, N, K, lda}; pg8::StaticOrder S; S.init(TH, N, (int)gridDim.x, opaque_bid());
    pg8::gemm_phase<Epi, pg8::StaticOrder>(lds, g, S, E);
}

__device__ void lat_prep(bf16_t* lat) {
    const int tid_ = opaque_tid(), lane = tid_ & 63, gw = opaque_bid() * 8 + (tid_ >> 6), nw = gridDim.x * 8;
    for (int t = gw; t < TH; t += nw) {
        bf16_t* p = lat + (size_t)t * 512 + lane * 8; const u32x4 w = *(const u32x4*)p; float v[8]; UNPACK8(w, v);
        float s = 0.f;
#pragma unroll
        for (int e = 0; e < 8; ++e) s += v[e] * v[e];
        s += __shfl_xor(s, 1); s += __shfl_xor(s, 2); s += __shfl_xor(s, 4); s += __shfl_xor(s, 8);
        const float s32 = s + __shfl_xor(s, 16);
        const float rstd = lane < 32 ? rsqrtf(s32 * (1.0f / 256.0f) + EPS) : rsqrtf(s * (1.0f / 128.0f) + EPS);
        if (lane < 48) {
#pragma unroll
            for (int e = 0; e < 8; ++e) v[e] *= rstd;
            *(u32x4*)p = PACK8(v); }
    }
}
__device__ void kpe_prep(const bf16_t* lat, const int* pos, const float* gk, bf16_t* kper) {
    const int tid = opaque_tid(), grp = tid >> 3, l8 = tid & 7;
    float invf[8], g[8];
#pragma unroll
    for (int e = 0; e < 8; ++e) { invf[e] = exp2f(-(float)((l8 & 3) * 8 + e) * (LOG2_THETA / 32.0f)) * 0.15915494309189535f; g[e] = gk[128 + l8 * 8 + e]; }
    for (int t = opaque_bid() * 64 + grp; t < TH; t += (int)gridDim.x * 64) {
        const float posf = (float)pos[t];
        const u32x4 w = *(const u32x4*)(lat + (size_t)t * 512 + 384 + l8 * 8); float v[8]; UNPACK8(w, v);
#pragma unroll
        for (int e = 0; e < 8; ++e) { const float y = v[e] * g[e]; const float pr = __shfl_xor(y, 4); float sn_, cs_; sincos_rev(posf, invf[e], sn_, cs_);
            v[e] = (l8 & 4) ? y * cs_ + pr * sn_ : y * cs_ - pr * sn_; }
        *(u32x4*)(kper + (size_t)t * 64 + l8 * 8) = PACK8(v);
    }
}
__device__ void head_prep(bf16_t* kbuf  , bf16_t* qbuf, const int* pos, const float* gk, const float* gq) {
    const int tid_ = opaque_tid(), lane = tid_ & 63, gw = opaque_bid() * 8 + (tid_ >> 6), nw = gridDim.x * 8;
    const float qscale = 0.08838834764831845f * LOG2E;
    const int c16 = lane & 15;
    float invf[8];
#pragma unroll
    for (int e = 0; e < 8; ++e) invf[e] = exp2f(-(float)((c16 & 7) * 8 + e) * (LOG2_THETA / 64.0f)) * 0.15915494309189535f;
    for (int t = gw; t < TH; t += nw) {
        const float posf = (float)pos[t];
        float cs[8], sn[8];
#pragma unroll
        for (int e = 0; e < 8; ++e) sincos_rev(posf, invf[e], sn[e], cs[e]);
        u32x4 wv[6];
#pragma unroll
        for (int itr = 0; itr < 6; ++itr) wv[itr] = *(const u32x4*)(kbuf + (size_t)t * 6144 + (itr * 4 + (lane >> 4)) * 128 + c16 * 8);
#pragma unroll
        for (int itr = 0; itr < 6; ++itr) { const bool isq = false;
            const int hh = (isq ? itr - 6 : itr) * 4 + (lane >> 4), g = hh >> 3;
            bf16_t* p = isq ? qbuf + (size_t)t * 3072 + hh * 128 + c16 * 8 : kbuf + (size_t)t * 6144 + hh * 128 + c16 * 8;
            const float* gn = (isq ? gq : gk) + g * 128 + c16 * 8;
            float v[8]; UNPACK8(wv[itr], v); float s = 0.f;
#pragma unroll
            for (int e = 0; e < 8; ++e) s += v[e] * v[e];
            s += __shfl_xor(s, 1); s += __shfl_xor(s, 2); s += __shfl_xor(s, 4); s += __shfl_xor(s, 8);
            const float rstd = rsqrtf(s * (1.0f / 128.0f) + EPS), osc = isq ? qscale : 1.0f;
#pragma unroll
            for (int e = 0; e < 8; ++e) { const float y = v[e] * rstd * gn[e]; const float pr = __shfl_xor(y, 8);
                v[e] = ((c16 & 8) ? y * cs[e] + pr * sn[e] : y * cs[e] - pr * sn[e]) * osc; }
            *(u32x4*)p = PACK8(v); }
    }
}

struct AttnItem { const bf16_t* q; const bf16_t* k; const bf16_t* kpe; const bf16_t* v; bf16_t* o; float* lse; const int* pos; const float* gq; const float* gk; const float* ssk; const float* ssl; int q_ld, k_ld, kpe_ld, v_ld, o_ld, P0, ld, merge; };
__device__ __forceinline__ int v_st(int k, int c) { const int kk = (k & ~0xC) | ((k & 4) << 1) | ((k & 8) >> 1); return ((kk >> 3) * 4 + (c >> 5)) * 512 + ((kk & 7) * 32 + (c & 31)) * 2; }
__device__ __forceinline__ int v_rd_base(int lane) { return ((lane & 3) << 3) | (((lane >> 2) & 3) << 6) | (((lane >> 4) & 1) << 5) | (((lane >> 5) & 1) << 8); }
#define PK4(P, B_, OUT) do { unsigned a0_ = cvtpk(P[B_+0], P[B_+1]), a1_ = cvtpk(P[B_+2], P[B_+3]); unsigned b0_ = cvtpk(P[B_+4], P[B_+5]), b1_ = cvtpk(P[B_+6], P[B_+7]); \
        auto r0_ = __builtin_amdgcn_permlane32_swap(a0_, b0_, false, false); auto r1_ = __builtin_amdgcn_permlane32_swap(a1_, b1_, false, false); \
        u32x4 w_ = {r0_[0], r1_[0], r0_[1], r1_[1]}; OUT = w_; } while (0)
__device__ __forceinline__ bf16x8 as_bf(u32x4 w) { return *reinterpret_cast<bf16x8*>(&w); }

template <int DQK, int MODE>
__device__ __forceinline__ void attn_block(const AttnItem& it, LAS unsigned char* lds) {
    constexpr int RS = DQK * 2, SHM_K = 64 * RS, SHM_V = 16384, ND0 = DQK / 16, KCH = DQK / 8, NKC = (64 * KCH) / 512;
    const int tid = opaque_tid(), wid = __builtin_amdgcn_readfirstlane(tid >> 6), lane = tid & 63, r32 = lane & 31, hi = lane >> 5;
    const int ld = it.ld, Lm1 = (2048 >> ld) - 1, lsh = 11 - ld;
#define TOK(p) (MODE == 0 ? (p) : ((((p) & Lm1) << ld) | ((p) >> lsh)))
#define LOF(p) (MODE == 0 ? 0 : max((p) - 128, (p) & ~Lm1))
    const int q0 = it.P0 + wid * 32, qp = q0 + r32;
    const int span = qp - LOF(qp), lo_w = LOF(q0), lo_last = LOF(q0 + 31);
    LAS unsigned char* V_lds = lds; LAS unsigned char* K_lds = lds + 2 * SHM_V;
    const int j_lo = LOF(it.P0) >> 6, NT = (it.P0 >> 6) + 4 - j_lo;
    const int sr = tid >> 4, sc = (tid & 15) * 8, vst0 = v_st(sr, sc), vst1 = v_st(32 + sr, sc);
    constexpr int NSET = (MODE == 1) ? 2 : 1;
    bf16x8 sk[NSET][NKC], sv0[NSET], sv1[NSET]; f32x4 s_k4 = {0.f, 0.f, 0.f, 0.f}, s_p4 = {0.f, 0.f, 0.f, 0.f};
    constexpr int KRS_OFF = 2 * SHM_V + 2 * SHM_K;
    int offk[NKC], offv0 = sr * it.v_ld + sc, offv1 = (32 + sr) * it.v_ld + sc;
#pragma unroll
    for (int i_ = 0; i_ < NKC; ++i_) { const int c_ = tid + 512 * i_, row_ = c_ / KCH, cc_ = c_ - row_ * KCH; offk[i_] = (DQK == 192 && cc_ >= 16) ? row_ * it.kpe_ld + (cc_ - 16) * 8 : row_ * it.k_ld + cc_ * 8; }
#define SLOAD(S_, kb_) do { if (MODE == 0) { const bf16_t* kt_ = it.k + (size_t)(kb_) * it.k_ld; const bf16_t* pt_ = it.kpe + (size_t)(kb_) * it.kpe_ld; const bf16_t* vt_ = it.v + (size_t)(kb_) * it.v_ld; \
            _Pragma("unroll") for (int i_ = 0; i_ < NKC; ++i_) { const int c_ = tid + 512 * i_, row_ = c_ / KCH, cc_ = c_ - row_ * KCH; sk[S_][i_] = *(const bf16x8*)(((DQK == 192 && cc_ >= 16) ? pt_ : kt_) + offk[i_]); } \
            sv0[S_] = *(const bf16x8*)(vt_ + offv0); sv1[S_] = *(const bf16x8*)(vt_ + offv1); \
            if (tid < 64) { s_k4 = *(const f32x4*)(it.ssk + (size_t)((kb_) + tid) * 64); s_p4 = *(const f32x4*)(it.ssl + (size_t)((kb_) + tid) * 16); } } else { \
        _Pragma("unroll") for (int i_ = 0; i_ < NKC; ++i_) { const int c_ = tid + 512 * i_, row_ = c_ / KCH, cc_ = c_ - row_ * KCH; const int tk_ = TOK((kb_) + row_); \
            sk[S_][i_] = *(const bf16x8*)(it.k + (size_t)tk_ * it.k_ld + cc_ * 8); } \
        { const int t0_ = TOK((kb_) + sr), t1_ = TOK((kb_) + 32 + sr); sv0[S_] = *(const bf16x8*)(it.v + (size_t)t0_ * it.v_ld + sc); sv1[S_] = *(const bf16x8*)(it.v + (size_t)t1_ * it.v_ld + sc); } } } while (0)
#define SWRITE(S_, bf_) do { _Pragma("unroll") for (int i_ = 0; i_ < NKC; ++i_) { const int c_ = tid + 512 * i_, row_ = c_ / KCH, cc_ = c_ - row_ * KCH; const int swz_ = (((DQK == 128) ? row_ : (row_ >> 1)) & 7) << 4; \
            *(LAS bf16x8*)(K_lds + (bf_) * SHM_K + row_ * RS + ((cc_ * 16) ^ swz_)) = sk[S_][i_]; } \
        *(LAS bf16x8*)(V_lds + (bf_) * SHM_V + vst0) = sv0[S_]; *(LAS bf16x8*)(V_lds + (bf_) * SHM_V + vst1) = sv1[S_]; \
        if (MODE == 0 && tid < 64) { const f32x4 a_ = s_k4 + s_p4; *(LAS float*)(lds + KRS_OFF + (bf_) * 256 + tid * 4) = rsqrtf(((a_.x + a_.y) + (a_.z + a_.w)) * (1.0f / 192.0f) + EPS); } } while (0)
    float m_reg = -1e30f, l_reg = 0.f; f32x16 o[4];
#pragma unroll
    for (int d = 0; d < 4; ++d)
#pragma unroll
        for (int r = 0; r < 16; ++r) o[d][r] = 0.f;
    SLOAD(0, j_lo * 64); if (MODE == 1) SLOAD(NSET - 1, j_lo * 64 + 64);
    bf16x8 qr[ND0];
    {
      constexpr int NR = (MODE == 0) ? 2 : 4;
      constexpr int R0 = (MODE == 0) ? 8 : 0;
      constexpr float QS = ((MODE == 0) ? 0.07216878364870322f : 0.08838834764831845f) * LOG2E;
      constexpr float FSTEP = LOG2_THETA / ((MODE == 0) ? 32.0f : 64.0f);
      const int tq_ = TOK(qp);
      const bf16_t* qrow = it.q + (size_t)tq_ * it.q_ld + hi * 8;
      u32x4 raw[ND0]; float ssq = 0.f;
#pragma unroll
      for (int d0 = 0; d0 < ND0; ++d0) raw[d0] = *(const u32x4*)(qrow + d0 * 16);
      const float posf = (float)it.pos[tq_];
#pragma unroll
      for (int d0 = 0; d0 < ND0; ++d0) { float v[8]; UNPACK8(raw[d0], v);
#pragma unroll
          for (int e = 0; e < 8; ++e) ssq += v[e] * v[e]; }
      { auto rr = __builtin_amdgcn_permlane32_swap(__float_as_uint(ssq), __float_as_uint(ssq), false, false); ssq = __uint_as_float(rr[0]) + __uint_as_float(rr[1]); }
      const float rq = rsqrtf(ssq * (1.0f / (float)DQK) + EPS) * QS;
      const float* gp = it.gq + hi * 8;
#pragma unroll
      for (int d0 = 0; d0 < ND0; ++d0) {
          if (d0 >= R0 + NR && d0 < R0 + 2 * NR) continue;
          f32x4 g0 = *(const f32x4*)(gp + d0 * 16), g1 = *(const f32x4*)(gp + d0 * 16 + 4);
          if (MODE == 0 && d0 < 8) { g0 *= *(const f32x4*)(it.gk + hi * 8 + d0 * 16); g1 *= *(const f32x4*)(it.gk + hi * 8 + d0 * 16 + 4); }
          float v[8]; UNPACK8(raw[d0], v);
#pragma unroll
          for (int e = 0; e < 8; ++e) v[e] *= rq * (e < 4 ? g0[e & 3] : g1[e & 3]);
          if (d0 >= R0 && d0 < R0 + NR) {
              const f32x4 h0 = *(const f32x4*)(gp + (d0 + NR) * 16), h1 = *(const f32x4*)(gp + (d0 + NR) * 16 + 4);
              float w[8]; UNPACK8(raw[d0 + NR], w);
#pragma unroll
              for (int e = 0; e < 8; ++e) { w[e] *= rq * (e < 4 ? h0[e & 3] : h1[e & 3]);
                  float sn_, cs_; sincos_rev(posf, exp2f(-(float)((d0 - R0) * 16 + hi * 8 + e) * FSTEP) * 0.15915494309189535f, sn_, cs_);
                  const float x1 = v[e], x2 = w[e]; v[e] = x1 * cs_ - x2 * sn_; w[e] = x2 * cs_ + x1 * sn_; }
              qr[d0 + NR] = as_bf(PACK8(w)); }
          qr[d0] = as_bf(PACK8(v)); } }
    SWRITE(0, 0); __syncthreads();
    const int swzr = (((DQK == 128) ? r32 : (r32 >> 1)) & 7) << 4;
    int kro[4];
#pragma unroll
    for (int dd = 0; dd < 4; ++dd) kro[dd] = r32 * RS + ((dd * 32 + hi * 16) ^ swzr);
#pragma unroll 1
    for (int t2 = 0; t2 < NT; t2 += NSET) {
#pragma unroll
      for (int us = 0; us < NSET; ++us) { const int t = t2 + us; if (t < NT) {
        const int kb = (j_lo + t) * 64, buf = t & 1;
        if (MODE == 1) { if (t + 2 < NT) SLOAD(us, kb + 128); } else { if (t + 1 < NT) SLOAD(0, kb + 64); }
#pragma unroll 1
        for (int hf = 0; hf < 2; ++hf) {
            const int kh = kb + 32 * hf;
            const bool act = (kh <= q0 + 31) && (kh + 31 >= lo_w);
            if (act) {
                f32x16 p0;
#pragma unroll
                for (int r = 0; r < 16; ++r) p0[r] = 0.f;
                { const LAS unsigned char* kbp = K_lds + buf * SHM_K + hf * (32 * RS);
#pragma unroll
                  for (int d0 = 0; d0 < ND0; ++d0) {
                      const bf16x8 b0 = *(const LAS bf16x8*)(kbp + kro[d0 & 3] + (d0 >> 2) * 128);
                      p0 = __builtin_amdgcn_mfma_f32_32x32x16_bf16(b0, qr[d0], p0, 0, 0, 0); } }
                if (MODE == 0) { const LAS float* kr_ = (const LAS float*)(lds + KRS_OFF + buf * 256) + 32 * hf + 4 * hi;
#pragma unroll
                    for (int j4 = 0; j4 < 4; ++j4) { const f32x4 s4 = *(const LAS f32x4*)(kr_ + 8 * j4);
#pragma unroll
                        for (int e = 0; e < 4; ++e) p0[4 * j4 + e] *= s4[e]; } }
                if (!((kh + 31 <= q0) && (kh >= lo_last))) {
                    const int dq = qp - kh - 4 * hi; const float NEG = -__builtin_inff();
#pragma unroll
                    for (int r = 0; r < 16; ++r) { const int c = (r & 3) + 8 * (r >> 2); if ((unsigned)(dq - c) > (unsigned)span) p0[r] = NEG; } }
                float pmax = p0[0];
#pragma unroll
                for (int r = 1; r < 16; ++r) pmax = fmaxf(pmax, p0[r]);
                { auto rr = __builtin_amdgcn_permlane32_swap(__float_as_uint(pmax), __float_as_uint(pmax), false, false); pmax = fmaxf(__uint_as_float(rr[0]), __uint_as_float(rr[1])); }
                const float mn = fmaxf(m_reg, pmax), alpha = __builtin_amdgcn_exp2f(m_reg - mn); m_reg = mn;
                float ps = 0.f;
#pragma unroll
                for (int r = 0; r < 16; ++r) { p0[r] = __builtin_amdgcn_exp2f(p0[r] - mn); ps += p0[r]; }
                { auto rr = __builtin_amdgcn_permlane32_swap(__float_as_uint(ps), __float_as_uint(ps), false, false); ps = __uint_as_float(rr[0]) + __uint_as_float(rr[1]); }
                l_reg = l_reg * alpha + ps;
                u32x4 pa0, pa1; PK4(p0, 0, pa0); PK4(p0, 8, pa1);
                if (__any(alpha != 1.0f)) {
#pragma unroll
                    for (int d = 0; d < 4; ++d)
#pragma unroll
                        for (int r = 0; r < 16; ++r) o[d][r] *= alpha; }
                const unsigned vb = (unsigned)(uintptr_t)(V_lds + buf * SHM_V + hf * 8192) + (unsigned)v_rd_base(lane);
#define TRRD(dst, off) asm volatile("ds_read_b64_tr_b16 %0, %1 offset:%2" : "=&v"(dst) : "v"(vb), "i"(off) : "memory")
#define PV_D0(d0) do { s16x4 l0, l1, h0, h1; constexpr int b_ = (d0) * 512; \
                TRRD(l0, b_); TRRD(h0, b_ + 2048); TRRD(l1, b_ + 4096); TRRD(h1, b_ + 6144); \
                asm volatile("s_waitcnt lgkmcnt(0)" ::: "memory"); __builtin_amdgcn_sched_barrier(0); \
                o[d0] = __builtin_amdgcn_mfma_f32_32x32x16_bf16((bf16x8){l0[0], l0[1], l0[2], l0[3], h0[0], h0[1], h0[2], h0[3]}, as_bf(pa0), o[d0], 0, 0, 0); \
                o[d0] = __builtin_amdgcn_mfma_f32_32x32x16_bf16((bf16x8){l1[0], l1[1], l1[2], l1[3], h1[0], h1[1], h1[2], h1[3]}, as_bf(pa1), o[d0], 0, 0, 0); } while (0)
                PV_D0(0); PV_D0(1); PV_D0(2); PV_D0(3);
#undef PV_D0
#undef TRRD
            }
        }
        if (t + 1 < NT) SWRITE((NSET - 1) - us, buf ^ 1);
        __syncthreads();
      } }
    }
    const int tq = TOK(qp);
    float a_cur = 1.0f / l_reg, a_prev = 0.f;
    if (MODE == 1) {
        const float lse_cur = m_reg + __builtin_amdgcn_logf(l_reg); float lse_new = lse_cur;
        if (it.merge) { const float lse_prev = it.lse[(size_t)tq * 8]; const float mx = fmaxf(lse_prev, lse_cur);
            const float e0 = __builtin_amdgcn_exp2f(lse_prev - mx), e1 = __builtin_amdgcn_exp2f(lse_cur - mx); const float inv = 1.0f / (e0 + e1);
            lse_new = mx + __builtin_amdgcn_logf(e0 + e1); a_prev = e0 * inv; a_cur *= e1 * inv; }
        if (hi == 0) it.lse[(size_t)tq * 8] = lse_new;
    }
    bf16_t* orow = it.o + (size_t)tq * it.o_ld + hi * 8;
#pragma unroll
    for (int d0 = 0; d0 < 4; ++d0) {
#pragma unroll
        for (int r = 0; r < 16; ++r) o[d0][r] *= a_cur;
        u32x4 w0, w1; PK4(o[d0], 0, w0); PK4(o[d0], 8, w1);
        if (MODE == 1 && it.merge) {
            const u32x4 q0w = *(const u32x4*)(orow + d0 * 32), q1w = *(const u32x4*)(orow + d0 * 32 + 16);
            float a[8], b[8];
            UNPACK8(w0, a); UNPACK8(q0w, b);
#pragma unroll
            for (int e = 0; e < 8; ++e) a[e] += b[e] * a_prev;
            w0 = PACK8(a);
            UNPACK8(w1, a); UNPACK8(q1w, b);
#pragma unroll
            for (int e = 0; e < 8; ++e) a[e] += b[e] * a_prev;
            w1 = PACK8(a);
        }
        *(u32x4*)(orow + d0 * 32) = w0; *(u32x4*)(orow + d0 * 32 + 16) = w1;
    }
#undef SLOAD
#undef SWRITE
#undef TOK
#undef LOF
}

__device__ void mla_attn_phase(const Params& p, LAS unsigned char* lds, const int* pos, const float* gq, const float* gk) {
    unsigned char* ws = p.ws;
    const int G_ = (int)gridDim.x, bid_ = opaque_bid(), vb_ = (G_ % 8 == 0) ? (bid_ % 8) * (G_ / 8) + bid_ / 8 : bid_;
    for (int item = vb_; item < BH * 16 * 4; item += G_) {
        const int bh = item >> 2, pr = item & 3, b = bh >> 4, h = bh & 15; const size_t tb = (size_t)b * SEQ;
        AttnItem it; it.q = (const bf16_t*)(ws + WS_Q) + tb * 3072 + h * 192; it.q_ld = 3072;
        it.k = (const bf16_t*)(ws + WS_KV) + tb * 4096 + h * 256; it.k_ld = 4096; it.kpe = (const bf16_t*)(ws + WS_KPER) + tb * 64; it.kpe_ld = 64; it.gk = gk; it.ssk = (const float*)(ws + WS_SSK) + (tb * 16 + h) * 4; it.ssl = (const float*)(ws + WS_SSL) + tb * 16 + 8;
        it.v = (const bf16_t*)(ws + WS_KV) + tb * 4096 + h * 256 + 128; it.v_ld = 4096; it.o = (bf16_t*)(ws + WS_AO) + tb * 2048 + h * 128; it.o_ld = 2048;
        it.lse = nullptr; it.ld = 0; it.merge = 0; it.pos = pos + tb; it.gq = gq;
#pragma unroll 1
        for (int k2 = 0; k2 < 2; ++k2) { it.P0 = (k2 == 0 ? 7 - pr : pr) * 256; attn_block<192, 0>(it, lds); }
    }
}
__device__ void dil_attn_phase(const Params& p, LAS unsigned char* lds, int g, const int* pos, const float* gq) {
    unsigned char* ws = p.ws;
    const int G_ = (int)gridDim.x, bid_ = opaque_bid(), vb_ = (G_ % 8 == 0) ? (bid_ % 8) * (G_ / 8) + bid_ / 8 : bid_;
    for (int item = vb_; item < BH * 8 * 8; item += G_) {
        const int bh = item >> 3, qb = item & 7, b = bh >> 3, h = bh & 7, hh = g * 8 + h; const size_t tb = (size_t)b * SEQ;
        AttnItem it; it.q = (const bf16_t*)(ws + WS_QB) + tb * 3072 + hh * 128; it.q_ld = 3072;
        it.k = (const bf16_t*)(ws + WS_KVB) + tb * 6144 + hh * 128; it.k_ld = 6144; it.kpe = nullptr; it.kpe_ld = 0; it.gk = nullptr; it.ssk = nullptr; it.ssl = nullptr;
        it.v = (const bf16_t*)(ws + WS_KVB) + tb * 6144 + 3072 + hh * 128; it.v_ld = 6144; it.o = (bf16_t*)(ws + WS_OB) + tb * 1024 + h * 128; it.o_ld = 1024;
        it.lse = (float*)(ws + WS_LSE) + tb * 8 + h; it.ld = 2 * g; it.merge = g > 0; it.P0 = qb * 256; it.pos = pos + tb; it.gq = gq + g * 128;
        attn_block<128, 1>(it, lds);
    }
}

#define XB_TMO      128
#define XB_XCNT(j)  (256  + 64 * (j))
#define XB_XSUB(j)  (1280 + 64 * (j))
#define XB_XGEN(j)  (2304 + 64 * (j))
#define XB_TOP      3328
#define XB_TOPGEN   3392
#define XCD_BAR_WORDS 3456
#define XB_SPIN_CAP (1u << 18)

__device__ __forceinline__ unsigned xb_ld(unsigned* p)              { return __hip_atomic_load(p, __ATOMIC_RELAXED, __HIP_MEMORY_SCOPE_AGENT); }
__device__ __forceinline__ unsigned xb_add(unsigned* p, unsigned v) { return __hip_atomic_fetch_add(p, v, __ATOMIC_RELAXED, __HIP_MEMORY_SCOPE_AGENT); }
__device__ __forceinline__ unsigned xb_xcc_id() { return (unsigned)__builtin_amdgcn_s_getreg((3 << 11) | 20) & 0xFu; }
#define XB_SPIN(cond, bar) do { unsigned _sp = 0; while (cond) { __builtin_amdgcn_s_sleep(1); \
    if ((++_sp & 255u) == 0u) { if (xb_ld(&(bar)[XB_TMO])) break; if (_sp > XB_SPIN_CAP) { atomicAdd(&(bar)[XB_TMO], 1u); break; } } } } while (0)

struct XcdBarrier {
    unsigned* bar; unsigned x;
    volatile LAS unsigned* st;
};

__device__ __forceinline__ XcdBarrier xcd_barrier_post(unsigned* bar, volatile LAS unsigned* st) {
    XcdBarrier b; b.bar = bar; b.x = xb_xcc_id(); b.st = st;
    if (threadIdx.x == 0) (void)xb_add(&bar[XB_XCNT(b.x)], 1u);
    return b;
}
__device__ __forceinline__ void xcd_barrier_complete(unsigned* bar, unsigned x, unsigned& nloc, unsigned& nx) {
    const unsigned G = gridDim.x * gridDim.y * gridDim.z;
    unsigned sum, cnt, mine, sp = 0u;
    for (;;) {
        sum = 0u; cnt = 0u; mine = 0u;
#pragma unroll
        for (unsigned j = 0; j < 16; ++j) { const unsigned c = xb_ld(&bar[XB_XCNT(j)]); sum += c; cnt += (c > 0u) ? 1u : 0u; mine = (j == x) ? c : mine; }
        if (sum == G) break;
        __builtin_amdgcn_s_sleep(1);
        if ((++sp & 255u) == 0u) { if (xb_ld(&bar[XB_TMO])) break; if (sp > XB_SPIN_CAP) { atomicAdd(&bar[XB_TMO], 1u); break; } }
    }
    nloc = mine > 0u ? mine : 1u; nx = cnt > 0u ? cnt : 1u;
}

__device__ __forceinline__ void xcd_barrier(const XcdBarrier& b) {
    asm volatile("s_waitcnt vmcnt(0)" ::: "memory");
    __syncthreads();
    if (threadIdx.x == 0) {
        unsigned* bar = b.bar;
        __builtin_amdgcn_s_waitcnt(0);
        unsigned nloc = b.st[0], nx = b.st[1];
        if (nloc == 0u) { xcd_barrier_complete(bar, b.x, nloc, nx); b.st[0] = nloc; b.st[1] = nx; }
        const unsigned old = xb_add(&bar[XB_XSUB(b.x)], 1u);
        const unsigned gen = old / nloc;
        if (old + 1u == (gen + 1u) * nloc) {
            __builtin_amdgcn_fence(__ATOMIC_RELEASE, "agent");
            asm volatile("s_waitcnt vmcnt(0)" ::: "memory");
            const unsigned og = xb_add(&bar[XB_TOP], 1u);
            const unsigned tg = og / nx;
            if (og + 1u == (tg + 1u) * nx) xb_add(&bar[XB_TOPGEN], 1u);
            else XB_SPIN(xb_ld(&bar[XB_TOPGEN]) == tg, bar);
            __builtin_amdgcn_fence(__ATOMIC_ACQUIRE, "agent");
            xb_add(&bar[XB_XGEN(b.x)], 1u);
            asm volatile("s_waitcnt vmcnt(0)" ::: "memory");
        } else {
            XB_SPIN(xb_ld(&bar[XB_XGEN(b.x)]) == gen, bar);
            __builtin_amdgcn_fence(__ATOMIC_ACQUIRE, "agent");
            asm volatile("s_waitcnt vmcnt(0)" ::: "memory");
        }
    }
    __syncthreads();
}

constexpr int NPH_HALF = 1 + 2 * 6 + 8 + 7;
#ifndef SKIP_MASK
#define SKIP_MASK 0
#endif
__global__ void __launch_bounds__(NTHR) mega(Params p) {
    extern __shared__ __attribute__((aligned(16))) unsigned char lds_raw[];
    LAS unsigned char* lds = (LAS unsigned char*)lds_raw;
    cg::grid_group grid = cg::this_grid();
    unsigned char* ws = p.ws;
    bf16_t* XB = (bf16_t*)(ws + WS_XB); float* SS = (float*)(ws + WS_SS); bf16_t* HB = (bf16_t*)(ws + WS_H);
    bf16_t* LAT = (bf16_t*)(ws + WS_LAT); bf16_t* Q = (bf16_t*)(ws + WS_Q); bf16_t* KV = (bf16_t*)(ws + WS_KV); bf16_t* KPE = (bf16_t*)(ws + WS_KPE); bf16_t* AO = (bf16_t*)(ws + WS_AO);
    bf16_t* KVB = (bf16_t*)(ws + WS_KVB); bf16_t* QB = (bf16_t*)(ws + WS_QB); bf16_t* OB = (bf16_t*)(ws + WS_OB);
#ifndef PROBE_MASK
#define PROBE_MASK 0
#endif
    unsigned long long probe_acc = 0ull;
    volatile LAS unsigned* bar_st = (volatile LAS unsigned*)(lds + 131072);
    if (threadIdx.x < 4) bar_st[threadIdx.x] = 0u;
    __syncthreads();
    XcdBarrier xbar = xcd_barrier_post((unsigned*)(ws + WS_BAR), bar_st);
#pragma unroll 1
    for (int ph = p.ph_lo; ph < p.ph_hi; ++ph) {
        const unsigned long long probe_t0 = PROBE_MASK ? __builtin_amdgcn_s_memrealtime() : 0ull;
        const int hb = ph >= NPH_HALF ? 1 : 0, li = ph - hb * NPH_HALF;
        const size_t toff = (size_t)hb * TH;
        const float* xin0 = (const float*)p.in[0] + toff * DM; float* xo = p.out + toff * DM; const int* pos = (const int*)p.in[1] + toff;
        int lyr = 0, j = -1;
        if (li >= 21) { lyr = 3; const int jm = li - 21; j = jm == 0 ? 0 : jm + 1; }
        else if (li >= 13) { lyr = 2; j = li - 13; }
        else if (li >= 1) { lyr = (li - 1) / 6; const int jm = (li - 1) - lyr * 6; j = jm == 0 ? 0 : jm == 1 ? 2 : jm + 2; }
        const bool mla = lyr < 2; const int ab = lyr & 1;
        int gk = 0;
        const bf16_t* A = nullptr; const bf16_t* Bt = nullptr; int lda = 0, N = 0, K = 0, nsub = 1;
        EpiBf16S E1{nullptr, 0, nullptr, 0, 1 << 30, nullptr, 4, 1.0f / 1024.0f, 0, nullptr, nullptr}; EpiRes E2{nullptr, nullptr, XB, SS};
        float* SSL = (float*)(ws + WS_SSL);
        if (li > 0) {
            if (j == 6) { gk = 1; A = XB; lda = 1024; Bt = (const bf16_t*)(ws + WS_W1) + (size_t)lyr * 4096 * 1024; N = 4096; K = 1024; E1.O = HB; E1.ldc = 4096; E1.ss = SS; E1.act = 1; }
            else if (j == 7) { gk = 2; A = HB; lda = 4096; Bt = (const bf16_t*)(ws + WS_W2) + (size_t)lyr * 1024 * 4096; N = 1024; K = 4096; E2.xin = xo; E2.xout = xo; }
            else if (j == 5) { gk = 2; N = 1024; E2.xin = lyr == 0 ? xin0 : xo; E2.xout = xo;
                if (mla) { A = AO; lda = 2048; K = 2048; Bt = (const bf16_t*)(ws + WS_WO) + (size_t)ab * 1024 * 2048; }
                else { A = OB; lda = 1024; K = 1024; Bt = (const bf16_t*)(ws + WS_WOB) + (size_t)ab * 1024 * 1024; } }
            else if (j == 0) { gk = 1; A = XB; lda = 1024; K = 1024; E1.ss = SS;
                if (mla) { Bt = (const bf16_t*)(ws + WS_WIN) + (size_t)ab * 512 * 1024; N = 512; E1.O = LAT; E1.ldc = 512; E1.ssl = SSL; }
                else if (ab == 0) { Bt = (const bf16_t*)(ws + WS_WKVQ); N = 9216; E1.O = KVB; E1.ldc = 6144; E1.O2 = QB; E1.ldc2 = 3072; E1.split = 6144; }
                else { Bt = (const bf16_t*)(ws + WS_WQ1); N = 3072; E1.O = QB; E1.ldc = 3072; } }
            else if (j == 2 && mla) { gk = 1; nsub = 2; A = LAT; lda = 512; K = 256; Bt = (const bf16_t*)(ws + WS_WQB) + (size_t)ab * 3072 * 256; N = 3072; E1.O = Q; E1.ldc = 3072; E1.ss = SSL; E1.nsl4 = 1; E1.inv_n = 1.0f / 256.0f; }
        }
        if (!(SKIP_MASK & 1) && gk == 1) {
            if (nsub == 2) kpe_prep(LAT, pos, (const float*)p.in[10] + ab * 192, (bf16_t*)(ws + WS_KPER));
#pragma unroll 1
            for (int sub = 0; sub < nsub; ++sub) {
                if (sub == 1) { A = LAT + 256; Bt = (const bf16_t*)(ws + WS_WKVB) + (size_t)ab * 4096 * 256; N = 4096; E1.O = KV; E1.ldc = 4096; E1.ss = SSL + 4; E1.inv_n = 1.0f / 128.0f; E1.ssk = (float*)(ws + WS_SSK); }
                run_gemm(lds, A, lda, Bt, N, K, E1);
            }
        } else if (!(SKIP_MASK & 2) && gk == 2) {
            run_gemm(lds, A, lda, Bt, N, K, E2);
        } else if (li == 0) {
            if (!(SKIP_MASK & 4)) { if (hb == 0) prep_weights(p, lds); prep_x(xin0, XB, SS); }
        } else if (mla) {
            if (j == 4) { if (!(SKIP_MASK & 32)) mla_attn_phase(p, lds, pos, (const float*)p.in[9] + ab * 192, (const float*)p.in[10] + ab * 192); }
        } else {
            if (j == 1) { if (!(SKIP_MASK & 64)) head_prep(ab == 0 ? KVB : nullptr, QB, pos, (const float*)p.in[14], (const float*)p.in[16] + ab * 384); }
            else if (j >= 2 && j <= 4) { if (!(SKIP_MASK & 128)) dil_attn_phase(p, lds, j - 2, pos, (const float*)p.in[16] + ab * 384); }
        }
        if (ph + 1 < p.ph_hi) { if (ph == p.ph_lo) grid.sync(); else xcd_barrier(xbar); }
        if (PROBE_MASK) { const int cat = gk == 1 ? 1 : gk == 2 ? 2 : li == 0 ? 3 : mla ? (j == 1 ? 4 : j == 3 ? 5 : 6) : (j == 1 ? 7 : 8);
            if ((PROBE_MASK >> cat) & 1) probe_acc += __builtin_amdgcn_s_memrealtime() - probe_t0; }
    }
    if (PROBE_MASK && blockIdx.x == 0) { const unsigned long long t1 = __builtin_amdgcn_s_memrealtime(); while (__builtin_amdgcn_s_memrealtime() - t1 < probe_acc) __builtin_amdgcn_s_sleep(16); }
}
constexpr int N_PHASES = 2 * NPH_HALF;

extern "C" void kernel_launch(void* const* d_in, const int* in_sizes, int n_in, void* d_out, int out_size, void* d_ws, size_t ws_size, hipStream_t stream) {
    static int grid_blocks = 0;
    if (!grid_blocks) {
        int dev = 0, cus = 0, per_cu = 0;
        (void)hipGetDevice(&dev);
        (void)hipDeviceGetAttribute(&cus, hipDeviceAttributeMultiprocessorCount, dev);
        (void)hipFuncSetAttribute((const void*)mega, hipFuncAttributeMaxDynamicSharedMemorySize, LDS_BYTES);
        (void)hipOccupancyMaxActiveBlocksPerMultiprocessor(&per_cu, (const void*)mega, NTHR, LDS_BYTES);
        (void)hipGetLastError();
        grid_blocks = cus > 0 ? cus : 256;
        if (ws_size < WS_END || n_in != 20) { fprintf(stderr, "kernel_launch: workspace %zu < %zu or n_in %d != 20\n", ws_size, (size_t)WS_END, n_in); }
    }
    (void)hipMemsetAsync((unsigned char*)d_ws + WS_BAR, 0, XCD_BAR_WORDS * sizeof(unsigned), stream);
    Params p{};
    for (int i = 0; i < 20; ++i) p.in[i] = d_in[i];
    p.out = (float*)d_out; p.ws = (unsigned char*)d_ws;
#if ONE_LAUNCH
    p.ph_lo = 0; p.ph_hi = N_PHASES;
    void* args[] = {&p};
    hipError_t e = hipLaunchCooperativeKernel((const void*)mega, dim3(grid_blocks), dim3(NTHR), args, LDS_BYTES, stream);
    if (e != hipSuccess) fprintf(stderr, "cooperative launch failed: %s (grid %d)\n", hipGetErrorString(e), grid_blocks);
#else
    for (int ph = 0; ph < N_PHASES; ++ph) { p.ph_lo = ph; p.ph_hi = ph + 1; hipLaunchKernelGGL(mega, dim3(grid_blocks), dim3(NTHR), LDS_BYTES, stream, p); }
#endif
}
```

```cpp
#include <hip/hip_runtime.h>
#include <hip/hip_cooperative_groups.h>
#include <cstdio>
#include <cstdint>
namespace cg = cooperative_groups;

#ifndef ONE_LAUNCH
#define ONE_LAUNCH 1
#endif

__device__ __forceinline__ int opaque_tid() { int t = (int)threadIdx.x; asm volatile("" : "+v"(t)); return t; }
__device__ __forceinline__ int opaque_bid() { int b = (int)blockIdx.x; asm volatile("" : "+s"(b)); return b; }
namespace pg8 {
#define PG8_LAS __attribute__((address_space(3)))
typedef unsigned short bf16_t;
typedef short bf16x8 __attribute__((ext_vector_type(8)));
typedef float f32x4 __attribute__((ext_vector_type(4)));
typedef unsigned u32x4 __attribute__((ext_vector_type(4)));
constexpr int BM = 256, BK = 64, HALF = 128, HTB = HALF * BK * 2  , STAGE_BYTES = 8 * HTB, NXCD = 8, WGM = 8;

__host__ __device__ __forceinline__ int lds_byte(int r, int c) { const int st = (r >> 4) * 2 + (c >> 5), rr = r & 15, cc = c & 31, ob = rr * 64 + cc * 2; return st * 1024 + (ob ^ (((ob >> 9) & 1) << 5)); }
__host__ __device__ __forceinline__ void stage_rc(int b, int& R, int& C) { const int st = b / 1024, sb = b % 1024, swz = sb ^ (((sb >> 9) & 1) << 5); R = (st >> 1) * 16 + swz / 64; C = (st & 1) * 32 + (swz % 64) / 2; }
__host__ __device__ __forceinline__ int perm32(int rho) { const int n = rho >> 4, i = rho & 15; return 8 * (i >> 2) + 4 * n + (i & 3); }
struct Unit { int pm, pn; };
struct Gemm { const bf16_t* A; const bf16_t* Bt; int M, N, K, lda; };
struct StaticOrder {
    int nM, nN, nwg, G, c;
    __host__ __device__ void init(int M, int N, int G_, int c_) { nM = M / BM; nN = N / BM; nwg = nM * nN; G = G_; c = c_; }
    __host__ __device__ bool next(int i, Unit& u) const {
        const long L = (long)i * G + c; if (L >= nwg) return false;
        int wgid = (int)L; { const int q = nwg / NXCD, r = nwg % NXCD, xcd = wgid % NXCD, off = wgid / NXCD; wgid = (xcd < r ? xcd * (q + 1) : r * (q + 1) + (xcd - r) * q) + off; }
        const int nig = WGM * nN, gid = wgid / nig, fm = gid * WGM, gsz = (nM - fm) < WGM ? (nM - fm) : WGM;
        u.pm = fm + ((wgid % nig) % gsz); u.pn = (wgid % nig) / gsz; return true;
    }
    __device__ __forceinline__ void a_ready(const Unit&) const {}
    __device__ __forceinline__ void done(const Unit&) const {}
};
__device__ __forceinline__ unsigned cvt_pk_bf16(float lo, float hi) { unsigned r; asm volatile("v_cvt_pk_bf16_f32 %0, %1, %2" : "=v"(r) : "v"(lo), "v"(hi)); return r; }
template <class Epi, class Sched>
__device__ __forceinline__ void gemm_phase(PG8_LAS unsigned char* lds, const Gemm g, const Sched& S, const Epi& E) {
    const int tid = opaque_tid(), wid = __builtin_amdgcn_readfirstlane(tid >> 6), lane = tid & 63, wr = wid >> 2, wc = wid & 3, fr = lane & 15, fq = lane >> 4;
    const int K = g.K, nt = K / BK;
    unsigned voffA[2], voffB[2];
#pragma unroll
    for (int i = 0; i < 2; ++i) { int R, C; stage_rc(tid * 16 + i * 8192, R, C); const int Rb = Epi::PERM ? ((R & ~31) + perm32(R & 31)) : R;
        voffA[i] = (unsigned)(R * g.lda + C) * 2u; voffB[i] = (unsigned)(Rb * K + C) * 2u; }
    const size_t kstep = (size_t)(BK * 2);
    const size_t hstep = (size_t)HALF * K * 2, hstepA = (size_t)HALF * g.lda * 2;
    const size_t tstep = 2 * hstep, tstepA = 2 * hstepA;
    const unsigned ldsw = (unsigned)wid * 1024u;
    const int aoff = lds_byte(wr * 64 + fr, fq * 8), boff = lds_byte(wc * 32 + fr, fq * 8);
#define PG8_SA(b, h) (((b) * 2 + (h)) * HTB)
#define PG8_SB(b, h) ((4 + (b) * 2 + (h)) * HTB)
#define PG8_STAGE(bufoff, gbase, voff) do { _Pragma("unroll") for (int _i = 0; _i < 2; ++_i) \
        __builtin_amdgcn_global_load_lds((const unsigned*)((const char*)(gbase) + (voff)[_i]), (PG8_LAS unsigned*)(lds + (bufoff) + ldsw + _i * 8192), 16, 0, 0); } while (0)
#define PG8_LDA(dst, b, h) do { _Pragma("unroll") for (int m = 0; m < 4; ++m) _Pragma("unroll") for (int k = 0; k < 2; ++k) dst[m][k] = *(const PG8_LAS bf16x8*)(lds + PG8_SA(b, h) + aoff + m * 2048 + k * 1024); } while (0)
#define PG8_LDB(dst, b, h) do { _Pragma("unroll") for (int n = 0; n < 2; ++n) _Pragma("unroll") for (int k = 0; k < 2; ++k) dst[n][k] = *(const PG8_LAS bf16x8*)(lds + PG8_SB(b, h) + boff + n * 2048 + k * 1024); } while (0)
#define PG8_MMA(ai, bj, At, Bt) do { __builtin_amdgcn_s_setprio(1); _Pragma("unroll") for (int m = 0; m < 4; ++m) _Pragma("unroll") for (int n = 0; n < 2; ++n) _Pragma("unroll") for (int k = 0; k < 2; ++k) \
        acc[ai][bj][m][n] = __builtin_amdgcn_mfma_f32_16x16x32_bf16(Bt[n][k], At[m][k], acc[ai][bj][m][n], 0, 0, 0); __builtin_amdgcn_s_setprio(0); } while (0)
#define PG8_WAIT_V(n) asm volatile("s_waitcnt vmcnt(" #n ")" ::: "memory")
#define PG8_WAIT_L(n) asm volatile("s_waitcnt lgkmcnt(" #n ")" ::: "memory")
#define PG8_BAR __builtin_amdgcn_s_barrier()
#define PG8_SCHED __builtin_amdgcn_sched_barrier(0)
    Unit cur, nxt; int ui = 0;
    if (!S.next(0, cur)) return;
    f32x4 acc[2][2][4][2];
#pragma unroll
    for (int a = 0; a < 2; ++a)
#pragma unroll
        for (int b = 0; b < 2; ++b)
#pragma unroll
            for (int m = 0; m < 4; ++m)
#pragma unroll
                for (int n = 0; n < 2; ++n) acc[a][b][m][n] = (f32x4){0.f, 0.f, 0.f, 0.f};
    bf16x8 At[4][2], B0[2][2], B1[2][2];
    const char* cA = (const char*)g.A + (size_t)cur.pm * tstepA; const char* cB = (const char*)g.Bt + (size_t)cur.pn * tstep;
    S.a_ready(cur);
    PG8_STAGE(PG8_SB(0, 0), cB, voffB); PG8_STAGE(PG8_SA(0, 0), cA, voffA); PG8_STAGE(PG8_SB(0, 1), cB + hstep, voffB); PG8_STAGE(PG8_SA(0, 1), cA + hstepA, voffA);
    if (wr == 1) PG8_BAR;
    PG8_WAIT_V(4); PG8_BAR;
    PG8_STAGE(PG8_SB(1, 0), cB + kstep, voffB); PG8_STAGE(PG8_SA(1, 0), cA + kstep, voffA); PG8_STAGE(PG8_SB(1, 1), cB + hstep + kstep, voffB);
    PG8_WAIT_V(6); PG8_BAR;
    for (;;) {
        const bool has_next = S.next(ui + 1, nxt);
        const char* nA = has_next ? (const char*)g.A + (size_t)nxt.pm * tstepA : cA; const char* nB = has_next ? (const char*)g.Bt + (size_t)nxt.pn * tstep : cB;
        for (int t = 0; t < nt; t += 2) {
            const bool last = (t == nt - 2);
            const char* a1 = cA + (size_t)(t + 1) * kstep;
            const char* a2 = last ? nA : cA + (size_t)(t + 2) * kstep; const char* b2 = last ? nB : cB + (size_t)(t + 2) * kstep;
            const char* a3 = a2 + kstep; const char* b3 = b2 + kstep;
            if (last && has_next) S.a_ready(nxt);
            PG8_LDB(B0, 0, 0); PG8_SCHED; PG8_LDA(At, 0, 0); PG8_STAGE(PG8_SA(1, 1), a1 + hstepA, voffA);
            PG8_WAIT_L(8); PG8_BAR; PG8_WAIT_L(0); PG8_MMA(0, 0, At, B0); PG8_BAR; PG8_SCHED;
            PG8_LDB(B1, 0, 1); PG8_STAGE(PG8_SB(0, 0), b2, voffB);
            PG8_BAR; PG8_WAIT_L(0); PG8_MMA(0, 1, At, B1); PG8_BAR;
            PG8_LDA(At, 0, 1); PG8_STAGE(PG8_SA(0, 0), a2, voffA);
            PG8_BAR; PG8_WAIT_L(0); PG8_MMA(1, 0, At, B0); PG8_BAR; PG8_SCHED;
            PG8_STAGE(PG8_SB(0, 1), b2 + hstep, voffB);
            PG8_WAIT_V(6); PG8_BAR; PG8_MMA(1, 1, At, B1); PG8_BAR;
            PG8_LDB(B0, 1, 0); PG8_SCHED; PG8_LDA(At, 1, 0); PG8_STAGE(PG8_SA(0, 1), a2 + hstepA, voffA);
            PG8_WAIT_L(8); PG8_BAR; PG8_WAIT_L(0); PG8_MMA(0, 0, At, B0); PG8_BAR; PG8_SCHED;
            PG8_LDB(B1, 1, 1); PG8_STAGE(PG8_SB(1, 0), b3, voffB);
            PG8_BAR; PG8_WAIT_L(0); PG8_MMA(0, 1, At, B1); PG8_BAR;
            PG8_LDA(At, 1, 1); PG8_STAGE(PG8_SA(1, 0), a3, voffA);
            PG8_BAR; PG8_WAIT_L(0); PG8_MMA(1, 0, At, B0); PG8_BAR; PG8_SCHED;
            PG8_STAGE(PG8_SB(1, 1), b3 + hstep, voffB);
            PG8_WAIT_V(6); PG8_BAR; PG8_MMA(1, 1, At, B1); PG8_BAR;
        }
        if constexpr (!Epi::AFTER_DRAIN) { E(acc, cur, wr, wc, fr, fq); S.done(cur); }
        if (!has_next) break;
#pragma unroll
        for (int a = 0; a < 2; ++a)
#pragma unroll
            for (int b = 0; b < 2; ++b)
#pragma unroll
                for (int m = 0; m < 4; ++m)
#pragma unroll
                    for (int n = 0; n < 2; ++n) acc[a][b][m][n] = (f32x4){0.f, 0.f, 0.f, 0.f};
        cur = nxt; cA = nA; cB = nB; ++ui;
    }
    PG8_WAIT_V(0);
    if (wr == 0) PG8_BAR;
    PG8_BAR;
    if constexpr (Epi::AFTER_DRAIN) { E.fused(acc, cur, wr, wc, fr, fq, lds, wid, lane); S.done(cur); }
#undef PG8_SA
#undef PG8_SB
#undef PG8_STAGE
#undef PG8_LDA
#undef PG8_LDB
#undef PG8_MMA
#undef PG8_WAIT_V
#undef PG8_WAIT_L
#undef PG8_BAR
#undef PG8_SCHED
}
}
using pg8::bf16_t; using pg8::bf16x8; using pg8::f32x4; using pg8::u32x4;
#define LAS __attribute__((address_space(3)))
typedef short s16x4 __attribute__((ext_vector_type(4)));
typedef float f32x16 __attribute__((ext_vector_type(16)));
typedef unsigned u32x2 __attribute__((ext_vector_type(2)));

constexpr int SEQ = 2048, DM = 1024, NBATCH = 16, TT = NBATCH * SEQ, TH = TT / 2, BH = NBATCH / 2, DFF = 4096;
constexpr float EPS = 1e-6f, LOG2E = 1.4426950408889634f, LOG2_THETA = 13.287712379549449f;
constexpr int NTHR = 512;
constexpr int LDS_BYTES = 131072 + 8192;
constexpr int RS_OFF = 131072 + 2048;
constexpr size_t MiB = (size_t)1 << 20;
constexpr size_t WS_WIN = 0, WS_WQB = WS_WIN + 2 * MiB, WS_WKVB = WS_WQB + 3 * MiB, WS_WO = WS_WKVB + 4 * MiB, WS_WKVQ = WS_WO + 8 * MiB, WS_WQ1 = WS_WKVQ + 18 * MiB,
                 WS_WOB = WS_WQ1 + 6 * MiB, WS_W1 = WS_WOB + 4 * MiB, WS_W2 = WS_W1 + 32 * MiB, WS_XB = WS_W2 + 32 * MiB, WS_SS = WS_XB + 32 * MiB, WS_LSE = WS_SS + 1 * MiB,
                 WS_BAR = WS_LSE + 768 * 1024, WS_SSL = WS_LSE + 1 * MiB, WS_BIG = WS_SSL + 1 * MiB;
constexpr size_t WS_LAT = WS_BIG, WS_Q = WS_LAT + 16 * MiB, WS_KV = WS_Q + 96 * MiB, WS_KPE = WS_KV + 128 * MiB, WS_AO = WS_KPE + 32 * MiB;
constexpr size_t WS_SSK = WS_KPE, WS_KPER = WS_KPE + 8 * MiB;
constexpr size_t WS_KVB = WS_BIG, WS_QB = WS_BIG + 192 * MiB, WS_OB = WS_BIG + 288 * MiB;
constexpr size_t WS_H = WS_BIG + 192 * MiB;
constexpr size_t WS_END = WS_BIG + 336 * MiB;

struct Params { const void* in[20]; float* out; unsigned char* ws; int ph_lo, ph_hi; };

__device__ __forceinline__ unsigned cvtpk(float lo, float hi) { unsigned r; asm volatile("v_cvt_pk_bf16_f32 %0, %1, %2" : "=v"(r) : "v"(lo), "v"(hi)); return r; }
__device__ __forceinline__ float bf_lo(unsigned w) { return __uint_as_float(w << 16); }
__device__ __forceinline__ float bf_hi(unsigned w) { return __uint_as_float(w & 0xffff0000u); }
#define UNPACK8(W_, V_) do { const u32x4 t_ = (W_); V_[0] = bf_lo(t_[0]); V_[1] = bf_hi(t_[0]); V_[2] = bf_lo(t_[1]); V_[3] = bf_hi(t_[1]); V_[4] = bf_lo(t_[2]); V_[5] = bf_hi(t_[2]); V_[6] = bf_lo(t_[3]); V_[7] = bf_hi(t_[3]); } while (0)
#define PACK8(V_) ((u32x4){cvtpk(V_[0], V_[1]), cvtpk(V_[2], V_[3]), cvtpk(V_[4], V_[5]), cvtpk(V_[6], V_[7])})
__device__ __forceinline__ void sincos_rev(float pos, float invf_rev, float& s, float& c) {
    float rev = pos * invf_rev; rev = rev - floorf(rev);
    s = __builtin_amdgcn_sinf(rev); c = __builtin_amdgcn_cosf(rev);
}

__device__ __forceinline__ void cvt_job(const float* __restrict__ W, int K, int N, const float* __restrict__ gain, bf16_t* __restrict__ dst, int ldo, int& base, LAS float* tile) {
    const int tk = K / 64, tn = N / 64, nt = tk * tn, G = (int)gridDim.x, tid = opaque_tid();
    int start = (opaque_bid() - (base % G)); if (start < 0) start += G;
    for (int t0 = start; t0 < nt; t0 += 4 * G) {
        f32x4 v[4][2]; float g[4][2];
#pragma unroll
        for (int q = 0; q < 4; ++q) { const int t = t0 + q * G; if (t < nt) { const int kt = t / tn, ntile = t - kt * tn;
#pragma unroll
            for (int i = 0; i < 2; ++i) { const int k = (tid >> 4) + 32 * i, n4 = (tid & 15) * 4;
                v[q][i] = *(const f32x4*)(W + (size_t)(kt * 64 + k) * N + ntile * 64 + n4); g[q][i] = gain ? gain[kt * 64 + k] : 1.0f; } } }
        __syncthreads();
#pragma unroll
        for (int q = 0; q < 4; ++q) { const int t = t0 + q * G; if (t < nt) { LAS float* tq = tile + q * (64 * 65);
#pragma unroll
            for (int i = 0; i < 2; ++i) { const int k = (tid >> 4) + 32 * i, n4 = (tid & 15) * 4;
                tq[(n4 + 0) * 65 + k] = v[q][i].x * g[q][i]; tq[(n4 + 1) * 65 + k] = v[q][i].y * g[q][i]; tq[(n4 + 2) * 65 + k] = v[q][i].z * g[q][i]; tq[(n4 + 3) * 65 + k] = v[q][i].w * g[q][i]; } } }
        __syncthreads();
#pragma unroll
        for (int q = 0; q < 4; ++q) { const int t = t0 + q * G; if (t < nt) { const int kt = t / tn, ntile = t - kt * tn; const int n = tid >> 3, k8 = (tid & 7) * 8;
            const LAS float* tp = tile + q * (64 * 65) + n * 65 + k8;
            u32x4 w; w.x = cvtpk(tp[0], tp[1]); w.y = cvtpk(tp[2], tp[3]); w.z = cvtpk(tp[4], tp[5]); w.w = cvtpk(tp[6], tp[7]);
            *(u32x4*)(dst + (size_t)(ntile * 64 + n) * ldo + kt * 64 + k8) = w; } }
    }
    base += nt;
}
__device__ __forceinline__ void zero_fill(bf16_t* dst, int rows, int cols8, int ld) {
    const size_t n = (size_t)rows * cols8;
    for (size_t i = (size_t)opaque_bid() * NTHR + opaque_tid(); i < n; i += (size_t)gridDim.x * NTHR) { const size_t r = i / cols8, c = i - r * cols8; *(u32x4*)(dst + r * ld + c * 8) = (u32x4){0u, 0u, 0u, 0u}; }
}
__device__ void prep_weights(const Params& p, LAS unsigned char* lds) {
    LAS float* tile = (LAS float*)lds;
    unsigned char* ws = p.ws;
    const float* attn_norm = (const float*)p.in[2]; const float* mlp_norm = (const float*)p.in[3];
    int base = 0;
    for (int a = 0; a < 2; ++a) {
        cvt_job((const float*)p.in[4] + (size_t)a * 1024 * 448, 1024, 448, attn_norm + a * 1024, (bf16_t*)(ws + WS_WIN) + (size_t)a * 512 * 1024, 1024, base, tile);
        cvt_job((const float*)p.in[7] + (size_t)a * 256 * 3072, 256, 3072, (const float*)p.in[5] + a * 256, (bf16_t*)(ws + WS_WQB) + (size_t)a * 3072 * 256, 256, base, tile);
        cvt_job((const float*)p.in[8] + (size_t)a * 128 * 4096, 128, 4096, (const float*)p.in[6] + a * 128, (bf16_t*)(ws + WS_WKVB) + (size_t)a * 4096 * 256, 256, base, tile);
        cvt_job((const float*)p.in[11] + (size_t)a * 2048 * 1024, 2048, 1024, nullptr, (bf16_t*)(ws + WS_WO) + (size_t)a * 1024 * 2048, 2048, base, tile);
        cvt_job((const float*)p.in[17] + (size_t)a * 1024 * 1024, 1024, 1024, nullptr, (bf16_t*)(ws + WS_WOB) + (size_t)a * 1024 * 1024, 1024, base, tile);
        zero_fill((bf16_t*)(ws + WS_WIN) + (size_t)a * 512 * 1024 + (size_t)448 * 1024, 64, 128, 1024);
        zero_fill((bf16_t*)(ws + WS_WKVB) + (size_t)a * 4096 * 256 + 128, 4096, 16, 256);
    }
    cvt_job((const float*)p.in[13], 1024, 6144, (const float*)p.in[12], (bf16_t*)(ws + WS_WKVQ), 1024, base, tile);
    cvt_job((const float*)p.in[15], 1024, 3072, attn_norm + 2 * 1024, (bf16_t*)(ws + WS_WKVQ) + (size_t)6144 * 1024, 1024, base, tile);
    cvt_job((const float*)p.in[15] + (size_t)1024 * 3072, 1024, 3072, attn_norm + 3 * 1024, (bf16_t*)(ws + WS_WQ1), 1024, base, tile);
    for (int l = 0; l < 4; ++l) {
        cvt_job((const float*)p.in[18] + (size_t)l * 1024 * 4096, 1024, 4096, mlp_norm + l * 1024, (bf16_t*)(ws + WS_W1) + (size_t)l * 4096 * 1024, 1024, base, tile);
        cvt_job((const float*)p.in[19] + (size_t)l * 4096 * 1024, 4096, 1024, nullptr, (bf16_t*)(ws + WS_W2) + (size_t)l * 1024 * 4096, 4096, base, tile);
    }
    __syncthreads();
}
__device__ void prep_x(const float* __restrict__ x, bf16_t* __restrict__ xb, float* __restrict__ ss) {
    const int tid_ = opaque_tid(), lane = tid_ & 63, gw = opaque_bid() * 8 + (tid_ >> 6), nw = gridDim.x * 8;
    for (int r = gw; r < TH; r += nw) {
        const float* xr = x + (size_t)r * 1024; bf16_t* br = xb + (size_t)r * 1024; float s = 0.f;
#pragma unroll
        for (int i = 0; i < 4; ++i) { const f32x4 v = *(const f32x4*)(xr + i * 256 + lane * 4); s += v.x * v.x + v.y * v.y + v.z * v.z + v.w * v.w;
            *(u32x2*)(br + i * 256 + lane * 4) = (u32x2){cvtpk(v.x, v.y), cvtpk(v.z, v.w)}; }
#pragma unroll
        for (int o = 1; o < 64; o <<= 1) s += __shfl_xor(s, o);
        if (lane < 16) ss[(size_t)r * 16 + lane] = lane == 0 ? s : 0.f;
    }
}

struct EpiBf16S {
    static constexpr bool PERM = true, AFTER_DRAIN = false;
    bf16_t* O; int ldc; bf16_t* O2; int ldc2; int split; const float* ss; int nsl4; float inv_n; int act; float* ssl; float* ssk; const LAS float* rs; int pm0;
    __device__ __forceinline__ void operator()(const f32x4 (&acc)[2][2][4][2], const pg8::Unit& u, int wr, int wc, int fr, int fq) const {
        const int row0 = u.pm * 256 + wr * 64 + fr; int colt = u.pn * 256; bf16_t* base = O; int ld = ldc;
        if (colt >= split) { base = O2; colt -= split; ld = ldc2; }
        const int col0 = colt + wc * 32 + 8 * fq;
#pragma unroll
        for (int ai = 0; ai < 2; ++ai)
#pragma unroll
            for (int m = 0; m < 4; ++m) { const int row = row0 + ai * 128 + m * 16; float sc = 1.0f;
                if (ss) { if (u.pm == pm0) sc = rs[(wr * 4 + wc) * 128 + ai * 64 + m * 16 + fr];
                    else { const f32x4* sp = (const f32x4*)(ss + (size_t)row * 16); f32x4 a = sp[0]; if (nsl4 == 4) a = (a + sp[1]) + (sp[2] + sp[3]); sc = rsqrtf(((a.x + a.y) + (a.z + a.w)) * inv_n + EPS); } }
                bf16_t* rowp = base + (size_t)row * ld + col0; float sa = 0.f, sb = 0.f;
#pragma unroll
                for (int bj = 0; bj < 2; ++bj) { f32x4 v0 = acc[ai][bj][m][0] * sc, v1 = acc[ai][bj][m][1] * sc;
                    if (act) {
#pragma unroll
                        for (int j = 0; j < 4; ++j) { const float a0 = fmaxf(v0[j], 0.f), a1 = fmaxf(v1[j], 0.f); v0[j] = a0 * a0; v1[j] = a1 * a1; } }
                    const float sq = ((v0[0] * v0[0] + v0[1] * v0[1]) + (v0[2] * v0[2] + v0[3] * v0[3])) + ((v1[0] * v1[0] + v1[1] * v1[1]) + (v1[2] * v1[2] + v1[3] * v1[3]));
                    if (bj == 0) sa = sq; else sb = sq;
                    u32x4 w; w.x = cvtpk(v0[0], v0[1]); w.y = cvtpk(v0[2], v0[3]); w.z = cvtpk(v1[0], v1[1]); w.w = cvtpk(v1[2], v1[3]);
                    *(u32x4*)(rowp + bj * 128) = w; }
                if (ssk) { float sk_ = sa; sk_ += __shfl_xor(sk_, 16); sk_ += __shfl_xor(sk_, 32); if (fq == 0) ssk[((size_t)row * 16 + u.pn) * 4 + wc] = sk_; }
                if (ssl) { sa += __shfl_xor(sa, 16); sa += __shfl_xor(sa, 32); sb += __shfl_xor(sb, 16); sb += __shfl_xor(sb, 32);
                    if (fq == 0) { float* sr_ = ssl + (size_t)row * 16; if (u.pn == 0) sr_[wc] = sa + sb; else { sr_[4 + wc] = sa; sr_[8 + wc] = sb; } } } }
    }
};
struct EpiRes {
    static constexpr bool PERM = false, AFTER_DRAIN = false;
    const float* xin; float* xout; bf16_t* xb; float* ss;
    __device__ __forceinline__ void operator()(const f32x4 (&acc)[2][2][4][2], const pg8::Unit& u, int wr, int wc, int fr, int fq) const {
        const int row0 = u.pm * 256 + wr * 64 + fr, col0 = u.pn * 256 + wc * 32 + 4 * fq;
#pragma unroll
        for (int ai = 0; ai < 2; ++ai)
#pragma unroll
            for (int m = 0; m < 4; ++m) { const int row = row0 + ai * 128 + m * 16; const size_t off = (size_t)row * 1024 + col0; float s = 0.f;
#pragma unroll
                for (int bj = 0; bj < 2; ++bj)
#pragma unroll
                    for (int n = 0; n < 2; ++n) { const int c = bj * 128 + n * 16; const f32x4 o = *(const f32x4*)(xin + off + c) + acc[ai][bj][m][n];
                        *(f32x4*)(xout + off + c) = o; s += (o.x * o.x + o.y * o.y) + (o.z * o.z + o.w * o.w);
                        *(u32x2*)(xb + off + c) = (u32x2){cvtpk(o.x, o.y), cvtpk(o.z, o.w)}; }
                s += __shfl_xor(s, 16); s += __shfl_xor(s, 32);
                if (fq == 0) ss[(size_t)row * 16 + u.pn * 4 + wc] = s; }
    }
};
template <class Epi> __device__ __forceinline__ void run_gemm(LAS unsigned char* lds, const bf16_t* A, int lda, const bf16_t* Bt, int N, int K, const Epi& E) {
    pg8::Gemm g{A, Bt, TH, N, K, lda}; pg8::StaticOrder S; S.init(TH, N, (int)gridDim.x, opaque_bid());
    pg8::gemm_phase<Epi, pg8::StaticOrder>(lds, g, S, E);
}
__device__ __forceinline__ void run_gemm_bf16(LAS unsigned char* lds, const bf16_t* A, int lda, const bf16_t* Bt, int N, int K, EpiBf16S E) {
    pg8::Gemm g{A, Bt, TH, N, K, lda}; pg8::StaticOrder S; S.init(TH, N, (int)gridDim.x, opaque_bid());
    E.rs = (const LAS float*)(lds + RS_OFF); E.pm0 = -1;
    pg8::Unit u0;
    if (E.ss && S.next(0, u0)) {
        const int tid = opaque_tid(), wid = tid >> 6, lane = tid & 63, wr = wid >> 2;
        LAS float* tab = (LAS float*)(lds + RS_OFF) + wid * 128;
#pragma unroll
        for (int hh = 0; hh < 2; ++hh) { const int row = u0.pm * 256 + hh * 128 + wr * 64 + lane;
            const f32x4* sp = (const f32x4*)(E.ss + (size_t)row * 16); f32x4 a = sp[0]; if (E.nsl4 == 4) a = (a + sp[1]) + (sp[2] + sp[3]);
            tab[hh * 64 + lane] = rsqrtf(((a.x + a.y) + (a.z + a.w)) * E.inv_n + EPS); }
        E.pm0 = u0.pm;
    }
    pg8::gemm_phase<EpiBf16S, pg8::StaticOrder>(lds, g, S, E);
}

__device__ void lat_prep(bf16_t* lat) {
    const int tid_ = opaque_tid(), lane = tid_ & 63, gw = opaque_bid() * 8 + (tid_ >> 6), nw = gridDim.x * 8;
    for (int t = gw; t < TH; t += nw) {
        bf16_t* p = lat + (size_t)t * 512 + lane * 8; const u32x4 w = *(const u32x4*)p; float v[8]; UNPACK8(w, v);
        float s = 0.f;
#pragma unroll
        for (int e = 0; e < 8; ++e) s += v[e] * v[e];
        s += __shfl_xor(s, 1); s += __shfl_xor(s, 2); s += __shfl_xor(s, 4); s += __shfl_xor(s, 8);
        const float s32 = s + __shfl_xor(s, 16);
        const float rstd = lane < 32 ? rsqrtf(s32 * (1.0f / 256.0f) + EPS) : rsqrtf(s * (1.0f / 128.0f) + EPS);
        if (lane < 48) {
#pragma unroll
            for (int e = 0; e < 8; ++e) v[e] *= rstd;
            *(u32x4*)p = PACK8(v); }
    }
}
__device__ void kpe_prep(const bf16_t* lat, const int* pos, const float* gk, bf16_t* kper) {
    const int tid = opaque_tid(), grp = tid >> 3, l8 = tid & 7;
    float invf[8], g[8];
#pragma unroll
    for (int e = 0; e < 8; ++e) { invf[e] = exp2f(-(float)((l8 & 3) * 8 + e) * (LOG2_THETA / 32.0f)) * 0.15915494309189535f; g[e] = gk[128 + l8 * 8 + e]; }
    for (int t = opaque_bid() * 64 + grp; t < TH; t += (int)gridDim.x * 64) {
        const float posf = (float)pos[t];
        const u32x4 w = *(const u32x4*)(lat + (size_t)t * 512 + 384 + l8 * 8); float v[8]; UNPACK8(w, v);
#pragma unroll
        for (int e = 0; e < 8; ++e) { const float y = v[e] * g[e]; const float pr = __shfl_xor(y, 4); float sn_, cs_; sincos_rev(posf, invf[e], sn_, cs_);
            v[e] = (l8 & 4) ? y * cs_ + pr * sn_ : y * cs_ - pr * sn_; }
        *(u32x4*)(kper + (size_t)t * 64 + l8 * 8) = PACK8(v);
    }
}
__device__ void head_prep(bf16_t* kbuf  , bf16_t* qbuf, const int* pos, const float* gk, const float* gq) {
    const int tid_ = opaque_tid(), lane = tid_ & 63, gw = opaque_bid() * 8 + (tid_ >> 6), nw = gridDim.x * 8;
    const float qscale = 0.08838834764831845f * LOG2E;
    const int c16 = lane & 15;
    float invf[8];
#pragma unroll
    for (int e = 0; e < 8; ++e) invf[e] = exp2f(-(float)((c16 & 7) * 8 + e) * (LOG2_THETA / 64.0f)) * 0.15915494309189535f;
    for (int t = gw; t < TH; t += nw) {
        const float posf = (float)pos[t];
        float cs[8], sn[8];
#pragma unroll
        for (int e = 0; e < 8; ++e) sincos_rev(posf, invf[e], sn[e], cs[e]);
        u32x4 wv[6];
#pragma unroll
        for (int itr = 0; itr < 6; ++itr) wv[itr] = *(const u32x4*)(kbuf + (size_t)t * 6144 + (itr * 4 + (lane >> 4)) * 128 + c16 * 8);
#pragma unroll
        for (int itr = 0; itr < 6; ++itr) { const bool isq = false;
            const int hh = (isq ? itr - 6 : itr) * 4 + (lane >> 4), g = hh >> 3;
            bf16_t* p = isq ? qbuf + (size_t)t * 3072 + hh * 128 + c16 * 8 : kbuf + (size_t)t * 6144 + hh * 128 + c16 * 8;
            const float* gn = (isq ? gq : gk) + g * 128 + c16 * 8;
            float v[8]; UNPACK8(wv[itr], v); float s = 0.f;
#pragma unroll
            for (int e = 0; e < 8; ++e) s += v[e] * v[e];
            s += __shfl_xor(s, 1); s += __shfl_xor(s, 2); s += __shfl_xor(s, 4); s += __shfl_xor(s, 8);
            const float rstd = rsqrtf(s * (1.0f / 128.0f) + EPS), osc = isq ? qscale : 1.0f;
#pragma unroll
            for (int e = 0; e < 8; ++e) { const float y = v[e] * rstd * gn[e]; const float pr = __shfl_xor(y, 8);
                v[e] = ((c16 & 8) ? y * cs[e] + pr * sn[e] : y * cs[e] - pr * sn[e]) * osc; }
            *(u32x4*)p = PACK8(v); }
    }
}

struct AttnItem { const bf16_t* q; const bf16_t* k; const bf16_t* kpe; const bf16_t* v; bf16_t* o; float* lse; const int* pos; const float* gq; const float* gk; const float* ssk; const float* ssl; int q_ld, k_ld, kpe_ld, v_ld, o_ld, P0, ld, merge; };
__device__ __forceinline__ int v_st(int k, int c) { const int kk = (k & ~0xC) | ((k & 4) << 1) | ((k & 8) >> 1); return ((kk >> 3) * 4 + (c >> 5)) * 512 + ((kk & 7) * 32 + (c & 31)) * 2; }
__device__ __forceinline__ int v_rd_base(int lane) { return ((lane & 3) << 3) | (((lane >> 2) & 3) << 6) | (((lane >> 4) & 1) << 5) | (((lane >> 5) & 1) << 8); }
#define PK4(P, B_, OUT) do { unsigned a0_ = cvtpk(P[B_+0], P[B_+1]), a1_ = cvtpk(P[B_+2], P[B_+3]); unsigned b0_ = cvtpk(P[B_+4], P[B_+5]), b1_ = cvtpk(P[B_+6], P[B_+7]); \
        auto r0_ = __builtin_amdgcn_permlane32_swap(a0_, b0_, false, false); auto r1_ = __builtin_amdgcn_permlane32_swap(a1_, b1_, false, false); \
        u32x4 w_ = {r0_[0], r1_[0], r0_[1], r1_[1]}; OUT = w_; } while (0)
__device__ __forceinline__ bf16x8 as_bf(u32x4 w) { return *reinterpret_cast<bf16x8*>(&w); }

template <int DQK, int MODE>
__device__ __forceinline__ void attn_block(const AttnItem& it, LAS unsigned char* lds) {
    constexpr int RS = DQK * 2, SHM_K = 64 * RS, SHM_V = 16384, ND0 = DQK / 16, KCH = DQK / 8, NKC = (64 * KCH) / 512;
    const int tid = opaque_tid(), wid = __builtin_amdgcn_readfirstlane(tid >> 6), lane = tid & 63, r32 = lane & 31, hi = lane >> 5;
    const int ld = it.ld, Lm1 = (2048 >> ld) - 1, lsh = 11 - ld;
#define TOK(p) (MODE == 0 ? (p) : ((((p) & Lm1) << ld) | ((p) >> lsh)))
#define LOF(p) (MODE == 0 ? 0 : max((p) - 128, (p) & ~Lm1))
    const int q0 = it.P0 + wid * 32, qp = q0 + r32;
    const int span = qp - LOF(qp), lo_w = LOF(q0), lo_last = LOF(q0 + 31);
    LAS unsigned char* V_lds = lds; LAS unsigned char* K_lds = lds + 2 * SHM_V;
    const int j_lo = LOF(it.P0) >> 6, NT = (it.P0 >> 6) + 4 - j_lo;
    const int sr = tid >> 4, sc = (tid & 15) * 8, vst0 = v_st(sr, sc), vst1 = v_st(32 + sr, sc);
    constexpr int NSET = (MODE == 1) ? 2 : 1;
    bf16x8 sk[NSET][NKC], sv0[NSET], sv1[NSET]; f32x4 s_k4 = {0.f, 0.f, 0.f, 0.f}, s_p4 = {0.f, 0.f, 0.f, 0.f};
    constexpr int KRS_OFF = 2 * SHM_V + 2 * SHM_K;
    int offk[NKC], offv0 = sr * it.v_ld + sc, offv1 = (32 + sr) * it.v_ld + sc;
#pragma unroll
    for (int i_ = 0; i_ < NKC; ++i_) { const int c_ = tid + 512 * i_, row_ = c_ / KCH, cc_ = c_ - row_ * KCH; offk[i_] = (DQK == 192 && cc_ >= 16) ? row_ * it.kpe_ld + (cc_ - 16) * 8 : row_ * it.k_ld + cc_ * 8; }
#define SLOAD(S_, kb_) do { if (MODE == 0) { const bf16_t* kt_ = it.k + (size_t)(kb_) * it.k_ld; const bf16_t* pt_ = it.kpe + (size_t)(kb_) * it.kpe_ld; const bf16_t* vt_ = it.v + (size_t)(kb_) * it.v_ld; \
            _Pragma("unroll") for (int i_ = 0; i_ < NKC; ++i_) { const int c_ = tid + 512 * i_, row_ = c_ / KCH, cc_ = c_ - row_ * KCH; sk[S_][i_] = *(const bf16x8*)(((DQK == 192 && cc_ >= 16) ? pt_ : kt_) + offk[i_]); } \
            sv0[S_] = *(const bf16x8*)(vt_ + offv0); sv1[S_] = *(const bf16x8*)(vt_ + offv1); \
            if (tid < 64) { s_k4 = *(const f32x4*)(it.ssk + (size_t)((kb_) + tid) * 64); s_p4 = *(const f32x4*)(it.ssl + (size_t)((kb_) + tid) * 16); } } else { \
        _Pragma("unroll") for (int i_ = 0; i_ < NKC; ++i_) { const int c_ = tid + 512 * i_, row_ = c_ / KCH, cc_ = c_ - row_ * KCH; const int tk_ = TOK((kb_) + row_); \
            sk[S_][i_] = *(const bf16x8*)(it.k + (size_t)tk_ * it.k_ld + cc_ * 8); } \
        { const int t0_ = TOK((kb_) + sr), t1_ = TOK((kb_) + 32 + sr); sv0[S_] = *(const bf16x8*)(it.v + (size_t)t0_ * it.v_ld + sc); sv1[S_] = *(const bf16x8*)(it.v + (size_t)t1_ * it.v_ld + sc); } } } while (0)
#define SWRITE(S_, bf_) do { _Pragma("unroll") for (int i_ = 0; i_ < NKC; ++i_) { const int c_ = tid + 512 * i_, row_ = c_ / KCH, cc_ = c_ - row_ * KCH; const int swz_ = (((DQK == 128) ? row_ : (row_ >> 1)) & 7) << 4; \
            *(LAS bf16x8*)(K_lds + (bf_) * SHM_K + row_ * RS + ((cc_ * 16) ^ swz_)) = sk[S_][i_]; } \
        *(LAS bf16x8*)(V_lds + (bf_) * SHM_V + vst0) = sv0[S_]; *(LAS bf16x8*)(V_lds + (bf_) * SHM_V + vst1) = sv1[S_]; \
        if (MODE == 0 && tid < 64) { const f32x4 a_ = s_k4 + s_p4; *(LAS float*)(lds + KRS_OFF + (bf_) * 256 + tid * 4) = rsqrtf(((a_.x + a_.y) + (a_.z + a_.w)) * (1.0f / 192.0f) + EPS); } } while (0)
    float m_reg = -1e30f, l_reg = 0.f; f32x16 o[4];
#pragma unroll
    for (int d = 0; d < 4; ++d)
#pragma unroll
        for (int r = 0; r < 16; ++r) o[d][r] = 0.f;
    SLOAD(0, j_lo * 64); if (MODE == 1) SLOAD(NSET - 1, j_lo * 64 + 64);
    bf16x8 qr[ND0];
    {
      constexpr int NR = (MODE == 0) ? 2 : 4;
      constexpr int R0 = (MODE == 0) ? 8 : 0;
      constexpr float QS = ((MODE == 0) ? 0.07216878364870322f : 0.08838834764831845f) * LOG2E;
      constexpr float FSTEP = LOG2_THETA / ((MODE == 0) ? 32.0f : 64.0f);
      const int tq_ = TOK(qp);
      const bf16_t* qrow = it.q + (size_t)tq_ * it.q_ld + hi * 8;
      u32x4 raw[ND0]; float ssq = 0.f;
#pragma unroll
      for (int d0 = 0; d0 < ND0; ++d0) raw[d0] = *(const u32x4*)(qrow + d0 * 16);
      const float posf = (float)it.pos[tq_];
#pragma unroll
      for (int d0 = 0; d0 < ND0; ++d0) { float v[8]; UNPACK8(raw[d0], v);
#pragma unroll
          for (int e = 0; e < 8; ++e) ssq += v[e] * v[e]; }
      { auto rr = __builtin_amdgcn_permlane32_swap(__float_as_uint(ssq), __float_as_uint(ssq), false, false); ssq = __uint_as_float(rr[0]) + __uint_as_float(rr[1]); }
      const float rq = rsqrtf(ssq * (1.0f / (float)DQK) + EPS) * QS;
      const float* gp = it.gq + hi * 8;
#pragma unroll
      for (int d0 = 0; d0 < ND0; ++d0) {
          if (d0 >= R0 + NR && d0 < R0 + 2 * NR) continue;
          f32x4 g0 = *(const f32x4*)(gp + d0 * 16), g1 = *(const f32x4*)(gp + d0 * 16 + 4);
          if (MODE == 0 && d0 < 8) { g0 *= *(const f32x4*)(it.gk + hi * 8 + d0 * 16); g1 *= *(const f32x4*)(it.gk + hi * 8 + d0 * 16 + 4); }
          float v[8]; UNPACK8(raw[d0], v);
#pragma unroll
          for (int e = 0; e < 8; ++e) v[e] *= rq * (e < 4 ? g0[e & 3] : g1[e & 3]);
          if (d0 >= R0 && d0 < R0 + NR) {
              const f32x4 h0 = *(const f32x4*)(gp + (d0 + NR) * 16), h1 = *(const f32x4*)(gp + (d0 + NR) * 16 + 4);
              float w[8]; UNPACK8(raw[d0 + NR], w);
#pragma unroll
              for (int e = 0; e < 8; ++e) { w[e] *= rq * (e < 4 ? h0[e & 3] : h1[e & 3]);
                  float sn_, cs_; sincos_rev(posf, exp2f(-(float)((d0 - R0) * 16 + hi * 8 + e) * FSTEP) * 0.15915494309189535f, sn_, cs_);
                  const float x1 = v[e], x2 = w[e]; v[e] = x1 * cs_ - x2 * sn_; w[e] = x2 * cs_ + x1 * sn_; }
              qr[d0 + NR] = as_bf(PACK8(w)); }
          qr[d0] = as_bf(PACK8(v)); } }
    SWRITE(0, 0); __syncthreads();
    const int swzr = (((DQK == 128) ? r32 : (r32 >> 1)) & 7) << 4;
    int kro[4];
#pragma unroll
    for (int dd = 0; dd < 4; ++dd) kro[dd] = r32 * RS + ((dd * 32 + hi * 16) ^ swzr);
#pragma unroll 1
    for (int t2 = 0; t2 < NT; t2 += NSET) {
#pragma unroll
      for (int us = 0; us < NSET; ++us) { const int t = t2 + us; if (t < NT) {
        const int kb = (j_lo + t) * 64, buf = t & 1;
        if (MODE == 1) { if (t + 2 < NT) SLOAD(us, kb + 128); } else { if (t + 1 < NT) SLOAD(0, kb + 64); }
#pragma unroll 1
        for (int hf = 0; hf < 2; ++hf) {
            const int kh = kb + 32 * hf;
            const bool act = (kh <= q0 + 31) && (kh + 31 >= lo_w);
            if (act) {
                f32x16 p0;
#pragma unroll
                for (int r = 0; r < 16; ++r) p0[r] = 0.f;
                { const LAS unsigned char* kbp = K_lds + buf * SHM_K + hf * (32 * RS);
#pragma unroll
                  for (int d0 = 0; d0 < ND0; ++d0) {
                      const bf16x8 b0 = *(const LAS bf16x8*)(kbp + kro[d0 & 3] + (d0 >> 2) * 128);
                      p0 = __builtin_amdgcn_mfma_f32_32x32x16_bf16(b0, qr[d0], p0, 0, 0, 0); } }
                if (MODE == 0) { const LAS float* kr_ = (const LAS float*)(lds + KRS_OFF + buf * 256) + 32 * hf + 4 * hi;
#pragma unroll
                    for (int j4 = 0; j4 < 4; ++j4) { const f32x4 s4 = *(const LAS f32x4*)(kr_ + 8 * j4);
#pragma unroll
                        for (int e = 0; e < 4; ++e) p0[4 * j4 + e] *= s4[e]; } }
                if (!((kh + 31 <= q0) && (kh >= lo_last))) {
                    const int dq = qp - kh - 4 * hi; const float NEG = -__builtin_inff();
#pragma unroll
                    for (int r = 0; r < 16; ++r) { const int c = (r & 3) + 8 * (r >> 2); if ((unsigned)(dq - c) > (unsigned)span) p0[r] = NEG; } }
                float pmax = p0[0];
#pragma unroll
                for (int r = 1; r < 16; ++r) pmax = fmaxf(pmax, p0[r]);
                { auto rr = __builtin_amdgcn_permlane32_swap(__float_as_uint(pmax), __float_as_uint(pmax), false, false); pmax = fmaxf(__uint_as_float(rr[0]), __uint_as_float(rr[1])); }
                const float mn = fmaxf(m_reg, pmax), alpha = __builtin_amdgcn_exp2f(m_reg - mn); m_reg = mn;
                float ps = 0.f;
#pragma unroll
                for (int r = 0; r < 16; ++r) { p0[r] = __builtin_amdgcn_exp2f(p0[r] - mn); ps += p0[r]; }
                { auto rr = __builtin_amdgcn_permlane32_swap(__float_as_uint(ps), __float_as_uint(ps), false, false); ps = __uint_as_float(rr[0]) + __uint_as_float(rr[1]); }
                l_reg = l_reg * alpha + ps;
                u32x4 pa0, pa1; PK4(p0, 0, pa0); PK4(p0, 8, pa1);
                if (__any(alpha != 1.0f)) {
#pragma unroll
                    for (int d = 0; d < 4; ++d)
#pragma unroll
                        for (int r = 0; r < 16; ++r) o[d][r] *= alpha; }
                const unsigned vb = (unsigned)(uintptr_t)(V_lds + buf * SHM_V + hf * 8192) + (unsigned)v_rd_base(lane);
#define TRRD(dst, off) asm volatile("ds_read_b64_tr_b16 %0, %1 offset:%2" : "=&v"(dst) : "v"(vb), "i"(off) : "memory")
#define PV_D0(d0) do { s16x4 l0, l1, h0, h1; constexpr int b_ = (d0) * 512; \
                TRRD(l0, b_); TRRD(h0, b_ + 2048); TRRD(l1, b_ + 4096); TRRD(h1, b_ + 6144); \
                asm volatile("s_waitcnt lgkmcnt(0)" ::: "memory"); __builtin_amdgcn_sched_barrier(0); \
                o[d0] = __builtin_amdgcn_mfma_f32_32x32x16_bf16((bf16x8){l0[0], l0[1], l0[2], l0[3], h0[0], h0[1], h0[2], h0[3]}, as_bf(pa0), o[d0], 0, 0, 0); \
                o[d0] = __builtin_amdgcn_mfma_f32_32x32x16_bf16((bf16x8){l1[0], l1[1], l1[2], l1[3], h1[0], h1[1], h1[2], h1[3]}, as_bf(pa1), o[d0], 0, 0, 0); } while (0)
                PV_D0(0); PV_D0(1); PV_D0(2); PV_D0(3);
#undef PV_D0
#undef TRRD
            }
        }
        if (t + 1 < NT) SWRITE((NSET - 1) - us, buf ^ 1);
        __syncthreads();
      } }
    }
    const int tq = TOK(qp);
    float a_cur = 1.0f / l_reg, a_prev = 0.f;
    if (MODE == 1) {
        const float lse_cur = m_reg + __builtin_amdgcn_logf(l_reg); float lse_new = lse_cur;
        if (it.merge) { const float lse_prev = it.lse[(size_t)tq * 8]; const float mx = fmaxf(lse_prev, lse_cur);
            const float e0 = __builtin_amdgcn_exp2f(lse_prev - mx), e1 = __builtin_amdgcn_exp2f(lse_cur - mx); const float inv = 1.0f / (e0 + e1);
            lse_new = mx + __builtin_amdgcn_logf(e0 + e1); a_prev = e0 * inv; a_cur *= e1 * inv; }
        if (hi == 0) it.lse[(size_t)tq * 8] = lse_new;
    }
    bf16_t* orow = it.o + (size_t)tq * it.o_ld + hi * 8;
#pragma unroll
    for (int d0 = 0; d0 < 4; ++d0) {
#pragma unroll
        for (int r = 0; r < 16; ++r) o[d0][r] *= a_cur;
        u32x4 w0, w1; PK4(o[d0], 0, w0); PK4(o[d0], 8, w1);
        if (MODE == 1 && it.merge) {
            const u32x4 q0w = *(const u32x4*)(orow + d0 * 32), q1w = *(const u32x4*)(orow + d0 * 32 + 16);
            float a[8], b[8];
            UNPACK8(w0, a); UNPACK8(q0w, b);
#pragma unroll
            for (int e = 0; e < 8; ++e) a[e] += b[e] * a_prev;
            w0 = PACK8(a);
            UNPACK8(w1, a); UNPACK8(q1w, b);
#pragma unroll
            for (int e = 0; e < 8; ++e) a[e] += b[e] * a_prev;
            w1 = PACK8(a);
        }
        *(u32x4*)(orow + d0 * 32) = w0; *(u32x4*)(orow + d0 * 32 + 16) = w1;
    }
#undef SLOAD
#undef SWRITE
#undef TOK
#undef LOF
}

__device__ void mla_attn_phase(const Params& p, LAS unsigned char* lds, const int* pos, const float* gq, const float* gk) {
    unsigned char* ws = p.ws;
    const int G_ = (int)gridDim.x, bid_ = opaque_bid(), vb_ = (G_ % 8 == 0) ? (bid_ % 8) * (G_ / 8) + bid_ / 8 : bid_;
    for (int item = vb_; item < BH * 16 * 4; item += G_) {
        const int bh = item >> 2, pr = item & 3, b = bh >> 4, h = bh & 15; const size_t tb = (size_t)b * SEQ;
        AttnItem it; it.q = (const bf16_t*)(ws + WS_Q) + tb * 3072 + h * 192; it.q_ld = 3072;
        it.k = (const bf16_t*)(ws + WS_KV) + tb * 4096 + h * 256; it.k_ld = 4096; it.kpe = (const bf16_t*)(ws + WS_KPER) + tb * 64; it.kpe_ld = 64; it.gk = gk; it.ssk = (const float*)(ws + WS_SSK) + (tb * 16 + h) * 4; it.ssl = (const float*)(ws + WS_SSL) + tb * 16 + 8;
        it.v = (const bf16_t*)(ws + WS_KV) + tb * 4096 + h * 256 + 128; it.v_ld = 4096; it.o = (bf16_t*)(ws + WS_AO) + tb * 2048 + h * 128; it.o_ld = 2048;
        it.lse = nullptr; it.ld = 0; it.merge = 0; it.pos = pos + tb; it.gq = gq;
#pragma unroll 1
        for (int k2 = 0; k2 < 2; ++k2) { it.P0 = (k2 == 0 ? 7 - pr : pr) * 256; attn_block<192, 0>(it, lds); }
    }
}
__device__ void dil_attn_phase(const Params& p, LAS unsigned char* lds, int g, const int* pos, const float* gq) {
    unsigned char* ws = p.ws;
    const int G_ = (int)gridDim.x, bid_ = opaque_bid(), vb_ = (G_ % 8 == 0) ? (bid_ % 8) * (G_ / 8) + bid_ / 8 : bid_;
    for (int item = vb_; item < BH * 8 * 8; item += G_) {
        const int bh = item >> 3, qb = item & 7, b = bh >> 3, h = bh & 7, hh = g * 8 + h; const size_t tb = (size_t)b * SEQ;
        AttnItem it; it.q = (const bf16_t*)(ws + WS_QB) + tb * 3072 + hh * 128; it.q_ld = 3072;
        it.k = (const bf16_t*)(ws + WS_KVB) + tb * 6144 + hh * 128; it.k_ld = 6144; it.kpe = nullptr; it.kpe_ld = 0; it.gk = nullptr; it.ssk = nullptr; it.ssl = nullptr;
        it.v = (const bf16_t*)(ws + WS_KVB) + tb * 6144 + 3072 + hh * 128; it.v_ld = 6144; it.o = (bf16_t*)(ws + WS_OB) + tb * 1024 + h * 128; it.o_ld = 1024;
        it.lse = (float*)(ws + WS_LSE) + tb * 8 + h; it.ld = 2 * g; it.merge = g > 0; it.P0 = qb * 256; it.pos = pos + tb; it.gq = gq + g * 128;
        attn_block<128, 1>(it, lds);
    }
}

#define XB_TMO      128
#define XB_XCNT(j)  (256  + 64 * (j))
#define XB_XSUB(j)  (1280 + 64 * (j))
#define XB_XGEN(j)  (2304 + 64 * (j))
#define XB_TOP      3328
#define XB_TOPGEN   3392
#define XCD_BAR_WORDS 3456
#define XB_SPIN_CAP (1u << 18)

__device__ __forceinline__ unsigned xb_ld(unsigned* p)              { return __hip_atomic_load(p, __ATOMIC_RELAXED, __HIP_MEMORY_SCOPE_AGENT); }
__device__ __forceinline__ unsigned xb_add(unsigned* p, unsigned v) { return __hip_atomic_fetch_add(p, v, __ATOMIC_RELAXED, __HIP_MEMORY_SCOPE_AGENT); }
__device__ __forceinline__ unsigned xb_xcc_id() { return (unsigned)__builtin_amdgcn_s_getreg((3 << 11) | 20) & 0xFu; }
#define XB_SPIN(cond, bar) do { unsigned _sp = 0; while (cond) { __builtin_amdgcn_s_sleep(1); \
    if ((++_sp & 255u) == 0u) { if (xb_ld(&(bar)[XB_TMO])) break; if (_sp > XB_SPIN_CAP) { atomicAdd(&(bar)[XB_TMO], 1u); break; } } } } while (0)

struct XcdBarrier {
    unsigned* bar; unsigned x;
    volatile LAS unsigned* st;
};

__device__ __forceinline__ XcdBarrier xcd_barrier_post(unsigned* bar, volatile LAS unsigned* st) {
    XcdBarrier b; b.bar = bar; b.x = xb_xcc_id(); b.st = st;
    if (threadIdx.x == 0) (void)xb_add(&bar[XB_XCNT(b.x)], 1u);
    return b;
}
__device__ __forceinline__ void xcd_barrier_complete(unsigned* bar, unsigned x, unsigned& nloc, unsigned& nx) {
    const unsigned G = gridDim.x * gridDim.y * gridDim.z;
    unsigned sum, cnt, mine, sp = 0u;
    for (;;) {
        sum = 0u; cnt = 0u; mine = 0u;
#pragma unroll
        for (unsigned j = 0; j < 16; ++j) { const unsigned c = xb_ld(&bar[XB_XCNT(j)]); sum += c; cnt += (c > 0u) ? 1u : 0u; mine = (j == x) ? c : mine; }
        if (sum == G) break;
        __builtin_amdgcn_s_sleep(1);
        if ((++sp & 255u) == 0u) { if (xb_ld(&bar[XB_TMO])) break; if (sp > XB_SPIN_CAP) { atomicAdd(&bar[XB_TMO], 1u); break; } }
    }
    nloc = mine > 0u ? mine : 1u; nx = cnt > 0u ? cnt : 1u;
}

__device__ __forceinline__ void xcd_barrier(const XcdBarrier& b) {
    asm volatile("s_waitcnt vmcnt(0)" ::: "memory");
    __syncthreads();
    if (threadIdx.x == 0) {
        unsigned* bar = b.bar;
        __builtin_amdgcn_s_waitcnt(0);
        unsigned nloc = b.st[0], nx = b.st[1];
        if (nloc == 0u) { xcd_barrier_complete(bar, b.x, nloc, nx); b.st[0] = nloc; b.st[1] = nx; }
        const unsigned old = xb_add(&bar[XB_XSUB(b.x)], 1u);
        const unsigned gen = old / nloc;
        if (old + 1u == (gen + 1u) * nloc) {
            __builtin_amdgcn_fence(__ATOMIC_RELEASE, "agent");
            asm volatile("s_waitcnt vmcnt(0)" ::: "memory");
            const unsigned og = xb_add(&bar[XB_TOP], 1u);
            const unsigned tg = og / nx;
            if (og + 1u == (tg + 1u) * nx) xb_add(&bar[XB_TOPGEN], 1u);
            else XB_SPIN(xb_ld(&bar[XB_TOPGEN]) == tg, bar);
            __builtin_amdgcn_fence(__ATOMIC_ACQUIRE, "agent");
            xb_add(&bar[XB_XGEN(b.x)], 1u);
            asm volatile("s_waitcnt vmcnt(0)" ::: "memory");
        } else {
            XB_SPIN(xb_ld(&bar[XB_XGEN(b.x)]) == gen, bar);
            __builtin_amdgcn_fence(__ATOMIC_ACQUIRE, "agent");
            asm volatile("s_waitcnt vmcnt(0)" ::: "memory");
        }
    }
    __syncthreads();
}

constexpr int NPH_HALF = 1 + 2 * 6 + 8 + 7;
#ifndef SKIP_MASK
#define SKIP_MASK 0
#endif
__global__ void __launch_bounds__(NTHR) mega(Params p) {
    extern __shared__ __attribute__((aligned(16))) unsigned char lds_raw[];
    LAS unsigned char* lds = (LAS unsigned char*)lds_raw;
    cg::grid_group grid = cg::this_grid();
    unsigned char* ws = p.ws;
    bf16_t* XB = (bf16_t*)(ws + WS_XB); float* SS = (float*)(ws + WS_SS); bf16_t* HB = (bf16_t*)(ws + WS_H);
    bf16_t* LAT = (bf16_t*)(ws + WS_LAT); bf16_t* Q = (bf16_t*)(ws + WS_Q); bf16_t* KV = (bf16_t*)(ws + WS_KV); bf16_t* KPE = (bf16_t*)(ws + WS_KPE); bf16_t* AO = (bf16_t*)(ws + WS_AO);
    bf16_t* KVB = (bf16_t*)(ws + WS_KVB); bf16_t* QB = (bf16_t*)(ws + WS_QB); bf16_t* OB = (bf16_t*)(ws + WS_OB);
#ifndef PROBE_MASK
#define PROBE_MASK 0
#endif
    unsigned long long probe_acc = 0ull;
    volatile LAS unsigned* bar_st = (volatile LAS unsigned*)(lds + 131072);
    if (threadIdx.x < 4) bar_st[threadIdx.x] = 0u;
    __syncthreads();
    XcdBarrier xbar = xcd_barrier_post((unsigned*)(ws + WS_BAR), bar_st);
#pragma unroll 1
    for (int ph = p.ph_lo; ph < p.ph_hi; ++ph) {
        const unsigned long long probe_t0 = PROBE_MASK ? __builtin_amdgcn_s_memrealtime() : 0ull;
        const int hb = ph >= NPH_HALF ? 1 : 0, li = ph - hb * NPH_HALF;
        const size_t toff = (size_t)hb * TH;
        const float* xin0 = (const float*)p.in[0] + toff * DM; float* xo = p.out + toff * DM; const int* pos = (const int*)p.in[1] + toff;
        int lyr = 0, j = -1;
        if (li >= 21) { lyr = 3; const int jm = li - 21; j = jm == 0 ? 0 : jm + 1; }
        else if (li >= 13) { lyr = 2; j = li - 13; }
        else if (li >= 1) { lyr = (li - 1) / 6; const int jm = (li - 1) - lyr * 6; j = jm == 0 ? 0 : jm == 1 ? 2 : jm + 2; }
        const bool mla = lyr < 2; const int ab = lyr & 1;
        int gk = 0;
        const bf16_t* A = nullptr; const bf16_t* Bt = nullptr; int lda = 0, N = 0, K = 0, nsub = 1;
        EpiBf16S E1{nullptr, 0, nullptr, 0, 1 << 30, nullptr, 4, 1.0f / 1024.0f, 0, nullptr, nullptr, nullptr, -1}; EpiRes E2{nullptr, nullptr, XB, SS};
        float* SSL = (float*)(ws + WS_SSL);
        if (li > 0) {
            if (j == 6) { gk = 1; A = XB; lda = 1024; Bt = (const bf16_t*)(ws + WS_W1) + (size_t)lyr * 4096 * 1024; N = 4096; K = 1024; E1.O = HB; E1.ldc = 4096; E1.ss = SS; E1.act = 1; }
            else if (j == 7) { gk = 2; A = HB; lda = 4096; Bt = (const bf16_t*)(ws + WS_W2) + (size_t)lyr * 1024 * 4096; N = 1024; K = 4096; E2.xin = xo; E2.xout = xo; }
            else if (j == 5) { gk = 2; N = 1024; E2.xin = lyr == 0 ? xin0 : xo; E2.xout = xo;
                if (mla) { A = AO; lda = 2048; K = 2048; Bt = (const bf16_t*)(ws + WS_WO) + (size_t)ab * 1024 * 2048; }
                else { A = OB; lda = 1024; K = 1024; Bt = (const bf16_t*)(ws + WS_WOB) + (size_t)ab * 1024 * 1024; } }
            else if (j == 0) { gk = 1; A = XB; lda = 1024; K = 1024; E1.ss = SS;
                if (mla) { Bt = (const bf16_t*)(ws + WS_WIN) + (size_t)ab * 512 * 1024; N = 512; E1.O = LAT; E1.ldc = 512; E1.ssl = SSL; }
                else if (ab == 0) { Bt = (const bf16_t*)(ws + WS_WKVQ); N = 9216; E1.O = KVB; E1.ldc = 6144; E1.O2 = QB; E1.ldc2 = 3072; E1.split = 6144; }
                else { Bt = (const bf16_t*)(ws + WS_WQ1); N = 3072; E1.O = QB; E1.ldc = 3072; } }
            else if (j == 2 && mla) { gk = 1; nsub = 2; A = LAT; lda = 512; K = 256; Bt = (const bf16_t*)(ws + WS_WQB) + (size_t)ab * 3072 * 256; N = 3072; E1.O = Q; E1.ldc = 3072; E1.ss = SSL; E1.nsl4 = 1; E1.inv_n = 1.0f / 256.0f; }
        }
        if (!(SKIP_MASK & 1) && gk == 1) {
            if (nsub == 2) kpe_prep(LAT, pos, (const float*)p.in[10] + ab * 192, (bf16_t*)(ws + WS_KPER));
#pragma unroll 1
            for (int sub = 0; sub < nsub; ++sub) {
                if (sub == 1) { A = LAT + 256; Bt = (const bf16_t*)(ws + WS_WKVB) + (size_t)ab * 4096 * 256; N = 4096; E1.O = KV; E1.ldc = 4096; E1.ss = SSL + 4; E1.inv_n = 1.0f / 128.0f; E1.ssk = (float*)(ws + WS_SSK); }
                run_gemm_bf16(lds, A, lda, Bt, N, K, E1);
            }
        } else if (!(SKIP_MASK & 2) && gk == 2) {
            run_gemm(lds, A, lda, Bt, N, K, E2);
        } else if (li == 0) {
            if (!(SKIP_MASK & 4)) { if (hb == 0) prep_weights(p, lds); prep_x(xin0, XB, SS); }
        } else if (mla) {
            if (j == 4) { if (!(SKIP_MASK & 32)) mla_attn_phase(p, lds, pos, (const float*)p.in[9] + ab * 192, (const float*)p.in[10] + ab * 192); }
        } else {
            if (j == 1) { if (!(SKIP_MASK & 64)) head_prep(ab == 0 ? KVB : nullptr, QB, pos, (const float*)p.in[14], (const float*)p.in[16] + ab * 384); }
            else if (j >= 2 && j <= 4) { if (!(SKIP_MASK & 128)) dil_attn_phase(p, lds, j - 2, pos, (const float*)p.in[16] + ab * 384); }
        }
        if (ph + 1 < p.ph_hi) { if (ph == p.ph_lo) grid.sync(); else xcd_barrier(xbar); }
        if (PROBE_MASK) { const int cat = gk == 1 ? 1 : gk == 2 ? 2 : li == 0 ? 3 : mla ? (j == 1 ? 4 : j == 3 ? 5 : 6) : (j == 1 ? 7 : 8);
            if ((PROBE_MASK >> cat) & 1) probe_acc += __builtin_amdgcn_s_memrealtime() - probe_t0; }
    }
    if (PROBE_MASK && blockIdx.x == 0) { const unsigned long long t1 = __builtin_amdgcn_s_memrealtime(); while (__builtin_amdgcn_s_memrealtime() - t1 < probe_acc) __builtin_amdgcn_s_sleep(16); }
}
constexpr int N_PHASES = 2 * NPH_HALF;

extern "C" void kernel_launch(void* const* d_in, const int* in_sizes, int n_in, void* d_out, int out_size, void* d_ws, size_t ws_size, hipStream_t stream) {
    static int grid_blocks = 0;
    if (!grid_blocks) {
        int dev = 0, cus = 0, per_cu = 0;
        (void)hipGetDevice(&dev);
        (void)hipDeviceGetAttribute(&cus, hipDeviceAttributeMultiprocessorCount, dev);
        (void)hipFuncSetAttribute((const void*)mega, hipFuncAttributeMaxDynamicSharedMemorySize, LDS_BYTES);
        (void)hipOccupancyMaxActiveBlocksPerMultiprocessor(&per_cu, (const void*)mega, NTHR, LDS_BYTES);
        (void)hipGetLastError();
        grid_blocks = cus > 0 ? cus : 256;
        if (ws_size < WS_END || n_in != 20) { fprintf(stderr, "kernel_launch: workspace %zu < %zu or n_in %d != 20\n", ws_size, (size_t)WS_END, n_in); }
    }
    (void)hipMemsetAsync((unsigned char*)d_ws + WS_BAR, 0, XCD_BAR_WORDS * sizeof(unsigned), stream);
    Params p{};
    for (int i = 0; i < 20; ++i) p.in[i] = d_in[i];
    p.out = (float*)d_out; p.ws = (unsigned char*)d_ws;
#if ONE_LAUNCH
    p.ph_lo = 0; p.ph_hi = N_PHASES;
    void* args[] = {&p};
    hipError_t e = hipLaunchCooperativeKernel((const void*)mega, dim3(grid_blocks), dim3(NTHR), args, LDS_BYTES, stream);
    if (e != hipSuccess) fprintf(stderr, "cooperative launch failed: %s (grid %d)\n", hipGetErrorString(e), grid_blocks);
#else
    for (int ph = 0; ph < N_PHASES; ++ph) { p.ph_lo = ph; p.ph_hi = ph + 1; hipLaunchKernelGGL(mega, dim3(grid_blocks), dim3(NTHR), LDS_BYTES, stream, p); }
#endif
}
```

```cpp
#include <hip/hip_runtime.h>
#include <hip/hip_cooperative_groups.h>
#include <cstdio>
#include <cstdint>
namespace cg = cooperative_groups;

#ifndef ONE_LAUNCH
#define ONE_LAUNCH 1
#endif

__device__ __forceinline__ int opaque_tid() { int t = (int)threadIdx.x; asm volatile("" : "+v"(t)); return t; }
__device__ __forceinline__ int opaque_bid() { int b = (int)blockIdx.x; asm volatile("" : "+s"(b)); return b; }
namespace pg8 {
#define PG8_LAS __attribute__((address_space(3)))
typedef unsigned short bf16_t;
typedef short bf16x8 __attribute__((ext_vector_type(8)));
typedef float f32x4 __attribute__((ext_vector_type(4)));
typedef unsigned u32x4 __attribute__((ext_vector_type(4)));
constexpr int BM = 256, BK = 64, HALF = 128, HTB = HALF * BK * 2  , STAGE_BYTES = 8 * HTB, NXCD = 8, WGM = 8;

__host__ __device__ __forceinline__ int lds_byte(int r, int c) { const int st = (r >> 4) * 2 + (c >> 5), rr = r & 15, cc = c & 31, ob = rr * 64 + cc * 2; return st * 1024 + (ob ^ (((ob >> 9) & 1) << 5)); }
__host__ __device__ __forceinline__ void stage_rc(int b, int& R, int& C) { const int st = b / 1024, sb = b % 1024, swz = sb ^ (((sb >> 9) & 1) << 5); R = (st >> 1) * 16 + swz / 64; C = (st & 1) * 32 + (swz % 64) / 2; }
__host__ __device__ __forceinline__ int perm32(int rho) { const int n = rho >> 4, i = rho & 15; return 8 * (i >> 2) + 4 * n + (i & 3); }
struct Unit { int pm, pn; };
struct Gemm { const bf16_t* A; const bf16_t* Bt; int M, N, K, lda; };
struct StaticOrder {
    int nM, nN, nwg, G, c;
    __host__ __device__ void init(int M, int N, int G_, int c_) { nM = M / BM; nN = N / BM; nwg = nM * nN; G = G_; c = c_; }
    __host__ __device__ bool next(int i, Unit& u) const {
        const long L = (long)i * G + c; if (L >= nwg) return false;
        int wgid = (int)L; { const int q = nwg / NXCD, r = nwg % NXCD, xcd = wgid % NXCD, off = wgid / NXCD; wgid = (xcd < r ? xcd * (q + 1) : r * (q + 1) + (xcd - r) * q) + off; }
        const int nig = WGM * nN, gid = wgid / nig, fm = gid * WGM, gsz = (nM - fm) < WGM ? (nM - fm) : WGM;
        u.pm = fm + ((wgid % nig) % gsz); u.pn = (wgid % nig) / gsz; return true;
    }
    __device__ __forceinline__ void a_ready(const Unit&) const {}
    __device__ __forceinline__ void done(const Unit&) const {}
};
__device__ __forceinline__ unsigned cvt_pk_bf16(float lo, float hi) { unsigned r; asm volatile("v_cvt_pk_bf16_f32 %0, %1, %2" : "=v"(r) : "v"(lo), "v"(hi)); return r; }
template <class Epi, class Sched>
__device__ __forceinline__ void gemm_phase(PG8_LAS unsigned char* lds, const Gemm g, const Sched& S, const Epi& E) {
    const int tid = opaque_tid(), wid = __builtin_amdgcn_readfirstlane(tid >> 6), lane = tid & 63, wr = wid >> 2, wc = wid & 3, fr = lane & 15, fq = lane >> 4;
    const int K = g.K, nt = K / BK;
    unsigned voffA[2], voffB[2];
#pragma unroll
    for (int i = 0; i < 2; ++i) { int R, C; stage_rc(tid * 16 + i * 8192, R, C); const int Rb = Epi::PERM ? ((R & ~31) + perm32(R & 31)) : R;
        voffA[i] = (unsigned)(R * g.lda + C) * 2u; voffB[i] = (unsigned)(Rb * K + C) * 2u; }
    const size_t kstep = (size_t)(BK * 2);
    const size_t hstep = (size_t)HALF * K * 2, hstepA = (size_t)HALF * g.lda * 2;
    const size_t tstep = 2 * hstep, tstepA = 2 * hstepA;
    const unsigned ldsw = (unsigned)wid * 1024u;
    const int aoff = lds_byte(wr * 64 + fr, fq * 8), boff = lds_byte(wc * 32 + fr, fq * 8);
#define PG8_SA(b, h) (((b) * 2 + (h)) * HTB)
#define PG8_SB(b, h) ((4 + (b) * 2 + (h)) * HTB)
#define PG8_STAGE(bufoff, gbase, voff) do { _Pragma("unroll") for (int _i = 0; _i < 2; ++_i) \
        __builtin_amdgcn_global_load_lds((const unsigned*)((const char*)(gbase) + (voff)[_i]), (PG8_LAS unsigned*)(lds + (bufoff) + ldsw + _i * 8192), 16, 0, 0); } while (0)
#define PG8_LDA(dst, b, h) do { _Pragma("unroll") for (int m = 0; m < 4; ++m) _Pragma("unroll") for (int k = 0; k < 2; ++k) dst[m][k] = *(const PG8_LAS bf16x8*)(lds + PG8_SA(b, h) + aoff + m * 2048 + k * 1024); } while (0)
#define PG8_LDB(dst, b, h) do { _Pragma("unroll") for (int n = 0; n < 2; ++n) _Pragma("unroll") for (int k = 0; k < 2; ++k) dst[n][k] = *(const PG8_LAS bf16x8*)(lds + PG8_SB(b, h) + boff + n * 2048 + k * 1024); } while (0)
#define PG8_MMA(ai, bj, At, Bt) do { __builtin_amdgcn_s_setprio(1); _Pragma("unroll") for (int m = 0; m < 4; ++m) _Pragma("unroll") for (int n = 0; n < 2; ++n) _Pragma("unroll") for (int k = 0; k < 2; ++k) \
        acc[ai][bj][m][n] = __builtin_amdgcn_mfma_f32_16x16x32_bf16(Bt[n][k], At[m][k], acc[ai][bj][m][n], 0, 0, 0); __builtin_amdgcn_s_setprio(0); } while (0)
#define PG8_WAIT_V(n) asm volatile("s_waitcnt vmcnt(" #n ")" ::: "memory")
#define PG8_WAIT_L(n) asm volatile("s_waitcnt lgkmcnt(" #n ")" ::: "memory")
#define PG8_BAR __builtin_amdgcn_s_barrier()
#define PG8_SCHED __builtin_amdgcn_sched_barrier(0)
    Unit cur, nxt; int ui = 0;
    if (!S.next(0, cur)) return;
    f32x4 acc[2][2][4][2];
#pragma unroll
    for (int a = 0; a < 2; ++a)
#pragma unroll
        for (int b = 0; b < 2; ++b)
#pragma unroll
            for (int m = 0; m < 4; ++m)
#pragma unroll
                for (int n = 0; n < 2; ++n) acc[a][b][m][n] = (f32x4){0.f, 0.f, 0.f, 0.f};
    if constexpr (Epi::INIT_ACC) E.init_acc(acc, cur, wr, wc, fr, fq);
    bf16x8 At[4][2], B0[2][2], B1[2][2];
    const char* cA = (const char*)g.A + (size_t)cur.pm * tstepA; const char* cB = (const char*)g.Bt + (size_t)cur.pn * tstep;
    S.a_ready(cur);
    PG8_STAGE(PG8_SB(0, 0), cB, voffB); PG8_STAGE(PG8_SA(0, 0), cA, voffA); PG8_STAGE(PG8_SB(0, 1), cB + hstep, voffB); PG8_STAGE(PG8_SA(0, 1), cA + hstepA, voffA);
    if (wr == 1) PG8_BAR;
    PG8_WAIT_V(4); PG8_BAR;
    PG8_STAGE(PG8_SB(1, 0), cB + kstep, voffB); PG8_STAGE(PG8_SA(1, 0), cA + kstep, voffA); PG8_STAGE(PG8_SB(1, 1), cB + hstep + kstep, voffB);
    PG8_WAIT_V(6); PG8_BAR;
    for (;;) {
        const bool has_next = S.next(ui + 1, nxt);
        const char* nA = has_next ? (const char*)g.A + (size_t)nxt.pm * tstepA : cA; const char* nB = has_next ? (const char*)g.Bt + (size_t)nxt.pn * tstep : cB;
        for (int t = 0; t < nt; t += 2) {
            const bool last = (t == nt - 2);
            const char* a1 = cA + (size_t)(t + 1) * kstep;
            const char* a2 = last ? nA : cA + (size_t)(t + 2) * kstep; const char* b2 = last ? nB : cB + (size_t)(t + 2) * kstep;
            const char* a3 = a2 + kstep; const char* b3 = b2 + kstep;
            if (last && has_next) S.a_ready(nxt);
            PG8_LDB(B0, 0, 0); PG8_SCHED; PG8_LDA(At, 0, 0); PG8_STAGE(PG8_SA(1, 1), a1 + hstepA, voffA);
            PG8_WAIT_L(8); PG8_BAR; PG8_WAIT_L(0); PG8_MMA(0, 0, At, B0); PG8_BAR; PG8_SCHED;
            PG8_LDB(B1, 0, 1); PG8_STAGE(PG8_SB(0, 0), b2, voffB);
            PG8_BAR; PG8_WAIT_L(0); PG8_MMA(0, 1, At, B1); PG8_BAR;
            PG8_LDA(At, 0, 1); PG8_STAGE(PG8_SA(0, 0), a2, voffA);
            PG8_BAR; PG8_WAIT_L(0); PG8_MMA(1, 0, At, B0); PG8_BAR; PG8_SCHED;
            PG8_STAGE(PG8_SB(0, 1), b2 + hstep, voffB);
            PG8_WAIT_V(6); PG8_BAR; PG8_MMA(1, 1, At, B1); PG8_BAR;
            PG8_LDB(B0, 1, 0); PG8_SCHED; PG8_LDA(At, 1, 0); PG8_STAGE(PG8_SA(0, 1), a2 + hstepA, voffA);
            PG8_WAIT_L(8); PG8_BAR; PG8_WAIT_L(0); PG8_MMA(0, 0, At, B0); PG8_BAR; PG8_SCHED;
            PG8_LDB(B1, 1, 1); PG8_STAGE(PG8_SB(1, 0), b3, voffB);
            PG8_BAR; PG8_WAIT_L(0); PG8_MMA(0, 1, At, B1); PG8_BAR;
            PG8_LDA(At, 1, 1); PG8_STAGE(PG8_SA(1, 0), a3, voffA);
            PG8_BAR; PG8_WAIT_L(0); PG8_MMA(1, 0, At, B0); PG8_BAR; PG8_SCHED;
            PG8_STAGE(PG8_SB(1, 1), b3 + hstep, voffB);
            PG8_WAIT_V(6); PG8_BAR; PG8_MMA(1, 1, At, B1); PG8_BAR;
        }
        if constexpr (!Epi::AFTER_DRAIN) { E(acc, cur, wr, wc, fr, fq); S.done(cur); }
        if (!has_next) break;
#pragma unroll
        for (int a = 0; a < 2; ++a)
#pragma unroll
            for (int b = 0; b < 2; ++b)
#pragma unroll
                for (int m = 0; m < 4; ++m)
#pragma unroll
                    for (int n = 0; n < 2; ++n) acc[a][b][m][n] = (f32x4){0.f, 0.f, 0.f, 0.f};
        if constexpr (Epi::INIT_ACC) E.init_acc(acc, nxt, wr, wc, fr, fq);
        cur = nxt; cA = nA; cB = nB; ++ui;
    }
    PG8_WAIT_V(0);
    if (wr == 0) PG8_BAR;
    PG8_BAR;
    if constexpr (Epi::AFTER_DRAIN) { E.fused(acc, cur, wr, wc, fr, fq, lds, wid, lane); S.done(cur); }
#undef PG8_SA
#undef PG8_SB
#undef PG8_STAGE
#undef PG8_LDA
#undef PG8_LDB
#undef PG8_MMA
#undef PG8_WAIT_V
#undef PG8_WAIT_L
#undef PG8_BAR
#undef PG8_SCHED
}
}
using pg8::bf16_t; using pg8::bf16x8; using pg8::f32x4; using pg8::u32x4;
#define LAS __attribute__((address_space(3)))
typedef short s16x4 __attribute__((ext_vector_type(4)));
typedef float f32x16 __attribute__((ext_vector_type(16)));
typedef unsigned u32x2 __attribute__((ext_vector_type(2)));

constexpr int SEQ = 2048, DM = 1024, NBATCH = 16, TT = NBATCH * SEQ, TH = TT / 2, BH = NBATCH / 2, DFF = 4096;
constexpr float EPS = 1e-6f, LOG2E = 1.4426950408889634f, LOG2_THETA = 13.287712379549449f;
constexpr int NTHR = 512;
constexpr int LDS_BYTES = 131072 + 8192;
constexpr int RS_OFF = 131072 + 2048;
constexpr size_t MiB = (size_t)1 << 20;
constexpr size_t WS_WIN = 0, WS_WQB = WS_WIN + 2 * MiB, WS_WKVB = WS_WQB + 3 * MiB, WS_WO = WS_WKVB + 4 * MiB, WS_WKVQ = WS_WO + 8 * MiB, WS_WQ1 = WS_WKVQ + 18 * MiB,
                 WS_WOB = WS_WQ1 + 6 * MiB, WS_W1 = WS_WOB + 4 * MiB, WS_W2 = WS_W1 + 32 * MiB, WS_XB = WS_W2 + 32 * MiB, WS_SS = WS_XB + 32 * MiB, WS_LSE = WS_SS + 1 * MiB,
                 WS_BAR = WS_LSE + 768 * 1024, WS_SSL = WS_LSE + 1 * MiB, WS_BIG = WS_SSL + 1 * MiB;
constexpr size_t WS_LAT = WS_BIG, WS_Q = WS_LAT + 16 * MiB, WS_KV = WS_Q + 96 * MiB, WS_KPE = WS_KV + 128 * MiB, WS_AO = WS_KPE + 32 * MiB;
constexpr size_t WS_SSK = WS_KPE, WS_KPER = WS_KPE + 8 * MiB;
constexpr size_t WS_KVB = WS_BIG, WS_QB = WS_BIG + 192 * MiB, WS_OB = WS_BIG + 288 * MiB;
constexpr size_t WS_H = WS_BIG + 192 * MiB;
constexpr size_t WS_END = WS_BIG + 336 * MiB;

struct Params { const void* in[20]; float* out; unsigned char* ws; int ph_lo, ph_hi; };

__device__ __forceinline__ unsigned cvtpk(float lo, float hi) { unsigned r; asm volatile("v_cvt_pk_bf16_f32 %0, %1, %2" : "=v"(r) : "v"(lo), "v"(hi)); return r; }
__device__ __forceinline__ float bf_lo(unsigned w) { return __uint_as_float(w << 16); }
__device__ __forceinline__ float bf_hi(unsigned w) { return __uint_as_float(w & 0xffff0000u); }
#define UNPACK8(W_, V_) do { const u32x4 t_ = (W_); V_[0] = bf_lo(t_[0]); V_[1] = bf_hi(t_[0]); V_[2] = bf_lo(t_[1]); V_[3] = bf_hi(t_[1]); V_[4] = bf_lo(t_[2]); V_[5] = bf_hi(t_[2]); V_[6] = bf_lo(t_[3]); V_[7] = bf_hi(t_[3]); } while (0)
#define PACK8(V_) ((u32x4){cvtpk(V_[0], V_[1]), cvtpk(V_[2], V_[3]), cvtpk(V_[4], V_[5]), cvtpk(V_[6], V_[7])})
__device__ __forceinline__ void sincos_rev(float pos, float invf_rev, float& s, float& c) {
    float rev = pos * invf_rev; rev = rev - floorf(rev);
    s = __builtin_amdgcn_sinf(rev); c = __builtin_amdgcn_cosf(rev);
}

__device__ __forceinline__ void cvt_job(const float* __restrict__ W, int K, int N, const float* __restrict__ gain, bf16_t* __restrict__ dst, int ldo, int& base, LAS float* tile) {
    const int tk = K / 64, tn = N / 64, nt = tk * tn, G = (int)gridDim.x, tid = opaque_tid();
    int start = (opaque_bid() - (base % G)); if (start < 0) start += G;
    for (int t0 = start; t0 < nt; t0 += 4 * G) {
        f32x4 v[4][2]; float g[4][2];
#pragma unroll
        for (int q = 0; q < 4; ++q) { const int t = t0 + q * G; if (t < nt) { const int kt = t / tn, ntile = t - kt * tn;
#pragma unroll
            for (int i = 0; i < 2; ++i) { const int k = (tid >> 4) + 32 * i, n4 = (tid & 15) * 4;
                v[q][i] = *(const f32x4*)(W + (size_t)(kt * 64 + k) * N + ntile * 64 + n4); g[q][i] = gain ? gain[kt * 64 + k] : 1.0f; } } }
        __syncthreads();
#pragma unroll
        for (int q = 0; q < 4; ++q) { const int t = t0 + q * G; if (t < nt) { LAS float* tq = tile + q * (64 * 65);
#pragma unroll
            for (int i = 0; i < 2; ++i) { const int k = (tid >> 4) + 32 * i, n4 = (tid & 15) * 4;
                tq[(n4 + 0) * 65 + k] = v[q][i].x * g[q][i]; tq[(n4 + 1) * 65 + k] = v[q][i].y * g[q][i]; tq[(n4 + 2) * 65 + k] = v[q][i].z * g[q][i]; tq[(n4 + 3) * 65 + k] = v[q][i].w * g[q][i]; } } }
        __syncthreads();
#pragma unroll
        for (int q = 0; q < 4; ++q) { const int t = t0 + q * G; if (t < nt) { const int kt = t / tn, ntile = t - kt * tn; const int n = tid >> 3, k8 = (tid & 7) * 8;
            const LAS float* tp = tile + q * (64 * 65) + n * 65 + k8;
            u32x4 w; w.x = cvtpk(tp[0], tp[1]); w.y = cvtpk(tp[2], tp[3]); w.z = cvtpk(tp[4], tp[5]); w.w = cvtpk(tp[6], tp[7]);
            *(u32x4*)(dst + (size_t)(ntile * 64 + n) * ldo + kt * 64 + k8) = w; } }
    }
    base += nt;
}
__device__ __forceinline__ void zero_fill(bf16_t* dst, int rows, int cols8, int ld) {
    const size_t n = (size_t)rows * cols8;
    for (size_t i = (size_t)opaque_bid() * NTHR + opaque_tid(); i < n; i += (size_t)gridDim.x * NTHR) { const size_t r = i / cols8, c = i - r * cols8; *(u32x4*)(dst + r * ld + c * 8) = (u32x4){0u, 0u, 0u, 0u}; }
}
__device__ void prep_weights(const Params& p, LAS unsigned char* lds) {
    LAS float* tile = (LAS float*)lds;
    unsigned char* ws = p.ws;
    const float* attn_norm = (const float*)p.in[2]; const float* mlp_norm = (const float*)p.in[3];
    int base = 0;
    for (int a = 0; a < 2; ++a) {
        cvt_job((const float*)p.in[4] + (size_t)a * 1024 * 448, 1024, 448, attn_norm + a * 1024, (bf16_t*)(ws + WS_WIN) + (size_t)a * 512 * 1024, 1024, base, tile);
        cvt_job((const float*)p.in[7] + (size_t)a * 256 * 3072, 256, 3072, (const float*)p.in[5] + a * 256, (bf16_t*)(ws + WS_WQB) + (size_t)a * 3072 * 256, 256, base, tile);
        cvt_job((const float*)p.in[8] + (size_t)a * 128 * 4096, 128, 4096, (const float*)p.in[6] + a * 128, (bf16_t*)(ws + WS_WKVB) + (size_t)a * 4096 * 256, 256, base, tile);
        cvt_job((const float*)p.in[11] + (size_t)a * 2048 * 1024, 2048, 1024, nullptr, (bf16_t*)(ws + WS_WO) + (size_t)a * 1024 * 2048, 2048, base, tile);
        cvt_job((const float*)p.in[17] + (size_t)a * 1024 * 1024, 1024, 1024, nullptr, (bf16_t*)(ws + WS_WOB) + (size_t)a * 1024 * 1024, 1024, base, tile);
        zero_fill((bf16_t*)(ws + WS_WIN) + (size_t)a * 512 * 1024 + (size_t)448 * 1024, 64, 128, 1024);
        zero_fill((bf16_t*)(ws + WS_WKVB) + (size_t)a * 4096 * 256 + 128, 4096, 16, 256);
    }
    cvt_job((const float*)p.in[13], 1024, 6144, (const float*)p.in[12], (bf16_t*)(ws + WS_WKVQ), 1024, base, tile);
    cvt_job((const float*)p.in[15], 1024, 3072, attn_norm + 2 * 1024, (bf16_t*)(ws + WS_WKVQ) + (size_t)6144 * 1024, 1024, base, tile);
    cvt_job((const float*)p.in[15] + (size_t)1024 * 3072, 1024, 3072, attn_norm + 3 * 1024, (bf16_t*)(ws + WS_WQ1), 1024, base, tile);
    for (int l = 0; l < 4; ++l) {
        cvt_job((const float*)p.in[18] + (size_t)l * 1024 * 4096, 1024, 4096, mlp_norm + l * 1024, (bf16_t*)(ws + WS_W1) + (size_t)l * 4096 * 1024, 1024, base, tile);
        cvt_job((const float*)p.in[19] + (size_t)l * 4096 * 1024, 4096, 1024, nullptr, (bf16_t*)(ws + WS_W2) + (size_t)l * 1024 * 4096, 4096, base, tile);
    }
    __syncthreads();
}
__device__ void prep_x(const float* __restrict__ x, bf16_t* __restrict__ xb, float* __restrict__ ss) {
    const int tid_ = opaque_tid(), lane = tid_ & 63, gw = opaque_bid() * 8 + (tid_ >> 6), nw = gridDim.x * 8;
    for (int r = gw; r < TH; r += nw) {
        const float* xr = x + (size_t)r * 1024; bf16_t* br = xb + (size_t)r * 1024; float s = 0.f;
#pragma unroll
        for (int i = 0; i < 4; ++i) { const f32x4 v = *(const f32x4*)(xr + i * 256 + lane * 4); s += v.x * v.x + v.y * v.y + v.z * v.z + v.w * v.w;
            *(u32x2*)(br + i * 256 + lane * 4) = (u32x2){cvtpk(v.x, v.y), cvtpk(v.z, v.w)}; }
#pragma unroll
        for (int o = 1; o < 64; o <<= 1) s += __shfl_xor(s, o);
        if (lane < 16) ss[(size_t)r * 16 + lane] = lane == 0 ? s : 0.f;
    }
}

struct EpiBf16S {
    static constexpr bool PERM = true, AFTER_DRAIN = false, INIT_ACC = false;
    bf16_t* O; int ldc; bf16_t* O2; int ldc2; int split; const float* ss; int nsl4; float inv_n; int act; float* ssl; float* ssk; const LAS float* rs; int pm0;
    __device__ __forceinline__ void operator()(const f32x4 (&acc)[2][2][4][2], const pg8::Unit& u, int wr, int wc, int fr, int fq) const {
        const int row0 = u.pm * 256 + wr * 64 + fr; int colt = u.pn * 256; bf16_t* base = O; int ld = ldc;
        if (colt >= split) { base = O2; colt -= split; ld = ldc2; }
        const int col0 = colt + wc * 32 + 8 * fq;
#pragma unroll
        for (int ai = 0; ai < 2; ++ai)
#pragma unroll
            for (int m = 0; m < 4; ++m) { const int row = row0 + ai * 128 + m * 16; float sc = 1.0f;
                if (ss) { if (u.pm == pm0) sc = rs[(wr * 4 + wc) * 128 + ai * 64 + m * 16 + fr];
                    else { const f32x4* sp = (const f32x4*)(ss + (size_t)row * 16); f32x4 a = sp[0]; if (nsl4 == 4) a = (a + sp[1]) + (sp[2] + sp[3]); sc = rsqrtf(((a.x + a.y) + (a.z + a.w)) * inv_n + EPS); } }
                bf16_t* rowp = base + (size_t)row * ld + col0; float sa = 0.f, sb = 0.f;
#pragma unroll
                for (int bj = 0; bj < 2; ++bj) { f32x4 v0 = acc[ai][bj][m][0] * sc, v1 = acc[ai][bj][m][1] * sc;
                    if (act) {
#pragma unroll
                        for (int j = 0; j < 4; ++j) { const float a0 = fmaxf(v0[j], 0.f), a1 = fmaxf(v1[j], 0.f); v0[j] = a0 * a0; v1[j] = a1 * a1; } }
                    const float sq = ((v0[0] * v0[0] + v0[1] * v0[1]) + (v0[2] * v0[2] + v0[3] * v0[3])) + ((v1[0] * v1[0] + v1[1] * v1[1]) + (v1[2] * v1[2] + v1[3] * v1[3]));
                    if (bj == 0) sa = sq; else sb = sq;
                    u32x4 w; w.x = cvtpk(v0[0], v0[1]); w.y = cvtpk(v0[2], v0[3]); w.z = cvtpk(v1[0], v1[1]); w.w = cvtpk(v1[2], v1[3]);
                    *(u32x4*)(rowp + bj * 128) = w; }
                if (ssk) { float sk_ = sa; sk_ += __shfl_xor(sk_, 16); sk_ += __shfl_xor(sk_, 32); if (fq == 0) ssk[((size_t)row * 16 + u.pn) * 4 + wc] = sk_; }
                if (ssl) { sa += __shfl_xor(sa, 16); sa += __shfl_xor(sa, 32); sb += __shfl_xor(sb, 16); sb += __shfl_xor(sb, 32);
                    if (fq == 0) { float* sr_ = ssl + (size_t)row * 16; if (u.pn == 0) sr_[wc] = sa + sb; else { sr_[4 + wc] = sa; sr_[8 + wc] = sb; } } } }
    }
};
struct EpiRes {
    static constexpr bool PERM = false, AFTER_DRAIN = false, INIT_ACC = true;
    const float* xin; float* xout; bf16_t* xb; float* ss;
    __device__ __forceinline__ void init_acc(f32x4 (&acc)[2][2][4][2], const pg8::Unit& u, int wr, int wc, int fr, int fq) const {
        const int row0 = u.pm * 256 + wr * 64 + fr, col0 = u.pn * 256 + wc * 32 + 4 * fq;
#pragma unroll
        for (int ai = 0; ai < 2; ++ai)
#pragma unroll
            for (int m = 0; m < 4; ++m) { const size_t off = (size_t)(row0 + ai * 128 + m * 16) * 1024 + col0;
#pragma unroll
                for (int bj = 0; bj < 2; ++bj)
#pragma unroll
                    for (int n = 0; n < 2; ++n) acc[ai][bj][m][n] = *(const f32x4*)(xin + off + bj * 128 + n * 16); }
    }
    __device__ __forceinline__ void operator()(const f32x4 (&acc)[2][2][4][2], const pg8::Unit& u, int wr, int wc, int fr, int fq) const {
        const int row0 = u.pm * 256 + wr * 64 + fr, col0 = u.pn * 256 + wc * 32 + 4 * fq;
#pragma unroll
        for (int ai = 0; ai < 2; ++ai)
#pragma unroll
            for (int m = 0; m < 4; ++m) { const int row = row0 + ai * 128 + m * 16; const size_t off = (size_t)row * 1024 + col0; float s = 0.f;
#pragma unroll
                for (int bj = 0; bj < 2; ++bj)
#pragma unroll
                    for (int n = 0; n < 2; ++n) { const int c = bj * 128 + n * 16; const f32x4 o = acc[ai][bj][m][n];
                        *(f32x4*)(xout + off + c) = o; s += (o.x * o.x + o.y * o.y) + (o.z * o.z + o.w * o.w);
                        *(u32x2*)(xb + off + c) = (u32x2){cvtpk(o.x, o.y), cvtpk(o.z, o.w)}; }
                s += __shfl_xor(s, 16); s += __shfl_xor(s, 32);
                if (fq == 0) ss[(size_t)row * 16 + u.pn * 4 + wc] = s; }
    }
};
template <class Epi> __device__ __forceinline__ void run_gemm(LAS unsigned char* lds, const bf16_t* A, int lda, const bf16_t* Bt, int N, int K, const Epi& E) {
    pg8::Gemm g{A, Bt, TH, N, K, lda}; pg8::StaticOrder S; S.init(TH, N, (int)gridDim.x, opaque_bid());
    pg8::gemm_phase<Epi, pg8::StaticOrder>(lds, g, S, E);
}
__device__ __forceinline__ void run_gemm_bf16(LAS unsigned char* lds, const bf16_t* A, int lda, const bf16_t* Bt, int N, int K, EpiBf16S E) {
    pg8::Gemm g{A, Bt, TH, N, K, lda}; pg8::StaticOrder S; S.init(TH, N, (int)gridDim.x, opaque_bid());
    E.rs = (const LAS float*)(lds + RS_OFF); E.pm0 = -1;
    pg8::Unit u0;
    if (E.ss && S.next(0, u0)) {
        const int tid = opaque_tid(), wid = tid >> 6, lane = tid & 63, wr = wid >> 2;
        LAS float* tab = (LAS float*)(lds + RS_OFF) + wid * 128;
#pragma unroll
        for (int hh = 0; hh < 2; ++hh) { const int row = u0.pm * 256 + hh * 128 + wr * 64 + lane;
            const f32x4* sp = (const f32x4*)(E.ss + (size_t)row * 16); f32x4 a = sp[0]; if (E.nsl4 == 4) a = (a + sp[1]) + (sp[2] + sp[3]);
            tab[hh * 64 + lane] = rsqrtf(((a.x + a.y) + (a.z + a.w)) * E.inv_n + EPS); }
        E.pm0 = u0.pm;
    }
    pg8::gemm_phase<EpiBf16S, pg8::StaticOrder>(lds, g, S, E);
}

__device__ void lat_prep(bf16_t* lat) {
    const int tid_ = opaque_tid(), lane = tid_ & 63, gw = opaque_bid() * 8 + (tid_ >> 6), nw = gridDim.x * 8;
    for (int t = gw; t < TH; t += nw) {
        bf16_t* p = lat + (size_t)t * 512 + lane * 8; const u32x4 w = *(const u32x4*)p; float v[8]; UNPACK8(w, v);
        float s = 0.f;
#pragma unroll
        for (int e = 0; e < 8; ++e) s += v[e] * v[e];
        s += __shfl_xor(s, 1); s += __shfl_xor(s, 2); s += __shfl_xor(s, 4); s += __shfl_xor(s, 8);
        const float s32 = s + __shfl_xor(s, 16);
        const float rstd = lane < 32 ? rsqrtf(s32 * (1.0f / 256.0f) + EPS) : rsqrtf(s * (1.0f / 128.0f) + EPS);
        if (lane < 48) {
#pragma unroll
            for (int e = 0; e < 8; ++e) v[e] *= rstd;
            *(u32x4*)p = PACK8(v); }
    }
}
__device__ void kpe_prep(const bf16_t* lat, const int* pos, const float* gk, bf16_t* kper) {
    const int tid = opaque_tid(), grp = tid >> 3, l8 = tid & 7;
    float invf[8], g[8];
#pragma unroll
    for (int e = 0; e < 8; ++e) { invf[e] = exp2f(-(float)((l8 & 3) * 8 + e) * (LOG2_THETA / 32.0f)) * 0.15915494309189535f; g[e] = gk[128 + l8 * 8 + e]; }
    for (int t = opaque_bid() * 64 + grp; t < TH; t += (int)gridDim.x * 64) {
        const float posf = (float)pos[t];
        const u32x4 w = *(const u32x4*)(lat + (size_t)t * 512 + 384 + l8 * 8); float v[8]; UNPACK8(w, v);
#pragma unroll
        for (int e = 0; e < 8; ++e) { const float y = v[e] * g[e]; const float pr = __shfl_xor(y, 4); float sn_, cs_; sincos_rev(posf, invf[e], sn_, cs_);
            v[e] = (l8 & 4) ? y * cs_ + pr * sn_ : y * cs_ - pr * sn_; }
        *(u32x4*)(kper + (size_t)t * 64 + l8 * 8) = PACK8(v);
    }
}
__device__ void head_prep(bf16_t* kbuf  , bf16_t* qbuf, const int* pos, const float* gk, const float* gq) {
    const int tid_ = opaque_tid(), lane = tid_ & 63, gw = opaque_bid() * 8 + (tid_ >> 6), nw = gridDim.x * 8;
    const float qscale = 0.08838834764831845f * LOG2E;
    const int c16 = lane & 15;
    float invf[8];
#pragma unroll
    for (int e = 0; e < 8; ++e) invf[e] = exp2f(-(float)((c16 & 7) * 8 + e) * (LOG2_THETA / 64.0f)) * 0.15915494309189535f;
    for (int t = gw; t < TH; t += nw) {
        const float posf = (float)pos[t];
        float cs[8], sn[8];
#pragma unroll
        for (int e = 0; e < 8; ++e) sincos_rev(posf, invf[e], sn[e], cs[e]);
        u32x4 wv[6];
#pragma unroll
        for (int itr = 0; itr < 6; ++itr) wv[itr] = *(const u32x4*)(kbuf + (size_t)t * 6144 + (itr * 4 + (lane >> 4)) * 128 + c16 * 8);
#pragma unroll
        for (int itr = 0; itr < 6; ++itr) { const bool isq = false;
            const int hh = (isq ? itr - 6 : itr) * 4 + (lane >> 4), g = hh >> 3;
            bf16_t* p = isq ? qbuf + (size_t)t * 3072 + hh * 128 + c16 * 8 : kbuf + (size_t)t * 6144 + hh * 128 + c16 * 8;
            const float* gn = (isq ? gq : gk) + g * 128 + c16 * 8;
            float v[8]; UNPACK8(wv[itr], v); float s = 0.f;
#pragma unroll
            for (int e = 0; e < 8; ++e) s += v[e] * v[e];
            s += __shfl_xor(s, 1); s += __shfl_xor(s, 2); s += __shfl_xor(s, 4); s += __shfl_xor(s, 8);
            const float rstd = rsqrtf(s * (1.0f / 128.0f) + EPS), osc = isq ? qscale : 1.0f;
#pragma unroll
            for (int e = 0; e < 8; ++e) { const float y = v[e] * rstd * gn[e]; const float pr = __shfl_xor(y, 8);
                v[e] = ((c16 & 8) ? y * cs[e] + pr * sn[e] : y * cs[e] - pr * sn[e]) * osc; }
            *(u32x4*)p = PACK8(v); }
    }
}

struct AttnItem { const bf16_t* q; const bf16_t* k; const bf16_t* kpe; const bf16_t* v; bf16_t* o; float* lse; const int* pos; const float* gq; const float* gk; const float* ssk; const float* ssl; int q_ld, k_ld, kpe_ld, v_ld, o_ld, P0, ld, merge; };
__device__ __forceinline__ int v_st(int k, int c) { const int kk = (k & ~0xC) | ((k & 4) << 1) | ((k & 8) >> 1); return ((kk >> 3) * 4 + (c >> 5)) * 512 + ((kk & 7) * 32 + (c & 31)) * 2; }
__device__ __forceinline__ int v_rd_base(int lane) { return ((lane & 3) << 3) | (((lane >> 2) & 3) << 6) | (((lane >> 4) & 1) << 5) | (((lane >> 5) & 1) << 8); }
#define PK4(P, B_, OUT) do { unsigned a0_ = cvtpk(P[B_+0], P[B_+1]), a1_ = cvtpk(P[B_+2], P[B_+3]); unsigned b0_ = cvtpk(P[B_+4], P[B_+5]), b1_ = cvtpk(P[B_+6], P[B_+7]); \
        auto r0_ = __builtin_amdgcn_permlane32_swap(a0_, b0_, false, false); auto r1_ = __builtin_amdgcn_permlane32_swap(a1_, b1_, false, false); \
        u32x4 w_ = {r0_[0], r1_[0], r0_[1], r1_[1]}; OUT = w_; } while (0)
__device__ __forceinline__ bf16x8 as_bf(u32x4 w) { return *reinterpret_cast<bf16x8*>(&w); }

template <int DQK, int MODE>
__device__ __forceinline__ void attn_block(const AttnItem& it, LAS unsigned char* lds) {
    constexpr int RS = DQK * 2, SHM_K = 64 * RS, SHM_V = 16384, ND0 = DQK / 16, KCH = DQK / 8, NKC = (64 * KCH) / 512;
    const int tid = opaque_tid(), wid = __builtin_amdgcn_readfirstlane(tid >> 6), lane = tid & 63, r32 = lane & 31, hi = lane >> 5;
    const int ld = it.ld, Lm1 = (2048 >> ld) - 1, lsh = 11 - ld;
#define TOK(p) (MODE == 0 ? (p) : ((((p) & Lm1) << ld) | ((p) >> lsh)))
#define LOF(p) (MODE == 0 ? 0 : max((p) - 128, (p) & ~Lm1))
    const int q0 = it.P0 + wid * 32, qp = q0 + r32;
    const int span = qp - LOF(qp), lo_w = LOF(q0), lo_last = LOF(q0 + 31);
    LAS unsigned char* V_lds = lds; LAS unsigned char* K_lds = lds + 2 * SHM_V;
    const int j_lo = LOF(it.P0) >> 6, NT = (it.P0 >> 6) + 4 - j_lo;
    const int sr = tid >> 4, sc = (tid & 15) * 8, vst0 = v_st(sr, sc), vst1 = v_st(32 + sr, sc);
    constexpr int NSET = (MODE == 1) ? 2 : 1;
    bf16x8 sk[NSET][NKC], sv0[NSET], sv1[NSET]; f32x4 s_k4 = {0.f, 0.f, 0.f, 0.f}, s_p4 = {0.f, 0.f, 0.f, 0.f};
    constexpr int KRS_OFF = 2 * SHM_V + 2 * SHM_K;
    int offk[NKC], offv0 = sr * it.v_ld + sc, offv1 = (32 + sr) * it.v_ld + sc;
#pragma unroll
    for (int i_ = 0; i_ < NKC; ++i_) { const int c_ = tid + 512 * i_, row_ = c_ / KCH, cc_ = c_ - row_ * KCH; offk[i_] = (DQK == 192 && cc_ >= 16) ? row_ * it.kpe_ld + (cc_ - 16) * 8 : row_ * it.k_ld + cc_ * 8; }
#define SLOAD(S_, kb_) do { if (MODE == 0) { const bf16_t* kt_ = it.k + (size_t)(kb_) * it.k_ld; const bf16_t* pt_ = it.kpe + (size_t)(kb_) * it.kpe_ld; const bf16_t* vt_ = it.v + (size_t)(kb_) * it.v_ld; \
            _Pragma("unroll") for (int i_ = 0; i_ < NKC; ++i_) { const int c_ = tid + 512 * i_, row_ = c_ / KCH, cc_ = c_ - row_ * KCH; sk[S_][i_] = *(const bf16x8*)(((DQK == 192 && cc_ >= 16) ? pt_ : kt_) + offk[i_]); } \
            sv0[S_] = *(const bf16x8*)(vt_ + offv0); sv1[S_] = *(const bf16x8*)(vt_ + offv1); \
            if (tid < 64) { s_k4 = *(const f32x4*)(it.ssk + (size_t)((kb_) + tid) * 64); s_p4 = *(const f32x4*)(it.ssl + (size_t)((kb_) + tid) * 16); } } else { \
        _Pragma("unroll") for (int i_ = 0; i_ < NKC; ++i_) { const int c_ = tid + 512 * i_, row_ = c_ / KCH, cc_ = c_ - row_ * KCH; const int tk_ = TOK((kb_) + row_); \
            sk[S_][i_] = *(const bf16x8*)(it.k + (size_t)tk_ * it.k_ld + cc_ * 8); } \
        { const int t0_ = TOK((kb_) + sr), t1_ = TOK((kb_) + 32 + sr); sv0[S_] = *(const bf16x8*)(it.v + (size_t)t0_ * it.v_ld + sc); sv1[S_] = *(const bf16x8*)(it.v + (size_t)t1_ * it.v_ld + sc); } } } while (0)
#define SWRITE(S_, bf_) do { _Pragma("unroll") for (int i_ = 0; i_ < NKC; ++i_) { const int c_ = tid + 512 * i_, row_ = c_ / KCH, cc_ = c_ - row_ * KCH; const int swz_ = (((DQK == 128) ? row_ : (row_ >> 1)) & 7) << 4; \
            *(LAS bf16x8*)(K_lds + (bf_) * SHM_K + row_ * RS + ((cc_ * 16) ^ swz_)) = sk[S_][i_]; } \
        *(LAS bf16x8*)(V_lds + (bf_) * SHM_V + vst0) = sv0[S_]; *(LAS bf16x8*)(V_lds + (bf_) * SHM_V + vst1) = sv1[S_]; \
        if (MODE == 0 && tid < 64) { const f32x4 a_ = s_k4 + s_p4; *(LAS float*)(lds + KRS_OFF + (bf_) * 256 + tid * 4) = rsqrtf(((a_.x + a_.y) + (a_.z + a_.w)) * (1.0f / 192.0f) + EPS); } } while (0)
    float m_reg = -1e30f, l_reg = 0.f; f32x16 o[4];
#pragma unroll
    for (int d = 0; d < 4; ++d)
#pragma unroll
        for (int r = 0; r < 16; ++r) o[d][r] = 0.f;
    SLOAD(0, j_lo * 64); if (MODE == 1) SLOAD(NSET - 1, j_lo * 64 + 64);
    bf16x8 qr[ND0];
    {
      constexpr int NR = (MODE == 0) ? 2 : 4;
      constexpr int R0 = (MODE == 0) ? 8 : 0;
      constexpr float QS = ((MODE == 0) ? 0.07216878364870322f : 0.08838834764831845f) * LOG2E;
      constexpr float FSTEP = LOG2_THETA / ((MODE == 0) ? 32.0f : 64.0f);
      const int tq_ = TOK(qp);
      const bf16_t* qrow = it.q + (size_t)tq_ * it.q_ld + hi * 8;
      u32x4 raw[ND0]; float ssq = 0.f;
#pragma unroll
      for (int d0 = 0; d0 < ND0; ++d0) raw[d0] = *(const u32x4*)(qrow + d0 * 16);
      const float posf = (float)it.pos[tq_];
#pragma unroll
      for (int d0 = 0; d0 < ND0; ++d0) { float v[8]; UNPACK8(raw[d0], v);
#pragma unroll
          for (int e = 0; e < 8; ++e) ssq += v[e] * v[e]; }
      { auto rr = __builtin_amdgcn_permlane32_swap(__float_as_uint(ssq), __float_as_uint(ssq), false, false); ssq = __uint_as_float(rr[0]) + __uint_as_float(rr[1]); }
      const float rq = rsqrtf(ssq * (1.0f / (float)DQK) + EPS) * QS;
      const float* gp = it.gq + hi * 8;
#pragma unroll
      for (int d0 = 0; d0 < ND0; ++d0) {
          if (d0 >= R0 + NR && d0 < R0 + 2 * NR) continue;
          f32x4 g0 = *(const f32x4*)(gp + d0 * 16), g1 = *(const f32x4*)(gp + d0 * 16 + 4);
          if (MODE == 0 && d0 < 8) { g0 *= *(const f32x4*)(it.gk + hi * 8 + d0 * 16); g1 *= *(const f32x4*)(it.gk + hi * 8 + d0 * 16 + 4); }
          float v[8]; UNPACK8(raw[d0], v);
#pragma unroll
          for (int e = 0; e < 8; ++e) v[e] *= rq * (e < 4 ? g0[e & 3] : g1[e & 3]);
          if (d0 >= R0 && d0 < R0 + NR) {
              const f32x4 h0 = *(const f32x4*)(gp + (d0 + NR) * 16), h1 = *(const f32x4*)(gp + (d0 + NR) * 16 + 4);
              float w[8]; UNPACK8(raw[d0 + NR], w);
#pragma unroll
              for (int e = 0; e < 8; ++e) { w[e] *= rq * (e < 4 ? h0[e & 3] : h1[e & 3]);
                  float sn_, cs_; sincos_rev(posf, exp2f(-(float)((d0 - R0) * 16 + hi * 8 + e) * FSTEP) * 0.15915494309189535f, sn_, cs_);
                  const float x1 = v[e], x2 = w[e]; v[e] = x1 * cs_ - x2 * sn_; w[e] = x2 * cs_ + x1 * sn_; }
              qr[d0 + NR] = as_bf(PACK8(w)); }
          qr[d0] = as_bf(PACK8(v)); } }
    SWRITE(0, 0); __syncthreads();
    const int swzr = (((DQK == 128) ? r32 : (r32 >> 1)) & 7) << 4;
    int kro[4];
#pragma unroll
    for (int dd = 0; dd < 4; ++dd) kro[dd] = r32 * RS + ((dd * 32 + hi * 16) ^ swzr);
#pragma unroll 1
    for (int t2 = 0; t2 < NT; t2 += NSET) {
#pragma unroll
      for (int us = 0; us < NSET; ++us) { const int t = t2 + us; if (t < NT) {
        const int kb = (j_lo + t) * 64, buf = t & 1;
        if (MODE == 1) { if (t + 2 < NT) SLOAD(us, kb + 128); } else { if (t + 1 < NT) SLOAD(0, kb + 64); }
#pragma unroll 1
        for (int hf = 0; hf < 2; ++hf) {
            const int kh = kb + 32 * hf;
            const bool act = (kh <= q0 + 31) && (kh + 31 >= lo_w);
            if (act) {
                f32x16 p0;
#pragma unroll
                for (int r = 0; r < 16; ++r) p0[r] = 0.f;
                { const LAS unsigned char* kbp = K_lds + buf * SHM_K + hf * (32 * RS);
#pragma unroll
                  for (int d0 = 0; d0 < ND0; ++d0) {
                      const bf16x8 b0 = *(const LAS bf16x8*)(kbp + kro[d0 & 3] + (d0 >> 2) * 128);
                      p0 = __builtin_amdgcn_mfma_f32_32x32x16_bf16(b0, qr[d0], p0, 0, 0, 0); } }
                if (MODE == 0) { const LAS float* kr_ = (const LAS float*)(lds + KRS_OFF + buf * 256) + 32 * hf + 4 * hi;
#pragma unroll
                    for (int j4 = 0; j4 < 4; ++j4) { const f32x4 s4 = *(const LAS f32x4*)(kr_ + 8 * j4);
#pragma unroll
                        for (int e = 0; e < 4; ++e) p0[4 * j4 + e] *= s4[e]; } }
                if (!((kh + 31 <= q0) && (kh >= lo_last))) {
                    const int dq = qp - kh - 4 * hi; const float NEG = -__builtin_inff();
#pragma unroll
                    for (int r = 0; r < 16; ++r) { const int c = (r & 3) + 8 * (r >> 2); if ((unsigned)(dq - c) > (unsigned)span) p0[r] = NEG; } }
                float pmax = p0[0];
#pragma unroll
                for (int r = 1; r < 16; ++r) pmax = fmaxf(pmax, p0[r]);
                { auto rr = __builtin_amdgcn_permlane32_swap(__float_as_uint(pmax), __float_as_uint(pmax), false, false); pmax = fmaxf(__uint_as_float(rr[0]), __uint_as_float(rr[1])); }
                const float mn = fmaxf(m_reg, pmax), alpha = __builtin_amdgcn_exp2f(m_reg - mn); m_reg = mn;
                float ps = 0.f;
#pragma unroll
                for (int r = 0; r < 16; ++r) { p0[r] = __builtin_amdgcn_exp2f(p0[r] - mn); ps += p0[r]; }
                { auto rr = __builtin_amdgcn_permlane32_swap(__float_as_uint(ps), __float_as_uint(ps), false, false); ps = __uint_as_float(rr[0]) + __uint_as_float(rr[1]); }
                l_reg = l_reg * alpha + ps;
                u32x4 pa0, pa1; PK4(p0, 0, pa0); PK4(p0, 8, pa1);
                if (__any(alpha != 1.0f)) {
#pragma unroll
                    for (int d = 0; d < 4; ++d)
#pragma unroll
                        for (int r = 0; r < 16; ++r) o[d][r] *= alpha; }
                const unsigned vb = (unsigned)(uintptr_t)(V_lds + buf * SHM_V + hf * 8192) + (unsigned)v_rd_base(lane);
#define TRRD(dst, off) asm volatile("ds_read_b64_tr_b16 %0, %1 offset:%2" : "=&v"(dst) : "v"(vb), "i"(off) : "memory")
#define PV_D0(d0) do { s16x4 l0, l1, h0, h1; constexpr int b_ = (d0) * 512; \
                TRRD(l0, b_); TRRD(h0, b_ + 2048); TRRD(l1, b_ + 4096); TRRD(h1, b_ + 6144); \
                asm volatile("s_waitcnt lgkmcnt(0)" ::: "memory"); __builtin_amdgcn_sched_barrier(0); \
                o[d0] = __builtin_amdgcn_mfma_f32_32x32x16_bf16((bf16x8){l0[0], l0[1], l0[2], l0[3], h0[0], h0[1], h0[2], h0[3]}, as_bf(pa0), o[d0], 0, 0, 0); \
                o[d0] = __builtin_amdgcn_mfma_f32_32x32x16_bf16((bf16x8){l1[0], l1[1], l1[2], l1[3], h1[0], h1[1], h1[2], h1[3]}, as_bf(pa1), o[d0], 0, 0, 0); } while (0)
                PV_D0(0); PV_D0(1); PV_D0(2); PV_D0(3);
#undef PV_D0
#undef TRRD
            }
        }
        if (t + 1 < NT) SWRITE((NSET - 1) - us, buf ^ 1);
        __syncthreads();
      } }
    }
    const int tq = TOK(qp);
    float a_cur = 1.0f / l_reg, a_prev = 0.f;
    if (MODE == 1) {
        const float lse_cur = m_reg + __builtin_amdgcn_logf(l_reg); float lse_new = lse_cur;
        if (it.merge) { const float lse_prev = it.lse[(size_t)tq * 8]; const float mx = fmaxf(lse_prev, lse_cur);
            const float e0 = __builtin_amdgcn_exp2f(lse_prev - mx), e1 = __builtin_amdgcn_exp2f(lse_cur - mx); const float inv = 1.0f / (e0 + e1);
            lse_new = mx + __builtin_amdgcn_logf(e0 + e1); a_prev = e0 * inv; a_cur *= e1 * inv; }
        if (hi == 0) it.lse[(size_t)tq * 8] = lse_new;
    }
    bf16_t* orow = it.o + (size_t)tq * it.o_ld + hi * 8;
#pragma unroll
    for (int d0 = 0; d0 < 4; ++d0) {
#pragma unroll
        for (int r = 0; r < 16; ++r) o[d0][r] *= a_cur;
        u32x4 w0, w1; PK4(o[d0], 0, w0); PK4(o[d0], 8, w1);
        if (MODE == 1 && it.merge) {
            const u32x4 q0w = *(const u32x4*)(orow + d0 * 32), q1w = *(const u32x4*)(orow + d0 * 32 + 16);
            float a[8], b[8];
            UNPACK8(w0, a); UNPACK8(q0w, b);
#pragma unroll
            for (int e = 0; e < 8; ++e) a[e] += b[e] * a_prev;
            w0 = PACK8(a);
            UNPACK8(w1, a); UNPACK8(q1w, b);
#pragma unroll
            for (int e = 0; e < 8; ++e) a[e] += b[e] * a_prev;
            w1 = PACK8(a);
        }
        *(u32x4*)(orow + d0 * 32) = w0; *(u32x4*)(orow + d0 * 32 + 16) = w1;
    }
#undef SLOAD
#undef SWRITE
#undef TOK
#undef LOF
}

__device__ void mla_attn_phase(const Params& p, LAS unsigned char* lds, const int* pos, const float* gq, const float* gk) {
    unsigned char* ws = p.ws;
    const int G_ = (int)gridDim.x, bid_ = opaque_bid(), vb_ = (G_ % 8 == 0) ? (bid_ % 8) * (G_ / 8) + bid_ / 8 : bid_;
    for (int item = vb_; item < BH * 16 * 4; item += G_) {
        const int bh = item >> 2, pr = item & 3, b = bh >> 4, h = bh & 15; const size_t tb = (size_t)b * SEQ;
        AttnItem it; it.q = (const bf16_t*)(ws + WS_Q) + tb * 3072 + h * 192; it.q_ld = 3072;
        it.k = (const bf16_t*)(ws + WS_KV) + tb * 4096 + h * 256; it.k_ld = 4096; it.kpe = (const bf16_t*)(ws + WS_KPER) + tb * 64; it.kpe_ld = 64; it.gk = gk; it.ssk = (const float*)(ws + WS_SSK) + (tb * 16 + h) * 4; it.ssl = (const float*)(ws + WS_SSL) + tb * 16 + 8;
        it.v = (const bf16_t*)(ws + WS_KV) + tb * 4096 + h * 256 + 128; it.v_ld = 4096; it.o = (bf16_t*)(ws + WS_AO) + tb * 2048 + h * 128; it.o_ld = 2048;
        it.lse = nullptr; it.ld = 0; it.merge = 0; it.pos = pos + tb; it.gq = gq;
#pragma unroll 1
        for (int k2 = 0; k2 < 2; ++k2) { it.P0 = (k2 == 0 ? 7 - pr : pr) * 256; attn_block<192, 0>(it, lds); }
    }
}
__device__ void dil_attn_phase(const Params& p, LAS unsigned char* lds, int g, const int* pos, const float* gq) {
    unsigned char* ws = p.ws;
    const int G_ = (int)gridDim.x, bid_ = opaque_bid(), vb_ = (G_ % 8 == 0) ? (bid_ % 8) * (G_ / 8) + bid_ / 8 : bid_;
    for (int item = vb_; item < BH * 8 * 8; item += G_) {
        const int bh = item >> 3, qb = item & 7, b = bh >> 3, h = bh & 7, hh = g * 8 + h; const size_t tb = (size_t)b * SEQ;
        AttnItem it; it.q = (const bf16_t*)(ws + WS_QB) + tb * 3072 + hh * 128; it.q_ld = 3072;
        it.k = (const bf16_t*)(ws + WS_KVB) + tb * 6144 + hh * 128; it.k_ld = 6144; it.kpe = nullptr; it.kpe_ld = 0; it.gk = nullptr; it.ssk = nullptr; it.ssl = nullptr;
        it.v = (const bf16_t*)(ws + WS_KVB) + tb * 6144 + 3072 + hh * 128; it.v_ld = 6144; it.o = (bf16_t*)(ws + WS_OB) + tb * 1024 + h * 128; it.o_ld = 1024;
        it.lse = (float*)(ws + WS_LSE) + tb * 8 + h; it.ld = 2 * g; it.merge = g > 0; it.P0 = qb * 256; it.pos = pos + tb; it.gq = gq + g * 128;
        attn_block<128, 1>(it, lds);
    }
}

#define XB_TMO      128
#define XB_XCNT(j)  (256  + 64 * (j))
#define XB_XSUB(j)  (1280 + 64 * (j))
#define XB_XGEN(j)  (2304 + 64 * (j))
#define XB_TOP      3328
#define XB_TOPGEN   3392
#define XCD_BAR_WORDS 3456
#define XB_SPIN_CAP (1u << 18)

__device__ __forceinline__ unsigned xb_ld(unsigned* p)              { return __hip_atomic_load(p, __ATOMIC_RELAXED, __HIP_MEMORY_SCOPE_AGENT); }
__device__ __forceinline__ unsigned xb_add(unsigned* p, unsigned v) { return __hip_atomic_fetch_add(p, v, __ATOMIC_RELAXED, __HIP_MEMORY_SCOPE_AGENT); }
__device__ __forceinline__ unsigned xb_xcc_id() { return (unsigned)__builtin_amdgcn_s_getreg((3 << 11) | 20) & 0xFu; }
#define XB_SPIN(cond, bar) do { unsigned _sp = 0; while (cond) { __builtin_amdgcn_s_sleep(1); \
    if ((++_sp & 255u) == 0u) { if (xb_ld(&(bar)[XB_TMO])) break; if (_sp > XB_SPIN_CAP) { atomicAdd(&(bar)[XB_TMO], 1u); break; } } } } while (0)

struct XcdBarrier {
    unsigned* bar; unsigned x;
    volatile LAS unsigned* st;
};

__device__ __forceinline__ XcdBarrier xcd_barrier_post(unsigned* bar, volatile LAS unsigned* st) {
    XcdBarrier b; b.bar = bar; b.x = xb_xcc_id(); b.st = st;
    if (threadIdx.x == 0) (void)xb_add(&bar[XB_XCNT(b.x)], 1u);
    return b;
}
__device__ __forceinline__ void xcd_barrier_complete(unsigned* bar, unsigned x, unsigned& nloc, unsigned& nx) {
    const unsigned G = gridDim.x * gridDim.y * gridDim.z;
    unsigned sum, cnt, mine, sp = 0u;
    for (;;) {
        sum = 0u; cnt = 0u; mine = 0u;
#pragma unroll
        for (unsigned j = 0; j < 16; ++j) { const unsigned c = xb_ld(&bar[XB_XCNT(j)]); sum += c; cnt += (c > 0u) ? 1u : 0u; mine = (j == x) ? c : mine; }
        if (sum == G) break;
        __builtin_amdgcn_s_sleep(1);
        if ((++sp & 255u) == 0u) { if (xb_ld(&bar[XB_TMO])) break; if (sp > XB_SPIN_CAP) { atomicAdd(&bar[XB_TMO], 1u); break; } }
    }
    nloc = mine > 0u ? mine : 1u; nx = cnt > 0u ? cnt : 1u;
}

__device__ __forceinline__ void xcd_barrier(const XcdBarrier& b) {
    asm volatile("s_waitcnt vmcnt(0)" ::: "memory");
    __syncthreads();
    if (threadIdx.x == 0) {
        unsigned* bar = b.bar;
        __builtin_amdgcn_s_waitcnt(0);
        unsigned nloc = b.st[0], nx = b.st[1];
        if (nloc == 0u) { xcd_barrier_complete(bar, b.x, nloc, nx); b.st[0] = nloc; b.st[1] = nx; }
        const unsigned old = xb_add(&bar[XB_XSUB(b.x)], 1u);
        const unsigned gen = old / nloc;
        if (old + 1u == (gen + 1u) * nloc) {
            __builtin_amdgcn_fence(__ATOMIC_RELEASE, "agent");
            asm volatile("s_waitcnt vmcnt(0)" ::: "memory");
            const unsigned og = xb_add(&bar[XB_TOP], 1u);
            const unsigned tg = og / nx;
            if (og + 1u == (tg + 1u) * nx) xb_add(&bar[XB_TOPGEN], 1u);
            else XB_SPIN(xb_ld(&bar[XB_TOPGEN]) == tg, bar);
            __builtin_amdgcn_fence(__ATOMIC_ACQUIRE, "agent");
            xb_add(&bar[XB_XGEN(b.x)], 1u);
            asm volatile("s_waitcnt vmcnt(0)" ::: "memory");
        } else {
            XB_SPIN(xb_ld(&bar[XB_XGEN(b.x)]) == gen, bar);
            __builtin_amdgcn_fence(__ATOMIC_ACQUIRE, "agent");
            asm volatile("s_waitcnt vmcnt(0)" ::: "memory");
        }
    }
    __syncthreads();
}

constexpr int NPH_HALF = 1 + 2 * 6 + 8 + 7;
#ifndef SKIP_MASK
#define SKIP_MASK 0
#endif
__global__ void __launch_bounds__(NTHR) mega(Params p) {
    extern __shared__ __attribute__((aligned(16))) unsigned char lds_raw[];
    LAS unsigned char* lds = (LAS unsigned char*)lds_raw;
    cg::grid_group grid = cg::this_grid();
    unsigned char* ws = p.ws;
    bf16_t* XB = (bf16_t*)(ws + WS_XB); float* SS = (float*)(ws + WS_SS); bf16_t* HB = (bf16_t*)(ws + WS_H);
    bf16_t* LAT = (bf16_t*)(ws + WS_LAT); bf16_t* Q = (bf16_t*)(ws + WS_Q); bf16_t* KV = (bf16_t*)(ws + WS_KV); bf16_t* KPE = (bf16_t*)(ws + WS_KPE); bf16_t* AO = (bf16_t*)(ws + WS_AO);
    bf16_t* KVB = (bf16_t*)(ws + WS_KVB); bf16_t* QB = (bf16_t*)(ws + WS_QB); bf16_t* OB = (bf16_t*)(ws + WS_OB);
#ifndef PROBE_MASK
#define PROBE_MASK 0
#endif
    unsigned long long probe_acc = 0ull;
    volatile LAS unsigned* bar_st = (volatile LAS unsigned*)(lds + 131072);
    if (threadIdx.x < 4) bar_st[threadIdx.x] = 0u;
    __syncthreads();
    XcdBarrier xbar = xcd_barrier_post((unsigned*)(ws + WS_BAR), bar_st);
#pragma unroll 1
    for (int ph = p.ph_lo; ph < p.ph_hi; ++ph) {
        const unsigned long long probe_t0 = PROBE_MASK ? __builtin_amdgcn_s_memrealtime() : 0ull;
        const int hb = ph >= NPH_HALF ? 1 : 0, li = hb ? ph - NPH_HALF + 1 : ph;
        const size_t toff = (size_t)hb * TH;
        const float* xin0 = (const float*)p.in[0] + toff * DM; float* xo = p.out + toff * DM; const int* pos = (const int*)p.in[1] + toff;
        int lyr = 0, j = -1;
        if (li >= 21) { lyr = 3; const int jm = li - 21; j = jm == 0 ? 0 : jm + 1; }
        else if (li >= 13) { lyr = 2; j = li - 13; }
        else if (li >= 1) { lyr = (li - 1) / 6; const int jm = (li - 1) - lyr * 6; j = jm == 0 ? 0 : jm == 1 ? 2 : jm + 2; }
        const bool mla = lyr < 2; const int ab = lyr & 1;
        int gk = 0;
        const bf16_t* A = nullptr; const bf16_t* Bt = nullptr; int lda = 0, N = 0, K = 0, nsub = 1;
        EpiBf16S E1{nullptr, 0, nullptr, 0, 1 << 30, nullptr, 4, 1.0f / 1024.0f, 0, nullptr, nullptr, nullptr, -1}; EpiRes E2{nullptr, nullptr, XB, SS};
        float* SSL = (float*)(ws + WS_SSL);
        if (li > 0) {
            if (j == 6) { gk = 1; A = XB; lda = 1024; Bt = (const bf16_t*)(ws + WS_W1) + (size_t)lyr * 4096 * 1024; N = 4096; K = 1024; E1.O = HB; E1.ldc = 4096; E1.ss = SS; E1.act = 1; }
            else if (j == 7) { gk = 2; A = HB; lda = 4096; Bt = (const bf16_t*)(ws + WS_W2) + (size_t)lyr * 1024 * 4096; N = 1024; K = 4096; E2.xin = xo; E2.xout = xo; }
            else if (j == 5) { gk = 2; N = 1024; E2.xin = lyr == 0 ? xin0 : xo; E2.xout = xo;
                if (mla) { A = AO; lda = 2048; K = 2048; Bt = (const bf16_t*)(ws + WS_WO) + (size_t)ab * 1024 * 2048; }
                else { A = OB; lda = 1024; K = 1024; Bt = (const bf16_t*)(ws + WS_WOB) + (size_t)ab * 1024 * 1024; } }
            else if (j == 0) { gk = 1; A = XB; lda = 1024; K = 1024; E1.ss = SS;
                if (hb == 1 && lyr == 0) { A = (const bf16_t*)(p.out + (size_t)TH * DM); E1.ss = (const float*)(p.out + (size_t)TH * DM) + 8 * MiB; }
                if (mla) { Bt = (const bf16_t*)(ws + WS_WIN) + (size_t)ab * 512 * 1024; N = 512; E1.O = LAT; E1.ldc = 512; E1.ssl = SSL; }
                else if (ab == 0) { Bt = (const bf16_t*)(ws + WS_WKVQ); N = 9216; E1.O = KVB; E1.ldc = 6144; E1.O2 = QB; E1.ldc2 = 3072; E1.split = 6144; }
                else { Bt = (const bf16_t*)(ws + WS_WQ1); N = 3072; E1.O = QB; E1.ldc = 3072; } }
            else if (j == 2 && mla) { gk = 1; nsub = 2; A = LAT; lda = 512; K = 256; Bt = (const bf16_t*)(ws + WS_WQB) + (size_t)ab * 3072 * 256; N = 3072; E1.O = Q; E1.ldc = 3072; E1.ss = SSL; E1.nsl4 = 1; E1.inv_n = 1.0f / 256.0f; }
        }
        if (!(SKIP_MASK & 1) && gk == 1) {
            if (nsub == 2) kpe_prep(LAT, pos, (const float*)p.in[10] + ab * 192, (bf16_t*)(ws + WS_KPER));
#pragma unroll 1
            for (int sub = 0; sub < nsub; ++sub) {
                if (sub == 1) { A = LAT + 256; Bt = (const bf16_t*)(ws + WS_WKVB) + (size_t)ab * 4096 * 256; N = 4096; E1.O = KV; E1.ldc = 4096; E1.ss = SSL + 4; E1.inv_n = 1.0f / 128.0f; E1.ssk = (float*)(ws + WS_SSK); }
                run_gemm_bf16(lds, A, lda, Bt, N, K, E1);
            }
        } else if (!(SKIP_MASK & 2) && gk == 2) {
            run_gemm(lds, A, lda, Bt, N, K, E2);
        } else if (li == 0) {
            if (!(SKIP_MASK & 4)) { prep_weights(p, lds); prep_x(xin0, XB, SS);
                prep_x((const float*)p.in[0] + (size_t)TH * DM, (bf16_t*)(p.out + (size_t)TH * DM), p.out + (size_t)TH * DM + 8 * MiB); }
        } else if (mla) {
            if (j == 4) { if (!(SKIP_MASK & 32)) mla_attn_phase(p, lds, pos, (const float*)p.in[9] + ab * 192, (const float*)p.in[10] + ab * 192); }
        } else {
            if (j == 1) { if (!(SKIP_MASK & 64)) head_prep(ab == 0 ? KVB : nullptr, QB, pos, (const float*)p.in[14], (const float*)p.in[16] + ab * 384); }
            else if (j >= 2 && j <= 4) { if (!(SKIP_MASK & 128)) dil_attn_phase(p, lds, j - 2, pos, (const float*)p.in[16] + ab * 384); }
        }
        if (ph + 1 < p.ph_hi) { if (ph == p.ph_lo) grid.sync(); else xcd_barrier(xbar); }
        if (PROBE_MASK) { const int cat = gk == 1 ? 1 : gk == 2 ? 2 : li == 0 ? 3 : mla ? (j == 1 ? 4 : j == 3 ? 5 : 6) : (j == 1 ? 7 : 8);
            if ((PROBE_MASK >> cat) & 1) probe_acc += __builtin_amdgcn_s_memrealtime() - probe_t0; }
    }
    if (PROBE_MASK && blockIdx.x == 0) { const unsigned long long t1 = __builtin_amdgcn_s_memrealtime(); while (__builtin_amdgcn_s_memrealtime() - t1 < probe_acc) __builtin_amdgcn_s_sleep(16); }
}
constexpr int N_PHASES = 2 * NPH_HALF - 1;

extern "C" void kernel_launch(void* const* d_in, const int* in_sizes, int n_in, void* d_out, int out_size, void* d_ws, size_t ws_size, hipStream_t stream) {
    static int grid_blocks = 0;
    if (!grid_blocks) {
        int dev = 0, cus = 0, per_cu = 0;
        (void)hipGetDevice(&dev);
        (void)hipDeviceGetAttribute(&cus, hipDeviceAttributeMultiprocessorCount, dev);
        (void)hipFuncSetAttribute((const void*)mega, hipFuncAttributeMaxDynamicSharedMemorySize, LDS_BYTES);
        (void)hipOccupancyMaxActiveBlocksPerMultiprocessor(&per_cu, (const void*)mega, NTHR, LDS_BYTES);
        (void)hipGetLastError();
        grid_blocks = cus > 0 ? cus : 256;
        if (ws_size < WS_END || n_in != 20) { fprintf(stderr, "kernel_launch: workspace %zu < %zu or n_in %d != 20\n", ws_size, (size_t)WS_END, n_in); }
    }
    (void)hipMemsetAsync((unsigned char*)d_ws + WS_BAR, 0, XCD_BAR_WORDS * sizeof(unsigned), stream);
    Params p{};
    for (int i = 0; i < 20; ++i) p.in[i] = d_in[i];
    p.out = (float*)d_out; p.ws = (unsigned char*)d_ws;
#if ONE_LAUNCH
    p.ph_lo = 0; p.ph_hi = N_PHASES;
    void* args[] = {&p};
    hipError_t e = hipLaunchCooperativeKernel((const void*)mega, dim3(grid_blocks), dim3(NTHR), args, LDS_BYTES, stream);
    if (e != hipSuccess) fprintf(stderr, "cooperative launch failed: %s (grid %d)\n", hipGetErrorString(e), grid_blocks);
#else
    for (int ph = 0; ph < N_PHASES; ++ph) { p.ph_lo = ph; p.ph_hi = ph + 1; hipLaunchKernelGGL(mega, dim3(grid_blocks), dim3(NTHR), LDS_BYTES, stream, p); }
#endif
}
```

```cpp
#include <hip/hip_runtime.h>
#include <hip/hip_cooperative_groups.h>
#include <cstdio>
#include <cstdint>
namespace cg = cooperative_groups;

#ifndef ONE_LAUNCH
#define ONE_LAUNCH 1
#endif

__device__ __forceinline__ int opaque_tid() { int t = (int)threadIdx.x; asm volatile("" : "+v"(t)); return t; }
__device__ __forceinline__ int opaque_bid() { int b = (int)blockIdx.x; asm volatile("" : "+s"(b)); return b; }
namespace pg8 {
#define PG8_LAS __attribute__((address_space(3)))
typedef unsigned short bf16_t;
typedef short bf16x8 __attribute__((ext_vector_type(8)));
typedef float f32x4 __attribute__((ext_vector_type(4)));
typedef unsigned u32x4 __attribute__((ext_vector_type(4)));
constexpr int BM = 256, BK = 64, HALF = 128, HTB = HALF * BK * 2  , STAGE_BYTES = 8 * HTB, NXCD = 8, WGM = 8;

__host__ __device__ __forceinline__ int lds_byte(int r, int c) { const int st = (r >> 4) * 2 + (c >> 5), rr = r & 15, cc = c & 31, ob = rr * 64 + cc * 2; return st * 1024 + (ob ^ (((ob >> 9) & 1) << 5)); }
__host__ __device__ __forceinline__ void stage_rc(int b, int& R, int& C) { const int st = b / 1024, sb = b % 1024, swz = sb ^ (((sb >> 9) & 1) << 5); R = (st >> 1) * 16 + swz / 64; C = (st & 1) * 32 + (swz % 64) / 2; }
__host__ __device__ __forceinline__ int perm32(int rho) { const int n = rho >> 4, i = rho & 15; return 8 * (i >> 2) + 4 * n + (i & 3); }
struct Unit { int pm, pn; };
struct Gemm { const bf16_t* A; const bf16_t* Bt; int M, N, K, lda; };
struct StaticOrder {
    int nM, nN, nwg, G, c;
    __host__ __device__ void init(int M, int N, int G_, int c_) { nM = M / BM; nN = N / BM; nwg = nM * nN; G = G_; c = c_; }
    __host__ __device__ bool next(int i, Unit& u) const {
        const long L = (long)i * G + c; if (L >= nwg) return false;
        int wgid = (int)L; { const int q = nwg / NXCD, r = nwg % NXCD, xcd = wgid % NXCD, off = wgid / NXCD; wgid = (xcd < r ? xcd * (q + 1) : r * (q + 1) + (xcd - r) * q) + off; }
        const int nig = WGM * nN, gid = wgid / nig, fm = gid * WGM, gsz = (nM - fm) < WGM ? (nM - fm) : WGM;
        u.pm = fm + ((wgid % nig) % gsz); u.pn = (wgid % nig) / gsz; return true;
    }
    __device__ __forceinline__ void a_ready(const Unit&) const {}
    __device__ __forceinline__ void done(const Unit&) const {}
};
__device__ __forceinline__ unsigned cvt_pk_bf16(float lo, float hi) { unsigned r; asm volatile("v_cvt_pk_bf16_f32 %0, %1, %2" : "=v"(r) : "v"(lo), "v"(hi)); return r; }
template <class Epi, class Sched>
__device__ __forceinline__ void gemm_phase(PG8_LAS unsigned char* lds, const Gemm g, const Sched& S, const Epi& E) {
    const int tid = opaque_tid(), wid = __builtin_amdgcn_readfirstlane(tid >> 6), lane = tid & 63, wr = wid >> 2, wc = wid & 3, fr = lane & 15, fq = lane >> 4;
    const int K = g.K, nt = K / BK;
    unsigned voffA[2], voffB[2];
#pragma unroll
    for (int i = 0; i < 2; ++i) { int R, C; stage_rc(tid * 16 + i * 8192, R, C); const int Rb = Epi::PERM ? ((R & ~31) + perm32(R & 31)) : R;
        voffA[i] = (unsigned)(R * g.lda + C) * 2u; voffB[i] = (unsigned)(Rb * K + C) * 2u; }
    const size_t kstep = (size_t)(BK * 2);
    const size_t hstep = (size_t)HALF * K * 2, hstepA = (size_t)HALF * g.lda * 2;
    const size_t tstep = 2 * hstep, tstepA = 2 * hstepA;
    const unsigned ldsw = (unsigned)wid * 1024u;
    const int aoff = lds_byte(wr * 64 + fr, fq * 8), boff = lds_byte(wc * 32 + fr, fq * 8);
#define PG8_SA(b, h) (((b) * 2 + (h)) * HTB)
#define PG8_SB(b, h) ((4 + (b) * 2 + (h)) * HTB)
#define PG8_STAGE(bufoff, gbase, voff) do { _Pragma("unroll") for (int _i = 0; _i < 2; ++_i) \
        __builtin_amdgcn_global_load_lds((const unsigned*)((const char*)(gbase) + (voff)[_i]), (PG8_LAS unsigned*)(lds + (bufoff) + ldsw + _i * 8192), 16, 0, 0); } while (0)
#define PG8_LDA(dst, b, h) do { _Pragma("unroll") for (int m = 0; m < 4; ++m) _Pragma("unroll") for (int k = 0; k < 2; ++k) dst[m][k] = *(const PG8_LAS bf16x8*)(lds + PG8_SA(b, h) + aoff + m * 2048 + k * 1024); } while (0)
#define PG8_LDB(dst, b, h) do { _Pragma("unroll") for (int n = 0; n < 2; ++n) _Pragma("unroll") for (int k = 0; k < 2; ++k) dst[n][k] = *(const PG8_LAS bf16x8*)(lds + PG8_SB(b, h) + boff + n * 2048 + k * 1024); } while (0)
#define PG8_MMA(ai, bj, At, Bt) do { __builtin_amdgcn_s_setprio(1); _Pragma("unroll") for (int m = 0; m < 4; ++m) _Pragma("unroll") for (int n = 0; n < 2; ++n) _Pragma("unroll") for (int k = 0; k < 2; ++k) \
        acc[ai][bj][m][n] = __builtin_amdgcn_mfma_f32_16x16x32_bf16(Bt[n][k], At[m][k], acc[ai][bj][m][n], 0, 0, 0); __builtin_amdgcn_s_setprio(0); } while (0)
#define PG8_WAIT_V(n) asm volatile("s_waitcnt vmcnt(" #n ")" ::: "memory")
#define PG8_WAIT_L(n) asm volatile("s_waitcnt lgkmcnt(" #n ")" ::: "memory")
#define PG8_BAR __builtin_amdgcn_s_barrier()
#define PG8_SCHED __builtin_amdgcn_sched_barrier(0)
    Unit cur, nxt; int ui = 0;
    if (!S.next(0, cur)) return;
    f32x4 acc[2][2][4][2];
#pragma unroll
    for (int a = 0; a < 2; ++a)
#pragma unroll
        for (int b = 0; b < 2; ++b)
#pragma unroll
            for (int m = 0; m < 4; ++m)
#pragma unroll
                for (int n = 0; n < 2; ++n) acc[a][b][m][n] = (f32x4){0.f, 0.f, 0.f, 0.f};
    if constexpr (Epi::INIT_ACC) E.init_acc(acc, cur, wr, wc, fr, fq);
    bf16x8 At[4][2], B0[2][2], B1[2][2];
    const char* cA = (const char*)g.A + (size_t)cur.pm * tstepA; const char* cB = (const char*)g.Bt + (size_t)cur.pn * tstep;
    S.a_ready(cur);
    PG8_STAGE(PG8_SB(0, 0), cB, voffB); PG8_STAGE(PG8_SA(0, 0), cA, voffA); PG8_STAGE(PG8_SB(0, 1), cB + hstep, voffB); PG8_STAGE(PG8_SA(0, 1), cA + hstepA, voffA);
    if (wr == 1) PG8_BAR;
    PG8_WAIT_V(4); PG8_BAR;
    PG8_STAGE(PG8_SB(1, 0), cB + kstep, voffB); PG8_STAGE(PG8_SA(1, 0), cA + kstep, voffA); PG8_STAGE(PG8_SB(1, 1), cB + hstep + kstep, voffB);
    PG8_WAIT_V(6); PG8_BAR;
    for (;;) {
        const bool has_next = S.next(ui + 1, nxt);
        const char* nA = has_next ? (const char*)g.A + (size_t)nxt.pm * tstepA : cA; const char* nB = has_next ? (const char*)g.Bt + (size_t)nxt.pn * tstep : cB;
        for (int t = 0; t < nt; t += 2) {
            const bool last = (t == nt - 2);
            const char* a1 = cA + (size_t)(t + 1) * kstep;
            const char* a2 = last ? nA : cA + (size_t)(t + 2) * kstep; const char* b2 = last ? nB : cB + (size_t)(t + 2) * kstep;
            const char* a3 = a2 + kstep; const char* b3 = b2 + kstep;
            if (last && has_next) S.a_ready(nxt);
            PG8_LDB(B0, 0, 0); PG8_SCHED; PG8_LDA(At, 0, 0); PG8_STAGE(PG8_SA(1, 1), a1 + hstepA, voffA);
            PG8_WAIT_L(8); PG8_BAR; PG8_WAIT_L(0); PG8_MMA(0, 0, At, B0); PG8_BAR; PG8_SCHED;
            PG8_LDB(B1, 0, 1); PG8_STAGE(PG8_SB(0, 0), b2, voffB);
            PG8_BAR; PG8_WAIT_L(0); PG8_MMA(0, 1, At, B1); PG8_BAR;
            PG8_LDA(At, 0, 1); PG8_STAGE(PG8_SA(0, 0), a2, voffA);
            PG8_BAR; PG8_WAIT_L(0); PG8_MMA(1, 0, At, B0); PG8_BAR; PG8_SCHED;
            PG8_STAGE(PG8_SB(0, 1), b2 + hstep, voffB);
            PG8_WAIT_V(6); PG8_BAR; PG8_MMA(1, 1, At, B1); PG8_BAR;
            PG8_LDB(B0, 1, 0); PG8_SCHED; PG8_LDA(At, 1, 0); PG8_STAGE(PG8_SA(0, 1), a2 + hstepA, voffA);
            PG8_WAIT_L(8); PG8_BAR; PG8_WAIT_L(0); PG8_MMA(0, 0, At, B0); PG8_BAR; PG8_SCHED;
            PG8_LDB(B1, 1, 1); PG8_STAGE(PG8_SB(1, 0), b3, voffB);
            PG8_BAR; PG8_WAIT_L(0); PG8_MMA(0, 1, At, B1); PG8_BAR;
            PG8_LDA(At, 1, 1); PG8_STAGE(PG8_SA(1, 0), a3, voffA);
            PG8_BAR; PG8_WAIT_L(0); PG8_MMA(1, 0, At, B0); PG8_BAR; PG8_SCHED;
            PG8_STAGE(PG8_SB(1, 1), b3 + hstep, voffB);
            PG8_WAIT_V(6); PG8_BAR; PG8_MMA(1, 1, At, B1); PG8_BAR;
        }
        if constexpr (!Epi::AFTER_DRAIN) { E(acc, cur, wr, wc, fr, fq); S.done(cur); }
        if (!has_next) break;
#pragma unroll
        for (int a = 0; a < 2; ++a)
#pragma unroll
            for (int b = 0; b < 2; ++b)
#pragma unroll
                for (int m = 0; m < 4; ++m)
#pragma unroll
                    for (int n = 0; n < 2; ++n) acc[a][b][m][n] = (f32x4){0.f, 0.f, 0.f, 0.f};
        if constexpr (Epi::INIT_ACC) E.init_acc(acc, nxt, wr, wc, fr, fq);
        cur = nxt; cA = nA; cB = nB; ++ui;
    }
    PG8_WAIT_V(0);
    if (wr == 0) PG8_BAR;
    PG8_BAR;
    if constexpr (Epi::AFTER_DRAIN) { E.fused(acc, cur, wr, wc, fr, fq, lds, wid, lane); S.done(cur); }
#undef PG8_SA
#undef PG8_SB
#undef PG8_STAGE
#undef PG8_LDA
#undef PG8_LDB
#undef PG8_MMA
#undef PG8_WAIT_V
#undef PG8_WAIT_L
#undef PG8_BAR
#undef PG8_SCHED
}
}
using pg8::bf16_t; using pg8::bf16x8; using pg8::f32x4; using pg8::u32x4;
#define LAS __attribute__((address_space(3)))
typedef short s16x4 __attribute__((ext_vector_type(4)));
typedef float f32x16 __attribute__((ext_vector_type(16)));
typedef unsigned u32x2 __attribute__((ext_vector_type(2)));

constexpr int SEQ = 2048, DM = 1024, NBATCH = 16, TT = NBATCH * SEQ, TH = TT / 2, BH = NBATCH / 2, DFF = 4096;
constexpr float EPS = 1e-6f, LOG2E = 1.4426950408889634f, LOG2_THETA = 13.287712379549449f;
constexpr int NTHR = 512;
constexpr int LDS_BYTES = 131072 + 8192;
constexpr int RS_OFF = 131072 + 2048;
constexpr size_t MiB = (size_t)1 << 20;
constexpr size_t WS_WIN = 0, WS_WQB = WS_WIN + 2 * MiB, WS_WKVB = WS_WQB + 3 * MiB, WS_WO = WS_WKVB + 4 * MiB, WS_WKVQ = WS_WO + 8 * MiB, WS_WQ1 = WS_WKVQ + 18 * MiB,
                 WS_WOB = WS_WQ1 + 6 * MiB, WS_W1 = WS_WOB + 4 * MiB, WS_W2 = WS_W1 + 32 * MiB, WS_XB = WS_W2 + 32 * MiB, WS_SS = WS_XB + 32 * MiB, WS_LSE = WS_SS + 1 * MiB,
                 WS_BAR = WS_LSE + 768 * 1024, WS_SSL = WS_LSE + 1 * MiB, WS_BIG = WS_SSL + 1 * MiB;
constexpr size_t WS_LAT = WS_BIG, WS_Q = WS_LAT + 16 * MiB, WS_KV = WS_Q + 96 * MiB, WS_KPE = WS_KV + 128 * MiB, WS_AO = WS_KPE + 32 * MiB;
constexpr size_t WS_SSK = WS_KPE, WS_KPER = WS_KPE + 8 * MiB;
constexpr size_t WS_KVB = WS_BIG, WS_QB = WS_BIG + 192 * MiB, WS_OB = WS_BIG + 288 * MiB;
constexpr size_t WS_H = WS_BIG + 192 * MiB;
constexpr size_t WS_END = WS_BIG + 336 * MiB;

struct Params { const void* in[20]; float* out; unsigned char* ws; int ph_lo, ph_hi; };

__device__ __forceinline__ unsigned cvtpk(float lo, float hi) { unsigned r; asm volatile("v_cvt_pk_bf16_f32 %0, %1, %2" : "=v"(r) : "v"(lo), "v"(hi)); return r; }
__device__ __forceinline__ float bf_lo(unsigned w) { return __uint_as_float(w << 16); }
__device__ __forceinline__ float bf_hi(unsigned w) { return __uint_as_float(w & 0xffff0000u); }
#define UNPACK8(W_, V_) do { const u32x4 t_ = (W_); V_[0] = bf_lo(t_[0]); V_[1] = bf_hi(t_[0]); V_[2] = bf_lo(t_[1]); V_[3] = bf_hi(t_[1]); V_[4] = bf_lo(t_[2]); V_[5] = bf_hi(t_[2]); V_[6] = bf_lo(t_[3]); V_[7] = bf_hi(t_[3]); } while (0)
#define PACK8(V_) ((u32x4){cvtpk(V_[0], V_[1]), cvtpk(V_[2], V_[3]), cvtpk(V_[4], V_[5]), cvtpk(V_[6], V_[7])})
__device__ __forceinline__ void sincos_rev(float pos, float invf_rev, float& s, float& c) {
    float rev = pos * invf_rev; rev = rev - floorf(rev);
    s = __builtin_amdgcn_sinf(rev); c = __builtin_amdgcn_cosf(rev);
}

constexpr int NCV = 7;
__device__ __forceinline__ void cvt_job(const float* __restrict__ W, int K, int N, const float* __restrict__ gain, bf16_t* __restrict__ dst, int ldo, int& base, LAS float* tile) {
    const int tk = K / 64, tn = N / 64, nt = tk * tn, G = (int)gridDim.x, tid = opaque_tid();
    int start = (opaque_bid() - (base % G)); if (start < 0) start += G;
    for (int t0 = start; t0 < nt; t0 += NCV * G) {
        f32x4 v[NCV][2]; float g[NCV][2];
#pragma unroll
        for (int q = 0; q < NCV; ++q) { const int t = t0 + q * G; if (t < nt) { const int kt = t / tn, ntile = t - kt * tn;
#pragma unroll
            for (int i = 0; i < 2; ++i) { const int k = (tid >> 4) + 32 * i, n4 = (tid & 15) * 4;
                v[q][i] = *(const f32x4*)(W + (size_t)(kt * 64 + k) * N + ntile * 64 + n4); g[q][i] = gain ? gain[kt * 64 + k] : 1.0f; } } }
        __syncthreads();
#pragma unroll
        for (int q = 0; q < NCV; ++q) { const int t = t0 + q * G; if (t < nt) { LAS float* tq = tile + q * (64 * 65);
#pragma unroll
            for (int i = 0; i < 2; ++i) { const int k = (tid >> 4) + 32 * i, n4 = (tid & 15) * 4;
                tq[(n4 + 0) * 65 + k] = v[q][i].x * g[q][i]; tq[(n4 + 1) * 65 + k] = v[q][i].y * g[q][i]; tq[(n4 + 2) * 65 + k] = v[q][i].z * g[q][i]; tq[(n4 + 3) * 65 + k] = v[q][i].w * g[q][i]; } } }
        __syncthreads();
#pragma unroll
        for (int q = 0; q < NCV; ++q) { const int t = t0 + q * G; if (t < nt) { const int kt = t / tn, ntile = t - kt * tn; const int n = tid >> 3, k8 = (tid & 7) * 8;
            const LAS float* tp = tile + q * (64 * 65) + n * 65 + k8;
            u32x4 w; w.x = cvtpk(tp[0], tp[1]); w.y = cvtpk(tp[2], tp[3]); w.z = cvtpk(tp[4], tp[5]); w.w = cvtpk(tp[6], tp[7]);
            *(u32x4*)(dst + (size_t)(ntile * 64 + n) * ldo + kt * 64 + k8) = w; } }
    }
    base += nt;
}
__device__ __forceinline__ void zero_fill(bf16_t* dst, int rows, int cols8, int ld) {
    const size_t n = (size_t)rows * cols8;
    for (size_t i = (size_t)opaque_bid() * NTHR + opaque_tid(); i < n; i += (size_t)gridDim.x * NTHR) { const size_t r = i / cols8, c = i - r * cols8; *(u32x4*)(dst + r * ld + c * 8) = (u32x4){0u, 0u, 0u, 0u}; }
}
__device__ void prep_weights(const Params& p, LAS unsigned char* lds) {
    LAS float* tile = (LAS float*)lds;
    unsigned char* ws = p.ws;
    const float* attn_norm = (const float*)p.in[2]; const float* mlp_norm = (const float*)p.in[3];
    int base = 0;
    for (int a = 0; a < 2; ++a) {
        cvt_job((const float*)p.in[4] + (size_t)a * 1024 * 448, 1024, 448, attn_norm + a * 1024, (bf16_t*)(ws + WS_WIN) + (size_t)a * 512 * 1024, 1024, base, tile);
        cvt_job((const float*)p.in[7] + (size_t)a * 256 * 3072, 256, 3072, (const float*)p.in[5] + a * 256, (bf16_t*)(ws + WS_WQB) + (size_t)a * 3072 * 256, 256, base, tile);
        cvt_job((const float*)p.in[8] + (size_t)a * 128 * 4096, 128, 4096, (const float*)p.in[6] + a * 128, (bf16_t*)(ws + WS_WKVB) + (size_t)a * 4096 * 256, 256, base, tile);
        cvt_job((const float*)p.in[11] + (size_t)a * 2048 * 1024, 2048, 1024, nullptr, (bf16_t*)(ws + WS_WO) + (size_t)a * 1024 * 2048, 2048, base, tile);
        cvt_job((const float*)p.in[17] + (size_t)a * 1024 * 1024, 1024, 1024, nullptr, (bf16_t*)(ws + WS_WOB) + (size_t)a * 1024 * 1024, 1024, base, tile);
        zero_fill((bf16_t*)(ws + WS_WIN) + (size_t)a * 512 * 1024 + (size_t)448 * 1024, 64, 128, 1024);
        zero_fill((bf16_t*)(ws + WS_WKVB) + (size_t)a * 4096 * 256 + 128, 4096, 16, 256);
    }
    cvt_job((const float*)p.in[13], 1024, 6144, (const float*)p.in[12], (bf16_t*)(ws + WS_WKVQ), 1024, base, tile);
    cvt_job((const float*)p.in[15], 1024, 3072, attn_norm + 2 * 1024, (bf16_t*)(ws + WS_WKVQ) + (size_t)6144 * 1024, 1024, base, tile);
    cvt_job((const float*)p.in[15] + (size_t)1024 * 3072, 1024, 3072, attn_norm + 3 * 1024, (bf16_t*)(ws + WS_WQ1), 1024, base, tile);
    for (int l = 0; l < 4; ++l) {
        cvt_job((const float*)p.in[18] + (size_t)l * 1024 * 4096, 1024, 4096, mlp_norm + l * 1024, (bf16_t*)(ws + WS_W1) + (size_t)l * 4096 * 1024, 1024, base, tile);
        cvt_job((const float*)p.in[19] + (size_t)l * 4096 * 1024, 4096, 1024, nullptr, (bf16_t*)(ws + WS_W2) + (size_t)l * 1024 * 4096, 4096, base, tile);
    }
    __syncthreads();
}
__device__ void prep_x(const float* __restrict__ x, bf16_t* __restrict__ xb, float* __restrict__ ss) {
    const int tid_ = opaque_tid(), lane = tid_ & 63, gw = opaque_bid() * 8 + (tid_ >> 6), nw = gridDim.x * 8;
    for (int r0 = gw; r0 < TH; r0 += 4 * nw) {
        f32x4 v[4][4];
#pragma unroll
        for (int q = 0; q < 4; ++q) { const int r = r0 + q * nw; if (r < TH) {
#pragma unroll
            for (int i = 0; i < 4; ++i) v[q][i] = *(const f32x4*)(x + (size_t)r * 1024 + i * 256 + lane * 4); } }
#pragma unroll
        for (int q = 0; q < 4; ++q) { const int r = r0 + q * nw; if (r < TH) { bf16_t* br = xb + (size_t)r * 1024; float s_ = 0.f;
#pragma unroll
            for (int i = 0; i < 4; ++i) { const f32x4 w = v[q][i]; s_ += w.x * w.x + w.y * w.y + w.z * w.z + w.w * w.w;
                *(u32x2*)(br + i * 256 + lane * 4) = (u32x2){cvtpk(w.x, w.y), cvtpk(w.z, w.w)}; }
#pragma unroll
            for (int o = 1; o < 64; o <<= 1) s_ += __shfl_xor(s_, o);
            if (lane < 16) ss[(size_t)r * 16 + lane] = lane == 0 ? s_ : 0.f; } }
    }
}

struct EpiBf16S {
    static constexpr bool PERM = true, AFTER_DRAIN = false, INIT_ACC = false;
    bf16_t* O; int ldc; bf16_t* O2; int ldc2; int split; const float* ss; int nsl4; float inv_n; int act; float* ssl; float* ssk; const LAS float* rs; int pm0;
    __device__ __forceinline__ void operator()(const f32x4 (&acc)[2][2][4][2], const pg8::Unit& u, int wr, int wc, int fr, int fq) const {
        const int row0 = u.pm * 256 + wr * 64 + fr; int colt = u.pn * 256; bf16_t* base = O; int ld = ldc;
        if (colt >= split) { base = O2; colt -= split; ld = ldc2; }
        const int col0 = colt + wc * 32 + 8 * fq;
#pragma unroll
        for (int ai = 0; ai < 2; ++ai)
#pragma unroll
            for (int m = 0; m < 4; ++m) { const int row = row0 + ai * 128 + m * 16; float sc = 1.0f;
                if (ss) { if (u.pm == pm0) sc = rs[(wr * 4 + wc) * 128 + ai * 64 + m * 16 + fr];
                    else { const f32x4* sp = (const f32x4*)(ss + (size_t)row * 16); f32x4 a = sp[0]; if (nsl4 == 4) a = (a + sp[1]) + (sp[2] + sp[3]); sc = rsqrtf(((a.x + a.y) + (a.z + a.w)) * inv_n + EPS); } }
                bf16_t* rowp = base + (size_t)row * ld + col0; float sa = 0.f, sb = 0.f;
#pragma unroll
                for (int bj = 0; bj < 2; ++bj) { f32x4 v0 = acc[ai][bj][m][0] * sc, v1 = acc[ai][bj][m][1] * sc;
                    if (act) {
#pragma unroll
                        for (int j = 0; j < 4; ++j) { const float a0 = fmaxf(v0[j], 0.f), a1 = fmaxf(v1[j], 0.f); v0[j] = a0 * a0; v1[j] = a1 * a1; } }
                    const float sq = ((v0[0] * v0[0] + v0[1] * v0[1]) + (v0[2] * v0[2] + v0[3] * v0[3])) + ((v1[0] * v1[0] + v1[1] * v1[1]) + (v1[2] * v1[2] + v1[3] * v1[3]));
                    if (bj == 0) sa = sq; else sb = sq;
                    u32x4 w; w.x = cvtpk(v0[0], v0[1]); w.y = cvtpk(v0[2], v0[3]); w.z = cvtpk(v1[0], v1[1]); w.w = cvtpk(v1[2], v1[3]);
                    *(u32x4*)(rowp + bj * 128) = w; }
                if (ssk) { float sk_ = sa; sk_ += __shfl_xor(sk_, 16); sk_ += __shfl_xor(sk_, 32); if (fq == 0) ssk[((size_t)row * 16 + u.pn) * 4 + wc] = sk_; }
                if (ssl) { sa += __shfl_xor(sa, 16); sa += __shfl_xor(sa, 32); sb += __shfl_xor(sb, 16); sb += __shfl_xor(sb, 32);
                    if (fq == 0) { float* sr_ = ssl + (size_t)row * 16; if (u.pn == 0) sr_[wc] = sa + sb; else { sr_[4 + wc] = sa; sr_[8 + wc] = sb; } } } }
    }
};
struct EpiRes {
    static constexpr bool PERM = false, AFTER_DRAIN = false, INIT_ACC = true;
    const float* xin; float* xout; bf16_t* xb; float* ss;
    __device__ __forceinline__ void init_acc(f32x4 (&acc)[2][2][4][2], const pg8::Unit& u, int wr, int wc, int fr, int fq) const {
        const int row0 = u.pm * 256 + wr * 64 + fr, col0 = u.pn * 256 + wc * 32 + 4 * fq;
#pragma unroll
        for (int ai = 0; ai < 2; ++ai)
#pragma unroll
            for (int m = 0; m < 4; ++m) { const size_t off = (size_t)(row0 + ai * 128 + m * 16) * 1024 + col0;
#pragma unroll
                for (int bj = 0; bj < 2; ++bj)
#pragma unroll
                    for (int n = 0; n < 2; ++n) acc[ai][bj][m][n] = *(const f32x4*)(xin + off + bj * 128 + n * 16); }
    }
    __device__ __forceinline__ void operator()(const f32x4 (&acc)[2][2][4][2], const pg8::Unit& u, int wr, int wc, int fr, int fq) const {
        const int row0 = u.pm * 256 + wr * 64 + fr, col0 = u.pn * 256 + wc * 32 + 4 * fq;
#pragma unroll
        for (int ai = 0; ai < 2; ++ai)
#pragma unroll
            for (int m = 0; m < 4; ++m) { const int row = row0 + ai * 128 + m * 16; const size_t off = (size_t)row * 1024 + col0; float s = 0.f;
#pragma unroll
                for (int bj = 0; bj < 2; ++bj)
#pragma unroll
                    for (int n = 0; n < 2; ++n) { const int c = bj * 128 + n * 16; const f32x4 o = acc[ai][bj][m][n];
                        *(f32x4*)(xout + off + c) = o; s += (o.x * o.x + o.y * o.y) + (o.z * o.z + o.w * o.w);
                        *(u32x2*)(xb + off + c) = (u32x2){cvtpk(o.x, o.y), cvtpk(o.z, o.w)}; }
                s += __shfl_xor(s, 16); s += __shfl_xor(s, 32);
                if (fq == 0) ss[(size_t)row * 16 + u.pn * 4 + wc] = s; }
    }
};
template <class Epi> __device__ __forceinline__ void run_gemm(LAS unsigned char* lds, const bf16_t* A, int lda, const bf16_t* Bt, int N, int K, const Epi& E) {
    pg8::Gemm g{A, Bt, TH, N, K, lda}; pg8::StaticOrder S; S.init(TH, N, (int)gridDim.x, opaque_bid());
    pg8::gemm_phase<Epi, pg8::StaticOrder>(lds, g, S, E);
}
__device__ __forceinline__ void run_gemm_bf16(LAS unsigned char* lds, const bf16_t* A, int lda, const bf16_t* Bt, int N, int K, EpiBf16S E) {
    pg8::Gemm g{A, Bt, TH, N, K, lda}; pg8::StaticOrder S; S.init(TH, N, (int)gridDim.x, opaque_bid());
    E.rs = (const LAS float*)(lds + RS_OFF); E.pm0 = -1;
    pg8::Unit u0;
    if (E.ss && S.next(0, u0)) {
        const int tid = opaque_tid(), wid = tid >> 6, lane = tid & 63, wr = wid >> 2;
        LAS float* tab = (LAS float*)(lds + RS_OFF) + wid * 128;
#pragma unroll
        for (int hh = 0; hh < 2; ++hh) { const int row = u0.pm * 256 + hh * 128 + wr * 64 + lane;
            const f32x4* sp = (const f32x4*)(E.ss + (size_t)row * 16); f32x4 a = sp[0]; if (E.nsl4 == 4) a = (a + sp[1]) + (sp[2] + sp[3]);
            tab[hh * 64 + lane] = rsqrtf(((a.x + a.y) + (a.z + a.w)) * E.inv_n + EPS); }
        E.pm0 = u0.pm;
    }
    pg8::gemm_phase<EpiBf16S, pg8::StaticOrder>(lds, g, S, E);
}

__device__ void lat_prep(bf16_t* lat) {
    const int tid_ = opaque_tid(), lane = tid_ & 63, gw = opaque_bid() * 8 + (tid_ >> 6), nw = gridDim.x * 8;
    for (int t = gw; t < TH; t += nw) {
        bf16_t* p = lat + (size_t)t * 512 + lane * 8; const u32x4 w = *(const u32x4*)p; float v[8]; UNPACK8(w, v);
        float s = 0.f;
#pragma unroll
        for (int e = 0; e < 8; ++e) s += v[e] * v[e];
        s += __shfl_xor(s, 1); s += __shfl_xor(s, 2); s += __shfl_xor(s, 4); s += __shfl_xor(s, 8);
        const float s32 = s + __shfl_xor(s, 16);
        const float rstd = lane < 32 ? rsqrtf(s32 * (1.0f / 256.0f) + EPS) : rsqrtf(s * (1.0f / 128.0f) + EPS);
        if (lane < 48) {
#pragma unroll
            for (int e = 0; e < 8; ++e) v[e] *= rstd;
            *(u32x4*)p = PACK8(v); }
    }
}
__device__ void kpe_prep(const bf16_t* lat, const int* pos, const float* gk, bf16_t* kper) {
    const int tid = opaque_tid(), grp = tid >> 3, l8 = tid & 7;
    float invf[8], g[8];
#pragma unroll
    for (int e = 0; e < 8; ++e) { invf[e] = exp2f(-(float)((l8 & 3) * 8 + e) * (LOG2_THETA / 32.0f)) * 0.15915494309189535f; g[e] = gk[128 + l8 * 8 + e]; }
    for (int t = opaque_bid() * 64 + grp; t < TH; t += (int)gridDim.x * 64) {
        const float posf = (float)pos[t];
        const u32x4 w = *(const u32x4*)(lat + (size_t)t * 512 + 384 + l8 * 8); float v[8]; UNPACK8(w, v);
#pragma unroll
        for (int e = 0; e < 8; ++e) { const float y = v[e] * g[e]; const float pr = __shfl_xor(y, 4); float sn_, cs_; sincos_rev(posf, invf[e], sn_, cs_);
            v[e] = (l8 & 4) ? y * cs_ + pr * sn_ : y * cs_ - pr * sn_; }
        *(u32x4*)(kper + (size_t)t * 64 + l8 * 8) = PACK8(v);
    }
}
__device__ void head_prep(bf16_t* kbuf  , bf16_t* qbuf, const int* pos, const float* gk, const float* gq) {
    const int tid_ = opaque_tid(), lane = tid_ & 63, gw = opaque_bid() * 8 + (tid_ >> 6), nw = gridDim.x * 8;
    const float qscale = 0.08838834764831845f * LOG2E;
    const int c16 = lane & 15;
    float invf[8];
#pragma unroll
    for (int e = 0; e < 8; ++e) invf[e] = exp2f(-(float)((c16 & 7) * 8 + e) * (LOG2_THETA / 64.0f)) * 0.15915494309189535f;
    for (int t = gw; t < TH; t += nw) {
        const float posf = (float)pos[t];
        float cs[8], sn[8];
#pragma unroll
        for (int e = 0; e < 8; ++e) sincos_rev(posf, invf[e], sn[e], cs[e]);
        u32x4 wv[6];
#pragma unroll
        for (int itr = 0; itr < 6; ++itr) wv[itr] = *(const u32x4*)(kbuf + (size_t)t * 6144 + (itr * 4 + (lane >> 4)) * 128 + c16 * 8);
#pragma unroll
        for (int itr = 0; itr < 6; ++itr) { const bool isq = false;
            const int hh = (isq ? itr - 6 : itr) * 4 + (lane >> 4), g = hh >> 3;
            bf16_t* p = isq ? qbuf + (size_t)t * 3072 + hh * 128 + c16 * 8 : kbuf + (size_t)t * 6144 + hh * 128 + c16 * 8;
            const float* gn = (isq ? gq : gk) + g * 128 + c16 * 8;
            float v[8]; UNPACK8(wv[itr], v); float s = 0.f;
#pragma unroll
            for (int e = 0; e < 8; ++e) s += v[e] * v[e];
            s += __shfl_xor(s, 1); s += __shfl_xor(s, 2); s += __shfl_xor(s, 4); s += __shfl_xor(s, 8);
            const float rstd = rsqrtf(s * (1.0f / 128.0f) + EPS), osc = isq ? qscale : 1.0f;
#pragma unroll
            for (int e = 0; e < 8; ++e) { const float y = v[e] * rstd * gn[e]; const float pr = __shfl_xor(y, 8);
                v[e] = ((c16 & 8) ? y * cs[e] + pr * sn[e] : y * cs[e] - pr * sn[e]) * osc; }
            *(u32x4*)p = PACK8(v); }
    }
}

struct AttnItem { const bf16_t* q; const bf16_t* k; const bf16_t* kpe; const bf16_t* v; bf16_t* o; float* lse; const int* pos; const float* gq; const float* gk; const float* ssk; const float* ssl; int q_ld, k_ld, kpe_ld, v_ld, o_ld, P0, ld, merge; };
__device__ __forceinline__ int v_st(int k, int c) { const int kk = (k & ~0xC) | ((k & 4) << 1) | ((k & 8) >> 1); return ((kk >> 3) * 4 + (c >> 5)) * 512 + ((kk & 7) * 32 + (c & 31)) * 2; }
__device__ __forceinline__ int v_rd_base(int lane) { return ((lane & 3) << 3) | (((lane >> 2) & 3) << 6) | (((lane >> 4) & 1) << 5) | (((lane >> 5) & 1) << 8); }
#define PK4(P, B_, OUT) do { unsigned a0_ = cvtpk(P[B_+0], P[B_+1]), a1_ = cvtpk(P[B_+2], P[B_+3]); unsigned b0_ = cvtpk(P[B_+4], P[B_+5]), b1_ = cvtpk(P[B_+6], P[B_+7]); \
        auto r0_ = __builtin_amdgcn_permlane32_swap(a0_, b0_, false, false); auto r1_ = __builtin_amdgcn_permlane32_swap(a1_, b1_, false, false); \
        u32x4 w_ = {r0_[0], r1_[0], r0_[1], r1_[1]}; OUT = w_; } while (0)
__device__ __forceinline__ bf16x8 as_bf(u32x4 w) { return *reinterpret_cast<bf16x8*>(&w); }

template <int DQK, int MODE>
__device__ __forceinline__ void attn_block(const AttnItem& it, LAS unsigned char* lds) {
    constexpr int RS = DQK * 2, SHM_K = 64 * RS, SHM_V = 16384, ND0 = DQK / 16, KCH = DQK / 8, NKC = (64 * KCH) / 512;
    const int tid = opaque_tid(), wid = __builtin_amdgcn_readfirstlane(tid >> 6), lane = tid & 63, r32 = lane & 31, hi = lane >> 5;
    const int ld = it.ld, Lm1 = (2048 >> ld) - 1, lsh = 11 - ld;
#define TOK(p) (MODE == 0 ? (p) : ((((p) & Lm1) << ld) | ((p) >> lsh)))
#define LOF(p) (MODE == 0 ? 0 : max((p) - 128, (p) & ~Lm1))
    const int q0 = it.P0 + wid * 32, qp = q0 + r32;
    const int span = qp - LOF(qp), lo_w = LOF(q0), lo_last = LOF(q0 + 31);
    LAS unsigned char* V_lds = lds; LAS unsigned char* K_lds = lds + 2 * SHM_V;
    const int j_lo = LOF(it.P0) >> 6, NT = (it.P0 >> 6) + 4 - j_lo;
    const int sr = tid >> 4, sc = (tid & 15) * 8, vst0 = v_st(sr, sc), vst1 = v_st(32 + sr, sc);
    constexpr int NSET = (MODE == 1) ? 2 : 1;
    bf16x8 sk[NSET][NKC], sv0[NSET], sv1[NSET]; f32x4 s_k4 = {0.f, 0.f, 0.f, 0.f}, s_p4 = {0.f, 0.f, 0.f, 0.f};
    constexpr int KRS_OFF = 2 * SHM_V + 2 * SHM_K;
    int offk[NKC], offv0 = sr * it.v_ld + sc, offv1 = (32 + sr) * it.v_ld + sc;
#pragma unroll
    for (int i_ = 0; i_ < NKC; ++i_) { const int c_ = tid + 512 * i_, row_ = c_ / KCH, cc_ = c_ - row_ * KCH; offk[i_] = (DQK == 192 && cc_ >= 16) ? row_ * it.kpe_ld + (cc_ - 16) * 8 : row_ * it.k_ld + cc_ * 8; }
#define SLOAD(S_, kb_) do { if (MODE == 0) { const bf16_t* kt_ = it.k + (size_t)(kb_) * it.k_ld; const bf16_t* pt_ = it.kpe + (size_t)(kb_) * it.kpe_ld; const bf16_t* vt_ = it.v + (size_t)(kb_) * it.v_ld; \
            _Pragma("unroll") for (int i_ = 0; i_ < NKC; ++i_) { const int c_ = tid + 512 * i_, row_ = c_ / KCH, cc_ = c_ - row_ * KCH; sk[S_][i_] = *(const bf16x8*)(((DQK == 192 && cc_ >= 16) ? pt_ : kt_) + offk[i_]); } \
            sv0[S_] = *(const bf16x8*)(vt_ + offv0); sv1[S_] = *(const bf16x8*)(vt_ + offv1); \
            if (tid < 64) { s_k4 = *(const f32x4*)(it.ssk + (size_t)((kb_) + tid) * 64); s_p4 = *(const f32x4*)(it.ssl + (size_t)((kb_) + tid) * 16); } } else { \
        _Pragma("unroll") for (int i_ = 0; i_ < NKC; ++i_) { const int c_ = tid + 512 * i_, row_ = c_ / KCH, cc_ = c_ - row_ * KCH; const int tk_ = TOK((kb_) + row_); \
            sk[S_][i_] = *(const bf16x8*)(it.k + (size_t)tk_ * it.k_ld + cc_ * 8); } \
        { const int t0_ = TOK((kb_) + sr), t1_ = TOK((kb_) + 32 + sr); sv0[S_] = *(const bf16x8*)(it.v + (size_t)t0_ * it.v_ld + sc); sv1[S_] = *(const bf16x8*)(it.v + (size_t)t1_ * it.v_ld + sc); } } } while (0)
#define SWRITE(S_, bf_) do { _Pragma("unroll") for (int i_ = 0; i_ < NKC; ++i_) { const int c_ = tid + 512 * i_, row_ = c_ / KCH, cc_ = c_ - row_ * KCH; const int swz_ = (((DQK == 128) ? row_ : (row_ >> 1)) & 7) << 4; \
            *(LAS bf16x8*)(K_lds + (bf_) * SHM_K + row_ * RS + ((cc_ * 16) ^ swz_)) = sk[S_][i_]; } \
        *(LAS bf16x8*)(V_lds + (bf_) * SHM_V + vst0) = sv0[S_]; *(LAS bf16x8*)(V_lds + (bf_) * SHM_V + vst1) = sv1[S_]; \
        if (MODE == 0 && tid < 64) { const f32x4 a_ = s_k4 + s_p4; *(LAS float*)(lds + KRS_OFF + (bf_) * 256 + tid * 4) = rsqrtf(((a_.x + a_.y) + (a_.z + a_.w)) * (1.0f / 192.0f) + EPS); } } while (0)
    float m_reg = -1e30f, l_reg = 0.f; f32x16 o[4];
#pragma unroll
    for (int d = 0; d < 4; ++d)
#pragma unroll
        for (int r = 0; r < 16; ++r) o[d][r] = 0.f;
    SLOAD(0, j_lo * 64); if (MODE == 1) SLOAD(NSET - 1, j_lo * 64 + 64);
    bf16x8 qr[ND0];
    {
      constexpr int NR = (MODE == 0) ? 2 : 4;
      constexpr int R0 = (MODE == 0) ? 8 : 0;
      constexpr float QS = ((MODE == 0) ? 0.07216878364870322f : 0.08838834764831845f) * LOG2E;
      constexpr float FSTEP = LOG2_THETA / ((MODE == 0) ? 32.0f : 64.0f);
      const int tq_ = TOK(qp);
      const bf16_t* qrow = it.q + (size_t)tq_ * it.q_ld + hi * 8;
      u32x4 raw[ND0]; float ssq = 0.f;
#pragma unroll
      for (int d0 = 0; d0 < ND0; ++d0) raw[d0] = *(const u32x4*)(qrow + d0 * 16);
      const float posf = (float)it.pos[tq_];
#pragma unroll
      for (int d0 = 0; d0 < ND0; ++d0) { float v[8]; UNPACK8(raw[d0], v);
#pragma unroll
          for (int e = 0; e < 8; ++e) ssq += v[e] * v[e]; }
      { auto rr = __builtin_amdgcn_permlane32_swap(__float_as_uint(ssq), __float_as_uint(ssq), false, false); ssq = __uint_as_float(rr[0]) + __uint_as_float(rr[1]); }
      const float rq = rsqrtf(ssq * (1.0f / (float)DQK) + EPS) * QS;
      const float* gp = it.gq + hi * 8;
#pragma unroll
      for (int d0 = 0; d0 < ND0; ++d0) {
          if (d0 >= R0 + NR && d0 < R0 + 2 * NR) continue;
          f32x4 g0 = *(const f32x4*)(gp + d0 * 16), g1 = *(const f32x4*)(gp + d0 * 16 + 4);
          if (MODE == 0 && d0 < 8) { g0 *= *(const f32x4*)(it.gk + hi * 8 + d0 * 16); g1 *= *(const f32x4*)(it.gk + hi * 8 + d0 * 16 + 4); }
          float v[8]; UNPACK8(raw[d0], v);
#pragma unroll
          for (int e = 0; e < 8; ++e) v[e] *= rq * (e < 4 ? g0[e & 3] : g1[e & 3]);
          if (d0 >= R0 && d0 < R0 + NR) {
              const f32x4 h0 = *(const f32x4*)(gp + (d0 + NR) * 16), h1 = *(const f32x4*)(gp + (d0 + NR) * 16 + 4);
              float w[8]; UNPACK8(raw[d0 + NR], w);
#pragma unroll
              for (int e = 0; e < 8; ++e) { w[e] *= rq * (e < 4 ? h0[e & 3] : h1[e & 3]);
                  float sn_, cs_; sincos_rev(posf, exp2f(-(float)((d0 - R0) * 16 + hi * 8 + e) * FSTEP) * 0.15915494309189535f, sn_, cs_);
                  const float x1 = v[e], x2 = w[e]; v[e] = x1 * cs_ - x2 * sn_; w[e] = x2 * cs_ + x1 * sn_; }
              qr[d0 + NR] = as_bf(PACK8(w)); }
          qr[d0] = as_bf(PACK8(v)); } }
    SWRITE(0, 0); __syncthreads();
    const int swzr = (((DQK == 128) ? r32 : (r32 >> 1)) & 7) << 4;
    int kro[4];
#pragma unroll
    for (int dd = 0; dd < 4; ++dd) kro[dd] = r32 * RS + ((dd * 32 + hi * 16) ^ swzr);
#pragma unroll 1
    for (int t2 = 0; t2 < NT; t2 += NSET) {
#pragma unroll
      for (int us = 0; us < NSET; ++us) { const int t = t2 + us; if (t < NT) {
        const int kb = (j_lo + t) * 64, buf = t & 1;
        if (MODE == 1) { if (t + 2 < NT) SLOAD(us, kb + 128); } else { if (t + 1 < NT) SLOAD(0, kb + 64); }
#pragma unroll 1
        for (int hf = 0; hf < 2; ++hf) {
            const int kh = kb + 32 * hf;
            const bool act = (kh <= q0 + 31) && (kh + 31 >= lo_w);
            if (act) {
                f32x16 p0;
#pragma unroll
                for (int r = 0; r < 16; ++r) p0[r] = 0.f;
                { const LAS unsigned char* kbp = K_lds + buf * SHM_K + hf * (32 * RS);
#pragma unroll
                  for (int d0 = 0; d0 < ND0; ++d0) {
                      const bf16x8 b0 = *(const LAS bf16x8*)(kbp + kro[d0 & 3] + (d0 >> 2) * 128);
                      p0 = __builtin_amdgcn_mfma_f32_32x32x16_bf16(b0, qr[d0], p0, 0, 0, 0); } }
                if (MODE == 0) { const LAS float* kr_ = (const LAS float*)(lds + KRS_OFF + buf * 256) + 32 * hf + 4 * hi;
#pragma unroll
                    for (int j4 = 0; j4 < 4; ++j4) { const f32x4 s4 = *(const LAS f32x4*)(kr_ + 8 * j4);
#pragma unroll
                        for (int e = 0; e < 4; ++e) p0[4 * j4 + e] *= s4[e]; } }
                if (!((kh + 31 <= q0) && (kh >= lo_last))) {
                    const int dq = qp - kh - 4 * hi; const float NEG = -__builtin_inff();
#pragma unroll
                    for (int r = 0; r < 16; ++r) { const int c = (r & 3) + 8 * (r >> 2); if ((unsigned)(dq - c) > (unsigned)span) p0[r] = NEG; } }
                float pmax = p0[0];
#pragma unroll
                for (int r = 1; r < 16; ++r) pmax = fmaxf(pmax, p0[r]);
                { auto rr = __builtin_amdgcn_permlane32_swap(__float_as_uint(pmax), __float_as_uint(pmax), false, false); pmax = fmaxf(__uint_as_float(rr[0]), __uint_as_float(rr[1])); }
                const float mn = fmaxf(m_reg, pmax), alpha = __builtin_amdgcn_exp2f(m_reg - mn); m_reg = mn;
                float ps = 0.f;
#pragma unroll
                for (int r = 0; r < 16; ++r) { p0[r] = __builtin_amdgcn_exp2f(p0[r] - mn); ps += p0[r]; }
                { auto rr = __builtin_amdgcn_permlane32_swap(__float_as_uint(ps), __float_as_uint(ps), false, false); ps = __uint_as_float(rr[0]) + __uint_as_float(rr[1]); }
                l_reg = l_reg * alpha + ps;
                u32x4 pa0, pa1; PK4(p0, 0, pa0); PK4(p0, 8, pa1);
                if (__any(alpha != 1.0f)) {
#pragma unroll
                    for (int d = 0; d < 4; ++d)
#pragma unroll
                        for (int r = 0; r < 16; ++r) o[d][r] *= alpha; }
                const unsigned vb = (unsigned)(uintptr_t)(V_lds + buf * SHM_V + hf * 8192) + (unsigned)v_rd_base(lane);
#define TRRD(dst, off) asm volatile("ds_read_b64_tr_b16 %0, %1 offset:%2" : "=&v"(dst) : "v"(vb), "i"(off) : "memory")
#define PV_D0(d0) do { s16x4 l0, l1, h0, h1; constexpr int b_ = (d0) * 512; \
                TRRD(l0, b_); TRRD(h0, b_ + 2048); TRRD(l1, b_ + 4096); TRRD(h1, b_ + 6144); \
                asm volatile("s_waitcnt lgkmcnt(0)" ::: "memory"); __builtin_amdgcn_sched_barrier(0); \
                o[d0] = __builtin_amdgcn_mfma_f32_32x32x16_bf16((bf16x8){l0[0], l0[1], l0[2], l0[3], h0[0], h0[1], h0[2], h0[3]}, as_bf(pa0), o[d0], 0, 0, 0); \
                o[d0] = __builtin_amdgcn_mfma_f32_32x32x16_bf16((bf16x8){l1[0], l1[1], l1[2], l1[3], h1[0], h1[1], h1[2], h1[3]}, as_bf(pa1), o[d0], 0, 0, 0); } while (0)
                PV_D0(0); PV_D0(1); PV_D0(2); PV_D0(3);
#undef PV_D0
#undef TRRD
            }
        }
        if (t + 1 < NT) SWRITE((NSET - 1) - us, buf ^ 1);
        __syncthreads();
      } }
    }
    const int tq = TOK(qp);
    float a_cur = 1.0f / l_reg, a_prev = 0.f;
    if (MODE == 1) {
        const float lse_cur = m_reg + __builtin_amdgcn_logf(l_reg); float lse_new = lse_cur;
        if (it.merge) { const float lse_prev = it.lse[(size_t)tq * 8]; const float mx = fmaxf(lse_prev, lse_cur);
            const float e0 = __builtin_amdgcn_exp2f(lse_prev - mx), e1 = __builtin_amdgcn_exp2f(lse_cur - mx); const float inv = 1.0f / (e0 + e1);
            lse_new = mx + __builtin_amdgcn_logf(e0 + e1); a_prev = e0 * inv; a_cur *= e1 * inv; }
        if (hi == 0) it.lse[(size_t)tq * 8] = lse_new;
    }
    bf16_t* orow = it.o + (size_t)tq * it.o_ld + hi * 8;
#pragma unroll
    for (int d0 = 0; d0 < 4; ++d0) {
#pragma unroll
        for (int r = 0; r < 16; ++r) o[d0][r] *= a_cur;
        u32x4 w0, w1; PK4(o[d0], 0, w0); PK4(o[d0], 8, w1);
        if (MODE == 1 && it.merge) {
            const u32x4 q0w = *(const u32x4*)(orow + d0 * 32), q1w = *(const u32x4*)(orow + d0 * 32 + 16);
            float a[8], b[8];
            UNPACK8(w0, a); UNPACK8(q0w, b);
#pragma unroll
            for (int e = 0; e < 8; ++e) a[e] += b[e] * a_prev;
            w0 = PACK8(a);
            UNPACK8(w1, a); UNPACK8(q1w, b);
#pragma unroll
            for (int e = 0; e < 8; ++e) a[e] += b[e] * a_prev;
            w1 = PACK8(a);
        }
        *(u32x4*)(orow + d0 * 32) = w0; *(u32x4*)(orow + d0 * 32 + 16) = w1;
    }
#undef SLOAD
#undef SWRITE
#undef TOK
#undef LOF
}

__device__ void mla_attn_phase(const Params& p, LAS unsigned char* lds, const int* pos, const float* gq, const float* gk) {
    unsigned char* ws = p.ws;
    const int G_ = (int)gridDim.x, bid_ = opaque_bid(), vb_ = (G_ % 8 == 0) ? (bid_ % 8) * (G_ / 8) + bid_ / 8 : bid_;
    for (int item = vb_; item < BH * 16 * 4; item += G_) {
        const int bh = item >> 2, pr = item & 3, b = bh >> 4, h = bh & 15; const size_t tb = (size_t)b * SEQ;
        AttnItem it; it.q = (const bf16_t*)(ws + WS_Q) + tb * 3072 + h * 192; it.q_ld = 3072;
        it.k = (const bf16_t*)(ws + WS_KV) + tb * 4096 + h * 256; it.k_ld = 4096; it.kpe = (const bf16_t*)(ws + WS_KPER) + tb * 64; it.kpe_ld = 64; it.gk = gk; it.ssk = (const float*)(ws + WS_SSK) + (tb * 16 + h) * 4; it.ssl = (const float*)(ws + WS_SSL) + tb * 16 + 8;
        it.v = (const bf16_t*)(ws + WS_KV) + tb * 4096 + h * 256 + 128; it.v_ld = 4096; it.o = (bf16_t*)(ws + WS_AO) + tb * 2048 + h * 128; it.o_ld = 2048;
        it.lse = nullptr; it.ld = 0; it.merge = 0; it.pos = pos + tb; it.gq = gq;
#pragma unroll 1
        for (int k2 = 0; k2 < 2; ++k2) { it.P0 = (k2 == 0 ? 7 - pr : pr) * 256; attn_block<192, 0>(it, lds); }
    }
}
__device__ void dil_attn_phase(const Params& p, LAS unsigned char* lds, int g, const int* pos, const float* gq) {
    unsigned char* ws = p.ws;
    const int G_ = (int)gridDim.x, bid_ = opaque_bid(), vb_ = (G_ % 8 == 0) ? (bid_ % 8) * (G_ / 8) + bid_ / 8 : bid_;
    for (int item = vb_; item < BH * 8 * 8; item += G_) {
        const int bh = item >> 3, qb = item & 7, b = bh >> 3, h = bh & 7, hh = g * 8 + h; const size_t tb = (size_t)b * SEQ;
        AttnItem it; it.q = (const bf16_t*)(ws + WS_QB) + tb * 3072 + hh * 128; it.q_ld = 3072;
        it.k = (const bf16_t*)(ws + WS_KVB) + tb * 6144 + hh * 128; it.k_ld = 6144; it.kpe = nullptr; it.kpe_ld = 0; it.gk = nullptr; it.ssk = nullptr; it.ssl = nullptr;
        it.v = (const bf16_t*)(ws + WS_KVB) + tb * 6144 + 3072 + hh * 128; it.v_ld = 6144; it.o = (bf16_t*)(ws + WS_OB) + tb * 1024 + h * 128; it.o_ld = 1024;
        it.lse = (float*)(ws + WS_LSE) + tb * 8 + h; it.ld = 2 * g; it.merge = g > 0; it.P0 = qb * 256; it.pos = pos + tb; it.gq = gq + g * 128;
        attn_block<128, 1>(it, lds);
    }
}

#define XB_TMO      128
#define XB_XCNT(j)  (256  + 64 * (j))
#define XB_XSUB(j)  (1280 + 64 * (j))
#define XB_XGEN(j)  (2304 + 64 * (j))
#define XB_TOP      3328
#define XB_TOPGEN   3392
#define XCD_BAR_WORDS 3456
#define XB_SPIN_CAP (1u << 18)

__device__ __forceinline__ unsigned xb_ld(unsigned* p)              { return __hip_atomic_load(p, __ATOMIC_RELAXED, __HIP_MEMORY_SCOPE_AGENT); }
__device__ __forceinline__ unsigned xb_add(unsigned* p, unsigned v) { return __hip_atomic_fetch_add(p, v, __ATOMIC_RELAXED, __HIP_MEMORY_SCOPE_AGENT); }
__device__ __forceinline__ unsigned xb_xcc_id() { return (unsigned)__builtin_amdgcn_s_getreg((3 << 11) | 20) & 0xFu; }
#define XB_SPIN(cond, bar) do { unsigned _sp = 0; while (cond) { __builtin_amdgcn_s_sleep(1); \
    if ((++_sp & 255u) == 0u) { if (xb_ld(&(bar)[XB_TMO])) break; if (_sp > XB_SPIN_CAP) { atomicAdd(&(bar)[XB_TMO], 1u); break; } } } } while (0)

struct XcdBarrier {
    unsigned* bar; unsigned x;
    volatile LAS unsigned* st;
};

__device__ __forceinline__ XcdBarrier xcd_barrier_post(unsigned* bar, volatile LAS unsigned* st) {
    XcdBarrier b; b.bar = bar; b.x = xb_xcc_id(); b.st = st;
    if (threadIdx.x == 0) (void)xb_add(&bar[XB_XCNT(b.x)], 1u);
    return b;
}
__device__ __forceinline__ void xcd_barrier_complete(unsigned* bar, unsigned x, unsigned& nloc, unsigned& nx) {
    const unsigned G = gridDim.x * gridDim.y * gridDim.z;
    unsigned sum, cnt, mine, sp = 0u;
    for (;;) {
        sum = 0u; cnt = 0u; mine = 0u;
#pragma unroll
        for (unsigned j = 0; j < 16; ++j) { const unsigned c = xb_ld(&bar[XB_XCNT(j)]); sum += c; cnt += (c > 0u) ? 1u : 0u; mine = (j == x) ? c : mine; }
        if (sum == G) break;
        __builtin_amdgcn_s_sleep(1);
        if ((++sp & 255u) == 0u) { if (xb_ld(&bar[XB_TMO])) break; if (sp > XB_SPIN_CAP) { atomicAdd(&bar[XB_TMO], 1u); break; } }
    }
    nloc = mine > 0u ? mine : 1u; nx = cnt > 0u ? cnt : 1u;
}

__device__ __forceinline__ void xcd_barrier(const XcdBarrier& b) {
    asm volatile("s_waitcnt vmcnt(0)" ::: "memory");
    __syncthreads();
    if (threadIdx.x == 0) {
        unsigned* bar = b.bar;
        __builtin_amdgcn_s_waitcnt(0);
        unsigned nloc = b.st[0], nx = b.st[1];
        if (nloc == 0u) { xcd_barrier_complete(bar, b.x, nloc, nx); b.st[0] = nloc; b.st[1] = nx; }
        const unsigned old = xb_add(&bar[XB_XSUB(b.x)], 1u);
        const unsigned gen = old / nloc;
        if (old + 1u == (gen + 1u) * nloc) {
            __builtin_amdgcn_fence(__ATOMIC_RELEASE, "agent");
            asm volatile("s_waitcnt vmcnt(0)" ::: "memory");
            const unsigned og = xb_add(&bar[XB_TOP], 1u);
            const unsigned tg = og / nx;
            if (og + 1u == (tg + 1u) * nx) xb_add(&bar[XB_TOPGEN], 1u);
            else XB_SPIN(xb_ld(&bar[XB_TOPGEN]) == tg, bar);
            __builtin_amdgcn_fence(__ATOMIC_ACQUIRE, "agent");
            xb_add(&bar[XB_XGEN(b.x)], 1u);
            asm volatile("s_waitcnt vmcnt(0)" ::: "memory");
        } else {
            XB_SPIN(xb_ld(&bar[XB_XGEN(b.x)]) == gen, bar);
            __builtin_amdgcn_fence(__ATOMIC_ACQUIRE, "agent");
            asm volatile("s_waitcnt vmcnt(0)" ::: "memory");
        }
    }
    __syncthreads();
}

constexpr int NPH_HALF = 1 + 2 * 6 + 8 + 7;
#ifndef SKIP_MASK
#define SKIP_MASK 0
#endif
__global__ void __launch_bounds__(NTHR) mega(Params p) {
    extern __shared__ __attribute__((aligned(16))) unsigned char lds_raw[];
    LAS unsigned char* lds = (LAS unsigned char*)lds_raw;
    cg::grid_group grid = cg::this_grid();
    unsigned char* ws = p.ws;
    bf16_t* XB = (bf16_t*)(ws + WS_XB); float* SS = (float*)(ws + WS_SS); bf16_t* HB = (bf16_t*)(ws + WS_H);
    bf16_t* LAT = (bf16_t*)(ws + WS_LAT); bf16_t* Q = (bf16_t*)(ws + WS_Q); bf16_t* KV = (bf16_t*)(ws + WS_KV); bf16_t* KPE = (bf16_t*)(ws + WS_KPE); bf16_t* AO = (bf16_t*)(ws + WS_AO);
    bf16_t* KVB = (bf16_t*)(ws + WS_KVB); bf16_t* QB = (bf16_t*)(ws + WS_QB); bf16_t* OB = (bf16_t*)(ws + WS_OB);
#ifndef PROBE_MASK
#define PROBE_MASK 0
#endif
    unsigned long long probe_acc = 0ull;
    volatile LAS unsigned* bar_st = (volatile LAS unsigned*)(lds + 131072);
    if (threadIdx.x < 4) bar_st[threadIdx.x] = 0u;
    __syncthreads();
    XcdBarrier xbar = xcd_barrier_post((unsigned*)(ws + WS_BAR), bar_st);
#pragma unroll 1
    for (int ph = p.ph_lo; ph < p.ph_hi; ++ph) {
        const unsigned long long probe_t0 = PROBE_MASK ? __builtin_amdgcn_s_memrealtime() : 0ull;
        const int hb = ph >= NPH_HALF ? 1 : 0, li = hb ? ph - NPH_HALF + 1 : ph;
        const size_t toff = (size_t)hb * TH;
        const float* xin0 = (const float*)p.in[0] + toff * DM; float* xo = p.out + toff * DM; const int* pos = (const int*)p.in[1] + toff;
        int lyr = 0, j = -1;
        if (li >= 21) { lyr = 3; const int jm = li - 21; j = jm == 0 ? 0 : jm + 1; }
        else if (li >= 13) { lyr = 2; j = li - 13; }
        else if (li >= 1) { lyr = (li - 1) / 6; const int jm = (li - 1) - lyr * 6; j = jm == 0 ? 0 : jm == 1 ? 2 : jm + 2; }
        const bool mla = lyr < 2; const int ab = lyr & 1;
        int gk = 0;
        const bf16_t* A = nullptr; const bf16_t* Bt = nullptr; int lda = 0, N = 0, K = 0, nsub = 1;
        EpiBf16S E1{nullptr, 0, nullptr, 0, 1 << 30, nullptr, 4, 1.0f / 1024.0f, 0, nullptr, nullptr, nullptr, -1}; EpiRes E2{nullptr, nullptr, XB, SS};
        float* SSL = (float*)(ws + WS_SSL);
        if (li > 0) {
            if (j == 6) { gk = 1; A = XB; lda = 1024; Bt = (const bf16_t*)(ws + WS_W1) + (size_t)lyr * 4096 * 1024; N = 4096; K = 1024; E1.O = HB; E1.ldc = 4096; E1.ss = SS; E1.act = 1; }
            else if (j == 7) { gk = 2; A = HB; lda = 4096; Bt = (const bf16_t*)(ws + WS_W2) + (size_t)lyr * 1024 * 4096; N = 1024; K = 4096; E2.xin = xo; E2.xout = xo; }
            else if (j == 5) { gk = 2; N = 1024; E2.xin = lyr == 0 ? xin0 : xo; E2.xout = xo;
                if (mla) { A = AO; lda = 2048; K = 2048; Bt = (const bf16_t*)(ws + WS_WO) + (size_t)ab * 1024 * 2048; }
                else { A = OB; lda = 1024; K = 1024; Bt = (const bf16_t*)(ws + WS_WOB) + (size_t)ab * 1024 * 1024; } }
            else if (j == 0) { gk = 1; A = XB; lda = 1024; K = 1024; E1.ss = SS;
                if (hb == 1 && lyr == 0) { A = (const bf16_t*)(p.out + (size_t)TH * DM); E1.ss = (const float*)(p.out + (size_t)TH * DM) + 8 * MiB; }
                if (mla) { Bt = (const bf16_t*)(ws + WS_WIN) + (size_t)ab * 512 * 1024; N = 512; E1.O = LAT; E1.ldc = 512; E1.ssl = SSL; }
                else if (ab == 0) { Bt = (const bf16_t*)(ws + WS_WKVQ); N = 9216; E1.O = KVB; E1.ldc = 6144; E1.O2 = QB; E1.ldc2 = 3072; E1.split = 6144; }
                else { Bt = (const bf16_t*)(ws + WS_WQ1); N = 3072; E1.O = QB; E1.ldc = 3072; } }
            else if (j == 2 && mla) { gk = 1; nsub = 2; A = LAT; lda = 512; K = 256; Bt = (const bf16_t*)(ws + WS_WQB) + (size_t)ab * 3072 * 256; N = 3072; E1.O = Q; E1.ldc = 3072; E1.ss = SSL; E1.nsl4 = 1; E1.inv_n = 1.0f / 256.0f; }
        }
        if (!(SKIP_MASK & 1) && gk == 1) {
            if (nsub == 2) kpe_prep(LAT, pos, (const float*)p.in[10] + ab * 192, (bf16_t*)(ws + WS_KPER));
#pragma unroll 1
            for (int sub = 0; sub < nsub; ++sub) {
                if (sub == 1) { A = LAT + 256; Bt = (const bf16_t*)(ws + WS_WKVB) + (size_t)ab * 4096 * 256; N = 4096; E1.O = KV; E1.ldc = 4096; E1.ss = SSL + 4; E1.inv_n = 1.0f / 128.0f; E1.ssk = (float*)(ws + WS_SSK); }
                run_gemm_bf16(lds, A, lda, Bt, N, K, E1);
            }
        } else if (!(SKIP_MASK & 2) && gk == 2) {
            run_gemm(lds, A, lda, Bt, N, K, E2);
        } else if (li == 0) {
            if (!(SKIP_MASK & 4)) { prep_weights(p, lds); prep_x(xin0, XB, SS);
                prep_x((const float*)p.in[0] + (size_t)TH * DM, (bf16_t*)(p.out + (size_t)TH * DM), p.out + (size_t)TH * DM + 8 * MiB); }
        } else if (mla) {
            if (j == 4) { if (!(SKIP_MASK & 32)) mla_attn_phase(p, lds, pos, (const float*)p.in[9] + ab * 192, (const float*)p.in[10] + ab * 192); }
        } else {
            if (j == 1) { if (!(SKIP_MASK & 64)) head_prep(ab == 0 ? KVB : nullptr, QB, pos, (const float*)p.in[14], (const float*)p.in[16] + ab * 384); }
            else if (j >= 2 && j <= 4) { if (!(SKIP_MASK & 128)) dil_attn_phase(p, lds, j - 2, pos, (const float*)p.in[16] + ab * 384); }
        }
        if (ph + 1 < p.ph_hi) { if (p.ph_hi > 4096) grid.sync(); else xcd_barrier(xbar); }
        if (PROBE_MASK) { const int cat = gk == 1 ? 1 : gk == 2 ? 2 : li == 0 ? 3 : mla ? (j == 1 ? 4 : j == 3 ? 5 : 6) : (j == 1 ? 7 : 8);
            if ((PROBE_MASK >> cat) & 1) probe_acc += __builtin_amdgcn_s_memrealtime() - probe_t0; }
    }
    if (PROBE_MASK && blockIdx.x == 0) { const unsigned long long t1 = __builtin_amdgcn_s_memrealtime(); while (__builtin_amdgcn_s_memrealtime() - t1 < probe_acc) __builtin_amdgcn_s_sleep(16); }
}
constexpr int N_PHASES = 2 * NPH_HALF - 1;

extern "C" void kernel_launch(void* const* d_in, const int* in_sizes, int n_in, void* d_out, int out_size, void* d_ws, size_t ws_size, hipStream_t stream) {
    static int grid_blocks = 0;
    if (!grid_blocks) {
        int dev = 0, cus = 0, per_cu = 0;
        (void)hipGetDevice(&dev);
        (void)hipDeviceGetAttribute(&cus, hipDeviceAttributeMultiprocessorCount, dev);
        (void)hipFuncSetAttribute((const void*)mega, hipFuncAttributeMaxDynamicSharedMemorySize, LDS_BYTES);
        (void)hipOccupancyMaxActiveBlocksPerMultiprocessor(&per_cu, (const void*)mega, NTHR, LDS_BYTES);
        (void)hipGetLastError();
        grid_blocks = cus > 0 ? cus : 256;
        if (ws_size < WS_END || n_in != 20) { fprintf(stderr, "kernel_launch: workspace %zu < %zu or n_in %d != 20\n", ws_size, (size_t)WS_END, n_in); }
    }
    (void)hipMemsetAsync((unsigned char*)d_ws + WS_BAR, 0, XCD_BAR_WORDS * sizeof(unsigned), stream);
    Params p{};
    for (int i = 0; i < 20; ++i) p.in[i] = d_in[i];
    p.out = (float*)d_out; p.ws = (unsigned char*)d_ws;
#if ONE_LAUNCH
    p.ph_lo = 0; p.ph_hi = N_PHASES;
    void* args[] = {&p};
    hipError_t e = hipLaunchCooperativeKernel((const void*)mega, dim3(grid_blocks), dim3(NTHR), args, LDS_BYTES, stream);
    if (e != hipSuccess) fprintf(stderr, "cooperative launch failed: %s (grid %d)\n", hipGetErrorString(e), grid_blocks);
#else
    for (int ph = 0; ph < N_PHASES; ++ph) { p.ph_lo = ph; p.ph_hi = ph + 1; hipLaunchKernelGGL(mega, dim3(grid_blocks), dim3(NTHR), LDS_BYTES, stream, p); }
#endif
}
```

```cpp
#include <hip/hip_runtime.h>
#include <hip/hip_cooperative_groups.h>
#include <cstdio>
#include <cstdint>
namespace cg = cooperative_groups;

#ifndef ONE_LAUNCH
#define ONE_LAUNCH 1
#endif

__device__ __forceinline__ int opaque_tid() { int t = (int)threadIdx.x; asm volatile("" : "+v"(t)); return t; }
__device__ __forceinline__ int opaque_bid() { int b = (int)blockIdx.x; asm volatile("" : "+s"(b)); return b; }
namespace pg8 {
#define PG8_LAS __attribute__((address_space(3)))
typedef unsigned short bf16_t;
typedef short bf16x8 __attribute__((ext_vector_type(8)));
typedef float f32x4 __attribute__((ext_vector_type(4)));
typedef unsigned u32x4 __attribute__((ext_vector_type(4)));
constexpr int BM = 256, BK = 64, HALF = 128, HTB = HALF * BK * 2  , STAGE_BYTES = 8 * HTB, NXCD = 8, WGM = 8;

__host__ __device__ __forceinline__ int lds_byte(int r, int c) { const int st = (r >> 4) * 2 + (c >> 5), rr = r & 15, cc = c & 31, ob = rr * 64 + cc * 2; return st * 1024 + (ob ^ (((ob >> 9) & 1) << 5)); }
__host__ __device__ __forceinline__ void stage_rc(int b, int& R, int& C) { const int st = b / 1024, sb = b % 1024, swz = sb ^ (((sb >> 9) & 1) << 5); R = (st >> 1) * 16 + swz / 64; C = (st & 1) * 32 + (swz % 64) / 2; }
__host__ __device__ __forceinline__ int perm32(int rho) { const int n = rho >> 4, i = rho & 15; return 8 * (i >> 2) + 4 * n + (i & 3); }
struct Unit { int pm, pn; };
struct Gemm { const bf16_t* A; const bf16_t* Bt; int M, N, K, lda; };
struct StaticOrder {
    int nM, nN, nwg, G, c;
    __host__ __device__ void init(int M, int N, int G_, int c_) { nM = M / BM; nN = N / BM; nwg = nM * nN; G = G_; c = c_; }
    __host__ __device__ bool next(int i, Unit& u) const {
        const long L = (long)i * G + c; if (L >= nwg) return false;
        int wgid = (int)L; { const int q = nwg / NXCD, r = nwg % NXCD, xcd = wgid % NXCD, off = wgid / NXCD; wgid = (xcd < r ? xcd * (q + 1) : r * (q + 1) + (xcd - r) * q) + off; }
        const int nig = WGM * nN, gid = wgid / nig, fm = gid * WGM, gsz = (nM - fm) < WGM ? (nM - fm) : WGM;
        u.pm = fm + ((wgid % nig) % gsz); u.pn = (wgid % nig) / gsz; return true;
    }
    __device__ __forceinline__ void a_ready(const Unit&) const {}
    __device__ __forceinline__ void done(const Unit&) const {}
};
__device__ __forceinline__ unsigned cvt_pk_bf16(float lo, float hi) { unsigned r; asm volatile("v_cvt_pk_bf16_f32 %0, %1, %2" : "=v"(r) : "v"(lo), "v"(hi)); return r; }
template <class Epi, class Sched>
__device__ __forceinline__ void gemm_phase(PG8_LAS unsigned char* lds, const Gemm g, const Sched& S, const Epi& E) {
    const int tid = opaque_tid(), wid = __builtin_amdgcn_readfirstlane(tid >> 6), lane = tid & 63, wr = wid >> 2, wc = wid & 3, fr = lane & 15, fq = lane >> 4;
    const int K = g.K, nt = K / BK;
    unsigned voffA[2], voffB[2];
#pragma unroll
    for (int i = 0; i < 2; ++i) { int R, C; stage_rc(tid * 16 + i * 8192, R, C); const int Rb = Epi::PERM ? ((R & ~31) + perm32(R & 31)) : R;
        voffA[i] = (unsigned)(R * g.lda + C) * 2u; voffB[i] = (unsigned)(Rb * K + C) * 2u; }
    const size_t kstep = (size_t)(BK * 2);
    const size_t hstep = (size_t)HALF * K * 2, hstepA = (size_t)HALF * g.lda * 2;
    const size_t tstep = 2 * hstep, tstepA = 2 * hstepA;
    const unsigned ldsw = (unsigned)wid * 1024u;
    const int aoff = lds_byte(wr * 64 + fr, fq * 8), boff = lds_byte(wc * 32 + fr, fq * 8);
#define PG8_SA(b, h) (((b) * 2 + (h)) * HTB)
#define PG8_SB(b, h) ((4 + (b) * 2 + (h)) * HTB)
#define PG8_STAGE(bufoff, gbase, voff) do { _Pragma("unroll") for (int _i = 0; _i < 2; ++_i) \
        __builtin_amdgcn_global_load_lds((const unsigned*)((const char*)(gbase) + (voff)[_i]), (PG8_LAS unsigned*)(lds + (bufoff) + ldsw + _i * 8192), 16, 0, 0); } while (0)
#define PG8_LDA(dst, b, h) do { _Pragma("unroll") for (int m = 0; m < 4; ++m) _Pragma("unroll") for (int k = 0; k < 2; ++k) dst[m][k] = *(const PG8_LAS bf16x8*)(lds + PG8_SA(b, h) + aoff + m * 2048 + k * 1024); } while (0)
#define PG8_LDB(dst, b, h) do { _Pragma("unroll") for (int n = 0; n < 2; ++n) _Pragma("unroll") for (int k = 0; k < 2; ++k) dst[n][k] = *(const PG8_LAS bf16x8*)(lds + PG8_SB(b, h) + boff + n * 2048 + k * 1024); } while (0)
#define PG8_MMA(ai, bj, At, Bt) do { __builtin_amdgcn_s_setprio(1); _Pragma("unroll") for (int m = 0; m < 4; ++m) _Pragma("unroll") for (int n = 0; n < 2; ++n) _Pragma("unroll") for (int k = 0; k < 2; ++k) \
        acc[ai][bj][m][n] = __builtin_amdgcn_mfma_f32_16x16x32_bf16(Bt[n][k], At[m][k], acc[ai][bj][m][n], 0, 0, 0); __builtin_amdgcn_s_setprio(0); } while (0)
#define PG8_WAIT_V(n) asm volatile("s_waitcnt vmcnt(" #n ")" ::: "memory")
#define PG8_WAIT_L(n) asm volatile("s_waitcnt lgkmcnt(" #n ")" ::: "memory")
#define PG8_BAR __builtin_amdgcn_s_barrier()
#define PG8_SCHED __builtin_amdgcn_sched_barrier(0)
#define PG8_TOUCH(gA, gB) do { if (nt >= 4) { const int r_ = tid >> 1, kt_ = 2 + (tid & 1); \
        __builtin_amdgcn_global_load_lds((const unsigned*)((const char*)(gA) + (size_t)r_ * g.lda * 2 + kt_ * 128), (PG8_LAS unsigned*)(lds + 131072 + 6144 + wid * 256), 4, 0, 0); \
        __builtin_amdgcn_global_load_lds((const unsigned*)((const char*)(gB) + (size_t)r_ * K * 2 + kt_ * 128), (PG8_LAS unsigned*)(lds + 131072 + 6144 + wid * 256), 4, 0, 0); } } while (0)
    Unit cur, nxt; int ui = 0;
    if (!S.next(0, cur)) return;
    f32x4 acc[2][2][4][2];
#pragma unroll
    for (int a = 0; a < 2; ++a)
#pragma unroll
        for (int b = 0; b < 2; ++b)
#pragma unroll
            for (int m = 0; m < 4; ++m)
#pragma unroll
                for (int n = 0; n < 2; ++n) acc[a][b][m][n] = (f32x4){0.f, 0.f, 0.f, 0.f};
    if constexpr (Epi::INIT_ACC) E.init_acc(acc, cur, wr, wc, fr, fq);
    bf16x8 At[4][2], B0[2][2], B1[2][2];
    const char* cA = (const char*)g.A + (size_t)cur.pm * tstepA; const char* cB = (const char*)g.Bt + (size_t)cur.pn * tstep;
    S.a_ready(cur);
    PG8_TOUCH(cA, cB);
    PG8_STAGE(PG8_SB(0, 0), cB, voffB); PG8_STAGE(PG8_SA(0, 0), cA, voffA); PG8_STAGE(PG8_SB(0, 1), cB + hstep, voffB); PG8_STAGE(PG8_SA(0, 1), cA + hstepA, voffA);
    if (wr == 1) PG8_BAR;
    PG8_WAIT_V(4); PG8_BAR;
    PG8_STAGE(PG8_SB(1, 0), cB + kstep, voffB); PG8_STAGE(PG8_SA(1, 0), cA + kstep, voffA); PG8_STAGE(PG8_SB(1, 1), cB + hstep + kstep, voffB);
    PG8_WAIT_V(6); PG8_BAR;
    for (;;) {
        const bool has_next = S.next(ui + 1, nxt);
        const char* nA = has_next ? (const char*)g.A + (size_t)nxt.pm * tstepA : cA; const char* nB = has_next ? (const char*)g.Bt + (size_t)nxt.pn * tstep : cB;
        for (int t = 0; t < nt; t += 2) {
            const bool last = (t == nt - 2);
            const char* a1 = cA + (size_t)(t + 1) * kstep;
            const char* a2 = last ? nA : cA + (size_t)(t + 2) * kstep; const char* b2 = last ? nB : cB + (size_t)(t + 2) * kstep;
            const char* a3 = a2 + kstep; const char* b3 = b2 + kstep;
            if (last && has_next) S.a_ready(nxt);
            PG8_LDB(B0, 0, 0); PG8_SCHED; PG8_LDA(At, 0, 0); PG8_STAGE(PG8_SA(1, 1), a1 + hstepA, voffA);
            PG8_WAIT_L(8); PG8_BAR; PG8_WAIT_L(0); PG8_MMA(0, 0, At, B0); PG8_BAR; PG8_SCHED;
            PG8_LDB(B1, 0, 1); PG8_STAGE(PG8_SB(0, 0), b2, voffB);
            PG8_BAR; PG8_WAIT_L(0); PG8_MMA(0, 1, At, B1); PG8_BAR;
            PG8_LDA(At, 0, 1); PG8_STAGE(PG8_SA(0, 0), a2, voffA);
            PG8_BAR; PG8_WAIT_L(0); PG8_MMA(1, 0, At, B0); PG8_BAR; PG8_SCHED;
            PG8_STAGE(PG8_SB(0, 1), b2 + hstep, voffB);
            PG8_WAIT_V(6); PG8_BAR; PG8_MMA(1, 1, At, B1); PG8_BAR;
            PG8_LDB(B0, 1, 0); PG8_SCHED; PG8_LDA(At, 1, 0); PG8_STAGE(PG8_SA(0, 1), a2 + hstepA, voffA);
            PG8_WAIT_L(8); PG8_BAR; PG8_WAIT_L(0); PG8_MMA(0, 0, At, B0); PG8_BAR; PG8_SCHED;
            PG8_LDB(B1, 1, 1); PG8_STAGE(PG8_SB(1, 0), b3, voffB);
            PG8_BAR; PG8_WAIT_L(0); PG8_MMA(0, 1, At, B1); PG8_BAR;
            PG8_LDA(At, 1, 1); PG8_STAGE(PG8_SA(1, 0), a3, voffA);
            PG8_BAR; PG8_WAIT_L(0); PG8_MMA(1, 0, At, B0); PG8_BAR; PG8_SCHED;
            PG8_STAGE(PG8_SB(1, 1), b3 + hstep, voffB);
            PG8_WAIT_V(6); PG8_BAR; PG8_MMA(1, 1, At, B1); PG8_BAR;
        }
        if (has_next) PG8_TOUCH(nA, nB);
        if constexpr (!Epi::AFTER_DRAIN) { E(acc, cur, wr, wc, fr, fq); S.done(cur); }
        if (!has_next) break;
#pragma unroll
        for (int a = 0; a < 2; ++a)
#pragma unroll
            for (int b = 0; b < 2; ++b)
#pragma unroll
                for (int m = 0; m < 4; ++m)
#pragma unroll
                    for (int n = 0; n < 2; ++n) acc[a][b][m][n] = (f32x4){0.f, 0.f, 0.f, 0.f};
        if constexpr (Epi::INIT_ACC) E.init_acc(acc, nxt, wr, wc, fr, fq);
        cur = nxt; cA = nA; cB = nB; ++ui;
    }
    PG8_WAIT_V(0);
    if (wr == 0) PG8_BAR;
    PG8_BAR;
    if constexpr (Epi::AFTER_DRAIN) { E.fused(acc, cur, wr, wc, fr, fq, lds, wid, lane); S.done(cur); }
#undef PG8_TOUCH
#undef PG8_SA
#undef PG8_SB
#undef PG8_STAGE
#undef PG8_LDA
#undef PG8_LDB
#undef PG8_MMA
#undef PG8_WAIT_V
#undef PG8_WAIT_L
#undef PG8_BAR
#undef PG8_SCHED
}
}
using pg8::bf16_t; using pg8::bf16x8; using pg8::f32x4; using pg8::u32x4;
#define LAS __attribute__((address_space(3)))
typedef short s16x4 __attribute__((ext_vector_type(4)));
typedef float f32x16 __attribute__((ext_vector_type(16)));
typedef unsigned u32x2 __attribute__((ext_vector_type(2)));

constexpr int SEQ = 2048, DM = 1024, NBATCH = 16, TT = NBATCH * SEQ, TH = TT / 2, BH = NBATCH / 2, DFF = 4096;
constexpr float EPS = 1e-6f, LOG2E = 1.4426950408889634f, LOG2_THETA = 13.287712379549449f;
constexpr int NTHR = 512;
constexpr int LDS_BYTES = 131072 + 8192;
constexpr int RS_OFF = 131072 + 2048;
constexpr size_t MiB = (size_t)1 << 20;
constexpr size_t WS_WIN = 0, WS_WQB = WS_WIN + 2 * MiB, WS_WKVB = WS_WQB + 3 * MiB, WS_WO = WS_WKVB + 4 * MiB, WS_WKVQ = WS_WO + 8 * MiB, WS_WQ1 = WS_WKVQ + 18 * MiB,
                 WS_WOB = WS_WQ1 + 6 * MiB, WS_W1 = WS_WOB + 4 * MiB, WS_W2 = WS_W1 + 32 * MiB, WS_XB = WS_W2 + 32 * MiB, WS_SS = WS_XB + 32 * MiB, WS_LSE = WS_SS + 1 * MiB,
                 WS_BAR = WS_LSE + 768 * 1024, WS_SSL = WS_LSE + 1 * MiB, WS_BIG = WS_SSL + 1 * MiB;
constexpr size_t WS_LAT = WS_BIG, WS_Q = WS_LAT + 16 * MiB, WS_KV = WS_Q + 96 * MiB, WS_KPE = WS_KV + 128 * MiB, WS_AO = WS_KPE + 32 * MiB;
constexpr size_t WS_SSK = WS_KPE, WS_KPER = WS_KPE + 8 * MiB;
constexpr size_t WS_KVB = WS_BIG, WS_QB = WS_BIG + 192 * MiB, WS_OB = WS_BIG + 288 * MiB;
constexpr size_t WS_H = WS_BIG + 192 * MiB;
constexpr size_t WS_END = WS_BIG + 336 * MiB;

struct Params { const void* in[20]; float* out; unsigned char* ws; int ph_lo, ph_hi; };

__device__ __forceinline__ unsigned cvtpk(float lo, float hi) { unsigned r; asm volatile("v_cvt_pk_bf16_f32 %0, %1, %2" : "=v"(r) : "v"(lo), "v"(hi)); return r; }
__device__ __forceinline__ float bf_lo(unsigned w) { return __uint_as_float(w << 16); }
__device__ __forceinline__ float bf_hi(unsigned w) { return __uint_as_float(w & 0xffff0000u); }
#define UNPACK8(W_, V_) do { const u32x4 t_ = (W_); V_[0] = bf_lo(t_[0]); V_[1] = bf_hi(t_[0]); V_[2] = bf_lo(t_[1]); V_[3] = bf_hi(t_[1]); V_[4] = bf_lo(t_[2]); V_[5] = bf_hi(t_[2]); V_[6] = bf_lo(t_[3]); V_[7] = bf_hi(t_[3]); } while (0)
#define PACK8(V_) ((u32x4){cvtpk(V_[0], V_[1]), cvtpk(V_[2], V_[3]), cvtpk(V_[4], V_[5]), cvtpk(V_[6], V_[7])})
__device__ __forceinline__ void sincos_rev(float pos, float invf_rev, float& s, float& c) {
    float rev = pos * invf_rev; rev = rev - floorf(rev);
    s = __builtin_amdgcn_sinf(rev); c = __builtin_amdgcn_cosf(rev);
}

constexpr int NCV = 7;
__device__ __forceinline__ void cvt_job(const float* __restrict__ W, int K, int N, const float* __restrict__ gain, bf16_t* __restrict__ dst, int ldo, int& base, LAS float* tile) {
    const int tk = K / 64, tn = N / 64, nt = tk * tn, G = (int)gridDim.x, tid = opaque_tid();
    int start = (opaque_bid() - (base % G)); if (start < 0) start += G;
    for (int t0 = start; t0 < nt; t0 += NCV * G) {
        f32x4 v[NCV][2]; float g[NCV][2];
#pragma unroll
        for (int q = 0; q < NCV; ++q) { const int t = t0 + q * G; if (t < nt) { const int kt = t / tn, ntile = t - kt * tn;
#pragma unroll
            for (int i = 0; i < 2; ++i) { const int k = (tid >> 4) + 32 * i, n4 = (tid & 15) * 4;
                v[q][i] = *(const f32x4*)(W + (size_t)(kt * 64 + k) * N + ntile * 64 + n4); g[q][i] = gain ? gain[kt * 64 + k] : 1.0f; } } }
        __syncthreads();
#pragma unroll
        for (int q = 0; q < NCV; ++q) { const int t = t0 + q * G; if (t < nt) { LAS float* tq = tile + q * (64 * 65);
#pragma unroll
            for (int i = 0; i < 2; ++i) { const int k = (tid >> 4) + 32 * i, n4 = (tid & 15) * 4;
                tq[(n4 + 0) * 65 + k] = v[q][i].x * g[q][i]; tq[(n4 + 1) * 65 + k] = v[q][i].y * g[q][i]; tq[(n4 + 2) * 65 + k] = v[q][i].z * g[q][i]; tq[(n4 + 3) * 65 + k] = v[q][i].w * g[q][i]; } } }
        __syncthreads();
#pragma unroll
        for (int q = 0; q < NCV; ++q) { const int t = t0 + q * G; if (t < nt) { const int kt = t / tn, ntile = t - kt * tn; const int n = tid >> 3, k8 = (tid & 7) * 8;
            const LAS float* tp = tile + q * (64 * 65) + n * 65 + k8;
            u32x4 w; w.x = cvtpk(tp[0], tp[1]); w.y = cvtpk(tp[2], tp[3]); w.z = cvtpk(tp[4], tp[5]); w.w = cvtpk(tp[6], tp[7]);
            *(u32x4*)(dst + (size_t)(ntile * 64 + n) * ldo + kt * 64 + k8) = w; } }
    }
    base += nt;
}
__device__ __forceinline__ void zero_fill(bf16_t* dst, int rows, int cols8, int ld) {
    const size_t n = (size_t)rows * cols8;
    for (size_t i = (size_t)opaque_bid() * NTHR + opaque_tid(); i < n; i += (size_t)gridDim.x * NTHR) { const size_t r = i / cols8, c = i - r * cols8; *(u32x4*)(dst + r * ld + c * 8) = (u32x4){0u, 0u, 0u, 0u}; }
}
__device__ void prep_weights(const Params& p, LAS unsigned char* lds) {
    LAS float* tile = (LAS float*)lds;
    unsigned char* ws = p.ws;
    const float* attn_norm = (const float*)p.in[2]; const float* mlp_norm = (const float*)p.in[3];
    int base = 0;
    for (int a = 0; a < 2; ++a) {
        cvt_job((const float*)p.in[4] + (size_t)a * 1024 * 448, 1024, 448, attn_norm + a * 1024, (bf16_t*)(ws + WS_WIN) + (size_t)a * 512 * 1024, 1024, base, tile);
        cvt_job((const float*)p.in[7] + (size_t)a * 256 * 3072, 256, 3072, (const float*)p.in[5] + a * 256, (bf16_t*)(ws + WS_WQB) + (size_t)a * 3072 * 256, 256, base, tile);
        cvt_job((const float*)p.in[8] + (size_t)a * 128 * 4096, 128, 4096, (const float*)p.in[6] + a * 128, (bf16_t*)(ws + WS_WKVB) + (size_t)a * 4096 * 128, 128, base, tile);
        cvt_job((const float*)p.in[11] + (size_t)a * 2048 * 1024, 2048, 1024, nullptr, (bf16_t*)(ws + WS_WO) + (size_t)a * 1024 * 2048, 2048, base, tile);
        cvt_job((const float*)p.in[17] + (size_t)a * 1024 * 1024, 1024, 1024, nullptr, (bf16_t*)(ws + WS_WOB) + (size_t)a * 1024 * 1024, 1024, base, tile);
        zero_fill((bf16_t*)(ws + WS_WIN) + (size_t)a * 512 * 1024 + (size_t)448 * 1024, 64, 128, 1024);
    }
    cvt_job((const float*)p.in[13], 1024, 6144, (const float*)p.in[12], (bf16_t*)(ws + WS_WKVQ), 1024, base, tile);
    cvt_job((const float*)p.in[15], 1024, 3072, attn_norm + 2 * 1024, (bf16_t*)(ws + WS_WKVQ) + (size_t)6144 * 1024, 1024, base, tile);
    cvt_job((const float*)p.in[15] + (size_t)1024 * 3072, 1024, 3072, attn_norm + 3 * 1024, (bf16_t*)(ws + WS_WQ1), 1024, base, tile);
    for (int l = 0; l < 4; ++l) {
        cvt_job((const float*)p.in[18] + (size_t)l * 1024 * 4096, 1024, 4096, mlp_norm + l * 1024, (bf16_t*)(ws + WS_W1) + (size_t)l * 4096 * 1024, 1024, base, tile);
        cvt_job((const float*)p.in[19] + (size_t)l * 4096 * 1024, 4096, 1024, nullptr, (bf16_t*)(ws + WS_W2) + (size_t)l * 1024 * 4096, 4096, base, tile);
    }
    __syncthreads();
}
__device__ void prep_x(const float* __restrict__ x, bf16_t* __restrict__ xb, float* __restrict__ ss) {
    const int tid_ = opaque_tid(), lane = tid_ & 63, gw = opaque_bid() * 8 + (tid_ >> 6), nw = gridDim.x * 8;
    for (int r0 = gw; r0 < TH; r0 += 4 * nw) {
        f32x4 v[4][4];
#pragma unroll
        for (int q = 0; q < 4; ++q) { const int r = r0 + q * nw; if (r < TH) {
#pragma unroll
            for (int i = 0; i < 4; ++i) v[q][i] = *(const f32x4*)(x + (size_t)r * 1024 + i * 256 + lane * 4); } }
#pragma unroll
        for (int q = 0; q < 4; ++q) { const int r = r0 + q * nw; if (r < TH) { bf16_t* br = xb + (size_t)r * 1024; float s_ = 0.f;
#pragma unroll
            for (int i = 0; i < 4; ++i) { const f32x4 w = v[q][i]; s_ += w.x * w.x + w.y * w.y + w.z * w.z + w.w * w.w;
                *(u32x2*)(br + i * 256 + lane * 4) = (u32x2){cvtpk(w.x, w.y), cvtpk(w.z, w.w)}; }
#pragma unroll
            for (int o = 1; o < 64; o <<= 1) s_ += __shfl_xor(s_, o);
            if (lane < 16) ss[(size_t)r * 16 + lane] = lane == 0 ? s_ : 0.f; } }
    }
}

struct EpiBf16S {
    static constexpr bool PERM = true, AFTER_DRAIN = false, INIT_ACC = false;
    bf16_t* O; int ldc; bf16_t* O2; int ldc2; int split; const float* ss; int nsl4; float inv_n; int act; float* ssl; float* ssk; const LAS float* rs; int pm0;
    __device__ __forceinline__ void operator()(const f32x4 (&acc)[2][2][4][2], const pg8::Unit& u, int wr, int wc, int fr, int fq) const {
        const int row0 = u.pm * 256 + wr * 64 + fr; int colt = u.pn * 256; bf16_t* base = O; int ld = ldc;
        if (colt >= split) { base = O2; colt -= split; ld = ldc2; }
        const int col0 = colt + wc * 32 + 8 * fq;
#pragma unroll
        for (int ai = 0; ai < 2; ++ai)
#pragma unroll
            for (int m = 0; m < 4; ++m) { const int row = row0 + ai * 128 + m * 16; float sc = 1.0f;
                if (ss) { if (u.pm == pm0) sc = rs[(wr * 4 + wc) * 128 + ai * 64 + m * 16 + fr];
                    else { const f32x4* sp = (const f32x4*)(ss + (size_t)row * 16); f32x4 a = sp[0]; if (nsl4 == 4) a = (a + sp[1]) + (sp[2] + sp[3]); sc = rsqrtf(((a.x + a.y) + (a.z + a.w)) * inv_n + EPS); } }
                bf16_t* rowp = base + (size_t)row * ld + col0; float sa = 0.f, sb = 0.f;
#pragma unroll
                for (int bj = 0; bj < 2; ++bj) { f32x4 v0 = acc[ai][bj][m][0] * sc, v1 = acc[ai][bj][m][1] * sc;
                    if (act) {
#pragma unroll
                        for (int j = 0; j < 4; ++j) { const float a0 = fmaxf(v0[j], 0.f), a1 = fmaxf(v1[j], 0.f); v0[j] = a0 * a0; v1[j] = a1 * a1; } }
                    float sq = 0.f; if (ssl || ssk) sq = ((v0[0] * v0[0] + v0[1] * v0[1]) + (v0[2] * v0[2] + v0[3] * v0[3])) + ((v1[0] * v1[0] + v1[1] * v1[1]) + (v1[2] * v1[2] + v1[3] * v1[3]));
                    if (bj == 0) sa = sq; else sb = sq;
                    u32x4 w; w.x = cvtpk(v0[0], v0[1]); w.y = cvtpk(v0[2], v0[3]); w.z = cvtpk(v1[0], v1[1]); w.w = cvtpk(v1[2], v1[3]);
                    *(u32x4*)(rowp + bj * 128) = w; }
                if (ssk) { float sk_ = sa; sk_ += __shfl_xor(sk_, 16); sk_ += __shfl_xor(sk_, 32); if (fq == 0) ssk[((size_t)row * 16 + u.pn) * 4 + wc] = sk_; }
                if (ssl) { sa += __shfl_xor(sa, 16); sa += __shfl_xor(sa, 32); sb += __shfl_xor(sb, 16); sb += __shfl_xor(sb, 32);
                    if (fq == 0) { float* sr_ = ssl + (size_t)row * 16; if (u.pn == 0) sr_[wc] = sa + sb; else { sr_[4 + wc] = sa; sr_[8 + wc] = sb; } } } }
    }
};
struct EpiRes {
    static constexpr bool PERM = false, AFTER_DRAIN = false, INIT_ACC = true;
    const float* xin; float* xout; bf16_t* xb; float* ss;
    __device__ __forceinline__ void init_acc(f32x4 (&acc)[2][2][4][2], const pg8::Unit& u, int wr, int wc, int fr, int fq) const {
        const int row0 = u.pm * 256 + wr * 64 + fr, col0 = u.pn * 256 + wc * 32 + 4 * fq;
#pragma unroll
        for (int ai = 0; ai < 2; ++ai)
#pragma unroll
            for (int m = 0; m < 4; ++m) { const size_t off = (size_t)(row0 + ai * 128 + m * 16) * 1024 + col0;
#pragma unroll
                for (int bj = 0; bj < 2; ++bj)
#pragma unroll
                    for (int n = 0; n < 2; ++n) acc[ai][bj][m][n] = *(const f32x4*)(xin + off + bj * 128 + n * 16); }
    }
    __device__ __forceinline__ void operator()(const f32x4 (&acc)[2][2][4][2], const pg8::Unit& u, int wr, int wc, int fr, int fq) const {
        const int row0 = u.pm * 256 + wr * 64 + fr, col0 = u.pn * 256 + wc * 32 + 4 * fq;
#pragma unroll
        for (int ai = 0; ai < 2; ++ai)
#pragma unroll
            for (int m = 0; m < 4; ++m) { const int row = row0 + ai * 128 + m * 16; const size_t off = (size_t)row * 1024 + col0; float s = 0.f;
#pragma unroll
                for (int bj = 0; bj < 2; ++bj)
#pragma unroll
                    for (int n = 0; n < 2; ++n) { const int c = bj * 128 + n * 16; const f32x4 o = acc[ai][bj][m][n];
                        *(f32x4*)(xout + off + c) = o; s += (o.x * o.x + o.y * o.y) + (o.z * o.z + o.w * o.w);
                        *(u32x2*)(xb + off + c) = (u32x2){cvtpk(o.x, o.y), cvtpk(o.z, o.w)}; }
                s += __shfl_xor(s, 16); s += __shfl_xor(s, 32);
                if (fq == 0) ss[(size_t)row * 16 + u.pn * 4 + wc] = s; }
    }
};
template <class Epi> __device__ __forceinline__ void run_gemm(LAS unsigned char* lds, const bf16_t* A, int lda, const bf16_t* Bt, int N, int K, const Epi& E) {
    pg8::Gemm g{A, Bt, TH, N, K, lda}; pg8::StaticOrder S; S.init(TH, N, (int)gridDim.x, opaque_bid());
    pg8::gemm_phase<Epi, pg8::StaticOrder>(lds, g, S, E);
}
__device__ __forceinline__ void run_gemm_bf16(LAS unsigned char* lds, const bf16_t* A, int lda, const bf16_t* Bt, int N, int K, EpiBf16S E) {
    pg8::Gemm g{A, Bt, TH, N, K, lda}; pg8::StaticOrder S; S.init(TH, N, (int)gridDim.x, opaque_bid());
    E.rs = (const LAS float*)(lds + RS_OFF); E.pm0 = -1;
    pg8::Unit u0;
    if (E.ss && S.next(0, u0)) {
        const int tid = opaque_tid(), wid = tid >> 6, lane = tid & 63, wr = wid >> 2;
        LAS float* tab = (LAS float*)(lds + RS_OFF) + wid * 128;
#pragma unroll
        for (int hh = 0; hh < 2; ++hh) { const int row = u0.pm * 256 + hh * 128 + wr * 64 + lane;
            const f32x4* sp = (const f32x4*)(E.ss + (size_t)row * 16); f32x4 a = sp[0]; if (E.nsl4 == 4) a = (a + sp[1]) + (sp[2] + sp[3]);
            tab[hh * 64 + lane] = rsqrtf(((a.x + a.y) + (a.z + a.w)) * E.inv_n + EPS); }
        E.pm0 = u0.pm;
    }
    pg8::gemm_phase<EpiBf16S, pg8::StaticOrder>(lds, g, S, E);
}

__device__ void lat_prep(bf16_t* lat) {
    const int tid_ = opaque_tid(), lane = tid_ & 63, gw = opaque_bid() * 8 + (tid_ >> 6), nw = gridDim.x * 8;
    for (int t = gw; t < TH; t += nw) {
        bf16_t* p = lat + (size_t)t * 512 + lane * 8; const u32x4 w = *(const u32x4*)p; float v[8]; UNPACK8(w, v);
        float s = 0.f;
#pragma unroll
        for (int e = 0; e < 8; ++e) s += v[e] * v[e];
        s += __shfl_xor(s, 1); s += __shfl_xor(s, 2); s += __shfl_xor(s, 4); s += __shfl_xor(s, 8);
        const float s32 = s + __shfl_xor(s, 16);
        const float rstd = lane < 32 ? rsqrtf(s32 * (1.0f / 256.0f) + EPS) : rsqrtf(s * (1.0f / 128.0f) + EPS);
        if (lane < 48) {
#pragma unroll
            for (int e = 0; e < 8; ++e) v[e] *= rstd;
            *(u32x4*)p = PACK8(v); }
    }
}
__device__ void kpe_prep(const bf16_t* lat, const int* pos, const float* gk, bf16_t* kper) {
    const int tid = opaque_tid(), grp = tid >> 3, l8 = tid & 7;
    float invf[8], g[8];
#pragma unroll
    for (int e = 0; e < 8; ++e) { invf[e] = exp2f(-(float)((l8 & 3) * 8 + e) * (LOG2_THETA / 32.0f)) * 0.15915494309189535f; g[e] = gk[128 + l8 * 8 + e]; }
    for (int t = opaque_bid() * 64 + grp; t < TH; t += (int)gridDim.x * 64) {
        const float posf = (float)pos[t];
        const u32x4 w = *(const u32x4*)(lat + (size_t)t * 512 + 384 + l8 * 8); float v[8]; UNPACK8(w, v);
#pragma unroll
        for (int e = 0; e < 8; ++e) { const float y = v[e] * g[e]; const float pr = __shfl_xor(y, 4); float sn_, cs_; sincos_rev(posf, invf[e], sn_, cs_);
            v[e] = (l8 & 4) ? y * cs_ + pr * sn_ : y * cs_ - pr * sn_; }
        *(u32x4*)(kper + (size_t)t * 64 + l8 * 8) = PACK8(v);
    }
}
__device__ void head_prep(bf16_t* kbuf  , bf16_t* qbuf, const int* pos, const float* gk, const float* gq) {
    const int tid_ = opaque_tid(), lane = tid_ & 63, gw = opaque_bid() * 8 + (tid_ >> 6), nw = gridDim.x * 8;
    const float qscale = 0.08838834764831845f * LOG2E;
    const int c16 = lane & 15;
    float invf[8];
#pragma unroll
    for (int e = 0; e < 8; ++e) invf[e] = exp2f(-(float)((c16 & 7) * 8 + e) * (LOG2_THETA / 64.0f)) * 0.15915494309189535f;
    for (int t = gw; t < TH; t += nw) {
        const float posf = (float)pos[t];
        float cs[8], sn[8];
#pragma unroll
        for (int e = 0; e < 8; ++e) sincos_rev(posf, invf[e], sn[e], cs[e]);
        u32x4 wv[6];
#pragma unroll
        for (int itr = 0; itr < 6; ++itr) wv[itr] = *(const u32x4*)(kbuf + (size_t)t * 6144 + (itr * 4 + (lane >> 4)) * 128 + c16 * 8);
#pragma unroll
        for (int itr = 0; itr < 6; ++itr) { const bool isq = false;
            const int hh = (isq ? itr - 6 : itr) * 4 + (lane >> 4), g = hh >> 3;
            bf16_t* p = isq ? qbuf + (size_t)t * 3072 + hh * 128 + c16 * 8 : kbuf + (size_t)t * 6144 + hh * 128 + c16 * 8;
            const float* gn = (isq ? gq : gk) + g * 128 + c16 * 8;
            float v[8]; UNPACK8(wv[itr], v); float s = 0.f;
#pragma unroll
            for (int e = 0; e < 8; ++e) s += v[e] * v[e];
            s += __shfl_xor(s, 1); s += __shfl_xor(s, 2); s += __shfl_xor(s, 4); s += __shfl_xor(s, 8);
            const float rstd = rsqrtf(s * (1.0f / 128.0f) + EPS), osc = isq ? qscale : 1.0f;
#pragma unroll
            for (int e = 0; e < 8; ++e) { const float y = v[e] * rstd * gn[e]; const float pr = __shfl_xor(y, 8);
                v[e] = ((c16 & 8) ? y * cs[e] + pr * sn[e] : y * cs[e] - pr * sn[e]) * osc; }
            *(u32x4*)p = PACK8(v); }
    }
}

struct AttnItem { const bf16_t* q; const bf16_t* k; const bf16_t* kpe; const bf16_t* v; bf16_t* o; float* lse; const int* pos; const float* gq; const float* gk; const float* ssk; const float* ssl; int q_ld, k_ld, kpe_ld, v_ld, o_ld, P0, ld, merge; };
__device__ __forceinline__ int v_st(int k, int c) { const int kk = (k & ~0xC) | ((k & 4) << 1) | ((k & 8) >> 1); return ((kk >> 3) * 4 + (c >> 5)) * 512 + ((kk & 7) * 32 + (c & 31)) * 2; }
__device__ __forceinline__ int v_rd_base(int lane) { return ((lane & 3) << 3) | (((lane >> 2) & 3) << 6) | (((lane >> 4) & 1) << 5) | (((lane >> 5) & 1) << 8); }
#define PK4(P, B_, OUT) do { unsigned a0_ = cvtpk(P[B_+0], P[B_+1]), a1_ = cvtpk(P[B_+2], P[B_+3]); unsigned b0_ = cvtpk(P[B_+4], P[B_+5]), b1_ = cvtpk(P[B_+6], P[B_+7]); \
        auto r0_ = __builtin_amdgcn_permlane32_swap(a0_, b0_, false, false); auto r1_ = __builtin_amdgcn_permlane32_swap(a1_, b1_, false, false); \
        u32x4 w_ = {r0_[0], r1_[0], r0_[1], r1_[1]}; OUT = w_; } while (0)
__device__ __forceinline__ bf16x8 as_bf(u32x4 w) { return *reinterpret_cast<bf16x8*>(&w); }

template <int DQK, int MODE>
__device__ __forceinline__ void attn_block(const AttnItem& it, LAS unsigned char* lds) {
    constexpr int RS = DQK * 2, SHM_K = 64 * RS, SHM_V = 16384, ND0 = DQK / 16, KCH = DQK / 8, NKC = (64 * KCH) / 512;
    const int tid = opaque_tid(), wid = __builtin_amdgcn_readfirstlane(tid >> 6), lane = tid & 63, r32 = lane & 31, hi = lane >> 5;
    const int ld = it.ld, Lm1 = (2048 >> ld) - 1, lsh = 11 - ld;
#define TOK(p) (MODE == 0 ? (p) : ((((p) & Lm1) << ld) | ((p) >> lsh)))
#define LOF(p) (MODE == 0 ? 0 : max((p) - 128, (p) & ~Lm1))
    const int q0 = it.P0 + wid * 32, qp = q0 + r32;
    const int span = qp - LOF(qp), lo_w = LOF(q0), lo_last = LOF(q0 + 31);
    LAS unsigned char* V_lds = lds; LAS unsigned char* K_lds = lds + 2 * SHM_V;
    const int j_lo = LOF(it.P0) >> 6, NT = (it.P0 >> 6) + 4 - j_lo;
    const int sr = tid >> 4, sc = (tid & 15) * 8, vst0 = v_st(sr, sc), vst1 = v_st(32 + sr, sc);
    constexpr int NSET = (MODE == 1) ? 2 : 1;
    bf16x8 sk[NSET][NKC], sv0[NSET], sv1[NSET]; f32x4 s_k4 = {0.f, 0.f, 0.f, 0.f}, s_p4 = {0.f, 0.f, 0.f, 0.f};
    constexpr int KRS_OFF = 2 * SHM_V + 2 * SHM_K;
    int offk[NKC], offv0 = sr * it.v_ld + sc, offv1 = (32 + sr) * it.v_ld + sc;
#pragma unroll
    for (int i_ = 0; i_ < NKC; ++i_) { const int c_ = tid + 512 * i_, row_ = c_ / KCH, cc_ = c_ - row_ * KCH; offk[i_] = (DQK == 192 && cc_ >= 16) ? row_ * it.kpe_ld + (cc_ - 16) * 8 : row_ * it.k_ld + cc_ * 8; }
#define SLOAD(S_, kb_) do { if (MODE == 0) { const bf16_t* kt_ = it.k + (size_t)(kb_) * it.k_ld; const bf16_t* pt_ = it.kpe + (size_t)(kb_) * it.kpe_ld; const bf16_t* vt_ = it.v + (size_t)(kb_) * it.v_ld; \
            _Pragma("unroll") for (int i_ = 0; i_ < NKC; ++i_) { const int c_ = tid + 512 * i_, row_ = c_ / KCH, cc_ = c_ - row_ * KCH; sk[S_][i_] = *(const bf16x8*)(((DQK == 192 && cc_ >= 16) ? pt_ : kt_) + offk[i_]); } \
            sv0[S_] = *(const bf16x8*)(vt_ + offv0); sv1[S_] = *(const bf16x8*)(vt_ + offv1); \
            if (tid < 64) { s_k4 = *(const f32x4*)(it.ssk + (size_t)((kb_) + tid) * 64); s_p4 = *(const f32x4*)(it.ssl + (size_t)((kb_) + tid) * 16); } } else { \
        _Pragma("unroll") for (int i_ = 0; i_ < NKC; ++i_) { const int c_ = tid + 512 * i_, row_ = c_ / KCH, cc_ = c_ - row_ * KCH; const int tk_ = TOK((kb_) + row_); \
            sk[S_][i_] = *(const bf16x8*)(it.k + (size_t)tk_ * it.k_ld + cc_ * 8); } \
        { const int t0_ = TOK((kb_) + sr), t1_ = TOK((kb_) + 32 + sr); sv0[S_] = *(const bf16x8*)(it.v + (size_t)t0_ * it.v_ld + sc); sv1[S_] = *(const bf16x8*)(it.v + (size_t)t1_ * it.v_ld + sc); } } } while (0)
#define SWRITE(S_, bf_) do { _Pragma("unroll") for (int i_ = 0; i_ < NKC; ++i_) { const int c_ = tid + 512 * i_, row_ = c_ / KCH, cc_ = c_ - row_ * KCH; const int swz_ = (((DQK == 128) ? row_ : (row_ >> 1)) & 7) << 4; \
            *(LAS bf16x8*)(K_lds + (bf_) * SHM_K + row_ * RS + ((cc_ * 16) ^ swz_)) = sk[S_][i_]; } \
        *(LAS bf16x8*)(V_lds + (bf_) * SHM_V + vst0) = sv0[S_]; *(LAS bf16x8*)(V_lds + (bf_) * SHM_V + vst1) = sv1[S_]; \
        if (MODE == 0 && tid < 64) { const f32x4 a_ = s_k4 + s_p4; *(LAS float*)(lds + KRS_OFF + (bf_) * 256 + tid * 4) = rsqrtf(((a_.x + a_.y) + (a_.z + a_.w)) * (1.0f / 192.0f) + EPS); } } while (0)
    float m_reg = -1e30f, l_reg = 0.f; f32x16 o[4];
#pragma unroll
    for (int d = 0; d < 4; ++d)
#pragma unroll
        for (int r = 0; r < 16; ++r) o[d][r] = 0.f;
    SLOAD(0, j_lo * 64); if (MODE == 1) SLOAD(NSET - 1, j_lo * 64 + 64);
    bf16x8 qr[ND0];
    {
      constexpr int NR = (MODE == 0) ? 2 : 4;
      constexpr int R0 = (MODE == 0) ? 8 : 0;
      constexpr float QS = ((MODE == 0) ? 0.07216878364870322f : 0.08838834764831845f) * LOG2E;
      constexpr float FSTEP = LOG2_THETA / ((MODE == 0) ? 32.0f : 64.0f);
      const int tq_ = TOK(qp);
      const bf16_t* qrow = it.q + (size_t)tq_ * it.q_ld + hi * 8;
      u32x4 raw[ND0]; float ssq = 0.f;
#pragma unroll
      for (int d0 = 0; d0 < ND0; ++d0) raw[d0] = *(const u32x4*)(qrow + d0 * 16);
      const float posf = (float)it.pos[tq_];
#pragma unroll
      for (int d0 = 0; d0 < ND0; ++d0) { float v[8]; UNPACK8(raw[d0], v);
#pragma unroll
          for (int e = 0; e < 8; ++e) ssq += v[e] * v[e]; }
      { auto rr = __builtin_amdgcn_permlane32_swap(__float_as_uint(ssq), __float_as_uint(ssq), false, false); ssq = __uint_as_float(rr[0]) + __uint_as_float(rr[1]); }
      const float rq = rsqrtf(ssq * (1.0f / (float)DQK) + EPS) * QS;
      const float* gp = it.gq + hi * 8;
#pragma unroll
      for (int d0 = 0; d0 < ND0; ++d0) {
          if (d0 >= R0 + NR && d0 < R0 + 2 * NR) continue;
          f32x4 g0 = *(const f32x4*)(gp + d0 * 16), g1 = *(const f32x4*)(gp + d0 * 16 + 4);
          if (MODE == 0 && d0 < 8) { g0 *= *(const f32x4*)(it.gk + hi * 8 + d0 * 16); g1 *= *(const f32x4*)(it.gk + hi * 8 + d0 * 16 + 4); }
          float v[8]; UNPACK8(raw[d0], v);
#pragma unroll
          for (int e = 0; e < 8; ++e) v[e] *= rq * (e < 4 ? g0[e & 3] : g1[e & 3]);
          if (d0 >= R0 && d0 < R0 + NR) {
              const f32x4 h0 = *(const f32x4*)(gp + (d0 + NR) * 16), h1 = *(const f32x4*)(gp + (d0 + NR) * 16 + 4);
              float w[8]; UNPACK8(raw[d0 + NR], w);
#pragma unroll
              for (int e = 0; e < 8; ++e) { w[e] *= rq * (e < 4 ? h0[e & 3] : h1[e & 3]);
                  float sn_, cs_; sincos_rev(posf, exp2f(-(float)((d0 - R0) * 16 + hi * 8 + e) * FSTEP) * 0.15915494309189535f, sn_, cs_);
                  const float x1 = v[e], x2 = w[e]; v[e] = x1 * cs_ - x2 * sn_; w[e] = x2 * cs_ + x1 * sn_; }
              qr[d0 + NR] = as_bf(PACK8(w)); }
          qr[d0] = as_bf(PACK8(v)); } }
    SWRITE(0, 0); __syncthreads();
    const int swzr = (((DQK == 128) ? r32 : (r32 >> 1)) & 7) << 4;
    int kro[4];
#pragma unroll
    for (int dd = 0; dd < 4; ++dd) kro[dd] = r32 * RS + ((dd * 32 + hi * 16) ^ swzr);
#pragma unroll 1
    for (int t2 = 0; t2 < NT; t2 += NSET) {
#pragma unroll
      for (int us = 0; us < NSET; ++us) { const int t = t2 + us; if (t < NT) {
        const int kb = (j_lo + t) * 64, buf = t & 1;
        if (MODE == 1) { if (t + 2 < NT) SLOAD(us, kb + 128); } else { if (t + 1 < NT) SLOAD(0, kb + 64); }
#pragma unroll 1
        for (int hf = 0; hf < 2; ++hf) {
            const int kh = kb + 32 * hf;
            const bool act = (kh <= q0 + 31) && (kh + 31 >= lo_w);
            if (act) {
                f32x16 p0;
#pragma unroll
                for (int r = 0; r < 16; ++r) p0[r] = 0.f;
                { const LAS unsigned char* kbp = K_lds + buf * SHM_K + hf * (32 * RS);
#pragma unroll
                  for (int d0 = 0; d0 < ND0; ++d0) {
                      const bf16x8 b0 = *(const LAS bf16x8*)(kbp + kro[d0 & 3] + (d0 >> 2) * 128);
                      p0 = __builtin_amdgcn_mfma_f32_32x32x16_bf16(b0, qr[d0], p0, 0, 0, 0); } }
                if (MODE == 0) { const LAS float* kr_ = (const LAS float*)(lds + KRS_OFF + buf * 256) + 32 * hf + 4 * hi;
#pragma unroll
                    for (int j4 = 0; j4 < 4; ++j4) { const f32x4 s4 = *(const LAS f32x4*)(kr_ + 8 * j4);
#pragma unroll
                        for (int e = 0; e < 4; ++e) p0[4 * j4 + e] *= s4[e]; } }
                if (!((kh + 31 <= q0) && (kh >= lo_last))) {
                    const int dq = qp - kh - 4 * hi; const float NEG = -__builtin_inff();
#pragma unroll
                    for (int r = 0; r < 16; ++r) { const int c = (r & 3) + 8 * (r >> 2); if ((unsigned)(dq - c) > (unsigned)span) p0[r] = NEG; } }
                float pmax = p0[0];
#pragma unroll
                for (int r = 1; r < 16; ++r) pmax = fmaxf(pmax, p0[r]);
                { auto rr = __builtin_amdgcn_permlane32_swap(__float_as_uint(pmax), __float_as_uint(pmax), false, false); pmax = fmaxf(__uint_as_float(rr[0]), __uint_as_float(rr[1])); }
                float mn = m_reg, alpha = 1.0f;
                const bool resc = !__all(pmax - m_reg <= 8.0f);
                if (resc) { mn = fmaxf(m_reg, pmax); alpha = __builtin_amdgcn_exp2f(m_reg - mn); m_reg = mn; }
                float ps = 0.f;
#pragma unroll
                for (int r = 0; r < 16; ++r) { p0[r] = __builtin_amdgcn_exp2f(p0[r] - mn); ps += p0[r]; }
                { auto rr = __builtin_amdgcn_permlane32_swap(__float_as_uint(ps), __float_as_uint(ps), false, false); ps = __uint_as_float(rr[0]) + __uint_as_float(rr[1]); }
                l_reg = l_reg * alpha + ps;
                u32x4 pa0, pa1; PK4(p0, 0, pa0); PK4(p0, 8, pa1);
                if (resc) {
#pragma unroll
                    for (int d = 0; d < 4; ++d)
#pragma unroll
                        for (int r = 0; r < 16; ++r) o[d][r] *= alpha; }
                const unsigned vb = (unsigned)(uintptr_t)(V_lds + buf * SHM_V + hf * 8192) + (unsigned)v_rd_base(lane);
#define TRRD(dst, off) asm volatile("ds_read_b64_tr_b16 %0, %1 offset:%2" : "=&v"(dst) : "v"(vb), "i"(off) : "memory")
#define PV_D0(d0) do { s16x4 l0, l1, h0, h1; constexpr int b_ = (d0) * 512; \
                TRRD(l0, b_); TRRD(h0, b_ + 2048); TRRD(l1, b_ + 4096); TRRD(h1, b_ + 6144); \
                asm volatile("s_waitcnt lgkmcnt(0)" ::: "memory"); __builtin_amdgcn_sched_barrier(0); \
                o[d0] = __builtin_amdgcn_mfma_f32_32x32x16_bf16((bf16x8){l0[0], l0[1], l0[2], l0[3], h0[0], h0[1], h0[2], h0[3]}, as_bf(pa0), o[d0], 0, 0, 0); \
                o[d0] = __builtin_amdgcn_mfma_f32_32x32x16_bf16((bf16x8){l1[0], l1[1], l1[2], l1[3], h1[0], h1[1], h1[2], h1[3]}, as_bf(pa1), o[d0], 0, 0, 0); } while (0)
                PV_D0(0); PV_D0(1); PV_D0(2); PV_D0(3);
#undef PV_D0
#undef TRRD
            }
        }
        if (t + 1 < NT) SWRITE((NSET - 1) - us, buf ^ 1);
        __syncthreads();
      } }
    }
    const int tq = TOK(qp);
    float a_cur = 1.0f / l_reg, a_prev = 0.f;
    if (MODE == 1) {
        const float lse_cur = m_reg + __builtin_amdgcn_logf(l_reg); float lse_new = lse_cur;
        if (it.merge) { const float lse_prev = it.lse[(size_t)tq * 8]; const float mx = fmaxf(lse_prev, lse_cur);
            const float e0 = __builtin_amdgcn_exp2f(lse_prev - mx), e1 = __builtin_amdgcn_exp2f(lse_cur - mx); const float inv = 1.0f / (e0 + e1);
            lse_new = mx + __builtin_amdgcn_logf(e0 + e1); a_prev = e0 * inv; a_cur *= e1 * inv; }
        if (hi == 0) it.lse[(size_t)tq * 8] = lse_new;
    }
    bf16_t* orow = it.o + (size_t)tq * it.o_ld + hi * 8;
#pragma unroll
    for (int d0 = 0; d0 < 4; ++d0) {
#pragma unroll
        for (int r = 0; r < 16; ++r) o[d0][r] *= a_cur;
        u32x4 w0, w1; PK4(o[d0], 0, w0); PK4(o[d0], 8, w1);
        if (MODE == 1 && it.merge) {
            const u32x4 q0w = *(const u32x4*)(orow + d0 * 32), q1w = *(const u32x4*)(orow + d0 * 32 + 16);
            float a[8], b[8];
            UNPACK8(w0, a); UNPACK8(q0w, b);
#pragma unroll
            for (int e = 0; e < 8; ++e) a[e] += b[e] * a_prev;
            w0 = PACK8(a);
            UNPACK8(w1, a); UNPACK8(q1w, b);
#pragma unroll
            for (int e = 0; e < 8; ++e) a[e] += b[e] * a_prev;
            w1 = PACK8(a);
        }
        *(u32x4*)(orow + d0 * 32) = w0; *(u32x4*)(orow + d0 * 32 + 16) = w1;
    }
#undef SLOAD
#undef SWRITE
#undef TOK
#undef LOF
}

__device__ void mla_attn_phase(const Params& p, LAS unsigned char* lds, const int* pos, const float* gq, const float* gk) {
    unsigned char* ws = p.ws;
    const int G_ = (int)gridDim.x, bid_ = opaque_bid(), vb_ = (G_ % 8 == 0) ? (bid_ % 8) * (G_ / 8) + bid_ / 8 : bid_;
    for (int item = vb_; item < BH * 16 * 4; item += G_) {
        const int bh = item >> 2, pr = item & 3, b = bh >> 4, h = bh & 15; const size_t tb = (size_t)b * SEQ;
        AttnItem it; it.q = (const bf16_t*)(ws + WS_Q) + tb * 3072 + h * 192; it.q_ld = 3072;
        it.k = (const bf16_t*)(ws + WS_KV) + tb * 4096 + h * 256; it.k_ld = 4096; it.kpe = (const bf16_t*)(ws + WS_KPER) + tb * 64; it.kpe_ld = 64; it.gk = gk; it.ssk = (const float*)(ws + WS_SSK) + (tb * 16 + h) * 4; it.ssl = (const float*)(ws + WS_SSL) + tb * 16 + 8;
        it.v = (const bf16_t*)(ws + WS_KV) + tb * 4096 + h * 256 + 128; it.v_ld = 4096; it.o = (bf16_t*)(ws + WS_AO) + tb * 2048 + h * 128; it.o_ld = 2048;
        it.lse = nullptr; it.ld = 0; it.merge = 0; it.pos = pos + tb; it.gq = gq;
#pragma unroll 1
        for (int k2 = 0; k2 < 2; ++k2) { it.P0 = (k2 == 0 ? 7 - pr : pr) * 256; attn_block<192, 0>(it, lds); }
    }
}
__device__ void dil_attn_phase(const Params& p, LAS unsigned char* lds, int g, const int* pos, const float* gq) {
    unsigned char* ws = p.ws;
    const int G_ = (int)gridDim.x, bid_ = opaque_bid(), vb_ = (G_ % 8 == 0) ? (bid_ % 8) * (G_ / 8) + bid_ / 8 : bid_;
    for (int item = vb_; item < BH * 8 * 8; item += G_) {
        const int bh = item >> 3, qb = item & 7, b = bh >> 3, h = bh & 7, hh = g * 8 + h; const size_t tb = (size_t)b * SEQ;
        AttnItem it; it.q = (const bf16_t*)(ws + WS_QB) + tb * 3072 + hh * 128; it.q_ld = 3072;
        it.k = (const bf16_t*)(ws + WS_KVB) + tb * 6144 + hh * 128; it.k_ld = 6144; it.kpe = nullptr; it.kpe_ld = 0; it.gk = nullptr; it.ssk = nullptr; it.ssl = nullptr;
        it.v = (const bf16_t*)(ws + WS_KVB) + tb * 6144 + 3072 + hh * 128; it.v_ld = 6144; it.o = (bf16_t*)(ws + WS_OB) + tb * 1024 + h * 128; it.o_ld = 1024;
        it.lse = (float*)(ws + WS_LSE) + tb * 8 + h; it.ld = 2 * g; it.merge = g > 0; it.P0 = qb * 256; it.pos = pos + tb; it.gq = gq + g * 128;
        attn_block<128, 1>(it, lds);
    }
}

#define XB_TMO      128
#define XB_XCNT(j)  (256  + 64 * (j))
#define XB_XSUB(j)  (1280 + 64 * (j))
#define XB_XGEN(j)  (2304 + 64 * (j))
#define XB_TOP      3328
#define XB_TOPGEN   3392
#define XCD_BAR_WORDS 3456
#define XB_SPIN_CAP (1u << 18)

__device__ __forceinline__ unsigned xb_ld(unsigned* p)              { return __hip_atomic_load(p, __ATOMIC_RELAXED, __HIP_MEMORY_SCOPE_AGENT); }
__device__ __forceinline__ unsigned xb_add(unsigned* p, unsigned v) { return __hip_atomic_fetch_add(p, v, __ATOMIC_RELAXED, __HIP_MEMORY_SCOPE_AGENT); }
__device__ __forceinline__ unsigned xb_xcc_id() { return (unsigned)__builtin_amdgcn_s_getreg((3 << 11) | 20) & 0xFu; }
#define XB_SPIN(cond, bar) do { unsigned _sp = 0; while (cond) { __builtin_amdgcn_s_sleep(1); \
    if ((++_sp & 255u) == 0u) { if (xb_ld(&(bar)[XB_TMO])) break; if (_sp > XB_SPIN_CAP) { atomicAdd(&(bar)[XB_TMO], 1u); break; } } } } while (0)

struct XcdBarrier {
    unsigned* bar; unsigned x;
    volatile LAS unsigned* st;
};

__device__ __forceinline__ XcdBarrier xcd_barrier_post(unsigned* bar, volatile LAS unsigned* st) {
    XcdBarrier b; b.bar = bar; b.x = xb_xcc_id(); b.st = st;
    if (threadIdx.x == 0) (void)xb_add(&bar[XB_XCNT(b.x)], 1u);
    return b;
}
__device__ __forceinline__ void xcd_barrier_complete(unsigned* bar, unsigned x, unsigned& nloc, unsigned& nx) {
    const unsigned G = gridDim.x * gridDim.y * gridDim.z;
    unsigned sum, cnt, mine, sp = 0u;
    for (;;) {
        sum = 0u; cnt = 0u; mine = 0u;
#pragma unroll
        for (unsigned j = 0; j < 16; ++j) { const unsigned c = xb_ld(&bar[XB_XCNT(j)]); sum += c; cnt += (c > 0u) ? 1u : 0u; mine = (j == x) ? c : mine; }
        if (sum == G) break;
        __builtin_amdgcn_s_sleep(1);
        if ((++sp & 255u) == 0u) { if (xb_ld(&bar[XB_TMO])) break; if (sp > XB_SPIN_CAP) { atomicAdd(&bar[XB_TMO], 1u); break; } }
    }
    nloc = mine > 0u ? mine : 1u; nx = cnt > 0u ? cnt : 1u;
}

__device__ __forceinline__ void xcd_barrier(const XcdBarrier& b) {
    asm volatile("s_waitcnt vmcnt(0)" ::: "memory");
    __syncthreads();
    if (threadIdx.x == 0) {
        unsigned* bar = b.bar;
        __builtin_amdgcn_s_waitcnt(0);
        unsigned nloc = b.st[0], nx = b.st[1];
        if (nloc == 0u) { xcd_barrier_complete(bar, b.x, nloc, nx); b.st[0] = nloc; b.st[1] = nx; }
        const unsigned old = xb_add(&bar[XB_XSUB(b.x)], 1u);
        const unsigned gen = old / nloc;
        if (old + 1u == (gen + 1u) * nloc) {
            __builtin_amdgcn_fence(__ATOMIC_RELEASE, "agent");
            asm volatile("s_waitcnt vmcnt(0)" ::: "memory");
            const unsigned og = xb_add(&bar[XB_TOP], 1u);
            const unsigned tg = og / nx;
            if (og + 1u == (tg + 1u) * nx) xb_add(&bar[XB_TOPGEN], 1u);
            else XB_SPIN(xb_ld(&bar[XB_TOPGEN]) == tg, bar);
            __builtin_amdgcn_fence(__ATOMIC_ACQUIRE, "agent");
            xb_add(&bar[XB_XGEN(b.x)], 1u);
            asm volatile("s_waitcnt vmcnt(0)" ::: "memory");
        } else {
            XB_SPIN(xb_ld(&bar[XB_XGEN(b.x)]) == gen, bar);
            __builtin_amdgcn_fence(__ATOMIC_ACQUIRE, "agent");
            asm volatile("s_waitcnt vmcnt(0)" ::: "memory");
        }
    }
    __syncthreads();
}

constexpr int NPH_HALF = 1 + 2 * 6 + 8 + 7;
#ifndef SKIP_MASK
#define SKIP_MASK 0
#endif
__global__ void __launch_bounds__(NTHR) mega(Params p) {
    extern __shared__ __attribute__((aligned(16))) unsigned char lds_raw[];
    LAS unsigned char* lds = (LAS unsigned char*)lds_raw;
    cg::grid_group grid = cg::this_grid();
    unsigned char* ws = p.ws;
    bf16_t* XB = (bf16_t*)(ws + WS_XB); float* SS = (float*)(ws + WS_SS); bf16_t* HB = (bf16_t*)(ws + WS_H);
    bf16_t* LAT = (bf16_t*)(ws + WS_LAT); bf16_t* Q = (bf16_t*)(ws + WS_Q); bf16_t* KV = (bf16_t*)(ws + WS_KV); bf16_t* KPE = (bf16_t*)(ws + WS_KPE); bf16_t* AO = (bf16_t*)(ws + WS_AO);
    bf16_t* KVB = (bf16_t*)(ws + WS_KVB); bf16_t* QB = (bf16_t*)(ws + WS_QB); bf16_t* OB = (bf16_t*)(ws + WS_OB);
#ifndef PROBE_MASK
#define PROBE_MASK 0
#endif
    unsigned long long probe_acc = 0ull;
    volatile LAS unsigned* bar_st = (volatile LAS unsigned*)(lds + 131072);
    if (threadIdx.x < 4) bar_st[threadIdx.x] = 0u;
    __syncthreads();
    XcdBarrier xbar = xcd_barrier_post((unsigned*)(ws + WS_BAR), bar_st);
#pragma unroll 1
    for (int ph = p.ph_lo; ph < p.ph_hi; ++ph) {
        const unsigned long long probe_t0 = PROBE_MASK ? __builtin_amdgcn_s_memrealtime() : 0ull;
        const int hb = ph >= NPH_HALF ? 1 : 0, li = hb ? ph - NPH_HALF + 1 : ph;
        const size_t toff = (size_t)hb * TH;
        const float* xin0 = (const float*)p.in[0] + toff * DM; float* xo = p.out + toff * DM; const int* pos = (const int*)p.in[1] + toff;
        int lyr = 0, j = -1;
        if (li >= 21) { lyr = 3; const int jm = li - 21; j = jm == 0 ? 0 : jm + 1; }
        else if (li >= 13) { lyr = 2; j = li - 13; }
        else if (li >= 1) { lyr = (li - 1) / 6; const int jm = (li - 1) - lyr * 6; j = jm == 0 ? 0 : jm == 1 ? 2 : jm + 2; }
        const bool mla = lyr < 2; const int ab = lyr & 1;
        int gk = 0;
        const bf16_t* A = nullptr; const bf16_t* Bt = nullptr; int lda = 0, N = 0, K = 0, nsub = 1;
        EpiBf16S E1{nullptr, 0, nullptr, 0, 1 << 30, nullptr, 4, 1.0f / 1024.0f, 0, nullptr, nullptr, nullptr, -1}; EpiRes E2{nullptr, nullptr, XB, SS};
        float* SSL = (float*)(ws + WS_SSL);
        if (li > 0) {
            if (j == 6) { gk = 1; A = XB; lda = 1024; Bt = (const bf16_t*)(ws + WS_W1) + (size_t)lyr * 4096 * 1024; N = 4096; K = 1024; E1.O = HB; E1.ldc = 4096; E1.ss = SS; E1.act = 1; }
            else if (j == 7) { gk = 2; A = HB; lda = 4096; Bt = (const bf16_t*)(ws + WS_W2) + (size_t)lyr * 1024 * 4096; N = 1024; K = 4096; E2.xin = xo; E2.xout = xo; }
            else if (j == 5) { gk = 2; N = 1024; E2.xin = lyr == 0 ? xin0 : xo; E2.xout = xo;
                if (mla) { A = AO; lda = 2048; K = 2048; Bt = (const bf16_t*)(ws + WS_WO) + (size_t)ab * 1024 * 2048; }
                else { A = OB; lda = 1024; K = 1024; Bt = (const bf16_t*)(ws + WS_WOB) + (size_t)ab * 1024 * 1024; } }
            else if (j == 0) { gk = 1; A = XB; lda = 1024; K = 1024; E1.ss = SS;
                if (hb == 1 && lyr == 0) { A = (const bf16_t*)(p.out + (size_t)TH * DM); E1.ss = (const float*)(p.out + (size_t)TH * DM) + 8 * MiB; }
                if (mla) { Bt = (const bf16_t*)(ws + WS_WIN) + (size_t)ab * 512 * 1024; N = 512; E1.O = LAT; E1.ldc = 512; E1.ssl = SSL; }
                else if (ab == 0) { Bt = (const bf16_t*)(ws + WS_WKVQ); N = 9216; E1.O = KVB; E1.ldc = 6144; E1.O2 = QB; E1.ldc2 = 3072; E1.split = 6144; }
                else { Bt = (const bf16_t*)(ws + WS_WQ1); N = 3072; E1.O = QB; E1.ldc = 3072; } }
            else if (j == 2 && mla) { gk = 1; nsub = 2; A = LAT; lda = 512; K = 256; Bt = (const bf16_t*)(ws + WS_WQB) + (size_t)ab * 3072 * 256; N = 3072; E1.O = Q; E1.ldc = 3072; E1.ss = SSL; E1.nsl4 = 1; E1.inv_n = 1.0f / 256.0f; }
        }
        if (!(SKIP_MASK & 1) && gk == 1) {
            if (nsub == 2) kpe_prep(LAT, pos, (const float*)p.in[10] + ab * 192, (bf16_t*)(ws + WS_KPER));
#pragma unroll 1
            for (int sub = 0; sub < nsub; ++sub) {
                if (sub == 1) { A = LAT + 256; Bt = (const bf16_t*)(ws + WS_WKVB) + (size_t)ab * 4096 * 128; N = 4096; K = 128; E1.O = KV; E1.ldc = 4096; E1.ss = SSL + 4; E1.inv_n = 1.0f / 128.0f; E1.ssk = (float*)(ws + WS_SSK); }
                run_gemm_bf16(lds, A, lda, Bt, N, K, E1);
            }
        } else if (!(SKIP_MASK & 2) && gk == 2) {
            run_gemm(lds, A, lda, Bt, N, K, E2);
        } else if (li == 0) {
            if (!(SKIP_MASK & 4)) { prep_weights(p, lds); prep_x(xin0, XB, SS);
                prep_x((const float*)p.in[0] + (size_t)TH * DM, (bf16_t*)(p.out + (size_t)TH * DM), p.out + (size_t)TH * DM + 8 * MiB); }
        } else if (mla) {
            if (j == 4) { if (!(SKIP_MASK & 32)) mla_attn_phase(p, lds, pos, (const float*)p.in[9] + ab * 192, (const float*)p.in[10] + ab * 192); }
        } else {
            if (j == 1) { if (!(SKIP_MASK & 64)) head_prep(ab == 0 ? KVB : nullptr, QB, pos, (const float*)p.in[14], (const float*)p.in[16] + ab * 384); }
            else if (j >= 2 && j <= 4) { if (!(SKIP_MASK & 128)) dil_attn_phase(p, lds, j - 2, pos, (const float*)p.in[16] + ab * 384); }
        }
        if (ph + 1 < p.ph_hi) { if (p.ph_hi > 4096) grid.sync(); else xcd_barrier(xbar); }
        if (PROBE_MASK) { const int cat = gk == 1 ? 1 : gk == 2 ? 2 : li == 0 ? 3 : mla ? (j == 1 ? 4 : j == 3 ? 5 : 6) : (j == 1 ? 7 : 8);
            if ((PROBE_MASK >> cat) & 1) probe_acc += __builtin_amdgcn_s_memrealtime() - probe_t0; }
    }
    if (PROBE_MASK && blockIdx.x == 0) { const unsigned long long t1 = __builtin_amdgcn_s_memrealtime(); while (__builtin_amdgcn_s_memrealtime() - t1 < probe_acc) __builtin_amdgcn_s_sleep(16); }
}
constexpr int N_PHASES = 2 * NPH_HALF - 1;

extern "C" void kernel_launch(void* const* d_in, const int* in_sizes, int n_in, void* d_out, int out_size, void* d_ws, size_t ws_size, hipStream_t stream) {
    static int grid_blocks = 0;
    if (!grid_blocks) {
        int dev = 0, cus = 0, per_cu = 0;
        (void)hipGetDevice(&dev);
        (void)hipDeviceGetAttribute(&cus, hipDeviceAttributeMultiprocessorCount, dev);
        (void)hipFuncSetAttribute((const void*)mega, hipFuncAttributeMaxDynamicSharedMemorySize, LDS_BYTES);
        (void)hipOccupancyMaxActiveBlocksPerMultiprocessor(&per_cu, (const void*)mega, NTHR, LDS_BYTES);
        (void)hipGetLastError();
        grid_blocks = cus > 0 ? cus : 256;
        if (ws_size < WS_END || n_in != 20) { fprintf(stderr, "kernel_launch: workspace %zu < %zu or n_in %d != 20\n", ws_size, (size_t)WS_END, n_in); }
    }
    (void)hipMemsetAsync((unsigned char*)d_ws + WS_BAR, 0, XCD_BAR_WORDS * sizeof(unsigned), stream);
    Params p{};
    for (int i = 0; i < 20; ++i) p.in[i] = d_in[i];
    p.out = (float*)d_out; p.ws = (unsigned char*)d_ws;
#if ONE_LAUNCH
    p.ph_lo = 0; p.ph_hi = N_PHASES;
    void* args[] = {&p};
    hipError_t e = hipLaunchCooperativeKernel((const void*)mega, dim3(grid_blocks), dim3(NTHR), args, LDS_BYTES, stream);
    if (e != hipSuccess) fprintf(stderr, "cooperative launch failed: %s (grid %d)\n", hipGetErrorString(e), grid_blocks);
#else
    for (int ph = 0; ph < N_PHASES; ++ph) { p.ph_lo = ph; p.ph_hi = ph + 1; hipLaunchKernelGGL(mega, dim3(grid_blocks), dim3(NTHR), LDS_BYTES, stream, p); }
#endif
}
```

```cpp
#include <hip/hip_runtime.h>
#include <hip/hip_cooperative_groups.h>
#include <cstdio>
#include <cstdint>
namespace cg = cooperative_groups;

#ifndef ONE_LAUNCH
#define ONE_LAUNCH 1
#endif

__device__ __forceinline__ int opaque_tid() { int t = (int)threadIdx.x; asm volatile("" : "+v"(t)); return t; }
__device__ __forceinline__ int opaque_bid() { int b = (int)blockIdx.x; asm volatile("" : "+s"(b)); return b; }
namespace pg8 {
#define PG8_LAS __attribute__((address_space(3)))
typedef unsigned short bf16_t;
typedef short bf16x8 __attribute__((ext_vector_type(8)));
typedef float f32x4 __attribute__((ext_vector_type(4)));
typedef unsigned u32x4 __attribute__((ext_vector_type(4)));
constexpr int BM = 256, BK = 64, HALF = 128, HTB = HALF * BK * 2  , STAGE_BYTES = 8 * HTB, NXCD = 8, WGM = 8;

__host__ __device__ __forceinline__ int lds_byte(int r, int c) { const int st = (r >> 4) * 2 + (c >> 5), rr = r & 15, cc = c & 31, ob = rr * 64 + cc * 2; return st * 1024 + (ob ^ (((ob >> 9) & 1) << 5)); }
__host__ __device__ __forceinline__ void stage_rc(int b, int& R, int& C) { const int st = b / 1024, sb = b % 1024, swz = sb ^ (((sb >> 9) & 1) << 5); R = (st >> 1) * 16 + swz / 64; C = (st & 1) * 32 + (swz % 64) / 2; }
__host__ __device__ __forceinline__ int perm32(int rho) { const int n = rho >> 4, i = rho & 15; return 8 * (i >> 2) + 4 * n + (i & 3); }
struct Unit { int pm, pn; };
struct Gemm { const bf16_t* A; const bf16_t* Bt; int M, N, K, lda; };
struct StaticOrder {
    int nM, nN, nwg, G, c;
    __host__ __device__ void init(int M, int N, int G_, int c_) { nM = M / BM; nN = N / BM; nwg = nM * nN; G = G_; c = c_; }
    __host__ __device__ bool next(int i, Unit& u) const {
        const long L = (long)i * G + c; if (L >= nwg) return false;
        int wgid = (int)L; { const int q = nwg / NXCD, r = nwg % NXCD, xcd = wgid % NXCD, off = wgid / NXCD; wgid = (xcd < r ? xcd * (q + 1) : r * (q + 1) + (xcd - r) * q) + off; }
        const int nig = WGM * nN, gid = wgid / nig, fm = gid * WGM, gsz = (nM - fm) < WGM ? (nM - fm) : WGM;
        u.pm = fm + ((wgid % nig) % gsz); u.pn = (wgid % nig) / gsz; return true;
    }
    __device__ __forceinline__ void a_ready(const Unit&) const {}
    __device__ __forceinline__ void done(const Unit&) const {}
};
__device__ __forceinline__ unsigned cvt_pk_bf16(float lo, float hi) { unsigned r; asm volatile("v_cvt_pk_bf16_f32 %0, %1, %2" : "=v"(r) : "v"(lo), "v"(hi)); return r; }
template <class Epi, class Sched>
__device__ __forceinline__ void gemm_phase(PG8_LAS unsigned char* lds, const Gemm g, const Sched& S, const Epi& E) {
    const int tid = opaque_tid(), wid = __builtin_amdgcn_readfirstlane(tid >> 6), lane = tid & 63, wr = wid >> 2, wc = wid & 3, fr = lane & 15, fq = lane >> 4;
    const int K = g.K, nt = K / BK;
    unsigned voffA[2], voffB[2];
#pragma unroll
    for (int i = 0; i < 2; ++i) { int R, C; stage_rc(tid * 16 + i * 8192, R, C); const int Rb = Epi::PERM ? ((R & ~31) + perm32(R & 31)) : R;
        voffA[i] = (unsigned)(R * g.lda + C) * 2u; voffB[i] = (unsigned)(Rb * K + C) * 2u; }
    const size_t kstep = (size_t)(BK * 2);
    const size_t hstep = (size_t)HALF * K * 2, hstepA = (size_t)HALF * g.lda * 2;
    const size_t tstep = 2 * hstep, tstepA = 2 * hstepA;
    const unsigned ldsw = (unsigned)wid * 1024u;
    const int aoff = lds_byte(wr * 64 + fr, fq * 8), boff = lds_byte(wc * 32 + fr, fq * 8);
#define PG8_SA(b, h) (((b) * 2 + (h)) * HTB)
#define PG8_SB(b, h) ((4 + (b) * 2 + (h)) * HTB)
#define PG8_STAGE(bufoff, gbase, voff) do { _Pragma("unroll") for (int _i = 0; _i < 2; ++_i) \
        __builtin_amdgcn_global_load_lds((const unsigned*)((const char*)(gbase) + (voff)[_i]), (PG8_LAS unsigned*)(lds + (bufoff) + ldsw + _i * 8192), 16, 0, 0); } while (0)
#define PG8_LDA(dst, b, h) do { _Pragma("unroll") for (int m = 0; m < 4; ++m) _Pragma("unroll") for (int k = 0; k < 2; ++k) dst[m][k] = *(const PG8_LAS bf16x8*)(lds + PG8_SA(b, h) + aoff + m * 2048 + k * 1024); } while (0)
#define PG8_LDB(dst, b, h) do { _Pragma("unroll") for (int n = 0; n < 2; ++n) _Pragma("unroll") for (int k = 0; k < 2; ++k) dst[n][k] = *(const PG8_LAS bf16x8*)(lds + PG8_SB(b, h) + boff + n * 2048 + k * 1024); } while (0)
#define PG8_MMA(ai, bj, At, Bt) do { __builtin_amdgcn_s_setprio(1); _Pragma("unroll") for (int m = 0; m < 4; ++m) _Pragma("unroll") for (int n = 0; n < 2; ++n) _Pragma("unroll") for (int k = 0; k < 2; ++k) \
        acc[ai][bj][m][n] = __builtin_amdgcn_mfma_f32_16x16x32_bf16(Bt[n][k], At[m][k], acc[ai][bj][m][n], 0, 0, 0); __builtin_amdgcn_s_setprio(0); } while (0)
#define PG8_WAIT_V(n) asm volatile("s_waitcnt vmcnt(" #n ")" ::: "memory")
#define PG8_WAIT_L(n) asm volatile("s_waitcnt lgkmcnt(" #n ")" ::: "memory")
#define PG8_BAR __builtin_amdgcn_s_barrier()
#define PG8_SCHED __builtin_amdgcn_sched_barrier(0)
#define PG8_TOUCH(gA, gB) do { if (nt >= 4) { const int r_ = tid >> 1, kt_ = 2 + (tid & 1); \
        __builtin_amdgcn_global_load_lds((const unsigned*)((const char*)(gA) + (size_t)r_ * g.lda * 2 + kt_ * 128), (PG8_LAS unsigned*)(lds + 131072 + 6144 + wid * 256), 4, 0, 0); \
        __builtin_amdgcn_global_load_lds((const unsigned*)((const char*)(gB) + (size_t)r_ * K * 2 + kt_ * 128), (PG8_LAS unsigned*)(lds + 131072 + 6144 + wid * 256), 4, 0, 0); } } while (0)
    Unit cur, nxt; int ui = 0;
    if (!S.next(0, cur)) return;
    f32x4 acc[2][2][4][2];
#pragma unroll
    for (int a = 0; a < 2; ++a)
#pragma unroll
        for (int b = 0; b < 2; ++b)
#pragma unroll
            for (int m = 0; m < 4; ++m)
#pragma unroll
                for (int n = 0; n < 2; ++n) acc[a][b][m][n] = (f32x4){0.f, 0.f, 0.f, 0.f};
    if constexpr (Epi::INIT_ACC) E.init_acc(acc, cur, wr, wc, fr, fq);
    bf16x8 At[4][2], B0[2][2], B1[2][2];
    const char* cA = (const char*)g.A + (size_t)cur.pm * tstepA; const char* cB = (const char*)g.Bt + (size_t)cur.pn * tstep;
    S.a_ready(cur);
    PG8_TOUCH(cA, cB);
    PG8_STAGE(PG8_SB(0, 0), cB, voffB); PG8_STAGE(PG8_SA(0, 0), cA, voffA); PG8_STAGE(PG8_SB(0, 1), cB + hstep, voffB); PG8_STAGE(PG8_SA(0, 1), cA + hstepA, voffA);
    if (wr == 1) PG8_BAR;
    PG8_WAIT_V(4); PG8_BAR;
    PG8_STAGE(PG8_SB(1, 0), cB + kstep, voffB); PG8_STAGE(PG8_SA(1, 0), cA + kstep, voffA); PG8_STAGE(PG8_SB(1, 1), cB + hstep + kstep, voffB);
    PG8_WAIT_V(6); PG8_BAR;
    for (;;) {
        const bool has_next = S.next(ui + 1, nxt);
        const char* nA = has_next ? (const char*)g.A + (size_t)nxt.pm * tstepA : cA; const char* nB = has_next ? (const char*)g.Bt + (size_t)nxt.pn * tstep : cB;
        for (int t = 0; t < nt; t += 2) {
            const bool last = (t == nt - 2);
            const char* a1 = cA + (size_t)(t + 1) * kstep;
            const char* a2 = last ? nA : cA + (size_t)(t + 2) * kstep; const char* b2 = last ? nB : cB + (size_t)(t + 2) * kstep;
            const char* a3 = a2 + kstep; const char* b3 = b2 + kstep;
            if (last && has_next) S.a_ready(nxt);
            PG8_LDB(B0, 0, 0); PG8_SCHED; PG8_LDA(At, 0, 0); PG8_STAGE(PG8_SA(1, 1), a1 + hstepA, voffA);
            PG8_WAIT_L(8); PG8_BAR; PG8_WAIT_L(0); PG8_MMA(0, 0, At, B0); PG8_BAR; PG8_SCHED;
            PG8_LDB(B1, 0, 1); PG8_STAGE(PG8_SB(0, 0), b2, voffB);
            PG8_BAR; PG8_WAIT_L(0); PG8_MMA(0, 1, At, B1); PG8_BAR;
            PG8_LDA(At, 0, 1); PG8_STAGE(PG8_SA(0, 0), a2, voffA);
            PG8_BAR; PG8_WAIT_L(0); PG8_MMA(1, 0, At, B0); PG8_BAR; PG8_SCHED;
            PG8_STAGE(PG8_SB(0, 1), b2 + hstep, voffB);
            PG8_WAIT_V(6); PG8_BAR; PG8_MMA(1, 1, At, B1); PG8_BAR;
            PG8_LDB(B0, 1, 0); PG8_SCHED; PG8_LDA(At, 1, 0); PG8_STAGE(PG8_SA(0, 1), a2 + hstepA, voffA);
            PG8_WAIT_L(8); PG8_BAR; PG8_WAIT_L(0); PG8_MMA(0, 0, At, B0); PG8_BAR; PG8_SCHED;
            PG8_LDB(B1, 1, 1); PG8_STAGE(PG8_SB(1, 0), b3, voffB);
            PG8_BAR; PG8_WAIT_L(0); PG8_MMA(0, 1, At, B1); PG8_BAR;
            PG8_LDA(At, 1, 1); PG8_STAGE(PG8_SA(1, 0), a3, voffA);
            PG8_BAR; PG8_WAIT_L(0); PG8_MMA(1, 0, At, B0); PG8_BAR; PG8_SCHED;
            PG8_STAGE(PG8_SB(1, 1), b3 + hstep, voffB);
            PG8_WAIT_V(6); PG8_BAR; PG8_MMA(1, 1, At, B1); PG8_BAR;
        }
        if (has_next) PG8_TOUCH(nA, nB);
        if constexpr (!Epi::AFTER_DRAIN) { E(acc, cur, wr, wc, fr, fq); S.done(cur); }
        if (!has_next) break;
#pragma unroll
        for (int a = 0; a < 2; ++a)
#pragma unroll
            for (int b = 0; b < 2; ++b)
#pragma unroll
                for (int m = 0; m < 4; ++m)
#pragma unroll
                    for (int n = 0; n < 2; ++n) acc[a][b][m][n] = (f32x4){0.f, 0.f, 0.f, 0.f};
        if constexpr (Epi::INIT_ACC) E.init_acc(acc, nxt, wr, wc, fr, fq);
        cur = nxt; cA = nA; cB = nB; ++ui;
    }
    PG8_WAIT_V(0);
    if (wr == 0) PG8_BAR;
    PG8_BAR;
    if constexpr (Epi::AFTER_DRAIN) { E.fused(acc, cur, wr, wc, fr, fq, lds, wid, lane); S.done(cur); }
#undef PG8_TOUCH
#undef PG8_SA
#undef PG8_SB
#undef PG8_STAGE
#undef PG8_LDA
#undef PG8_LDB
#undef PG8_MMA
#undef PG8_WAIT_V
#undef PG8_WAIT_L
#undef PG8_BAR
#undef PG8_SCHED
}
}
using pg8::bf16_t; using pg8::bf16x8; using pg8::f32x4; using pg8::u32x4;
#define LAS __attribute__((address_space(3)))
typedef short s16x4 __attribute__((ext_vector_type(4)));
typedef float f32x16 __attribute__((ext_vector_type(16)));
typedef unsigned u32x2 __attribute__((ext_vector_type(2)));

constexpr int SEQ = 2048, DM = 1024, NBATCH = 16, TT = NBATCH * SEQ, TH = TT / 2, BH = NBATCH / 2, DFF = 4096;
constexpr float EPS = 1e-6f, LOG2E = 1.4426950408889634f, LOG2_THETA = 13.287712379549449f;
constexpr int NTHR = 512;
constexpr int LDS_BYTES = 131072 + 8192;
constexpr int RS_OFF = 131072 + 2048;
constexpr size_t MiB = (size_t)1 << 20;
constexpr size_t WS_WIN = 0, WS_WQB = WS_WIN + 2 * MiB, WS_WKVB = WS_WQB + 3 * MiB, WS_WO = WS_WKVB + 4 * MiB, WS_WKVQ = WS_WO + 8 * MiB, WS_WQ1 = WS_WKVQ + 18 * MiB,
                 WS_WOB = WS_WQ1 + 6 * MiB, WS_W1 = WS_WOB + 4 * MiB, WS_W2 = WS_W1 + 32 * MiB, WS_XB = WS_W2 + 32 * MiB, WS_SS = WS_XB + 32 * MiB, WS_LSE = WS_SS + 1 * MiB,
                 WS_BAR = WS_LSE + 768 * 1024, WS_SSL = WS_LSE + 1 * MiB, WS_BIG = WS_SSL + 1 * MiB;
constexpr size_t WS_LAT = WS_BIG, WS_Q = WS_LAT + 16 * MiB, WS_KV = WS_Q + 96 * MiB, WS_KPE = WS_KV + 128 * MiB, WS_AO = WS_KPE + 32 * MiB;
constexpr size_t WS_SSK = WS_KPE, WS_KPER = WS_KPE + 8 * MiB;
constexpr size_t WS_KVB = WS_BIG, WS_QB = WS_BIG + 192 * MiB, WS_OB = WS_BIG + 288 * MiB;
constexpr size_t WS_H = WS_BIG + 192 * MiB;
constexpr size_t WS_OB2 = WS_XB, WS_LSE2 = WS_SSL;
constexpr size_t WS_END = WS_BIG + 336 * MiB;

struct Params { const void* in[20]; float* out; unsigned char* ws; int ph_lo, ph_hi; };

__device__ __forceinline__ unsigned cvtpk(float lo, float hi) { unsigned r; asm volatile("v_cvt_pk_bf16_f32 %0, %1, %2" : "=v"(r) : "v"(lo), "v"(hi)); return r; }
__device__ __forceinline__ float bf_lo(unsigned w) { return __uint_as_float(w << 16); }
__device__ __forceinline__ float bf_hi(unsigned w) { return __uint_as_float(w & 0xffff0000u); }
#define UNPACK8(W_, V_) do { const u32x4 t_ = (W_); V_[0] = bf_lo(t_[0]); V_[1] = bf_hi(t_[0]); V_[2] = bf_lo(t_[1]); V_[3] = bf_hi(t_[1]); V_[4] = bf_lo(t_[2]); V_[5] = bf_hi(t_[2]); V_[6] = bf_lo(t_[3]); V_[7] = bf_hi(t_[3]); } while (0)
#define PACK8(V_) ((u32x4){cvtpk(V_[0], V_[1]), cvtpk(V_[2], V_[3]), cvtpk(V_[4], V_[5]), cvtpk(V_[6], V_[7])})
__device__ __forceinline__ void sincos_rev(float pos, float invf_rev, float& s, float& c) {
    float rev = pos * invf_rev; rev = rev - floorf(rev);
    s = __builtin_amdgcn_sinf(rev); c = __builtin_amdgcn_cosf(rev);
}

constexpr int NCV = 7;
__device__ __forceinline__ void cvt_job(const float* __restrict__ W, int K, int N, const float* __restrict__ gain, bf16_t* __restrict__ dst, int ldo, int& base, LAS float* tile) {
    const int tk = K / 64, tn = N / 64, nt = tk * tn, G = (int)gridDim.x, tid = opaque_tid();
    int start = (opaque_bid() - (base % G)); if (start < 0) start += G;
    for (int t0 = start; t0 < nt; t0 += NCV * G) {
        f32x4 v[NCV][2]; float g[NCV][2];
#pragma unroll
        for (int q = 0; q < NCV; ++q) { const int t = t0 + q * G; if (t < nt) { const int kt = t / tn, ntile = t - kt * tn;
#pragma unroll
            for (int i = 0; i < 2; ++i) { const int k = (tid >> 4) + 32 * i, n4 = (tid & 15) * 4;
                v[q][i] = *(const f32x4*)(W + (size_t)(kt * 64 + k) * N + ntile * 64 + n4); g[q][i] = gain ? gain[kt * 64 + k] : 1.0f; } } }
        __syncthreads();
#pragma unroll
        for (int q = 0; q < NCV; ++q) { const int t = t0 + q * G; if (t < nt) { LAS float* tq = tile + q * (64 * 65);
#pragma unroll
            for (int i = 0; i < 2; ++i) { const int k = (tid >> 4) + 32 * i, n4 = (tid & 15) * 4;
                tq[(n4 + 0) * 65 + k] = v[q][i].x * g[q][i]; tq[(n4 + 1) * 65 + k] = v[q][i].y * g[q][i]; tq[(n4 + 2) * 65 + k] = v[q][i].z * g[q][i]; tq[(n4 + 3) * 65 + k] = v[q][i].w * g[q][i]; } } }
        __syncthreads();
#pragma unroll
        for (int q = 0; q < NCV; ++q) { const int t = t0 + q * G; if (t < nt) { const int kt = t / tn, ntile = t - kt * tn; const int n = tid >> 3, k8 = (tid & 7) * 8;
            const LAS float* tp = tile + q * (64 * 65) + n * 65 + k8;
            u32x4 w; w.x = cvtpk(tp[0], tp[1]); w.y = cvtpk(tp[2], tp[3]); w.z = cvtpk(tp[4], tp[5]); w.w = cvtpk(tp[6], tp[7]);
            *(u32x4*)(dst + (size_t)(ntile * 64 + n) * ldo + kt * 64 + k8) = w; } }
    }
    base += nt;
}
__device__ __forceinline__ void zero_fill(bf16_t* dst, int rows, int cols8, int ld) {
    const size_t n = (size_t)rows * cols8;
    for (size_t i = (size_t)opaque_bid() * NTHR + opaque_tid(); i < n; i += (size_t)gridDim.x * NTHR) { const size_t r = i / cols8, c = i - r * cols8; *(u32x4*)(dst + r * ld + c * 8) = (u32x4){0u, 0u, 0u, 0u}; }
}
__device__ void prep_weights(const Params& p, LAS unsigned char* lds) {
    LAS float* tile = (LAS float*)lds;
    unsigned char* ws = p.ws;
    const float* attn_norm = (const float*)p.in[2]; const float* mlp_norm = (const float*)p.in[3];
    int base = 0;
    for (int a = 0; a < 2; ++a) {
        cvt_job((const float*)p.in[4] + (size_t)a * 1024 * 448, 1024, 448, attn_norm + a * 1024, (bf16_t*)(ws + WS_WIN) + (size_t)a * 512 * 1024, 1024, base, tile);
        cvt_job((const float*)p.in[7] + (size_t)a * 256 * 3072, 256, 3072, (const float*)p.in[5] + a * 256, (bf16_t*)(ws + WS_WQB) + (size_t)a * 3072 * 256, 256, base, tile);
        cvt_job((const float*)p.in[8] + (size_t)a * 128 * 4096, 128, 4096, (const float*)p.in[6] + a * 128, (bf16_t*)(ws + WS_WKVB) + (size_t)a * 4096 * 128, 128, base, tile);
        cvt_job((const float*)p.in[11] + (size_t)a * 2048 * 1024, 2048, 1024, nullptr, (bf16_t*)(ws + WS_WO) + (size_t)a * 1024 * 2048, 2048, base, tile);
        cvt_job((const float*)p.in[17] + (size_t)a * 1024 * 1024, 1024, 1024, nullptr, (bf16_t*)(ws + WS_WOB) + (size_t)a * 1024 * 1024, 1024, base, tile);
        zero_fill((bf16_t*)(ws + WS_WIN) + (size_t)a * 512 * 1024 + (size_t)448 * 1024, 64, 128, 1024);
    }
    cvt_job((const float*)p.in[13], 1024, 6144, (const float*)p.in[12], (bf16_t*)(ws + WS_WKVQ), 1024, base, tile);
    cvt_job((const float*)p.in[15], 1024, 3072, attn_norm + 2 * 1024, (bf16_t*)(ws + WS_WKVQ) + (size_t)6144 * 1024, 1024, base, tile);
    cvt_job((const float*)p.in[15] + (size_t)1024 * 3072, 1024, 3072, attn_norm + 3 * 1024, (bf16_t*)(ws + WS_WQ1), 1024, base, tile);
    for (int l = 0; l < 4; ++l) {
        cvt_job((const float*)p.in[18] + (size_t)l * 1024 * 4096, 1024, 4096, mlp_norm + l * 1024, (bf16_t*)(ws + WS_W1) + (size_t)l * 4096 * 1024, 1024, base, tile);
        cvt_job((const float*)p.in[19] + (size_t)l * 4096 * 1024, 4096, 1024, nullptr, (bf16_t*)(ws + WS_W2) + (size_t)l * 1024 * 4096, 4096, base, tile);
    }
    __syncthreads();
}
__device__ void prep_x(const float* __restrict__ x, bf16_t* __restrict__ xb, float* __restrict__ ss) {
    const int tid_ = opaque_tid(), lane = tid_ & 63, gw = opaque_bid() * 8 + (tid_ >> 6), nw = gridDim.x * 8;
    for (int r0 = gw; r0 < TH; r0 += 4 * nw) {
        f32x4 v[4][4];
#pragma unroll
        for (int q = 0; q < 4; ++q) { const int r = r0 + q * nw; if (r < TH) {
#pragma unroll
            for (int i = 0; i < 4; ++i) v[q][i] = *(const f32x4*)(x + (size_t)r * 1024 + i * 256 + lane * 4); } }
#pragma unroll
        for (int q = 0; q < 4; ++q) { const int r = r0 + q * nw; if (r < TH) { bf16_t* br = xb + (size_t)r * 1024; float s_ = 0.f;
#pragma unroll
            for (int i = 0; i < 4; ++i) { const f32x4 w = v[q][i]; s_ += w.x * w.x + w.y * w.y + w.z * w.z + w.w * w.w;
                *(u32x2*)(br + i * 256 + lane * 4) = (u32x2){cvtpk(w.x, w.y), cvtpk(w.z, w.w)}; }
#pragma unroll
            for (int o = 1; o < 64; o <<= 1) s_ += __shfl_xor(s_, o);
            if (lane < 16) ss[(size_t)r * 16 + lane] = lane == 0 ? s_ : 0.f; } }
    }
}

struct EpiBf16S {
    static constexpr bool PERM = true, AFTER_DRAIN = false, INIT_ACC = false;
    bf16_t* O; int ldc; bf16_t* O2; int ldc2; int split; const float* ss; int nsl4; float inv_n; int act; float* ssl; float* ssk; const LAS float* rs; int pm0;
    __device__ __forceinline__ void operator()(const f32x4 (&acc)[2][2][4][2], const pg8::Unit& u, int wr, int wc, int fr, int fq) const {
        const int row0 = u.pm * 256 + wr * 64 + fr; int colt = u.pn * 256; bf16_t* base = O; int ld = ldc;
        if (colt >= split) { base = O2; colt -= split; ld = ldc2; }
        const int col0 = colt + wc * 32 + 8 * fq;
#pragma unroll
        for (int ai = 0; ai < 2; ++ai)
#pragma unroll
            for (int m = 0; m < 4; ++m) { const int row = row0 + ai * 128 + m * 16; float sc = 1.0f;
                if (ss) { if (u.pm == pm0) sc = rs[(wr * 4 + wc) * 128 + ai * 64 + m * 16 + fr];
                    else { const f32x4* sp = (const f32x4*)(ss + (size_t)row * 16); f32x4 a = sp[0]; if (nsl4 == 4) a = (a + sp[1]) + (sp[2] + sp[3]); sc = rsqrtf(((a.x + a.y) + (a.z + a.w)) * inv_n + EPS); } }
                bf16_t* rowp = base + (size_t)row * ld + col0; float sa = 0.f, sb = 0.f;
#pragma unroll
                for (int bj = 0; bj < 2; ++bj) { f32x4 v0 = acc[ai][bj][m][0] * sc, v1 = acc[ai][bj][m][1] * sc;
                    if (act) {
#pragma unroll
                        for (int j = 0; j < 4; ++j) { const float a0 = fmaxf(v0[j], 0.f), a1 = fmaxf(v1[j], 0.f); v0[j] = a0 * a0; v1[j] = a1 * a1; } }
                    float sq = 0.f; if (ssl || ssk) sq = ((v0[0] * v0[0] + v0[1] * v0[1]) + (v0[2] * v0[2] + v0[3] * v0[3])) + ((v1[0] * v1[0] + v1[1] * v1[1]) + (v1[2] * v1[2] + v1[3] * v1[3]));
                    if (bj == 0) sa = sq; else sb = sq;
                    u32x4 w; w.x = cvtpk(v0[0], v0[1]); w.y = cvtpk(v0[2], v0[3]); w.z = cvtpk(v1[0], v1[1]); w.w = cvtpk(v1[2], v1[3]);
                    *(u32x4*)(rowp + bj * 128) = w; }
                if (ssk) { float sk_ = sa; sk_ += __shfl_xor(sk_, 16); sk_ += __shfl_xor(sk_, 32); if (fq == 0) ssk[((size_t)row * 16 + u.pn) * 4 + wc] = sk_; }
                if (ssl) { sa += __shfl_xor(sa, 16); sa += __shfl_xor(sa, 32); sb += __shfl_xor(sb, 16); sb += __shfl_xor(sb, 32);
                    if (fq == 0) { float* sr_ = ssl + (size_t)row * 16; if (u.pn == 0) sr_[wc] = sa + sb; else { sr_[4 + wc] = sa; sr_[8 + wc] = sb; } } } }
    }
};
struct EpiRes {
    static constexpr bool PERM = false, AFTER_DRAIN = false, INIT_ACC = true;
    const float* xin; float* xout; bf16_t* xb; float* ss;
    __device__ __forceinline__ void init_acc(f32x4 (&acc)[2][2][4][2], const pg8::Unit& u, int wr, int wc, int fr, int fq) const {
        const int row0 = u.pm * 256 + wr * 64 + fr, col0 = u.pn * 256 + wc * 32 + 4 * fq;
#pragma unroll
        for (int ai = 0; ai < 2; ++ai)
#pragma unroll
            for (int m = 0; m < 4; ++m) { const size_t off = (size_t)(row0 + ai * 128 + m * 16) * 1024 + col0;
#pragma unroll
                for (int bj = 0; bj < 2; ++bj)
#pragma unroll
                    for (int n = 0; n < 2; ++n) acc[ai][bj][m][n] = *(const f32x4*)(xin + off + bj * 128 + n * 16); }
    }
    __device__ __forceinline__ void operator()(const f32x4 (&acc)[2][2][4][2], const pg8::Unit& u, int wr, int wc, int fr, int fq) const {
        const int row0 = u.pm * 256 + wr * 64 + fr, col0 = u.pn * 256 + wc * 32 + 4 * fq;
#pragma unroll
        for (int ai = 0; ai < 2; ++ai)
#pragma unroll
            for (int m = 0; m < 4; ++m) { const int row = row0 + ai * 128 + m * 16; const size_t off = (size_t)row * 1024 + col0; float s = 0.f;
#pragma unroll
                for (int bj = 0; bj < 2; ++bj)
#pragma unroll
                    for (int n = 0; n < 2; ++n) { const int c = bj * 128 + n * 16; const f32x4 o = acc[ai][bj][m][n];
                        *(f32x4*)(xout + off + c) = o; s += (o.x * o.x + o.y * o.y) + (o.z * o.z + o.w * o.w);
                        *(u32x2*)(xb + off + c) = (u32x2){cvtpk(o.x, o.y), cvtpk(o.z, o.w)}; }
                s += __shfl_xor(s, 16); s += __shfl_xor(s, 32);
                if (fq == 0) ss[(size_t)row * 16 + u.pn * 4 + wc] = s; }
    }
};
template <class Epi> __device__ __forceinline__ void run_gemm(LAS unsigned char* lds, const bf16_t* A, int lda, const bf16_t* Bt, int N, int K, const Epi& E) {
    pg8::Gemm g{A, Bt, TH, N, K, lda}; pg8::StaticOrder S; S.init(TH, N, (int)gridDim.x, opaque_bid());
    pg8::gemm_phase<Epi, pg8::StaticOrder>(lds, g, S, E);
}
__device__ __forceinline__ void run_gemm_bf16(LAS unsigned char* lds, const bf16_t* A, int lda, const bf16_t* Bt, int N, int K, EpiBf16S E) {
    pg8::Gemm g{A, Bt, TH, N, K, lda}; pg8::StaticOrder S; S.init(TH, N, (int)gridDim.x, opaque_bid());
    E.rs = (const LAS float*)(lds + RS_OFF); E.pm0 = -1;
    pg8::Unit u0;
    if (E.ss && S.next(0, u0)) {
        const int tid = opaque_tid(), wid = tid >> 6, lane = tid & 63, wr = wid >> 2;
        LAS float* tab = (LAS float*)(lds + RS_OFF) + wid * 128;
#pragma unroll
        for (int hh = 0; hh < 2; ++hh) { const int row = u0.pm * 256 + hh * 128 + wr * 64 + lane;
            const f32x4* sp = (const f32x4*)(E.ss + (size_t)row * 16); f32x4 a = sp[0]; if (E.nsl4 == 4) a = (a + sp[1]) + (sp[2] + sp[3]);
            tab[hh * 64 + lane] = rsqrtf(((a.x + a.y) + (a.z + a.w)) * E.inv_n + EPS); }
        E.pm0 = u0.pm;
    }
    pg8::gemm_phase<EpiBf16S, pg8::StaticOrder>(lds, g, S, E);
}

__device__ void lat_prep(bf16_t* lat) {
    const int tid_ = opaque_tid(), lane = tid_ & 63, gw = opaque_bid() * 8 + (tid_ >> 6), nw = gridDim.x * 8;
    for (int t = gw; t < TH; t += nw) {
        bf16_t* p = lat + (size_t)t * 512 + lane * 8; const u32x4 w = *(const u32x4*)p; float v[8]; UNPACK8(w, v);
        float s = 0.f;
#pragma unroll
        for (int e = 0; e < 8; ++e) s += v[e] * v[e];
        s += __shfl_xor(s, 1); s += __shfl_xor(s, 2); s += __shfl_xor(s, 4); s += __shfl_xor(s, 8);
        const float s32 = s + __shfl_xor(s, 16);
        const float rstd = lane < 32 ? rsqrtf(s32 * (1.0f / 256.0f) + EPS) : rsqrtf(s * (1.0f / 128.0f) + EPS);
        if (lane < 48) {
#pragma unroll
            for (int e = 0; e < 8; ++e) v[e] *= rstd;
            *(u32x4*)p = PACK8(v); }
    }
}
__device__ void kpe_prep(const bf16_t* lat, const int* pos, const float* gk, bf16_t* kper) {
    const int tid = opaque_tid(), grp = tid >> 3, l8 = tid & 7;
    float invf[8], g[8];
#pragma unroll
    for (int e = 0; e < 8; ++e) { invf[e] = exp2f(-(float)((l8 & 3) * 8 + e) * (LOG2_THETA / 32.0f)) * 0.15915494309189535f; g[e] = gk[128 + l8 * 8 + e]; }
    for (int t = opaque_bid() * 64 + grp; t < TH; t += (int)gridDim.x * 64) {
        const float posf = (float)pos[t];
        const u32x4 w = *(const u32x4*)(lat + (size_t)t * 512 + 384 + l8 * 8); float v[8]; UNPACK8(w, v);
#pragma unroll
        for (int e = 0; e < 8; ++e) { const float y = v[e] * g[e]; const float pr = __shfl_xor(y, 4); float sn_, cs_; sincos_rev(posf, invf[e], sn_, cs_);
            v[e] = (l8 & 4) ? y * cs_ + pr * sn_ : y * cs_ - pr * sn_; }
        *(u32x4*)(kper + (size_t)t * 64 + l8 * 8) = PACK8(v);
    }
}
__device__ void head_prep(bf16_t* kbuf  , bf16_t* qbuf, const int* pos, const float* gk, const float* gq) {
    const int tid_ = opaque_tid(), lane = tid_ & 63, gw = opaque_bid() * 8 + (tid_ >> 6), nw = gridDim.x * 8;
    const float qscale = 0.08838834764831845f * LOG2E;
    const int c16 = lane & 15;
    float invf[8];
#pragma unroll
    for (int e = 0; e < 8; ++e) invf[e] = exp2f(-(float)((c16 & 7) * 8 + e) * (LOG2_THETA / 64.0f)) * 0.15915494309189535f;
    for (int t = gw; t < TH; t += nw) {
        const float posf = (float)pos[t];
        float cs[8], sn[8];
#pragma unroll
        for (int e = 0; e < 8; ++e) sincos_rev(posf, invf[e], sn[e], cs[e]);
        u32x4 wv[6];
#pragma unroll
        for (int itr = 0; itr < 6; ++itr) wv[itr] = *(const u32x4*)(kbuf + (size_t)t * 6144 + (itr * 4 + (lane >> 4)) * 128 + c16 * 8);
#pragma unroll
        for (int itr = 0; itr < 6; ++itr) { const bool isq = false;
            const int hh = (isq ? itr - 6 : itr) * 4 + (lane >> 4), g = hh >> 3;
            bf16_t* p = isq ? qbuf + (size_t)t * 3072 + hh * 128 + c16 * 8 : kbuf + (size_t)t * 6144 + hh * 128 + c16 * 8;
            const float* gn = (isq ? gq : gk) + g * 128 + c16 * 8;
            float v[8]; UNPACK8(wv[itr], v); float s = 0.f;
#pragma unroll
            for (int e = 0; e < 8; ++e) s += v[e] * v[e];
            s += __shfl_xor(s, 1); s += __shfl_xor(s, 2); s += __shfl_xor(s, 4); s += __shfl_xor(s, 8);
            const float rstd = rsqrtf(s * (1.0f / 128.0f) + EPS), osc = isq ? qscale : 1.0f;
#pragma unroll
            for (int e = 0; e < 8; ++e) { const float y = v[e] * rstd * gn[e]; const float pr = __shfl_xor(y, 8);
                v[e] = ((c16 & 8) ? y * cs[e] + pr * sn[e] : y * cs[e] - pr * sn[e]) * osc; }
            *(u32x4*)p = PACK8(v); }
    }
}

struct AttnItem { const bf16_t* o2; const float* lse2; const bf16_t* q; const bf16_t* k; const bf16_t* kpe; const bf16_t* v; bf16_t* o; float* lse; const int* pos; const float* gq; const float* gk; const float* ssk; const float* ssl; int q_ld, k_ld, kpe_ld, v_ld, o_ld, P0, ld, merge; };
__device__ __forceinline__ int v_st(int k, int c) { const int kk = (k & ~0xC) | ((k & 4) << 1) | ((k & 8) >> 1); return ((kk >> 3) * 4 + (c >> 5)) * 512 + ((kk & 7) * 32 + (c & 31)) * 2; }
__device__ __forceinline__ int v_rd_base(int lane) { return ((lane & 3) << 3) | (((lane >> 2) & 3) << 6) | (((lane >> 4) & 1) << 5) | (((lane >> 5) & 1) << 8); }
#define PK4(P, B_, OUT) do { unsigned a0_ = cvtpk(P[B_+0], P[B_+1]), a1_ = cvtpk(P[B_+2], P[B_+3]); unsigned b0_ = cvtpk(P[B_+4], P[B_+5]), b1_ = cvtpk(P[B_+6], P[B_+7]); \
        auto r0_ = __builtin_amdgcn_permlane32_swap(a0_, b0_, false, false); auto r1_ = __builtin_amdgcn_permlane32_swap(a1_, b1_, false, false); \
        u32x4 w_ = {r0_[0], r1_[0], r0_[1], r1_[1]}; OUT = w_; } while (0)
__device__ __forceinline__ bf16x8 as_bf(u32x4 w) { return *reinterpret_cast<bf16x8*>(&w); }

template <int DQK, int MODE>
__device__ __forceinline__ void attn_block(const AttnItem& it, LAS unsigned char* lds) {
    constexpr int RS = DQK * 2, SHM_K = 64 * RS, SHM_V = 16384, ND0 = DQK / 16, KCH = DQK / 8, NKC = (64 * KCH) / 512;
    const int tid = opaque_tid(), wid = __builtin_amdgcn_readfirstlane(tid >> 6), lane = tid & 63, r32 = lane & 31, hi = lane >> 5;
    const int ld = it.ld, Lm1 = (2048 >> ld) - 1, lsh = 11 - ld;
#define TOK(p) (MODE == 0 ? (p) : ((((p) & Lm1) << ld) | ((p) >> lsh)))
#define LOF(p) (MODE == 0 ? 0 : max((p) - 128, (p) & ~Lm1))
    const int q0 = it.P0 + wid * 32, qp = q0 + r32;
    const int span = qp - LOF(qp), lo_w = LOF(q0), lo_last = LOF(q0 + 31);
    LAS unsigned char* V_lds = lds; LAS unsigned char* K_lds = lds + 2 * SHM_V;
    const int j_lo = LOF(it.P0) >> 6, NT = (it.P0 >> 6) + 4 - j_lo;
    const int sr = tid >> 4, sc = (tid & 15) * 8, vst0 = v_st(sr, sc), vst1 = v_st(32 + sr, sc);
    constexpr int NSET = (MODE == 1) ? 2 : 1;
    bf16x8 sk[NSET][NKC], sv0[NSET], sv1[NSET]; f32x4 s_k4 = {0.f, 0.f, 0.f, 0.f}, s_p4 = {0.f, 0.f, 0.f, 0.f};
    constexpr int KRS_OFF = 2 * SHM_V + 2 * SHM_K;
    int offk[NKC], offv0 = sr * it.v_ld + sc, offv1 = (32 + sr) * it.v_ld + sc;
#pragma unroll
    for (int i_ = 0; i_ < NKC; ++i_) { const int c_ = tid + 512 * i_, row_ = c_ / KCH, cc_ = c_ - row_ * KCH; offk[i_] = (DQK == 192 && cc_ >= 16) ? row_ * it.kpe_ld + (cc_ - 16) * 8 : row_ * it.k_ld + cc_ * 8; }
#define SLOAD(S_, kb_) do { if (MODE == 0) { const bf16_t* kt_ = it.k + (size_t)(kb_) * it.k_ld; const bf16_t* pt_ = it.kpe + (size_t)(kb_) * it.kpe_ld; const bf16_t* vt_ = it.v + (size_t)(kb_) * it.v_ld; \
            _Pragma("unroll") for (int i_ = 0; i_ < NKC; ++i_) { const int c_ = tid + 512 * i_, row_ = c_ / KCH, cc_ = c_ - row_ * KCH; sk[S_][i_] = *(const bf16x8*)(((DQK == 192 && cc_ >= 16) ? pt_ : kt_) + offk[i_]); } \
            sv0[S_] = *(const bf16x8*)(vt_ + offv0); sv1[S_] = *(const bf16x8*)(vt_ + offv1); \
            if (tid < 64) { s_k4 = *(const f32x4*)(it.ssk + (size_t)((kb_) + tid) * 64); s_p4 = *(const f32x4*)(it.ssl + (size_t)((kb_) + tid) * 16); } } else { \
        _Pragma("unroll") for (int i_ = 0; i_ < NKC; ++i_) { const int c_ = tid + 512 * i_, row_ = c_ / KCH, cc_ = c_ - row_ * KCH; const int tk_ = TOK((kb_) + row_); \
            sk[S_][i_] = *(const bf16x8*)(it.k + (size_t)tk_ * it.k_ld + cc_ * 8); } \
        { const int t0_ = TOK((kb_) + sr), t1_ = TOK((kb_) + 32 + sr); sv0[S_] = *(const bf16x8*)(it.v + (size_t)t0_ * it.v_ld + sc); sv1[S_] = *(const bf16x8*)(it.v + (size_t)t1_ * it.v_ld + sc); } } } while (0)
#define SWRITE(S_, bf_) do { _Pragma("unroll") for (int i_ = 0; i_ < NKC; ++i_) { const int c_ = tid + 512 * i_, row_ = c_ / KCH, cc_ = c_ - row_ * KCH; const int swz_ = (((DQK == 128) ? row_ : (row_ >> 1)) & 7) << 4; \
            *(LAS bf16x8*)(K_lds + (bf_) * SHM_K + row_ * RS + ((cc_ * 16) ^ swz_)) = sk[S_][i_]; } \
        *(LAS bf16x8*)(V_lds + (bf_) * SHM_V + vst0) = sv0[S_]; *(LAS bf16x8*)(V_lds + (bf_) * SHM_V + vst1) = sv1[S_]; \
        if (MODE == 0 && tid < 64) { const f32x4 a_ = s_k4 + s_p4; *(LAS float*)(lds + KRS_OFF + (bf_) * 256 + tid * 4) = rsqrtf(((a_.x + a_.y) + (a_.z + a_.w)) * (1.0f / 192.0f) + EPS); } } while (0)
    float m_reg = -1e30f, l_reg = 0.f; f32x16 o[4];
#pragma unroll
    for (int d = 0; d < 4; ++d)
#pragma unroll
        for (int r = 0; r < 16; ++r) o[d][r] = 0.f;
    SLOAD(0, j_lo * 64); if (MODE == 1) SLOAD(NSET - 1, j_lo * 64 + 64);
    bf16x8 qr[ND0];
    {
      constexpr int NR = (MODE == 0) ? 2 : 4;
      constexpr int R0 = (MODE == 0) ? 8 : 0;
      constexpr float QS = ((MODE == 0) ? 0.07216878364870322f : 0.08838834764831845f) * LOG2E;
      constexpr float FSTEP = LOG2_THETA / ((MODE == 0) ? 32.0f : 64.0f);
      const int tq_ = TOK(qp);
      const bf16_t* qrow = it.q + (size_t)tq_ * it.q_ld + hi * 8;
      u32x4 raw[ND0]; float ssq = 0.f;
#pragma unroll
      for (int d0 = 0; d0 < ND0; ++d0) raw[d0] = *(const u32x4*)(qrow + d0 * 16);
      const float posf = (float)it.pos[tq_];
#pragma unroll
      for (int d0 = 0; d0 < ND0; ++d0) { float v[8]; UNPACK8(raw[d0], v);
#pragma unroll
          for (int e = 0; e < 8; ++e) ssq += v[e] * v[e]; }
      { auto rr = __builtin_amdgcn_permlane32_swap(__float_as_uint(ssq), __float_as_uint(ssq), false, false); ssq = __uint_as_float(rr[0]) + __uint_as_float(rr[1]); }
      const float rq = rsqrtf(ssq * (1.0f / (float)DQK) + EPS) * QS;
      const float* gp = it.gq + hi * 8;
#pragma unroll
      for (int d0 = 0; d0 < ND0; ++d0) {
          if (d0 >= R0 + NR && d0 < R0 + 2 * NR) continue;
          f32x4 g0 = *(const f32x4*)(gp + d0 * 16), g1 = *(const f32x4*)(gp + d0 * 16 + 4);
          if (MODE == 0 && d0 < 8) { g0 *= *(const f32x4*)(it.gk + hi * 8 + d0 * 16); g1 *= *(const f32x4*)(it.gk + hi * 8 + d0 * 16 + 4); }
          float v[8]; UNPACK8(raw[d0], v);
#pragma unroll
          for (int e = 0; e < 8; ++e) v[e] *= rq * (e < 4 ? g0[e & 3] : g1[e & 3]);
          if (d0 >= R0 && d0 < R0 + NR) {
              const f32x4 h0 = *(const f32x4*)(gp + (d0 + NR) * 16), h1 = *(const f32x4*)(gp + (d0 + NR) * 16 + 4);
              float w[8]; UNPACK8(raw[d0 + NR], w);
#pragma unroll
              for (int e = 0; e < 8; ++e) { w[e] *= rq * (e < 4 ? h0[e & 3] : h1[e & 3]);
                  float sn_, cs_; sincos_rev(posf, exp2f(-(float)((d0 - R0) * 16 + hi * 8 + e) * FSTEP) * 0.15915494309189535f, sn_, cs_);
                  const float x1 = v[e], x2 = w[e]; v[e] = x1 * cs_ - x2 * sn_; w[e] = x2 * cs_ + x1 * sn_; }
              qr[d0 + NR] = as_bf(PACK8(w)); }
          qr[d0] = as_bf(PACK8(v)); } }
    SWRITE(0, 0); __syncthreads();
    const int swzr = (((DQK == 128) ? r32 : (r32 >> 1)) & 7) << 4;
    int kro[4];
#pragma unroll
    for (int dd = 0; dd < 4; ++dd) kro[dd] = r32 * RS + ((dd * 32 + hi * 16) ^ swzr);
#pragma unroll 1
    for (int t2 = 0; t2 < NT; t2 += NSET) {
#pragma unroll
      for (int us = 0; us < NSET; ++us) { const int t = t2 + us; if (t < NT) {
        const int kb = (j_lo + t) * 64, buf = t & 1;
        if (MODE == 1) { if (t + 2 < NT) SLOAD(us, kb + 128); } else { if (t + 1 < NT) SLOAD(0, kb + 64); }
#pragma unroll 1
        for (int hf = 0; hf < 2; ++hf) {
            const int kh = kb + 32 * hf;
            const bool act = (kh <= q0 + 31) && (kh + 31 >= lo_w);
            if (act) {
                f32x16 p0;
#pragma unroll
                for (int r = 0; r < 16; ++r) p0[r] = 0.f;
                { const LAS unsigned char* kbp = K_lds + buf * SHM_K + hf * (32 * RS);
#pragma unroll
                  for (int d0 = 0; d0 < ND0; ++d0) {
                      const bf16x8 b0 = *(const LAS bf16x8*)(kbp + kro[d0 & 3] + (d0 >> 2) * 128);
                      p0 = __builtin_amdgcn_mfma_f32_32x32x16_bf16(b0, qr[d0], p0, 0, 0, 0); } }
                if (MODE == 0) { const LAS float* kr_ = (const LAS float*)(lds + KRS_OFF + buf * 256) + 32 * hf + 4 * hi;
#pragma unroll
                    for (int j4 = 0; j4 < 4; ++j4) { const f32x4 s4 = *(const LAS f32x4*)(kr_ + 8 * j4);
#pragma unroll
                        for (int e = 0; e < 4; ++e) p0[4 * j4 + e] *= s4[e]; } }
                if (!((kh + 31 <= q0) && (kh >= lo_last))) {
                    const int dq = qp - kh - 4 * hi; const float NEG = -__builtin_inff();
#pragma unroll
                    for (int r = 0; r < 16; ++r) { const int c = (r & 3) + 8 * (r >> 2); if ((unsigned)(dq - c) > (unsigned)span) p0[r] = NEG; } }
                float pmax = p0[0];
#pragma unroll
                for (int r = 1; r < 16; ++r) pmax = fmaxf(pmax, p0[r]);
                { auto rr = __builtin_amdgcn_permlane32_swap(__float_as_uint(pmax), __float_as_uint(pmax), false, false); pmax = fmaxf(__uint_as_float(rr[0]), __uint_as_float(rr[1])); }
                float mn = m_reg, alpha = 1.0f;
                const bool resc = !__all(pmax - m_reg <= 8.0f);
                if (resc) { mn = fmaxf(m_reg, pmax); alpha = __builtin_amdgcn_exp2f(m_reg - mn); m_reg = mn; }
                float ps = 0.f;
#pragma unroll
                for (int r = 0; r < 16; ++r) { p0[r] = __builtin_amdgcn_exp2f(p0[r] - mn); ps += p0[r]; }
                { auto rr = __builtin_amdgcn_permlane32_swap(__float_as_uint(ps), __float_as_uint(ps), false, false); ps = __uint_as_float(rr[0]) + __uint_as_float(rr[1]); }
                l_reg = l_reg * alpha + ps;
                u32x4 pa0, pa1; PK4(p0, 0, pa0); PK4(p0, 8, pa1);
                if (resc) {
#pragma unroll
                    for (int d = 0; d < 4; ++d)
#pragma unroll
                        for (int r = 0; r < 16; ++r) o[d][r] *= alpha; }
                const unsigned vb = (unsigned)(uintptr_t)(V_lds + buf * SHM_V + hf * 8192) + (unsigned)v_rd_base(lane);
#define TRRD(dst, off) asm volatile("ds_read_b64_tr_b16 %0, %1 offset:%2" : "=&v"(dst) : "v"(vb), "i"(off) : "memory")
#define PV_D0(d0) do { s16x4 l0, l1, h0, h1; constexpr int b_ = (d0) * 512; \
                TRRD(l0, b_); TRRD(h0, b_ + 2048); TRRD(l1, b_ + 4096); TRRD(h1, b_ + 6144); \
                asm volatile("s_waitcnt lgkmcnt(0)" ::: "memory"); __builtin_amdgcn_sched_barrier(0); \
                o[d0] = __builtin_amdgcn_mfma_f32_32x32x16_bf16((bf16x8){l0[0], l0[1], l0[2], l0[3], h0[0], h0[1], h0[2], h0[3]}, as_bf(pa0), o[d0], 0, 0, 0); \
                o[d0] = __builtin_amdgcn_mfma_f32_32x32x16_bf16((bf16x8){l1[0], l1[1], l1[2], l1[3], h1[0], h1[1], h1[2], h1[3]}, as_bf(pa1), o[d0], 0, 0, 0); } while (0)
                PV_D0(0); PV_D0(1); PV_D0(2); PV_D0(3);
#undef PV_D0
#undef TRRD
            }
        }
        if (t + 1 < NT) SWRITE((NSET - 1) - us, buf ^ 1);
        __syncthreads();
      } }
    }
    const int tq = TOK(qp);
    float a_cur = 1.0f / l_reg, a_pa = 0.f, a_pb = 0.f;
    if (MODE == 1) {
        const float lse_cur = m_reg + __builtin_amdgcn_logf(l_reg); float lse_new = lse_cur;
        if (it.merge) { const float la = it.lse[(size_t)tq * 8], lb = it.lse2[(size_t)tq * 8]; const float mx = fmaxf(fmaxf(la, lb), lse_cur);
            const float ea = __builtin_amdgcn_exp2f(la - mx), eb = __builtin_amdgcn_exp2f(lb - mx), ec = __builtin_amdgcn_exp2f(lse_cur - mx); const float inv = 1.0f / (ea + eb + ec);
            lse_new = mx + __builtin_amdgcn_logf(ea + eb + ec); a_pa = ea * inv; a_pb = eb * inv; a_cur *= ec * inv; }
        if (hi == 0) it.lse[(size_t)tq * 8] = lse_new;
    }
    bf16_t* orow = it.o + (size_t)tq * it.o_ld + hi * 8;
    const bf16_t* orow2 = (MODE == 1) ? it.o2 + (size_t)tq * it.o_ld + hi * 8 : nullptr;
#pragma unroll
    for (int d0 = 0; d0 < 4; ++d0) {
#pragma unroll
        for (int r = 0; r < 16; ++r) o[d0][r] *= a_cur;
        u32x4 w0, w1; PK4(o[d0], 0, w0); PK4(o[d0], 8, w1);
        if (MODE == 1 && it.merge) {
            const u32x4 q0w = *(const u32x4*)(orow + d0 * 32), q1w = *(const u32x4*)(orow + d0 * 32 + 16);
            const u32x4 r0w = *(const u32x4*)(orow2 + d0 * 32), r1w = *(const u32x4*)(orow2 + d0 * 32 + 16);
            float a[8], b[8], c[8];
            UNPACK8(w0, a); UNPACK8(q0w, b); UNPACK8(r0w, c);
#pragma unroll
            for (int e = 0; e < 8; ++e) a[e] += b[e] * a_pa + c[e] * a_pb;
            w0 = PACK8(a);
            UNPACK8(w1, a); UNPACK8(q1w, b); UNPACK8(r1w, c);
#pragma unroll
            for (int e = 0; e < 8; ++e) a[e] += b[e] * a_pa + c[e] * a_pb;
            w1 = PACK8(a);
        }
        *(u32x4*)(orow + d0 * 32) = w0; *(u32x4*)(orow + d0 * 32 + 16) = w1;
    }
#undef SLOAD
#undef SWRITE
#undef TOK
#undef LOF
}

__device__ void mla_attn_phase(const Params& p, LAS unsigned char* lds, const int* pos, const float* gq, const float* gk) {
    unsigned char* ws = p.ws;
    const int G_ = (int)gridDim.x, bid_ = opaque_bid(), vb_ = (G_ % 8 == 0) ? (bid_ % 8) * (G_ / 8) + bid_ / 8 : bid_;
    for (int item = vb_; item < BH * 16 * 4; item += G_) {
        const int bh = item >> 2, pr = item & 3, b = bh >> 4, h = bh & 15; const size_t tb = (size_t)b * SEQ;
        AttnItem it; it.q = (const bf16_t*)(ws + WS_Q) + tb * 3072 + h * 192; it.q_ld = 3072;
        it.k = (const bf16_t*)(ws + WS_KV) + tb * 4096 + h * 256; it.k_ld = 4096; it.kpe = (const bf16_t*)(ws + WS_KPER) + tb * 64; it.kpe_ld = 64; it.gk = gk; it.ssk = (const float*)(ws + WS_SSK) + (tb * 16 + h) * 4; it.ssl = (const float*)(ws + WS_SSL) + tb * 16 + 8;
        it.v = (const bf16_t*)(ws + WS_KV) + tb * 4096 + h * 256 + 128; it.v_ld = 4096; it.o = (bf16_t*)(ws + WS_AO) + tb * 2048 + h * 128; it.o_ld = 2048;
        it.lse = nullptr; it.o2 = nullptr; it.lse2 = nullptr; it.ld = 0; it.merge = 0; it.pos = pos + tb; it.gq = gq;
#pragma unroll 1
        for (int k2 = 0; k2 < 2; ++k2) { it.P0 = (k2 == 0 ? 7 - pr : pr) * 256; attn_block<192, 0>(it, lds); }
    }
}
__device__ void dil_attn_phase(const Params& p, LAS unsigned char* lds, int pg, const int* pos, const float* gq) {
    unsigned char* ws = p.ws;
    const int G_ = (int)gridDim.x, bid_ = opaque_bid(), vb_ = (G_ % 8 == 0) ? (bid_ % 8) * (G_ / 8) + bid_ / 8 : bid_;
    const int nitems = pg == 0 ? 2 * BH * 8 * 8 : BH * 8 * 8;
#pragma unroll 1
    for (int item = vb_; item < nitems; item += G_) {
        const int g = pg == 0 ? (item >= BH * 8 * 8 ? 1 : 0) : 2, li_ = item & (BH * 8 * 8 - 1);
        const int bh = li_ >> 3, qb = li_ & 7, b = bh >> 3, h = bh & 7, hh = g * 8 + h; const size_t tb = (size_t)b * SEQ;
        AttnItem it; it.q = (const bf16_t*)(ws + WS_QB) + tb * 3072 + hh * 128; it.q_ld = 3072;
        it.k = (const bf16_t*)(ws + WS_KVB) + tb * 6144 + hh * 128; it.k_ld = 6144; it.kpe = nullptr; it.kpe_ld = 0; it.gk = nullptr; it.ssk = nullptr; it.ssl = nullptr;
        it.v = (const bf16_t*)(ws + WS_KVB) + tb * 6144 + 3072 + hh * 128; it.v_ld = 6144; it.o_ld = 1024;
        it.o = (bf16_t*)(ws + (g == 1 ? WS_OB2 : WS_OB)) + tb * 1024 + h * 128; it.lse = (float*)(ws + (g == 1 ? WS_LSE2 : WS_LSE)) + tb * 8 + h;
        it.o2 = (const bf16_t*)(ws + WS_OB2) + tb * 1024 + h * 128; it.lse2 = (const float*)(ws + WS_LSE2) + tb * 8 + h;
        it.ld = 2 * g; it.merge = g == 2; it.P0 = qb * 256; it.pos = pos + tb; it.gq = gq + g * 128;
        attn_block<128, 1>(it, lds);
    }
}

#define XB_TMO      128
#define XB_XCNT(j)  (256  + 64 * (j))
#define XB_XSUB(j)  (1280 + 64 * (j))
#define XB_XGEN(j)  (2304 + 64 * (j))
#define XB_TOP      3328
#define XB_TOPGEN   3392
#define XCD_BAR_WORDS 3456
#define XB_SPIN_CAP (1u << 18)

__device__ __forceinline__ unsigned xb_ld(unsigned* p)              { return __hip_atomic_load(p, __ATOMIC_RELAXED, __HIP_MEMORY_SCOPE_AGENT); }
__device__ __forceinline__ unsigned xb_add(unsigned* p, unsigned v) { return __hip_atomic_fetch_add(p, v, __ATOMIC_RELAXED, __HIP_MEMORY_SCOPE_AGENT); }
__device__ __forceinline__ unsigned xb_xcc_id() { return (unsigned)__builtin_amdgcn_s_getreg((3 << 11) | 20) & 0xFu; }
#define XB_SPIN(cond, bar) do { unsigned _sp = 0; while (cond) { __builtin_amdgcn_s_sleep(1); \
    if ((++_sp & 255u) == 0u) { if (xb_ld(&(bar)[XB_TMO])) break; if (_sp > XB_SPIN_CAP) { atomicAdd(&(bar)[XB_TMO], 1u); break; } } } } while (0)

struct XcdBarrier {
    unsigned* bar; unsigned x;
    volatile LAS unsigned* st;
};

__device__ __forceinline__ XcdBarrier xcd_barrier_post(unsigned* bar, volatile LAS unsigned* st) {
    XcdBarrier b; b.bar = bar; b.x = xb_xcc_id(); b.st = st;
    if (threadIdx.x == 0) (void)xb_add(&bar[XB_XCNT(b.x)], 1u);
    return b;
}
__device__ __forceinline__ void xcd_barrier_complete(unsigned* bar, unsigned x, unsigned& nloc, unsigned& nx) {
    const unsigned G = gridDim.x * gridDim.y * gridDim.z;
    unsigned sum, cnt, mine, sp = 0u;
    for (;;) {
        sum = 0u; cnt = 0u; mine = 0u;
#pragma unroll
        for (unsigned j = 0; j < 16; ++j) { const unsigned c = xb_ld(&bar[XB_XCNT(j)]); sum += c; cnt += (c > 0u) ? 1u : 0u; mine = (j == x) ? c : mine; }
        if (sum == G) break;
        __builtin_amdgcn_s_sleep(1);
        if ((++sp & 255u) == 0u) { if (xb_ld(&bar[XB_TMO])) break; if (sp > XB_SPIN_CAP) { atomicAdd(&bar[XB_TMO], 1u); break; } }
    }
    nloc = mine > 0u ? mine : 1u; nx = cnt > 0u ? cnt : 1u;
}

__device__ __forceinline__ void xcd_barrier(const XcdBarrier& b) {
    asm volatile("s_waitcnt vmcnt(0)" ::: "memory");
    __syncthreads();
    if (threadIdx.x == 0) {
        unsigned* bar = b.bar;
        __builtin_amdgcn_s_waitcnt(0);
        unsigned nloc = b.st[0], nx = b.st[1];
        if (nloc == 0u) { xcd_barrier_complete(bar, b.x, nloc, nx); b.st[0] = nloc; b.st[1] = nx; }
        const unsigned old = xb_add(&bar[XB_XSUB(b.x)], 1u);
        const unsigned gen = old / nloc;
        if (old + 1u == (gen + 1u) * nloc) {
            __builtin_amdgcn_fence(__ATOMIC_RELEASE, "agent");
            asm volatile("s_waitcnt vmcnt(0)" ::: "memory");
            const unsigned og = xb_add(&bar[XB_TOP], 1u);
            const unsigned tg = og / nx;
            if (og + 1u == (tg + 1u) * nx) xb_add(&bar[XB_TOPGEN], 1u);
            else XB_SPIN(xb_ld(&bar[XB_TOPGEN]) == tg, bar);
            __builtin_amdgcn_fence(__ATOMIC_ACQUIRE, "agent");
            xb_add(&bar[XB_XGEN(b.x)], 1u);
            asm volatile("s_waitcnt vmcnt(0)" ::: "memory");
        } else {
            XB_SPIN(xb_ld(&bar[XB_XGEN(b.x)]) == gen, bar);
            __builtin_amdgcn_fence(__ATOMIC_ACQUIRE, "agent");
            asm volatile("s_waitcnt vmcnt(0)" ::: "memory");
        }
    }
    __syncthreads();
}

constexpr int NPH_HALF = 1 + 2 * 6 + 7 + 6;
#ifndef SKIP_MASK
#define SKIP_MASK 0
#endif
__global__ void __launch_bounds__(NTHR) mega(Params p) {
    extern __shared__ __attribute__((aligned(16))) unsigned char lds_raw[];
    LAS unsigned char* lds = (LAS unsigned char*)lds_raw;
    cg::grid_group grid = cg::this_grid();
    unsigned char* ws = p.ws;
    bf16_t* XB = (bf16_t*)(ws + WS_XB); float* SS = (float*)(ws + WS_SS); bf16_t* HB = (bf16_t*)(ws + WS_H);
    bf16_t* LAT = (bf16_t*)(ws + WS_LAT); bf16_t* Q = (bf16_t*)(ws + WS_Q); bf16_t* KV = (bf16_t*)(ws + WS_KV); bf16_t* KPE = (bf16_t*)(ws + WS_KPE); bf16_t* AO = (bf16_t*)(ws + WS_AO);
    bf16_t* KVB = (bf16_t*)(ws + WS_KVB); bf16_t* QB = (bf16_t*)(ws + WS_QB); bf16_t* OB = (bf16_t*)(ws + WS_OB);
#ifndef PROBE_MASK
#define PROBE_MASK 0
#endif
    unsigned long long probe_acc = 0ull;
    volatile LAS unsigned* bar_st = (volatile LAS unsigned*)(lds + 131072);
    if (threadIdx.x < 4) bar_st[threadIdx.x] = 0u;
    __syncthreads();
    XcdBarrier xbar = xcd_barrier_post((unsigned*)(ws + WS_BAR), bar_st);
#pragma unroll 1
    for (int ph = p.ph_lo; ph < p.ph_hi; ++ph) {
        const unsigned long long probe_t0 = PROBE_MASK ? __builtin_amdgcn_s_memrealtime() : 0ull;
        const int hb = ph >= NPH_HALF ? 1 : 0, li = hb ? ph - NPH_HALF + 1 : ph;
        const size_t toff = (size_t)hb * TH;
        const float* xin0 = (const float*)p.in[0] + toff * DM; float* xo = p.out + toff * DM; const int* pos = (const int*)p.in[1] + toff;
        int lyr = 0, j = -1;
        if (li >= 20) { lyr = 3; const int jm = li - 20; j = jm == 0 ? 0 : (jm <= 2 ? jm + 1 : jm + 2); }
        else if (li >= 13) { lyr = 2; const int jm = li - 13; j = jm <= 3 ? jm : jm + 1; }
        else if (li >= 1) { lyr = (li - 1) / 6; const int jm = (li - 1) - lyr * 6; j = jm == 0 ? 0 : jm == 1 ? 2 : jm + 2; }
        const bool mla = lyr < 2; const int ab = lyr & 1;
        int gk = 0;
        const bf16_t* A = nullptr; const bf16_t* Bt = nullptr; int lda = 0, N = 0, K = 0, nsub = 1;
        EpiBf16S E1{nullptr, 0, nullptr, 0, 1 << 30, nullptr, 4, 1.0f / 1024.0f, 0, nullptr, nullptr, nullptr, -1}; EpiRes E2{nullptr, nullptr, XB, SS};
        float* SSL = (float*)(ws + WS_SSL);
        if (li > 0) {
            if (j == 6) { gk = 1; A = XB; lda = 1024; Bt = (const bf16_t*)(ws + WS_W1) + (size_t)lyr * 4096 * 1024; N = 4096; K = 1024; E1.O = HB; E1.ldc = 4096; E1.ss = SS; E1.act = 1; }
            else if (j == 7) { gk = 2; A = HB; lda = 4096; Bt = (const bf16_t*)(ws + WS_W2) + (size_t)lyr * 1024 * 4096; N = 1024; K = 4096; E2.xin = xo; E2.xout = xo; }
            else if (j == 5) { gk = 2; N = 1024; E2.xin = lyr == 0 ? xin0 : xo; E2.xout = xo;
                if (mla) { A = AO; lda = 2048; K = 2048; Bt = (const bf16_t*)(ws + WS_WO) + (size_t)ab * 1024 * 2048; }
                else { A = OB; lda = 1024; K = 1024; Bt = (const bf16_t*)(ws + WS_WOB) + (size_t)ab * 1024 * 1024; } }
            else if (j == 0) { gk = 1; A = XB; lda = 1024; K = 1024; E1.ss = SS;
                if (hb == 1 && lyr == 0) { A = (const bf16_t*)(p.out + (size_t)TH * DM); E1.ss = (const float*)(p.out + (size_t)TH * DM) + 8 * MiB; }
                if (mla) { Bt = (const bf16_t*)(ws + WS_WIN) + (size_t)ab * 512 * 1024; N = 512; E1.O = LAT; E1.ldc = 512; E1.ssl = SSL; }
                else if (ab == 0) { Bt = (const bf16_t*)(ws + WS_WKVQ); N = 9216; E1.O = KVB; E1.ldc = 6144; E1.O2 = QB; E1.ldc2 = 3072; E1.split = 6144; }
                else { Bt = (const bf16_t*)(ws + WS_WQ1); N = 3072; E1.O = QB; E1.ldc = 3072; } }
            else if (j == 2 && mla) { gk = 1; nsub = 2; A = LAT; lda = 512; K = 256; Bt = (const bf16_t*)(ws + WS_WQB) + (size_t)ab * 3072 * 256; N = 3072; E1.O = Q; E1.ldc = 3072; E1.ss = SSL; E1.nsl4 = 1; E1.inv_n = 1.0f / 256.0f; }
        }
        if (!(SKIP_MASK & 1) && gk == 1) {
            if (nsub == 2) kpe_prep(LAT, pos, (const float*)p.in[10] + ab * 192, (bf16_t*)(ws + WS_KPER));
#pragma unroll 1
            for (int sub = 0; sub < nsub; ++sub) {
                if (sub == 1) { A = LAT + 256; Bt = (const bf16_t*)(ws + WS_WKVB) + (size_t)ab * 4096 * 128; N = 4096; K = 128; E1.O = KV; E1.ldc = 4096; E1.ss = SSL + 4; E1.inv_n = 1.0f / 128.0f; E1.ssk = (float*)(ws + WS_SSK); }
                run_gemm_bf16(lds, A, lda, Bt, N, K, E1);
            }
        } else if (!(SKIP_MASK & 2) && gk == 2) {
            run_gemm(lds, A, lda, Bt, N, K, E2);
        } else if (li == 0) {
            if (!(SKIP_MASK & 4)) { prep_weights(p, lds); prep_x(xin0, XB, SS);
                prep_x((const float*)p.in[0] + (size_t)TH * DM, (bf16_t*)(p.out + (size_t)TH * DM), p.out + (size_t)TH * DM + 8 * MiB); }
        } else if (mla) {
            if (j == 4) { if (!(SKIP_MASK & 32)) mla_attn_phase(p, lds, pos, (const float*)p.in[9] + ab * 192, (const float*)p.in[10] + ab * 192); }
        } else {
            if (j == 1) { if (!(SKIP_MASK & 64)) head_prep(ab == 0 ? KVB : nullptr, QB, pos, (const float*)p.in[14], (const float*)p.in[16] + ab * 384); }
            else if (j >= 2 && j <= 3) { if (!(SKIP_MASK & 128)) dil_attn_phase(p, lds, j - 2, pos, (const float*)p.in[16] + ab * 384); }
        }
        if (ph + 1 < p.ph_hi) { if (p.ph_hi > 4096) grid.sync(); else xcd_barrier(xbar); }
        if (PROBE_MASK) { const int cat = gk == 1 ? 1 : gk == 2 ? 2 : li == 0 ? 3 : mla ? (j == 1 ? 4 : j == 3 ? 5 : 6) : (j == 1 ? 7 : 8);
            if ((PROBE_MASK >> cat) & 1) probe_acc += __builtin_amdgcn_s_memrealtime() - probe_t0; }
    }
    if (PROBE_MASK && blockIdx.x == 0) { const unsigned long long t1 = __builtin_amdgcn_s_memrealtime(); while (__builtin_amdgcn_s_memrealtime() - t1 < probe_acc) __builtin_amdgcn_s_sleep(16); }
}
constexpr int N_PHASES = 2 * NPH_HALF - 1;

extern "C" void kernel_launch(void* const* d_in, const int* in_sizes, int n_in, void* d_out, int out_size, void* d_ws, size_t ws_size, hipStream_t stream) {
    static int grid_blocks = 0;
    if (!grid_blocks) {
        int dev = 0, cus = 0, per_cu = 0;
        (void)hipGetDevice(&dev);
        (void)hipDeviceGetAttribute(&cus, hipDeviceAttributeMultiprocessorCount, dev);
        (void)hipFuncSetAttribute((const void*)mega, hipFuncAttributeMaxDynamicSharedMemorySize, LDS_BYTES);
        (void)hipOccupancyMaxActiveBlocksPerMultiprocessor(&per_cu, (const void*)mega, NTHR, LDS_BYTES);
        (void)hipGetLastError();
        grid_blocks = cus > 0 ? cus : 256;
        if (ws_size < WS_END || n_in != 20) { fprintf(stderr, "kernel_launch: workspace %zu < %zu or n_in %d != 20\n", ws_size, (size_t)WS_END, n_in); }
    }
    (void)hipMemsetAsync((unsigned char*)d_ws + WS_BAR, 0, XCD_BAR_WORDS * sizeof(unsigned), stream);
    Params p{};
    for (int i = 0; i < 20; ++i) p.in[i] = d_in[i];
    p.out = (float*)d_out; p.ws = (unsigned char*)d_ws;
#if ONE_LAUNCH
    p.ph_lo = 0; p.ph_hi = N_PHASES;
    void* args[] = {&p};
    hipError_t e = hipLaunchCooperativeKernel((const void*)mega, dim3(grid_blocks), dim3(NTHR), args, LDS_BYTES, stream);
    if (e != hipSuccess) fprintf(stderr, "cooperative launch failed: %s (grid %d)\n", hipGetErrorString(e), grid_blocks);
#else
    for (int ph = 0; ph < N_PHASES; ++ph) { p.ph_lo = ph; p.ph_hi = ph + 1; hipLaunchKernelGGL(mega, dim3(grid_blocks), dim3(NTHR), LDS_BYTES, stream, p); }
#endif
}
```

```cpp
#include <hip/hip_runtime.h>
#include <hip/hip_cooperative_groups.h>
#include <cstdio>
#include <cstdint>
namespace cg = cooperative_groups;

#ifndef ONE_LAUNCH
#define ONE_LAUNCH 1
#endif

__device__ __forceinline__ int opaque_tid() { int t = (int)threadIdx.x; asm volatile("" : "+v"(t)); return t; }
__device__ __forceinline__ int opaque_bid() { int b = (int)blockIdx.x; asm volatile("" : "+s"(b)); return b; }
namespace pg8 {
#define PG8_LAS __attribute__((address_space(3)))
typedef unsigned short bf16_t;
typedef short bf16x8 __attribute__((ext_vector_type(8)));
typedef float f32x4 __attribute__((ext_vector_type(4)));
typedef unsigned u32x4 __attribute__((ext_vector_type(4)));
constexpr int BM = 256, BK = 64, HALF = 128, HTB = HALF * BK * 2  , STAGE_BYTES = 8 * HTB, NXCD = 8, WGM = 8;

__host__ __device__ __forceinline__ int lds_byte(int r, int c) { const int st = (r >> 4) * 2 + (c >> 5), rr = r & 15, cc = c & 31, ob = rr * 64 + cc * 2; return st * 1024 + (ob ^ (((ob >> 9) & 1) << 5)); }
__host__ __device__ __forceinline__ void stage_rc(int b, int& R, int& C) { const int st = b / 1024, sb = b % 1024, swz = sb ^ (((sb >> 9) & 1) << 5); R = (st >> 1) * 16 + swz / 64; C = (st & 1) * 32 + (swz % 64) / 2; }
__host__ __device__ __forceinline__ int perm32(int rho) { const int n = rho >> 4, i = rho & 15; return 8 * (i >> 2) + 4 * n + (i & 3); }
struct Unit { int pm, pn; };
struct Gemm { const bf16_t* A; const bf16_t* Bt; int M, N, K, lda; };
struct StaticOrder {
    int nM, nN, nwg, G, c;
    __host__ __device__ void init(int M, int N, int G_, int c_) { nM = M / BM; nN = N / BM; nwg = nM * nN; G = G_; c = c_; }
    __host__ __device__ bool next(int i, Unit& u) const {
        const long L = (long)i * G + c; if (L >= nwg) return false;
        int wgid = (int)L; { const int q = nwg / NXCD, r = nwg % NXCD, xcd = wgid % NXCD, off = wgid / NXCD; wgid = (xcd < r ? xcd * (q + 1) : r * (q + 1) + (xcd - r) * q) + off; }
        const int nig = WGM * nN, gid = wgid / nig, fm = gid * WGM, gsz = (nM - fm) < WGM ? (nM - fm) : WGM;
        u.pm = fm + ((wgid % nig) % gsz); u.pn = (wgid % nig) / gsz; return true;
    }
    __device__ __forceinline__ void a_ready(const Unit&) const {}
    __device__ __forceinline__ void done(const Unit&) const {}
};
__device__ __forceinline__ unsigned cvt_pk_bf16(float lo, float hi) { unsigned r; asm volatile("v_cvt_pk_bf16_f32 %0, %1, %2" : "=v"(r) : "v"(lo), "v"(hi)); return r; }
template <class Epi, class Sched>
__device__ __forceinline__ void gemm_phase(PG8_LAS unsigned char* lds, const Gemm g, const Sched& S, const Epi& E) {
    const int tid = opaque_tid(), wid = __builtin_amdgcn_readfirstlane(tid >> 6), lane = tid & 63, wr = wid >> 2, wc = wid & 3, fr = lane & 15, fq = lane >> 4;
    const int K = g.K, nt = K / BK;
    unsigned voffA[2], voffB[2];
#pragma unroll
    for (int i = 0; i < 2; ++i) { int R, C; stage_rc(tid * 16 + i * 8192, R, C); const int Rb = Epi::PERM ? ((R & ~31) + perm32(R & 31)) : R;
        voffA[i] = (unsigned)(R * g.lda + C) * 2u; voffB[i] = (unsigned)(Rb * K + C) * 2u; }
    const size_t kstep = (size_t)(BK * 2);
    const size_t hstep = (size_t)HALF * K * 2, hstepA = (size_t)HALF * g.lda * 2;
    const size_t tstep = 2 * hstep, tstepA = 2 * hstepA;
    const unsigned ldsw = (unsigned)wid * 1024u;
    const int aoff = lds_byte(wr * 64 + fr, fq * 8), boff = lds_byte(wc * 32 + fr, fq * 8);
#define PG8_SA(b, h) (((b) * 2 + (h)) * HTB)
#define PG8_SB(b, h) ((4 + (b) * 2 + (h)) * HTB)
#define PG8_STAGE(bufoff, gbase, voff) do { _Pragma("unroll") for (int _i = 0; _i < 2; ++_i) \
        __builtin_amdgcn_global_load_lds((const unsigned*)((const char*)(gbase) + (voff)[_i]), (PG8_LAS unsigned*)(lds + (bufoff) + ldsw + _i * 8192), 16, 0, 0); } while (0)
#define PG8_LDA(dst, b, h) do { _Pragma("unroll") for (int m = 0; m < 4; ++m) _Pragma("unroll") for (int k = 0; k < 2; ++k) dst[m][k] = *(const PG8_LAS bf16x8*)(lds + PG8_SA(b, h) + aoff + m * 2048 + k * 1024); } while (0)
#define PG8_LDB(dst, b, h) do { _Pragma("unroll") for (int n = 0; n < 2; ++n) _Pragma("unroll") for (int k = 0; k < 2; ++k) dst[n][k] = *(const PG8_LAS bf16x8*)(lds + PG8_SB(b, h) + boff + n * 2048 + k * 1024); } while (0)
#define PG8_MMA(ai, bj, At, Bt) do { __builtin_amdgcn_s_setprio(1); _Pragma("unroll") for (int m = 0; m < 4; ++m) _Pragma("unroll") for (int n = 0; n < 2; ++n) _Pragma("unroll") for (int k = 0; k < 2; ++k) \
        acc[ai][bj][m][n] = __builtin_amdgcn_mfma_f32_16x16x32_bf16(Bt[n][k], At[m][k], acc[ai][bj][m][n], 0, 0, 0); __builtin_amdgcn_s_setprio(0); } while (0)
#define PG8_WAIT_V(n) asm volatile("s_waitcnt vmcnt(" #n ")" ::: "memory")
#define PG8_WAIT_L(n) asm volatile("s_waitcnt lgkmcnt(" #n ")" ::: "memory")
#define PG8_BAR __builtin_amdgcn_s_barrier()
#define PG8_SCHED __builtin_amdgcn_sched_barrier(0)
#define PG8_TOUCH(gA, gB) do { if (nt >= 4) { const int r_ = tid >> 1, kt_ = 2 + (tid & 1); \
        __builtin_amdgcn_global_load_lds((const unsigned*)((const char*)(gA) + (size_t)r_ * g.lda * 2 + kt_ * 128), (PG8_LAS unsigned*)(lds + 131072 + 6144 + wid * 256), 4, 0, 0); \
        __builtin_amdgcn_global_load_lds((const unsigned*)((const char*)(gB) + (size_t)r_ * K * 2 + kt_ * 128), (PG8_LAS unsigned*)(lds + 131072 + 6144 + wid * 256), 4, 0, 0); } } while (0)
    Unit cur, nxt; int ui = 0;
    if (!S.next(0, cur)) return;
    f32x4 acc[2][2][4][2];
#pragma unroll
    for (int a = 0; a < 2; ++a)
#pragma unroll
        for (int b = 0; b < 2; ++b)
#pragma unroll
            for (int m = 0; m < 4; ++m)
#pragma unroll
                for (int n = 0; n < 2; ++n) acc[a][b][m][n] = (f32x4){0.f, 0.f, 0.f, 0.f};
    if constexpr (Epi::INIT_ACC) E.init_acc(acc, cur, wr, wc, fr, fq);
    bf16x8 At[4][2], B0[2][2], B1[2][2];
    const char* cA = (const char*)g.A + (size_t)cur.pm * tstepA; const char* cB = (const char*)g.Bt + (size_t)cur.pn * tstep;
    S.a_ready(cur);
    PG8_TOUCH(cA, cB);
    PG8_STAGE(PG8_SB(0, 0), cB, voffB); PG8_STAGE(PG8_SA(0, 0), cA, voffA); PG8_STAGE(PG8_SB(0, 1), cB + hstep, voffB); PG8_STAGE(PG8_SA(0, 1), cA + hstepA, voffA);
    if (wr == 1) PG8_BAR;
    PG8_WAIT_V(4); PG8_BAR;
    PG8_STAGE(PG8_SB(1, 0), cB + kstep, voffB); PG8_STAGE(PG8_SA(1, 0), cA + kstep, voffA); PG8_STAGE(PG8_SB(1, 1), cB + hstep + kstep, voffB);
    PG8_WAIT_V(6); PG8_BAR;
    for (;;) {
        const bool has_next = S.next(ui + 1, nxt);
        const char* nA = has_next ? (const char*)g.A + (size_t)nxt.pm * tstepA : cA; const char* nB = has_next ? (const char*)g.Bt + (size_t)nxt.pn * tstep : cB;
        for (int t = 0; t < nt; t += 2) {
            const bool last = (t == nt - 2);
            const char* a1 = cA + (size_t)(t + 1) * kstep;
            const char* a2 = last ? nA : cA + (size_t)(t + 2) * kstep; const char* b2 = last ? nB : cB + (size_t)(t + 2) * kstep;
            const char* a3 = a2 + kstep; const char* b3 = b2 + kstep;
            if (last && has_next) S.a_ready(nxt);
            PG8_LDB(B0, 0, 0); PG8_SCHED; PG8_LDA(At, 0, 0); PG8_STAGE(PG8_SA(1, 1), a1 + hstepA, voffA);
            PG8_WAIT_L(8); PG8_BAR; PG8_WAIT_L(0); PG8_MMA(0, 0, At, B0); PG8_BAR; PG8_SCHED;
            PG8_LDB(B1, 0, 1); PG8_STAGE(PG8_SB(0, 0), b2, voffB);
            PG8_BAR; PG8_WAIT_L(0); PG8_MMA(0, 1, At, B1); PG8_BAR;
            PG8_LDA(At, 0, 1); PG8_STAGE(PG8_SA(0, 0), a2, voffA);
            PG8_BAR; PG8_WAIT_L(0); PG8_MMA(1, 0, At, B0); PG8_BAR; PG8_SCHED;
            PG8_STAGE(PG8_SB(0, 1), b2 + hstep, voffB);
            PG8_WAIT_V(6); PG8_BAR; PG8_MMA(1, 1, At, B1); PG8_BAR;
            PG8_LDB(B0, 1, 0); PG8_SCHED; PG8_LDA(At, 1, 0); PG8_STAGE(PG8_SA(0, 1), a2 + hstepA, voffA);
            PG8_WAIT_L(8); PG8_BAR; PG8_WAIT_L(0); PG8_MMA(0, 0, At, B0); PG8_BAR; PG8_SCHED;
            PG8_LDB(B1, 1, 1); PG8_STAGE(PG8_SB(1, 0), b3, voffB);
            PG8_BAR; PG8_WAIT_L(0); PG8_MMA(0, 1, At, B1); PG8_BAR;
            PG8_LDA(At, 1, 1); PG8_STAGE(PG8_SA(1, 0), a3, voffA);
            PG8_BAR; PG8_WAIT_L(0); PG8_MMA(1, 0, At, B0); PG8_BAR; PG8_SCHED;
            PG8_STAGE(PG8_SB(1, 1), b3 + hstep, voffB);
            PG8_WAIT_V(6); PG8_BAR; PG8_MMA(1, 1, At, B1); PG8_BAR;
        }
        if (has_next) PG8_TOUCH(nA, nB);
        if constexpr (!Epi::AFTER_DRAIN) { E(acc, cur, wr, wc, fr, fq); S.done(cur); }
        if (!has_next) break;
#pragma unroll
        for (int a = 0; a < 2; ++a)
#pragma unroll
            for (int b = 0; b < 2; ++b)
#pragma unroll
                for (int m = 0; m < 4; ++m)
#pragma unroll
                    for (int n = 0; n < 2; ++n) acc[a][b][m][n] = (f32x4){0.f, 0.f, 0.f, 0.f};
        if constexpr (Epi::INIT_ACC) E.init_acc(acc, nxt, wr, wc, fr, fq);
        cur = nxt; cA = nA; cB = nB; ++ui;
    }
    PG8_WAIT_V(0);
    if (wr == 0) PG8_BAR;
    PG8_BAR;
    if constexpr (Epi::AFTER_DRAIN) { E.fused(acc, cur, wr, wc, fr, fq, lds, wid, lane); S.done(cur); }
#undef PG8_TOUCH
#undef PG8_SA
#undef PG8_SB
#undef PG8_STAGE
#undef PG8_LDA
#undef PG8_LDB
#undef PG8_MMA
#undef PG8_WAIT_V
#undef PG8_WAIT_L
#undef PG8_BAR
#undef PG8_SCHED
}
}
using pg8::bf16_t; using pg8::bf16x8; using pg8::f32x4; using pg8::u32x4;
#define LAS __attribute__((address_space(3)))
typedef short s16x4 __attribute__((ext_vector_type(4)));
typedef float f32x16 __attribute__((ext_vector_type(16)));
typedef unsigned u32x2 __attribute__((ext_vector_type(2)));

constexpr int SEQ = 2048, DM = 1024, NBATCH = 16, TT = NBATCH * SEQ, TH = TT / 2, BH = NBATCH / 2, DFF = 4096;
constexpr float EPS = 1e-6f, LOG2E = 1.4426950408889634f, LOG2_THETA = 13.287712379549449f;
constexpr int NTHR = 512;
constexpr int LDS_BYTES = 131072 + 8192;
constexpr int RS_OFF = 131072 + 2048;
constexpr size_t MiB = (size_t)1 << 20;
constexpr size_t WS_WIN = 0, WS_WQB = WS_WIN + 2 * MiB, WS_WKVB = WS_WQB + 3 * MiB, WS_WO = WS_WKVB + 4 * MiB, WS_WKVQ = WS_WO + 8 * MiB, WS_WQ1 = WS_WKVQ + 18 * MiB,
                 WS_WOB = WS_WQ1 + 6 * MiB, WS_W1 = WS_WOB + 4 * MiB, WS_W2 = WS_W1 + 32 * MiB, WS_XB = WS_W2 + 32 * MiB, WS_SS = WS_XB + 32 * MiB, WS_LSE = WS_SS + 1 * MiB,
                 WS_BAR = WS_LSE + 768 * 1024, WS_SSL = WS_LSE + 1 * MiB, WS_BIG = WS_SSL + 1 * MiB;
constexpr size_t WS_LAT = WS_BIG, WS_Q = WS_LAT + 16 * MiB, WS_KV = WS_Q + 96 * MiB, WS_KPE = WS_KV + 128 * MiB, WS_AO = WS_KPE + 32 * MiB;
constexpr size_t WS_SSK = WS_KPE, WS_KPER = WS_KPE + 8 * MiB;
constexpr size_t WS_KVB = WS_BIG, WS_QB = WS_BIG + 192 * MiB, WS_OB = WS_BIG + 288 * MiB;
constexpr size_t WS_H = WS_BIG + 192 * MiB;
constexpr size_t WS_OB2 = WS_XB, WS_LSE2 = WS_SSL;
constexpr size_t WS_END = WS_BIG + 336 * MiB;

struct Params { const void* in[20]; float* out; unsigned char* ws; int ph_lo, ph_hi; };

__device__ __forceinline__ unsigned cvtpk(float lo, float hi) { unsigned r; asm volatile("v_cvt_pk_bf16_f32 %0, %1, %2" : "=v"(r) : "v"(lo), "v"(hi)); return r; }
__device__ __forceinline__ float bf_lo(unsigned w) { return __uint_as_float(w << 16); }
__device__ __forceinline__ float bf_hi(unsigned w) { return __uint_as_float(w & 0xffff0000u); }
#define UNPACK8(W_, V_) do { const u32x4 t_ = (W_); V_[0] = bf_lo(t_[0]); V_[1] = bf_hi(t_[0]); V_[2] = bf_lo(t_[1]); V_[3] = bf_hi(t_[1]); V_[4] = bf_lo(t_[2]); V_[5] = bf_hi(t_[2]); V_[6] = bf_lo(t_[3]); V_[7] = bf_hi(t_[3]); } while (0)
#define PACK8(V_) ((u32x4){cvtpk(V_[0], V_[1]), cvtpk(V_[2], V_[3]), cvtpk(V_[4], V_[5]), cvtpk(V_[6], V_[7])})
__device__ __forceinline__ void sincos_rev(float pos, float invf_rev, float& s, float& c) {
    const float rev = __builtin_amdgcn_fractf(pos * invf_rev);
    s = __builtin_amdgcn_sinf(rev); c = __builtin_amdgcn_cosf(rev);
}

constexpr int NCV = 7;
__device__ __forceinline__ void cvt_job(const float* __restrict__ W, int K, int N, const float* __restrict__ gain, bf16_t* __restrict__ dst, int ldo, int& base, LAS float* tile) {
    const int tk = K / 64, tn = N / 64, nt = tk * tn, G = (int)gridDim.x, tid = opaque_tid();
    int start = (opaque_bid() - (base % G)); if (start < 0) start += G;
    for (int t0 = start; t0 < nt; t0 += NCV * G) {
        f32x4 v[NCV][2]; float g[NCV][2];
#pragma unroll
        for (int q = 0; q < NCV; ++q) { const int t = t0 + q * G; if (t < nt) { const int kt = t / tn, ntile = t - kt * tn;
#pragma unroll
            for (int i = 0; i < 2; ++i) { const int k = (tid >> 4) + 32 * i, n4 = (tid & 15) * 4;
                v[q][i] = *(const f32x4*)(W + (size_t)(kt * 64 + k) * N + ntile * 64 + n4); g[q][i] = gain ? gain[kt * 64 + k] : 1.0f; } } }
        __syncthreads();
#pragma unroll
        for (int q = 0; q < NCV; ++q) { const int t = t0 + q * G; if (t < nt) { LAS float* tq = tile + q * (64 * 65);
#pragma unroll
            for (int i = 0; i < 2; ++i) { const int k = (tid >> 4) + 32 * i, n4 = (tid & 15) * 4;
                tq[(n4 + 0) * 65 + k] = v[q][i].x * g[q][i]; tq[(n4 + 1) * 65 + k] = v[q][i].y * g[q][i]; tq[(n4 + 2) * 65 + k] = v[q][i].z * g[q][i]; tq[(n4 + 3) * 65 + k] = v[q][i].w * g[q][i]; } } }
        __syncthreads();
#pragma unroll
        for (int q = 0; q < NCV; ++q) { const int t = t0 + q * G; if (t < nt) { const int kt = t / tn, ntile = t - kt * tn; const int n = tid >> 3, k8 = (tid & 7) * 8;
            const LAS float* tp = tile + q * (64 * 65) + n * 65 + k8;
            u32x4 w; w.x = cvtpk(tp[0], tp[1]); w.y = cvtpk(tp[2], tp[3]); w.z = cvtpk(tp[4], tp[5]); w.w = cvtpk(tp[6], tp[7]);
            *(u32x4*)(dst + (size_t)(ntile * 64 + n) * ldo + kt * 64 + k8) = w; } }
    }
    base += nt;
}
__device__ __forceinline__ void zero_fill(bf16_t* dst, int rows, int cols8, int ld) {
    const size_t n = (size_t)rows * cols8;
    for (size_t i = (size_t)opaque_bid() * NTHR + opaque_tid(); i < n; i += (size_t)gridDim.x * NTHR) { const size_t r = i / cols8, c = i - r * cols8; *(u32x4*)(dst + r * ld + c * 8) = (u32x4){0u, 0u, 0u, 0u}; }
}
__device__ void prep_weights(const Params& p, LAS unsigned char* lds) {
    LAS float* tile = (LAS float*)lds;
    unsigned char* ws = p.ws;
    const float* attn_norm = (const float*)p.in[2]; const float* mlp_norm = (const float*)p.in[3];
    int base = 0;
    for (int a = 0; a < 2; ++a) {
        cvt_job((const float*)p.in[4] + (size_t)a * 1024 * 448, 1024, 448, attn_norm + a * 1024, (bf16_t*)(ws + WS_WIN) + (size_t)a * 512 * 1024, 1024, base, tile);
        cvt_job((const float*)p.in[7] + (size_t)a * 256 * 3072, 256, 3072, (const float*)p.in[5] + a * 256, (bf16_t*)(ws + WS_WQB) + (size_t)a * 3072 * 256, 256, base, tile);
        cvt_job((const float*)p.in[8] + (size_t)a * 128 * 4096, 128, 4096, (const float*)p.in[6] + a * 128, (bf16_t*)(ws + WS_WKVB) + (size_t)a * 4096 * 128, 128, base, tile);
        cvt_job((const float*)p.in[11] + (size_t)a * 2048 * 1024, 2048, 1024, nullptr, (bf16_t*)(ws + WS_WO) + (size_t)a * 1024 * 2048, 2048, base, tile);
        cvt_job((const float*)p.in[17] + (size_t)a * 1024 * 1024, 1024, 1024, nullptr, (bf16_t*)(ws + WS_WOB) + (size_t)a * 1024 * 1024, 1024, base, tile);
        zero_fill((bf16_t*)(ws + WS_WIN) + (size_t)a * 512 * 1024 + (size_t)448 * 1024, 64, 128, 1024);
    }
    cvt_job((const float*)p.in[13], 1024, 6144, (const float*)p.in[12], (bf16_t*)(ws + WS_WKVQ), 1024, base, tile);
    cvt_job((const float*)p.in[15], 1024, 3072, attn_norm + 2 * 1024, (bf16_t*)(ws + WS_WKVQ) + (size_t)6144 * 1024, 1024, base, tile);
    cvt_job((const float*)p.in[15] + (size_t)1024 * 3072, 1024, 3072, attn_norm + 3 * 1024, (bf16_t*)(ws + WS_WQ1), 1024, base, tile);
    for (int l = 0; l < 4; ++l) {
        cvt_job((const float*)p.in[18] + (size_t)l * 1024 * 4096, 1024, 4096, mlp_norm + l * 1024, (bf16_t*)(ws + WS_W1) + (size_t)l * 4096 * 1024, 1024, base, tile);
        cvt_job((const float*)p.in[19] + (size_t)l * 4096 * 1024, 4096, 1024, nullptr, (bf16_t*)(ws + WS_W2) + (size_t)l * 1024 * 4096, 4096, base, tile);
    }
    __syncthreads();
}
__device__ void prep_x(const float* __restrict__ x, bf16_t* __restrict__ xb, float* __restrict__ ss) {
    const int tid_ = opaque_tid(), lane = tid_ & 63, gw = opaque_bid() * 8 + (tid_ >> 6), nw = gridDim.x * 8;
    for (int r0 = gw; r0 < TH; r0 += 4 * nw) {
        f32x4 v[4][4];
#pragma unroll
        for (int q = 0; q < 4; ++q) { const int r = r0 + q * nw; if (r < TH) {
#pragma unroll
            for (int i = 0; i < 4; ++i) v[q][i] = *(const f32x4*)(x + (size_t)r * 1024 + i * 256 + lane * 4); } }
#pragma unroll
        for (int q = 0; q < 4; ++q) { const int r = r0 + q * nw; if (r < TH) { bf16_t* br = xb + (size_t)r * 1024; float s_ = 0.f;
#pragma unroll
            for (int i = 0; i < 4; ++i) { const f32x4 w = v[q][i]; s_ += w.x * w.x + w.y * w.y + w.z * w.z + w.w * w.w;
                *(u32x2*)(br + i * 256 + lane * 4) = (u32x2){cvtpk(w.x, w.y), cvtpk(w.z, w.w)}; }
#pragma unroll
            for (int o = 1; o < 64; o <<= 1) s_ += __shfl_xor(s_, o);
            if (lane < 16) ss[(size_t)r * 16 + lane] = lane == 0 ? s_ : 0.f; } }
    }
}

struct EpiBf16S {
    static constexpr bool PERM = true, AFTER_DRAIN = false, INIT_ACC = false;
    bf16_t* O; int ldc; bf16_t* O2; int ldc2; int split; const float* ss; int nsl4; float inv_n; int act; float* ssl; float* ssk; const LAS float* rs; int pm0;
    __device__ __forceinline__ void operator()(const f32x4 (&acc)[2][2][4][2], const pg8::Unit& u, int wr, int wc, int fr, int fq) const {
        const int row0 = u.pm * 256 + wr * 64 + fr; int colt = u.pn * 256; bf16_t* base = O; int ld = ldc;
        if (colt >= split) { base = O2; colt -= split; ld = ldc2; }
        const int col0 = colt + wc * 32 + 8 * fq;
#pragma unroll
        for (int ai = 0; ai < 2; ++ai)
#pragma unroll
            for (int m = 0; m < 4; ++m) { const int row = row0 + ai * 128 + m * 16; float sc = 1.0f;
                if (ss) { if (u.pm == pm0) sc = rs[(wr * 4 + wc) * 128 + ai * 64 + m * 16 + fr];
                    else { const f32x4* sp = (const f32x4*)(ss + (size_t)row * 16); f32x4 a = sp[0]; if (nsl4 == 4) a = (a + sp[1]) + (sp[2] + sp[3]); sc = rsqrtf(((a.x + a.y) + (a.z + a.w)) * inv_n + EPS); } }
                bf16_t* rowp = base + (size_t)row * ld + col0; float sa = 0.f, sb = 0.f;
#pragma unroll
                for (int bj = 0; bj < 2; ++bj) { f32x4 v0 = acc[ai][bj][m][0] * sc, v1 = acc[ai][bj][m][1] * sc;
                    if (act) {
#pragma unroll
                        for (int j = 0; j < 4; ++j) { const float a0 = fmaxf(v0[j], 0.f), a1 = fmaxf(v1[j], 0.f); v0[j] = a0 * a0; v1[j] = a1 * a1; } }
                    float sq = 0.f; if (ssl || ssk) sq = ((v0[0] * v0[0] + v0[1] * v0[1]) + (v0[2] * v0[2] + v0[3] * v0[3])) + ((v1[0] * v1[0] + v1[1] * v1[1]) + (v1[2] * v1[2] + v1[3] * v1[3]));
                    if (bj == 0) sa = sq; else sb = sq;
                    u32x4 w; w.x = cvtpk(v0[0], v0[1]); w.y = cvtpk(v0[2], v0[3]); w.z = cvtpk(v1[0], v1[1]); w.w = cvtpk(v1[2], v1[3]);
                    *(u32x4*)(rowp + bj * 128) = w; }
                if (ssk) { float sk_ = sa; sk_ += __shfl_xor(sk_, 16); sk_ += __shfl_xor(sk_, 32); if (fq == 0) ssk[((size_t)row * 16 + u.pn) * 4 + wc] = sk_; }
                if (ssl) { sa += __shfl_xor(sa, 16); sa += __shfl_xor(sa, 32); sb += __shfl_xor(sb, 16); sb += __shfl_xor(sb, 32);
                    if (fq == 0) { float* sr_ = ssl + (size_t)row * 16; if (u.pn == 0) sr_[wc] = sa + sb; else { sr_[4 + wc] = sa; sr_[8 + wc] = sb; } } } }
    }
};
struct EpiRes {
    static constexpr bool PERM = false, AFTER_DRAIN = false, INIT_ACC = true;
    const float* xin; float* xout; bf16_t* xb; float* ss;
    __device__ __forceinline__ void init_acc(f32x4 (&acc)[2][2][4][2], const pg8::Unit& u, int wr, int wc, int fr, int fq) const {
        const int row0 = u.pm * 256 + wr * 64 + fr, col0 = u.pn * 256 + wc * 32 + 4 * fq;
#pragma unroll
        for (int ai = 0; ai < 2; ++ai)
#pragma unroll
            for (int m = 0; m < 4; ++m) { const size_t off = (size_t)(row0 + ai * 128 + m * 16) * 1024 + col0;
#pragma unroll
                for (int bj = 0; bj < 2; ++bj)
#pragma unroll
                    for (int n = 0; n < 2; ++n) acc[ai][bj][m][n] = *(const f32x4*)(xin + off + bj * 128 + n * 16); }
    }
    __device__ __forceinline__ void operator()(const f32x4 (&acc)[2][2][4][2], const pg8::Unit& u, int wr, int wc, int fr, int fq) const {
        const int row0 = u.pm * 256 + wr * 64 + fr, col0 = u.pn * 256 + wc * 32 + 4 * fq;
#pragma unroll
        for (int ai = 0; ai < 2; ++ai)
#pragma unroll
            for (int m = 0; m < 4; ++m) { const int row = row0 + ai * 128 + m * 16; const size_t off = (size_t)row * 1024 + col0; float s = 0.f;
#pragma unroll
                for (int bj = 0; bj < 2; ++bj)
#pragma unroll
                    for (int n = 0; n < 2; ++n) { const int c = bj * 128 + n * 16; const f32x4 o = acc[ai][bj][m][n];
                        *(f32x4*)(xout + off + c) = o; s += (o.x * o.x + o.y * o.y) + (o.z * o.z + o.w * o.w);
                        *(u32x2*)(xb + off + c) = (u32x2){cvtpk(o.x, o.y), cvtpk(o.z, o.w)}; }
                s += __shfl_xor(s, 16); s += __shfl_xor(s, 32);
                if (fq == 0) ss[(size_t)row * 16 + u.pn * 4 + wc] = s; }
    }
};
template <class Epi> __device__ __forceinline__ void run_gemm(LAS unsigned char* lds, const bf16_t* A, int lda, const bf16_t* Bt, int N, int K, const Epi& E) {
    pg8::Gemm g{A, Bt, TH, N, K, lda}; pg8::StaticOrder S; S.init(TH, N, (int)gridDim.x, opaque_bid());
    pg8::gemm_phase<Epi, pg8::StaticOrder>(lds, g, S, E);
}
__device__ __forceinline__ void run_gemm_bf16(LAS unsigned char* lds, const bf16_t* A, int lda, const bf16_t* Bt, int N, int K, EpiBf16S E) {
    pg8::Gemm g{A, Bt, TH, N, K, lda}; pg8::StaticOrder S; S.init(TH, N, (int)gridDim.x, opaque_bid());
    E.rs = (const LAS float*)(lds + RS_OFF); E.pm0 = -1;
    pg8::Unit u0;
    if (E.ss && S.next(0, u0)) {
        const int tid = opaque_tid(), wid = tid >> 6, lane = tid & 63, wr = wid >> 2;
        LAS float* tab = (LAS float*)(lds + RS_OFF) + wid * 128;
#pragma unroll
        for (int hh = 0; hh < 2; ++hh) { const int row = u0.pm * 256 + hh * 128 + wr * 64 + lane;
            const f32x4* sp = (const f32x4*)(E.ss + (size_t)row * 16); f32x4 a = sp[0]; if (E.nsl4 == 4) a = (a + sp[1]) + (sp[2] + sp[3]);
            tab[hh * 64 + lane] = rsqrtf(((a.x + a.y) + (a.z + a.w)) * E.inv_n + EPS); }
        E.pm0 = u0.pm;
    }
    pg8::gemm_phase<EpiBf16S, pg8::StaticOrder>(lds, g, S, E);
}

__device__ void lat_prep(bf16_t* lat) {
    const int tid_ = opaque_tid(), lane = tid_ & 63, gw = opaque_bid() * 8 + (tid_ >> 6), nw = gridDim.x * 8;
    for (int t = gw; t < TH; t += nw) {
        bf16_t* p = lat + (size_t)t * 512 + lane * 8; const u32x4 w = *(const u32x4*)p; float v[8]; UNPACK8(w, v);
        float s = 0.f;
#pragma unroll
        for (int e = 0; e < 8; ++e) s += v[e] * v[e];
        s += __shfl_xor(s, 1); s += __shfl_xor(s, 2); s += __shfl_xor(s, 4); s += __shfl_xor(s, 8);
        const float s32 = s + __shfl_xor(s, 16);
        const float rstd = lane < 32 ? rsqrtf(s32 * (1.0f / 256.0f) + EPS) : rsqrtf(s * (1.0f / 128.0f) + EPS);
        if (lane < 48) {
#pragma unroll
            for (int e = 0; e < 8; ++e) v[e] *= rstd;
            *(u32x4*)p = PACK8(v); }
    }
}
__device__ void kpe_prep(const bf16_t* lat, const int* pos, const float* gk, bf16_t* kper) {
    const int tid = opaque_tid(), grp = tid >> 3, l8 = tid & 7;
    float invf[8], g[8];
#pragma unroll
    for (int e = 0; e < 8; ++e) { invf[e] = exp2f(-(float)((l8 & 3) * 8 + e) * (LOG2_THETA / 32.0f)) * 0.15915494309189535f; g[e] = gk[128 + l8 * 8 + e]; }
    for (int t = opaque_bid() * 64 + grp; t < TH; t += (int)gridDim.x * 64) {
        const float posf = (float)pos[t];
        const u32x4 w = *(const u32x4*)(lat + (size_t)t * 512 + 384 + l8 * 8); float v[8]; UNPACK8(w, v);
#pragma unroll
        for (int e = 0; e < 8; ++e) { const float y = v[e] * g[e]; const float pr = __shfl_xor(y, 4); float sn_, cs_; sincos_rev(posf, invf[e], sn_, cs_);
            v[e] = (l8 & 4) ? y * cs_ + pr * sn_ : y * cs_ - pr * sn_; }
        *(u32x4*)(kper + (size_t)t * 64 + l8 * 8) = PACK8(v);
    }
}
__device__ void head_prep(bf16_t* kbuf  , bf16_t* qbuf, const int* pos, const float* gk, const float* gq) {
    const int tid_ = opaque_tid(), lane = tid_ & 63, gw = opaque_bid() * 8 + (tid_ >> 6), nw = gridDim.x * 8;
    const float qscale = 0.08838834764831845f * LOG2E;
    const int c16 = lane & 15;
    float invf[8];
#pragma unroll
    for (int e = 0; e < 8; ++e) invf[e] = exp2f(-(float)((c16 & 7) * 8 + e) * (LOG2_THETA / 64.0f)) * 0.15915494309189535f;
    for (int t = gw; t < TH; t += nw) {
        const float posf = (float)pos[t];
        float cs[8], sn[8];
#pragma unroll
        for (int e = 0; e < 8; ++e) sincos_rev(posf, invf[e], sn[e], cs[e]);
        u32x4 wv[6];
#pragma unroll
        for (int itr = 0; itr < 6; ++itr) wv[itr] = *(const u32x4*)(kbuf + (size_t)t * 6144 + (itr * 4 + (lane >> 4)) * 128 + c16 * 8);
#pragma unroll
        for (int itr = 0; itr < 6; ++itr) { const bool isq = false;
            const int hh = (isq ? itr - 6 : itr) * 4 + (lane >> 4), g = hh >> 3;
            bf16_t* p = isq ? qbuf + (size_t)t * 3072 + hh * 128 + c16 * 8 : kbuf + (size_t)t * 6144 + hh * 128 + c16 * 8;
            const float* gn = (isq ? gq : gk) + g * 128 + c16 * 8;
            float v[8]; UNPACK8(wv[itr], v); float s = 0.f;
#pragma unroll
            for (int e = 0; e < 8; ++e) s += v[e] * v[e];
            s += __shfl_xor(s, 1); s += __shfl_xor(s, 2); s += __shfl_xor(s, 4); s += __shfl_xor(s, 8);
            const float rstd = rsqrtf(s * (1.0f / 128.0f) + EPS), osc = isq ? qscale : 1.0f;
#pragma unroll
            for (int e = 0; e < 8; ++e) { const float y = v[e] * rstd * gn[e]; const float pr = __shfl_xor(y, 8);
                v[e] = ((c16 & 8) ? y * cs[e] + pr * sn[e] : y * cs[e] - pr * sn[e]) * osc; }
            *(u32x4*)p = PACK8(v); }
    }
}

struct AttnItem { const bf16_t* o2; const float* lse2; const bf16_t* q; const bf16_t* k; const bf16_t* kpe; const bf16_t* v; bf16_t* o; float* lse; const int* pos; const float* gq; const float* gk; const float* ssk; const float* ssl; int q_ld, k_ld, kpe_ld, v_ld, o_ld, P0, ld, merge; };
__device__ __forceinline__ int v_st(int k, int c) { const int kk = (k & ~0xC) | ((k & 4) << 1) | ((k & 8) >> 1); return ((kk >> 3) * 4 + (c >> 5)) * 512 + ((kk & 7) * 32 + (c & 31)) * 2; }
__device__ __forceinline__ int v_rd_base(int lane) { return ((lane & 3) << 3) | (((lane >> 2) & 3) << 6) | (((lane >> 4) & 1) << 5) | (((lane >> 5) & 1) << 8); }
#define PK4(P, B_, OUT) do { unsigned a0_ = cvtpk(P[B_+0], P[B_+1]), a1_ = cvtpk(P[B_+2], P[B_+3]); unsigned b0_ = cvtpk(P[B_+4], P[B_+5]), b1_ = cvtpk(P[B_+6], P[B_+7]); \
        auto r0_ = __builtin_amdgcn_permlane32_swap(a0_, b0_, false, false); auto r1_ = __builtin_amdgcn_permlane32_swap(a1_, b1_, false, false); \
        u32x4 w_ = {r0_[0], r1_[0], r0_[1], r1_[1]}; OUT = w_; } while (0)
__device__ __forceinline__ bf16x8 as_bf(u32x4 w) { return *reinterpret_cast<bf16x8*>(&w); }

template <int DQK, int MODE>
__device__ __forceinline__ void attn_block(const AttnItem& it, LAS unsigned char* lds) {
    constexpr int RS = DQK * 2, SHM_K = 64 * RS, SHM_V = 16384, ND0 = DQK / 16, KCH = DQK / 8, NKC = (64 * KCH) / 512;
    const int tid = opaque_tid(), wid = __builtin_amdgcn_readfirstlane(tid >> 6), lane = tid & 63, r32 = lane & 31, hi = lane >> 5;
    const int ld = it.ld, Lm1 = (2048 >> ld) - 1, lsh = 11 - ld;
#define TOK(p) (MODE == 0 ? (p) : ((((p) & Lm1) << ld) | ((p) >> lsh)))
#define LOF(p) (MODE == 0 ? 0 : max((p) - 128, (p) & ~Lm1))
    const int q0 = it.P0 + wid * 32, qp = q0 + r32;
    const int span = qp - LOF(qp), lo_w = LOF(q0), lo_last = LOF(q0 + 31);
    LAS unsigned char* V_lds = lds; LAS unsigned char* K_lds = lds + 2 * SHM_V;
    const int j_lo = LOF(it.P0) >> 6, NT = (it.P0 >> 6) + 4 - j_lo;
    const int sr = tid >> 4, sc = (tid & 15) * 8, vst0 = v_st(sr, sc), vst1 = v_st(32 + sr, sc);
    constexpr int NSET = (MODE == 1) ? 2 : 1;
    bf16x8 sk[NSET][NKC], sv0[NSET], sv1[NSET]; f32x4 s_k4 = {0.f, 0.f, 0.f, 0.f}, s_p4 = {0.f, 0.f, 0.f, 0.f};
    constexpr int KRS_OFF = 2 * SHM_V + 2 * SHM_K;
    int offk[NKC], offv0 = sr * it.v_ld + sc, offv1 = (32 + sr) * it.v_ld + sc;
#pragma unroll
    for (int i_ = 0; i_ < NKC; ++i_) { const int c_ = tid + 512 * i_, row_ = c_ / KCH, cc_ = c_ - row_ * KCH; offk[i_] = (DQK == 192 && cc_ >= 16) ? row_ * it.kpe_ld + (cc_ - 16) * 8 : row_ * it.k_ld + cc_ * 8; }
#define SLOAD(S_, kb_) do { if (MODE == 0) { const bf16_t* kt_ = it.k + (size_t)(kb_) * it.k_ld; const bf16_t* pt_ = it.kpe + (size_t)(kb_) * it.kpe_ld; const bf16_t* vt_ = it.v + (size_t)(kb_) * it.v_ld; \
            _Pragma("unroll") for (int i_ = 0; i_ < NKC; ++i_) { const int c_ = tid + 512 * i_, row_ = c_ / KCH, cc_ = c_ - row_ * KCH; sk[S_][i_] = *(const bf16x8*)(((DQK == 192 && cc_ >= 16) ? pt_ : kt_) + offk[i_]); } \
            sv0[S_] = *(const bf16x8*)(vt_ + offv0); sv1[S_] = *(const bf16x8*)(vt_ + offv1); \
            if (tid < 64) { s_k4 = *(const f32x4*)(it.ssk + (size_t)((kb_) + tid) * 64); s_p4 = *(const f32x4*)(it.ssl + (size_t)((kb_) + tid) * 16); } } else { \
        _Pragma("unroll") for (int i_ = 0; i_ < NKC; ++i_) { const int c_ = tid + 512 * i_, row_ = c_ / KCH, cc_ = c_ - row_ * KCH; const int tk_ = TOK((kb_) + row_); \
            sk[S_][i_] = *(const bf16x8*)(it.k + (size_t)tk_ * it.k_ld + cc_ * 8); } \
        { const int t0_ = TOK((kb_) + sr), t1_ = TOK((kb_) + 32 + sr); sv0[S_] = *(const bf16x8*)(it.v + (size_t)t0_ * it.v_ld + sc); sv1[S_] = *(const bf16x8*)(it.v + (size_t)t1_ * it.v_ld + sc); } } } while (0)
#define SWRITE(S_, bf_) do { _Pragma("unroll") for (int i_ = 0; i_ < NKC; ++i_) { const int c_ = tid + 512 * i_, row_ = c_ / KCH, cc_ = c_ - row_ * KCH; const int swz_ = (((DQK == 128) ? row_ : (row_ >> 1)) & 7) << 4; \
            *(LAS bf16x8*)(K_lds + (bf_) * SHM_K + row_ * RS + ((cc_ * 16) ^ swz_)) = sk[S_][i_]; } \
        *(LAS bf16x8*)(V_lds + (bf_) * SHM_V + vst0) = sv0[S_]; *(LAS bf16x8*)(V_lds + (bf_) * SHM_V + vst1) = sv1[S_]; \
        if (MODE == 0 && tid < 64) { const f32x4 a_ = s_k4 + s_p4; *(LAS float*)(lds + KRS_OFF + (bf_) * 256 + tid * 4) = rsqrtf(((a_.x + a_.y) + (a_.z + a_.w)) * (1.0f / 192.0f) + EPS); } } while (0)
    float m_reg = -1e30f, l_reg = 0.f; f32x16 o[4];
#pragma unroll
    for (int d = 0; d < 4; ++d)
#pragma unroll
        for (int r = 0; r < 16; ++r) o[d][r] = 0.f;
    SLOAD(0, j_lo * 64); if (MODE == 1) SLOAD(NSET - 1, j_lo * 64 + 64);
    bf16x8 qr[ND0];
    {
      constexpr int NR = (MODE == 0) ? 2 : 4;
      constexpr int R0 = (MODE == 0) ? 8 : 0;
      constexpr float QS = ((MODE == 0) ? 0.07216878364870322f : 0.08838834764831845f) * LOG2E;
      constexpr float FSTEP = LOG2_THETA / ((MODE == 0) ? 32.0f : 64.0f);
      const int tq_ = TOK(qp);
      const bf16_t* qrow = it.q + (size_t)tq_ * it.q_ld + hi * 8;
      u32x4 raw[ND0]; float ssq = 0.f;
#pragma unroll
      for (int d0 = 0; d0 < ND0; ++d0) raw[d0] = *(const u32x4*)(qrow + d0 * 16);
      const float posf = (float)it.pos[tq_];
#pragma unroll
      for (int d0 = 0; d0 < ND0; ++d0) { float v[8]; UNPACK8(raw[d0], v);
#pragma unroll
          for (int e = 0; e < 8; ++e) ssq += v[e] * v[e]; }
      { auto rr = __builtin_amdgcn_permlane32_swap(__float_as_uint(ssq), __float_as_uint(ssq), false, false); ssq = __uint_as_float(rr[0]) + __uint_as_float(rr[1]); }
      const float rq = rsqrtf(ssq * (1.0f / (float)DQK) + EPS) * QS;
      const float* gp = it.gq + hi * 8;
#pragma unroll
      for (int d0 = 0; d0 < ND0; ++d0) {
          if (d0 >= R0 + NR && d0 < R0 + 2 * NR) continue;
          f32x4 g0 = *(const f32x4*)(gp + d0 * 16), g1 = *(const f32x4*)(gp + d0 * 16 + 4);
          if (MODE == 0 && d0 < 8) { g0 *= *(const f32x4*)(it.gk + hi * 8 + d0 * 16); g1 *= *(const f32x4*)(it.gk + hi * 8 + d0 * 16 + 4); }
          float v[8]; UNPACK8(raw[d0], v);
#pragma unroll
          for (int e = 0; e < 8; ++e) v[e] *= rq * (e < 4 ? g0[e & 3] : g1[e & 3]);
          if (d0 >= R0 && d0 < R0 + NR) {
              const f32x4 h0 = *(const f32x4*)(gp + (d0 + NR) * 16), h1 = *(const f32x4*)(gp + (d0 + NR) * 16 + 4);
              float w[8]; UNPACK8(raw[d0 + NR], w);
#pragma unroll
              for (int e = 0; e < 8; ++e) { w[e] *= rq * (e < 4 ? h0[e & 3] : h1[e & 3]);
                  float sn_, cs_; sincos_rev(posf, __builtin_amdgcn_exp2f(-(float)((d0 - R0) * 16 + hi * 8 + e) * FSTEP - 2.6514961294723187f), sn_, cs_);
                  const float x1 = v[e], x2 = w[e]; v[e] = x1 * cs_ - x2 * sn_; w[e] = x2 * cs_ + x1 * sn_; }
              qr[d0 + NR] = as_bf(PACK8(w)); }
          qr[d0] = as_bf(PACK8(v)); } }
    SWRITE(0, 0); __syncthreads();
    const int swzr = (((DQK == 128) ? r32 : (r32 >> 1)) & 7) << 4;
    int kro[4];
#pragma unroll
    for (int dd = 0; dd < 4; ++dd) kro[dd] = r32 * RS + ((dd * 32 + hi * 16) ^ swzr);
#pragma unroll 1
    for (int t2 = 0; t2 < NT; t2 += NSET) {
#pragma unroll
      for (int us = 0; us < NSET; ++us) { const int t = t2 + us; if (t < NT) {
        const int kb = (j_lo + t) * 64, buf = t & 1;
        if (MODE == 1) { if (t + 2 < NT) SLOAD(us, kb + 128); } else { if (t + 1 < NT) SLOAD(0, kb + 64); }
#pragma unroll 1
        for (int hf = 0; hf < 2; ++hf) {
            const int kh = kb + 32 * hf;
            const bool act = (kh <= q0 + 31) && (kh + 31 >= lo_w);
            if (act) {
                f32x16 p0;
#pragma unroll
                for (int r = 0; r < 16; ++r) p0[r] = 0.f;
                { const LAS unsigned char* kbp = K_lds + buf * SHM_K + hf * (32 * RS);
#pragma unroll
                  for (int d0 = 0; d0 < ND0; ++d0) {
                      const bf16x8 b0 = *(const LAS bf16x8*)(kbp + kro[d0 & 3] + (d0 >> 2) * 128);
                      p0 = __builtin_amdgcn_mfma_f32_32x32x16_bf16(b0, qr[d0], p0, 0, 0, 0); } }
                if (MODE == 0) { const LAS float* kr_ = (const LAS float*)(lds + KRS_OFF + buf * 256) + 32 * hf + 4 * hi;
#pragma unroll
                    for (int j4 = 0; j4 < 4; ++j4) { const f32x4 s4 = *(const LAS f32x4*)(kr_ + 8 * j4);
#pragma unroll
                        for (int e = 0; e < 4; ++e) p0[4 * j4 + e] *= s4[e]; } }
                if (!((kh + 31 <= q0) && (kh >= lo_last))) {
                    const int dq = qp - kh - 4 * hi; const float NEG = -__builtin_inff();
#pragma unroll
                    for (int r = 0; r < 16; ++r) { const int c = (r & 3) + 8 * (r >> 2); if ((unsigned)(dq - c) > (unsigned)span) p0[r] = NEG; } }
                float pmax = p0[0];
#pragma unroll
                for (int r = 1; r < 16; ++r) pmax = fmaxf(pmax, p0[r]);
                { auto rr = __builtin_amdgcn_permlane32_swap(__float_as_uint(pmax), __float_as_uint(pmax), false, false); pmax = fmaxf(__uint_as_float(rr[0]), __uint_as_float(rr[1])); }
                float mn = m_reg, alpha = 1.0f;
                const bool resc = !__all(pmax - m_reg <= 8.0f);
                if (resc) { mn = fmaxf(m_reg, pmax); alpha = __builtin_amdgcn_exp2f(m_reg - mn); m_reg = mn; }
                float ps = 0.f;
#pragma unroll
                for (int r = 0; r < 16; ++r) { p0[r] = __builtin_amdgcn_exp2f(p0[r] - mn); ps += p0[r]; }
                { auto rr = __builtin_amdgcn_permlane32_swap(__float_as_uint(ps), __float_as_uint(ps), false, false); ps = __uint_as_float(rr[0]) + __uint_as_float(rr[1]); }
                l_reg = l_reg * alpha + ps;
                u32x4 pa0, pa1; PK4(p0, 0, pa0); PK4(p0, 8, pa1);
                if (resc) {
#pragma unroll
                    for (int d = 0; d < 4; ++d)
#pragma unroll
                        for (int r = 0; r < 16; ++r) o[d][r] *= alpha; }
                const unsigned vb = (unsigned)(uintptr_t)(V_lds + buf * SHM_V + hf * 8192) + (unsigned)v_rd_base(lane);
#define TRRD(dst, off) asm volatile("ds_read_b64_tr_b16 %0, %1 offset:%2" : "=&v"(dst) : "v"(vb), "i"(off) : "memory")
#define PV_D0(d0) do { s16x4 l0, l1, h0, h1; constexpr int b_ = (d0) * 512; \
                TRRD(l0, b_); TRRD(h0, b_ + 2048); TRRD(l1, b_ + 4096); TRRD(h1, b_ + 6144); \
                asm volatile("s_waitcnt lgkmcnt(0)" ::: "memory"); __builtin_amdgcn_sched_barrier(0); \
                o[d0] = __builtin_amdgcn_mfma_f32_32x32x16_bf16((bf16x8){l0[0], l0[1], l0[2], l0[3], h0[0], h0[1], h0[2], h0[3]}, as_bf(pa0), o[d0], 0, 0, 0); \
                o[d0] = __builtin_amdgcn_mfma_f32_32x32x16_bf16((bf16x8){l1[0], l1[1], l1[2], l1[3], h1[0], h1[1], h1[2], h1[3]}, as_bf(pa1), o[d0], 0, 0, 0); } while (0)
                PV_D0(0); PV_D0(1); PV_D0(2); PV_D0(3);
#undef PV_D0
#undef TRRD
            }
        }
        if (t + 1 < NT) SWRITE((NSET - 1) - us, buf ^ 1);
        __syncthreads();
      } }
    }
    const int tq = TOK(qp);
    float a_cur = 1.0f / l_reg, a_pa = 0.f, a_pb = 0.f;
    if (MODE == 1) {
        const float lse_cur = m_reg + __builtin_amdgcn_logf(l_reg); float lse_new = lse_cur;
        if (it.merge) { const float la = it.lse[(size_t)tq * 8], lb = it.lse2[(size_t)tq * 8]; const float mx = fmaxf(fmaxf(la, lb), lse_cur);
            const float ea = __builtin_amdgcn_exp2f(la - mx), eb = __builtin_amdgcn_exp2f(lb - mx), ec = __builtin_amdgcn_exp2f(lse_cur - mx); const float inv = 1.0f / (ea + eb + ec);
            lse_new = mx + __builtin_amdgcn_logf(ea + eb + ec); a_pa = ea * inv; a_pb = eb * inv; a_cur *= ec * inv; }
        if (hi == 0) it.lse[(size_t)tq * 8] = lse_new;
    }
    bf16_t* orow = it.o + (size_t)tq * it.o_ld + hi * 8;
    const bf16_t* orow2 = (MODE == 1) ? it.o2 + (size_t)tq * it.o_ld + hi * 8 : nullptr;
#pragma unroll
    for (int d0 = 0; d0 < 4; ++d0) {
#pragma unroll
        for (int r = 0; r < 16; ++r) o[d0][r] *= a_cur;
        u32x4 w0, w1; PK4(o[d0], 0, w0); PK4(o[d0], 8, w1);
        if (MODE == 1 && it.merge) {
            const u32x4 q0w = *(const u32x4*)(orow + d0 * 32), q1w = *(const u32x4*)(orow + d0 * 32 + 16);
            const u32x4 r0w = *(const u32x4*)(orow2 + d0 * 32), r1w = *(const u32x4*)(orow2 + d0 * 32 + 16);
            float a[8], b[8], c[8];
            UNPACK8(w0, a); UNPACK8(q0w, b); UNPACK8(r0w, c);
#pragma unroll
            for (int e = 0; e < 8; ++e) a[e] += b[e] * a_pa + c[e] * a_pb;
            w0 = PACK8(a);
            UNPACK8(w1, a); UNPACK8(q1w, b); UNPACK8(r1w, c);
#pragma unroll
            for (int e = 0; e < 8; ++e) a[e] += b[e] * a_pa + c[e] * a_pb;
            w1 = PACK8(a);
        }
        *(u32x4*)(orow + d0 * 32) = w0; *(u32x4*)(orow + d0 * 32 + 16) = w1;
    }
#undef SLOAD
#undef SWRITE
#undef TOK
#undef LOF
}

__device__ void mla_attn_phase(const Params& p, LAS unsigned char* lds, const int* pos, const float* gq, const float* gk) {
    unsigned char* ws = p.ws;
    const int G_ = (int)gridDim.x, bid_ = opaque_bid(), vb_ = (G_ % 8 == 0) ? (bid_ % 8) * (G_ / 8) + bid_ / 8 : bid_;
    for (int item = vb_; item < BH * 16 * 4; item += G_) {
        const int bh = item >> 2, pr = item & 3, b = bh >> 4, h = bh & 15; const size_t tb = (size_t)b * SEQ;
        AttnItem it; it.q = (const bf16_t*)(ws + WS_Q) + tb * 3072 + h * 192; it.q_ld = 3072;
        it.k = (const bf16_t*)(ws + WS_KV) + tb * 4096 + h * 256; it.k_ld = 4096; it.kpe = (const bf16_t*)(ws + WS_KPER) + tb * 64; it.kpe_ld = 64; it.gk = gk; it.ssk = (const float*)(ws + WS_SSK) + (tb * 16 + h) * 4; it.ssl = (const float*)(ws + WS_SSL) + tb * 16 + 8;
        it.v = (const bf16_t*)(ws + WS_KV) + tb * 4096 + h * 256 + 128; it.v_ld = 4096; it.o = (bf16_t*)(ws + WS_AO) + tb * 2048 + h * 128; it.o_ld = 2048;
        it.lse = nullptr; it.o2 = nullptr; it.lse2 = nullptr; it.ld = 0; it.merge = 0; it.pos = pos + tb; it.gq = gq;
#pragma unroll 1
        for (int k2 = 0; k2 < 2; ++k2) { it.P0 = (k2 == 0 ? 7 - pr : pr) * 256; attn_block<192, 0>(it, lds); }
    }
}
__device__ void dil_attn_phase(const Params& p, LAS unsigned char* lds, int pg, const int* pos, const float* gq) {
    unsigned char* ws = p.ws;
    const int G_ = (int)gridDim.x, bid_ = opaque_bid(), vb_ = (G_ % 8 == 0) ? (bid_ % 8) * (G_ / 8) + bid_ / 8 : bid_;
    const int nitems = pg == 0 ? 2 * BH * 8 * 8 : BH * 8 * 8;
#pragma unroll 1
    for (int item = vb_; item < nitems; item += G_) {
        const int g = pg == 0 ? (item >= BH * 8 * 8 ? 1 : 0) : 2, li_ = item & (BH * 8 * 8 - 1);
        const int bh = li_ >> 3, qb = li_ & 7, b = bh >> 3, h = bh & 7, hh = g * 8 + h; const size_t tb = (size_t)b * SEQ;
        AttnItem it; it.q = (const bf16_t*)(ws + WS_QB) + tb * 3072 + hh * 128; it.q_ld = 3072;
        it.k = (const bf16_t*)(ws + WS_KVB) + tb * 6144 + hh * 128; it.k_ld = 6144; it.kpe = nullptr; it.kpe_ld = 0; it.gk = nullptr; it.ssk = nullptr; it.ssl = nullptr;
        it.v = (const bf16_t*)(ws + WS_KVB) + tb * 6144 + 3072 + hh * 128; it.v_ld = 6144; it.o_ld = 1024;
        it.o = (bf16_t*)(ws + (g == 1 ? WS_OB2 : WS_OB)) + tb * 1024 + h * 128; it.lse = (float*)(ws + (g == 1 ? WS_LSE2 : WS_LSE)) + tb * 8 + h;
        it.o2 = (const bf16_t*)(ws + WS_OB2) + tb * 1024 + h * 128; it.lse2 = (const float*)(ws + WS_LSE2) + tb * 8 + h;
        it.ld = 2 * g; it.merge = g == 2; it.P0 = qb * 256; it.pos = pos + tb; it.gq = gq + g * 128;
        attn_block<128, 1>(it, lds);
    }
}

#define XB_TMO      128
#define XB_XCNT(j)  (256  + 64 * (j))
#define XB_XSUB(j)  (1280 + 64 * (j))
#define XB_XGEN(j)  (2304 + 64 * (j))
#define XB_TOP      3328
#define XB_TOPGEN   3392
#define XCD_BAR_WORDS 3456
#define XB_SPIN_CAP (1u << 18)

__device__ __forceinline__ unsigned xb_ld(unsigned* p)              { return __hip_atomic_load(p, __ATOMIC_RELAXED, __HIP_MEMORY_SCOPE_AGENT); }
__device__ __forceinline__ unsigned xb_add(unsigned* p, unsigned v) { return __hip_atomic_fetch_add(p, v, __ATOMIC_RELAXED, __HIP_MEMORY_SCOPE_AGENT); }
__device__ __forceinline__ unsigned xb_xcc_id() { return (unsigned)__builtin_amdgcn_s_getreg((3 << 11) | 20) & 0xFu; }
#define XB_SPIN(cond, bar) do { unsigned _sp = 0; while (cond) { __builtin_amdgcn_s_sleep(1); \
    if ((++_sp & 255u) == 0u) { if (xb_ld(&(bar)[XB_TMO])) break; if (_sp > XB_SPIN_CAP) { atomicAdd(&(bar)[XB_TMO], 1u); break; } } } } while (0)

struct XcdBarrier {
    unsigned* bar; unsigned x;
    volatile LAS unsigned* st;
};

__device__ __forceinline__ XcdBarrier xcd_barrier_post(unsigned* bar, volatile LAS unsigned* st) {
    XcdBarrier b; b.bar = bar; b.x = xb_xcc_id(); b.st = st;
    if (threadIdx.x == 0) (void)xb_add(&bar[XB_XCNT(b.x)], 1u);
    return b;
}
__device__ __forceinline__ void xcd_barrier_complete(unsigned* bar, unsigned x, unsigned& nloc, unsigned& nx) {
    const unsigned G = gridDim.x * gridDim.y * gridDim.z;
    unsigned sum, cnt, mine, sp = 0u;
    for (;;) {
        sum = 0u; cnt = 0u; mine = 0u;
#pragma unroll
        for (unsigned j = 0; j < 16; ++j) { const unsigned c = xb_ld(&bar[XB_XCNT(j)]); sum += c; cnt += (c > 0u) ? 1u : 0u; mine = (j == x) ? c : mine; }
        if (sum == G) break;
        __builtin_amdgcn_s_sleep(1);
        if ((++sp & 255u) == 0u) { if (xb_ld(&bar[XB_TMO])) break; if (sp > XB_SPIN_CAP) { atomicAdd(&bar[XB_TMO], 1u); break; } }
    }
    nloc = mine > 0u ? mine : 1u; nx = cnt > 0u ? cnt : 1u;
}

__device__ __forceinline__ void xcd_barrier(const XcdBarrier& b) {
    asm volatile("s_waitcnt vmcnt(0)" ::: "memory");
    __syncthreads();
    if (threadIdx.x == 0) {
        unsigned* bar = b.bar;
        __builtin_amdgcn_s_waitcnt(0);
        unsigned nloc = b.st[0], nx = b.st[1];
        if (nloc == 0u) { xcd_barrier_complete(bar, b.x, nloc, nx); b.st[0] = nloc; b.st[1] = nx; }
        const unsigned old = xb_add(&bar[XB_XSUB(b.x)], 1u);
        const unsigned gen = old / nloc;
        if (old + 1u == (gen + 1u) * nloc) {
            __builtin_amdgcn_fence(__ATOMIC_RELEASE, "agent");
            asm volatile("s_waitcnt vmcnt(0)" ::: "memory");
            const unsigned og = xb_add(&bar[XB_TOP], 1u);
            const unsigned tg = og / nx;
            if (og + 1u == (tg + 1u) * nx) xb_add(&bar[XB_TOPGEN], 1u);
            else XB_SPIN(xb_ld(&bar[XB_TOPGEN]) == tg, bar);
            __builtin_amdgcn_fence(__ATOMIC_ACQUIRE, "agent");
            xb_add(&bar[XB_XGEN(b.x)], 1u);
            asm volatile("s_waitcnt vmcnt(0)" ::: "memory");
        } else {
            XB_SPIN(xb_ld(&bar[XB_XGEN(b.x)]) == gen, bar);
            __builtin_amdgcn_fence(__ATOMIC_ACQUIRE, "agent");
            asm volatile("s_waitcnt vmcnt(0)" ::: "memory");
        }
    }
    __syncthreads();
}

constexpr int NPH_HALF = 1 + 2 * 6 + 7 + 6;
#ifndef SKIP_MASK
#define SKIP_MASK 0
#endif
__global__ void __launch_bounds__(NTHR) mega(Params p) {
    extern __shared__ __attribute__((aligned(16))) unsigned char lds_raw[];
    LAS unsigned char* lds = (LAS unsigned char*)lds_raw;
    cg::grid_group grid = cg::this_grid();
    unsigned char* ws = p.ws;
    bf16_t* XB = (bf16_t*)(ws + WS_XB); float* SS = (float*)(ws + WS_SS); bf16_t* HB = (bf16_t*)(ws + WS_H);
    bf16_t* LAT = (bf16_t*)(ws + WS_LAT); bf16_t* Q = (bf16_t*)(ws + WS_Q); bf16_t* KV = (bf16_t*)(ws + WS_KV); bf16_t* KPE = (bf16_t*)(ws + WS_KPE); bf16_t* AO = (bf16_t*)(ws + WS_AO);
    bf16_t* KVB = (bf16_t*)(ws + WS_KVB); bf16_t* QB = (bf16_t*)(ws + WS_QB); bf16_t* OB = (bf16_t*)(ws + WS_OB);
#ifndef PROBE_MASK
#define PROBE_MASK 0
#endif
    unsigned long long probe_acc = 0ull;
    volatile LAS unsigned* bar_st = (volatile LAS unsigned*)(lds + 131072);
    if (threadIdx.x < 4) bar_st[threadIdx.x] = 0u;
    __syncthreads();
    XcdBarrier xbar = xcd_barrier_post((unsigned*)(ws + WS_BAR), bar_st);
#pragma unroll 1
    for (int ph = p.ph_lo; ph < p.ph_hi; ++ph) {
        const unsigned long long probe_t0 = PROBE_MASK ? __builtin_amdgcn_s_memrealtime() : 0ull;
        const int hb = ph >= NPH_HALF ? 1 : 0, li = hb ? ph - NPH_HALF + 1 : ph;
        const size_t toff = (size_t)hb * TH;
        const float* xin0 = (const float*)p.in[0] + toff * DM; float* xo = p.out + toff * DM; const int* pos = (const int*)p.in[1] + toff;
        int lyr = 0, j = -1;
        if (li >= 20) { lyr = 3; const int jm = li - 20; j = jm == 0 ? 0 : (jm <= 2 ? jm + 1 : jm + 2); }
        else if (li >= 13) { lyr = 2; const int jm = li - 13; j = jm <= 3 ? jm : jm + 1; }
        else if (li >= 1) { lyr = (li - 1) / 6; const int jm = (li - 1) - lyr * 6; j = jm == 0 ? 0 : jm == 1 ? 2 : jm + 2; }
        const bool mla = lyr < 2; const int ab = lyr & 1;
        int gk = 0;
        const bf16_t* A = nullptr; const bf16_t* Bt = nullptr; int lda = 0, N = 0, K = 0, nsub = 1;
        EpiBf16S E1{nullptr, 0, nullptr, 0, 1 << 30, nullptr, 4, 1.0f / 1024.0f, 0, nullptr, nullptr, nullptr, -1}; EpiRes E2{nullptr, nullptr, XB, SS};
        float* SSL = (float*)(ws + WS_SSL);
        if (li > 0) {
            if (j == 6) { gk = 1; A = XB; lda = 1024; Bt = (const bf16_t*)(ws + WS_W1) + (size_t)lyr * 4096 * 1024; N = 4096; K = 1024; E1.O = HB; E1.ldc = 4096; E1.ss = SS; E1.act = 1; }
            else if (j == 7) { gk = 2; A = HB; lda = 4096; Bt = (const bf16_t*)(ws + WS_W2) + (size_t)lyr * 1024 * 4096; N = 1024; K = 4096; E2.xin = xo; E2.xout = xo; }
            else if (j == 5) { gk = 2; N = 1024; E2.xin = lyr == 0 ? xin0 : xo; E2.xout = xo;
                if (mla) { A = AO; lda = 2048; K = 2048; Bt = (const bf16_t*)(ws + WS_WO) + (size_t)ab * 1024 * 2048; }
                else { A = OB; lda = 1024; K = 1024; Bt = (const bf16_t*)(ws + WS_WOB) + (size_t)ab * 1024 * 1024; } }
            else if (j == 0) { gk = 1; A = XB; lda = 1024; K = 1024; E1.ss = SS;
                if (hb == 1 && lyr == 0) { A = (const bf16_t*)(p.out + (size_t)TH * DM); E1.ss = (const float*)(p.out + (size_t)TH * DM) + 8 * MiB; }
                if (mla) { Bt = (const bf16_t*)(ws + WS_WIN) + (size_t)ab * 512 * 1024; N = 512; E1.O = LAT; E1.ldc = 512; E1.ssl = SSL; }
                else if (ab == 0) { Bt = (const bf16_t*)(ws + WS_WKVQ); N = 9216; E1.O = KVB; E1.ldc = 6144; E1.O2 = QB; E1.ldc2 = 3072; E1.split = 6144; }
                else { Bt = (const bf16_t*)(ws + WS_WQ1); N = 3072; E1.O = QB; E1.ldc = 3072; } }
            else if (j == 2 && mla) { gk = 1; nsub = 2; A = LAT; lda = 512; K = 256; Bt = (const bf16_t*)(ws + WS_WQB) + (size_t)ab * 3072 * 256; N = 3072; E1.O = Q; E1.ldc = 3072; E1.ss = SSL; E1.nsl4 = 1; E1.inv_n = 1.0f / 256.0f; }
        }
        if (!(SKIP_MASK & 1) && gk == 1) {
            if (nsub == 2) kpe_prep(LAT, pos, (const float*)p.in[10] + ab * 192, (bf16_t*)(ws + WS_KPER));
#pragma unroll 1
            for (int sub = 0; sub < nsub; ++sub) {
                if (sub == 1) { A = LAT + 256; Bt = (const bf16_t*)(ws + WS_WKVB) + (size_t)ab * 4096 * 128; N = 4096; K = 128; E1.O = KV; E1.ldc = 4096; E1.ss = SSL + 4; E1.inv_n = 1.0f / 128.0f; E1.ssk = (float*)(ws + WS_SSK); }
                run_gemm_bf16(lds, A, lda, Bt, N, K, E1);
            }
        } else if (!(SKIP_MASK & 2) && gk == 2) {
            run_gemm(lds, A, lda, Bt, N, K, E2);
        } else if (li == 0) {
            if (!(SKIP_MASK & 4)) { prep_weights(p, lds); prep_x(xin0, XB, SS);
                prep_x((const float*)p.in[0] + (size_t)TH * DM, (bf16_t*)(p.out + (size_t)TH * DM), p.out + (size_t)TH * DM + 8 * MiB); }
        } else if (mla) {
            if (j == 4) { if (!(SKIP_MASK & 32)) mla_attn_phase(p, lds, pos, (const float*)p.in[9] + ab * 192, (const float*)p.in[10] + ab * 192); }
        } else {
            if (j == 1) { if (!(SKIP_MASK & 64)) head_prep(ab == 0 ? KVB : nullptr, QB, pos, (const float*)p.in[14], (const float*)p.in[16] + ab * 384); }
            else if (j >= 2 && j <= 3) { if (!(SKIP_MASK & 128)) dil_attn_phase(p, lds, j - 2, pos, (const float*)p.in[16] + ab * 384); }
        }
        if (ph + 1 < p.ph_hi) { if (p.ph_hi > 4096) grid.sync(); else xcd_barrier(xbar); }
        if (PROBE_MASK) { const int cat = gk == 1 ? 1 : gk == 2 ? 2 : li == 0 ? 3 : mla ? (j == 1 ? 4 : j == 3 ? 5 : 6) : (j == 1 ? 7 : 8);
            if ((PROBE_MASK >> cat) & 1) probe_acc += __builtin_amdgcn_s_memrealtime() - probe_t0; }
    }
    if (PROBE_MASK && blockIdx.x == 0) { const unsigned long long t1 = __builtin_amdgcn_s_memrealtime(); while (__builtin_amdgcn_s_memrealtime() - t1 < probe_acc) __builtin_amdgcn_s_sleep(16); }
}
constexpr int N_PHASES = 2 * NPH_HALF - 1;

extern "C" void kernel_launch(void* const* d_in, const int* in_sizes, int n_in, void* d_out, int out_size, void* d_ws, size_t ws_size, hipStream_t stream) {
    static int grid_blocks = 0;
    if (!grid_blocks) {
        int dev = 0, cus = 0, per_cu = 0;
        (void)hipGetDevice(&dev);
        (void)hipDeviceGetAttribute(&cus, hipDeviceAttributeMultiprocessorCount, dev);
        (void)hipFuncSetAttribute((const void*)mega, hipFuncAttributeMaxDynamicSharedMemorySize, LDS_BYTES);
        (void)hipOccupancyMaxActiveBlocksPerMultiprocessor(&per_cu, (const void*)mega, NTHR, LDS_BYTES);
        (void)hipGetLastError();
        grid_blocks = cus > 0 ? cus : 256;
        if (ws_size < WS_END || n_in != 20) { fprintf(stderr, "kernel_launch: workspace %zu < %zu or n_in %d != 20\n", ws_size, (size_t)WS_END, n_in); }
    }
    (void)hipMemsetAsync((unsigned char*)d_ws + WS_BAR, 0, XCD_BAR_WORDS * sizeof(unsigned), stream);
    Params p{};
    for (int i = 0; i < 20; ++i) p.in[i] = d_in[i];
    p.out = (float*)d_out; p.ws = (unsigned char*)d_ws;
#if ONE_LAUNCH
    p.ph_lo = 0; p.ph_hi = N_PHASES;
    void* args[] = {&p};
    hipError_t e = hipLaunchCooperativeKernel((const void*)mega, dim3(grid_blocks), dim3(NTHR), args, LDS_BYTES, stream);
    if (e != hipSuccess) fprintf(stderr, "cooperative launch failed: %s (grid %d)\n", hipGetErrorString(e), grid_blocks);
#else
    for (int ph = 0; ph < N_PHASES; ++ph) { p.ph_lo = ph; p.ph_hi = ph + 1; hipLaunchKernelGGL(mega, dim3(grid_blocks), dim3(NTHR), LDS_BYTES, stream, p); }
#endif
}
```

```cpp
#include <hip/hip_runtime.h>
#include <hip/hip_cooperative_groups.h>
#include <cstdio>
#include <cstdint>
namespace cg = cooperative_groups;

#ifndef ONE_LAUNCH
#define ONE_LAUNCH 1
#endif

__device__ __forceinline__ int opaque_tid() { int t = (int)threadIdx.x; asm volatile("" : "+v"(t)); return t; }
__device__ __forceinline__ int opaque_bid() { int b = (int)blockIdx.x; asm volatile("" : "+s"(b)); return b; }
namespace pg8 {
#define PG8_LAS __attribute__((address_space(3)))
typedef unsigned short bf16_t;
typedef short bf16x8 __attribute__((ext_vector_type(8)));
typedef float f32x4 __attribute__((ext_vector_type(4)));
typedef unsigned u32x4 __attribute__((ext_vector_type(4)));
constexpr int BM = 256, BK = 64, HALF = 128, HTB = HALF * BK * 2  , STAGE_BYTES = 8 * HTB, NXCD = 8, WGM = 8;

__host__ __device__ __forceinline__ int lds_byte(int r, int c) { const int st = (r >> 4) * 2 + (c >> 5), rr = r & 15, cc = c & 31, ob = rr * 64 + cc * 2; return st * 1024 + (ob ^ (((ob >> 9) & 1) << 5)); }
__host__ __device__ __forceinline__ void stage_rc(int b, int& R, int& C) { const int st = b / 1024, sb = b % 1024, swz = sb ^ (((sb >> 9) & 1) << 5); R = (st >> 1) * 16 + swz / 64; C = (st & 1) * 32 + (swz % 64) / 2; }
__host__ __device__ __forceinline__ int perm32(int rho) { const int n = rho >> 4, i = rho & 15; return 8 * (i >> 2) + 4 * n + (i & 3); }
struct Unit { int pm, pn; };
struct Gemm { const bf16_t* A; const bf16_t* Bt; int M, N, K, lda; };
struct StaticOrder {
    int nM, nN, nwg, G, c;
    __host__ __device__ void init(int M, int N, int G_, int c_) { nM = M / BM; nN = N / BM; nwg = nM * nN; G = G_; c = c_; }
    __host__ __device__ bool next(int i, Unit& u) const {
        const long L = (long)i * G + c; if (L >= nwg) return false;
        int wgid = (int)L; { const int q = nwg / NXCD, r = nwg % NXCD, xcd = wgid % NXCD, off = wgid / NXCD; wgid = (xcd < r ? xcd * (q + 1) : r * (q + 1) + (xcd - r) * q) + off; }
        const int nig = WGM * nN, gid = wgid / nig, fm = gid * WGM, gsz = (nM - fm) < WGM ? (nM - fm) : WGM;
        u.pm = fm + ((wgid % nig) % gsz); u.pn = (wgid % nig) / gsz; return true;
    }
    __device__ __forceinline__ void a_ready(const Unit&) const {}
    __device__ __forceinline__ void done(const Unit&) const {}
};
__device__ __forceinline__ unsigned cvt_pk_bf16(float lo, float hi) { unsigned r; asm volatile("v_cvt_pk_bf16_f32 %0, %1, %2" : "=v"(r) : "v"(lo), "v"(hi)); return r; }
template <class Epi, class Sched>
__device__ __forceinline__ void gemm_phase(PG8_LAS unsigned char* lds, const Gemm g, const Sched& S, const Epi& E) {
    const int tid = opaque_tid(), wid = __builtin_amdgcn_readfirstlane(tid >> 6), lane = tid & 63, wr = wid >> 2, wc = wid & 3, fr = lane & 15, fq = lane >> 4;
    const int K = g.K, nt = K / BK;
    unsigned voffA[2], voffB[2];
#pragma unroll
    for (int i = 0; i < 2; ++i) { int R, C; stage_rc(tid * 16 + i * 8192, R, C); const int Rb = Epi::PERM ? ((R & ~31) + perm32(R & 31)) : R;
        voffA[i] = (unsigned)(R * g.lda + C) * 2u; voffB[i] = (unsigned)(Rb * K + C) * 2u; }
    const size_t kstep = (size_t)(BK * 2);
    const size_t hstep = (size_t)HALF * K * 2, hstepA = (size_t)HALF * g.lda * 2;
    const size_t tstep = 2 * hstep, tstepA = 2 * hstepA;
    const unsigned ldsw = (unsigned)wid * 1024u;
    const int aoff = lds_byte(wr * 64 + fr, fq * 8), boff = lds_byte(wc * 32 + fr, fq * 8);
#define PG8_SA(b, h) (((b) * 2 + (h)) * HTB)
#define PG8_SB(b, h) ((4 + (b) * 2 + (h)) * HTB)
#define PG8_STAGE(bufoff, gbase, voff) do { _Pragma("unroll") for (int _i = 0; _i < 2; ++_i) \
        __builtin_amdgcn_global_load_lds((const unsigned*)((const char*)(gbase) + (voff)[_i]), (PG8_LAS unsigned*)(lds + (bufoff) + ldsw + _i * 8192), 16, 0, 0); } while (0)
#define PG8_LDA(dst, b, h) do { _Pragma("unroll") for (int m = 0; m < 4; ++m) _Pragma("unroll") for (int k = 0; k < 2; ++k) dst[m][k] = *(const PG8_LAS bf16x8*)(lds + PG8_SA(b, h) + aoff + m * 2048 + k * 1024); } while (0)
#define PG8_LDB(dst, b, h) do { _Pragma("unroll") for (int n = 0; n < 2; ++n) _Pragma("unroll") for (int k = 0; k < 2; ++k) dst[n][k] = *(const PG8_LAS bf16x8*)(lds + PG8_SB(b, h) + boff + n * 2048 + k * 1024); } while (0)
#define PG8_MMA(ai, bj, At, Bt) do { __builtin_amdgcn_s_setprio(1); _Pragma("unroll") for (int m = 0; m < 4; ++m) _Pragma("unroll") for (int n = 0; n < 2; ++n) _Pragma("unroll") for (int k = 0; k < 2; ++k) \
        acc[ai][bj][m][n] = __builtin_amdgcn_mfma_f32_16x16x32_bf16(Bt[n][k], At[m][k], acc[ai][bj][m][n], 0, 0, 0); __builtin_amdgcn_s_setprio(0); } while (0)
#define PG8_WAIT_V(n) asm volatile("s_waitcnt vmcnt(" #n ")" ::: "memory")
#define PG8_WAIT_L(n) asm volatile("s_waitcnt lgkmcnt(" #n ")" ::: "memory")
#define PG8_BAR __builtin_amdgcn_s_barrier()
#define PG8_SCHED __builtin_amdgcn_sched_barrier(0)
#define PG8_TOUCH(gA, gB) do { if (nt >= 4) { const int r_ = tid >> 1, kt_ = 2 + (tid & 1); \
        __builtin_amdgcn_global_load_lds((const unsigned*)((const char*)(gA) + (size_t)r_ * g.lda * 2 + kt_ * 128), (PG8_LAS unsigned*)(lds + 131072 + 6144 + wid * 256), 4, 0, 0); \
        __builtin_amdgcn_global_load_lds((const unsigned*)((const char*)(gB) + (size_t)r_ * K * 2 + kt_ * 128), (PG8_LAS unsigned*)(lds + 131072 + 6144 + wid * 256), 4, 0, 0); } } while (0)
    Unit cur, nxt; int ui = 0;
    if (!S.next(0, cur)) return;
    f32x4 acc[2][2][4][2];
#pragma unroll
    for (int a = 0; a < 2; ++a)
#pragma unroll
        for (int b = 0; b < 2; ++b)
#pragma unroll
            for (int m = 0; m < 4; ++m)
#pragma unroll
                for (int n = 0; n < 2; ++n) acc[a][b][m][n] = (f32x4){0.f, 0.f, 0.f, 0.f};
    if constexpr (Epi::INIT_ACC) E.init_acc(acc, cur, wr, wc, fr, fq);
    bf16x8 At[4][2], B0[2][2], B1[2][2];
    const char* cA = (const char*)g.A + (size_t)cur.pm * tstepA; const char* cB = (const char*)g.Bt + (size_t)cur.pn * tstep;
    S.a_ready(cur);
    PG8_TOUCH(cA, cB);
    PG8_STAGE(PG8_SB(0, 0), cB, voffB); PG8_STAGE(PG8_SA(0, 0), cA, voffA); PG8_STAGE(PG8_SB(0, 1), cB + hstep, voffB); PG8_STAGE(PG8_SA(0, 1), cA + hstepA, voffA);
    if (wr == 1) PG8_BAR;
    PG8_WAIT_V(4); PG8_BAR;
    PG8_STAGE(PG8_SB(1, 0), cB + kstep, voffB); PG8_STAGE(PG8_SA(1, 0), cA + kstep, voffA); PG8_STAGE(PG8_SB(1, 1), cB + hstep + kstep, voffB);
    PG8_WAIT_V(6); PG8_BAR;
    for (;;) {
        const bool has_next = S.next(ui + 1, nxt);
        const char* nA = has_next ? (const char*)g.A + (size_t)nxt.pm * tstepA : cA; const char* nB = has_next ? (const char*)g.Bt + (size_t)nxt.pn * tstep : cB;
        for (int t = 0; t < nt; t += 2) {
            const bool last = (t == nt - 2);
            const char* a1 = cA + (size_t)(t + 1) * kstep;
            const char* a2 = last ? nA : cA + (size_t)(t + 2) * kstep; const char* b2 = last ? nB : cB + (size_t)(t + 2) * kstep;
            const char* a3 = a2 + kstep; const char* b3 = b2 + kstep;
            if (last && has_next) S.a_ready(nxt);
            PG8_LDB(B0, 0, 0); PG8_SCHED; PG8_LDA(At, 0, 0); PG8_STAGE(PG8_SA(1, 1), a1 + hstepA, voffA);
            PG8_WAIT_L(8); PG8_BAR; PG8_WAIT_L(0); PG8_MMA(0, 0, At, B0); PG8_BAR; PG8_SCHED;
            PG8_LDB(B1, 0, 1); PG8_STAGE(PG8_SB(0, 0), b2, voffB);
            PG8_BAR; PG8_WAIT_L(0); PG8_MMA(0, 1, At, B1); PG8_BAR;
            PG8_LDA(At, 0, 1); PG8_STAGE(PG8_SA(0, 0), a2, voffA);
            PG8_BAR; PG8_WAIT_L(0); PG8_MMA(1, 0, At, B0); PG8_BAR; PG8_SCHED;
            PG8_STAGE(PG8_SB(0, 1), b2 + hstep, voffB);
            PG8_WAIT_V(6); PG8_BAR; PG8_MMA(1, 1, At, B1); PG8_BAR;
            PG8_LDB(B0, 1, 0); PG8_SCHED; PG8_LDA(At, 1, 0); PG8_STAGE(PG8_SA(0, 1), a2 + hstepA, voffA);
            PG8_WAIT_L(8); PG8_BAR; PG8_WAIT_L(0); PG8_MMA(0, 0, At, B0); PG8_BAR; PG8_SCHED;
            PG8_LDB(B1, 1, 1); PG8_STAGE(PG8_SB(1, 0), b3, voffB);
            PG8_BAR; PG8_WAIT_L(0); PG8_MMA(0, 1, At, B1); PG8_BAR;
            PG8_LDA(At, 1, 1); PG8_STAGE(PG8_SA(1, 0), a3, voffA);
            PG8_BAR; PG8_WAIT_L(0); PG8_MMA(1, 0, At, B0); PG8_BAR; PG8_SCHED;
            PG8_STAGE(PG8_SB(1, 1), b3 + hstep, voffB);
            PG8_WAIT_V(6); PG8_BAR; PG8_MMA(1, 1, At, B1); PG8_BAR;
        }
        if (has_next) PG8_TOUCH(nA, nB);
        if constexpr (!Epi::AFTER_DRAIN) { E(acc, cur, wr, wc, fr, fq); S.done(cur); }
        if (!has_next) break;
#pragma unroll
        for (int a = 0; a < 2; ++a)
#pragma unroll
            for (int b = 0; b < 2; ++b)
#pragma unroll
                for (int m = 0; m < 4; ++m)
#pragma unroll
                    for (int n = 0; n < 2; ++n) acc[a][b][m][n] = (f32x4){0.f, 0.f, 0.f, 0.f};
        if constexpr (Epi::INIT_ACC) E.init_acc(acc, nxt, wr, wc, fr, fq);
        cur = nxt; cA = nA; cB = nB; ++ui;
    }
    PG8_WAIT_V(0);
    if (wr == 0) PG8_BAR;
    PG8_BAR;
    if constexpr (Epi::AFTER_DRAIN) { E.fused(acc, cur, wr, wc, fr, fq, lds, wid, lane); S.done(cur); }
#undef PG8_TOUCH
#undef PG8_SA
#undef PG8_SB
#undef PG8_STAGE
#undef PG8_LDA
#undef PG8_LDB
#undef PG8_MMA
#undef PG8_WAIT_V
#undef PG8_WAIT_L
#undef PG8_BAR
#undef PG8_SCHED
}
}
using pg8::bf16_t; using pg8::bf16x8; using pg8::f32x4; using pg8::u32x4;
#define LAS __attribute__((address_space(3)))
typedef short s16x4 __attribute__((ext_vector_type(4)));
typedef float f32x16 __attribute__((ext_vector_type(16)));
typedef unsigned u32x2 __attribute__((ext_vector_type(2)));

constexpr int SEQ = 2048, DM = 1024, NBATCH = 16, TT = NBATCH * SEQ, TH = TT / 2, BH = NBATCH / 2, DFF = 4096;
constexpr float EPS = 1e-6f, LOG2E = 1.4426950408889634f, LOG2_THETA = 13.287712379549449f;
constexpr int NTHR = 512;
constexpr int LDS_BYTES = 131072 + 8192;
constexpr int RS_OFF = 131072 + 2048;
constexpr size_t MiB = (size_t)1 << 20;
constexpr size_t WS_WIN = 0, WS_WQB = WS_WIN + 2 * MiB, WS_WKVB = WS_WQB + 3 * MiB, WS_WO = WS_WKVB + 4 * MiB, WS_WKVQ = WS_WO + 8 * MiB, WS_WQ1 = WS_WKVQ + 18 * MiB,
                 WS_WOB = WS_WQ1 + 6 * MiB, WS_W1 = WS_WOB + 4 * MiB, WS_W2 = WS_W1 + 32 * MiB, WS_XB = WS_W2 + 32 * MiB, WS_SS = WS_XB + 32 * MiB, WS_LSE = WS_SS + 1 * MiB,
                 WS_BAR = WS_LSE + 768 * 1024, WS_SSL = WS_LSE + 1 * MiB, WS_BIG = WS_SSL + 1 * MiB;
constexpr size_t WS_LAT = WS_BIG, WS_Q = WS_LAT + 16 * MiB, WS_KV = WS_Q + 96 * MiB, WS_KPE = WS_KV + 128 * MiB, WS_AO = WS_KPE + 32 * MiB;
constexpr size_t WS_SSK = WS_KPE, WS_KPER = WS_KPE + 8 * MiB;
constexpr size_t WS_KVB = WS_BIG, WS_QB = WS_BIG + 192 * MiB, WS_OB = WS_BIG + 288 * MiB;
constexpr size_t WS_H = WS_BIG + 192 * MiB;
constexpr size_t WS_OB2 = WS_XB, WS_LSE2 = WS_SSL;
constexpr size_t WS_END = WS_BIG + 336 * MiB;

struct Params { const void* in[20]; float* out; unsigned char* ws; int ph_lo, ph_hi; };

__device__ __forceinline__ unsigned cvtpk(float lo, float hi) { unsigned r; asm volatile("v_cvt_pk_bf16_f32 %0, %1, %2" : "=v"(r) : "v"(lo), "v"(hi)); return r; }
__device__ __forceinline__ float bf_lo(unsigned w) { return __uint_as_float(w << 16); }
__device__ __forceinline__ float bf_hi(unsigned w) { return __uint_as_float(w & 0xffff0000u); }
#define UNPACK8(W_, V_) do { const u32x4 t_ = (W_); V_[0] = bf_lo(t_[0]); V_[1] = bf_hi(t_[0]); V_[2] = bf_lo(t_[1]); V_[3] = bf_hi(t_[1]); V_[4] = bf_lo(t_[2]); V_[5] = bf_hi(t_[2]); V_[6] = bf_lo(t_[3]); V_[7] = bf_hi(t_[3]); } while (0)
#define PACK8(V_) ((u32x4){cvtpk(V_[0], V_[1]), cvtpk(V_[2], V_[3]), cvtpk(V_[4], V_[5]), cvtpk(V_[6], V_[7])})
__device__ __forceinline__ void sincos_rev(float pos, float invf_rev, float& s, float& c) {
    const float rev = __builtin_amdgcn_fractf(pos * invf_rev);
    s = __builtin_amdgcn_sinf(rev); c = __builtin_amdgcn_cosf(rev);
}

constexpr int NCV = 7;
__device__ __forceinline__ void cvt_job(const float* __restrict__ W, int K, int N, const float* __restrict__ gain, bf16_t* __restrict__ dst, int ldo, int& base, LAS float* tile) {
    const int tk = K / 64, tn = N / 64, nt = tk * tn, G = (int)gridDim.x, tid = opaque_tid();
    int start = (opaque_bid() - (base % G)); if (start < 0) start += G;
    for (int t0 = start; t0 < nt; t0 += NCV * G) {
        f32x4 v[NCV][2]; float g[NCV][2];
#pragma unroll
        for (int q = 0; q < NCV; ++q) { const int t = t0 + q * G; if (t < nt) { const int kt = t / tn, ntile = t - kt * tn;
#pragma unroll
            for (int i = 0; i < 2; ++i) { const int k = (tid >> 4) + 32 * i, n4 = (tid & 15) * 4;
                v[q][i] = *(const f32x4*)(W + (size_t)(kt * 64 + k) * N + ntile * 64 + n4); g[q][i] = gain ? gain[kt * 64 + k] : 1.0f; } } }
        __syncthreads();
#pragma unroll
        for (int q = 0; q < NCV; ++q) { const int t = t0 + q * G; if (t < nt) { LAS float* tq = tile + q * (64 * 65);
#pragma unroll
            for (int i = 0; i < 2; ++i) { const int k = (tid >> 4) + 32 * i, n4 = (tid & 15) * 4;
                tq[(n4 + 0) * 65 + k] = v[q][i].x * g[q][i]; tq[(n4 + 1) * 65 + k] = v[q][i].y * g[q][i]; tq[(n4 + 2) * 65 + k] = v[q][i].z * g[q][i]; tq[(n4 + 3) * 65 + k] = v[q][i].w * g[q][i]; } } }
        __syncthreads();
#pragma unroll
        for (int q = 0; q < NCV; ++q) { const int t = t0 + q * G; if (t < nt) { const int kt = t / tn, ntile = t - kt * tn; const int n = tid >> 3, k8 = (tid & 7) * 8;
            const LAS float* tp = tile + q * (64 * 65) + n * 65 + k8;
            u32x4 w; w.x = cvtpk(tp[0], tp[1]); w.y = cvtpk(tp[2], tp[3]); w.z = cvtpk(tp[4], tp[5]); w.w = cvtpk(tp[6], tp[7]);
            *(u32x4*)(dst + (size_t)(ntile * 64 + n) * ldo + kt * 64 + k8) = w; } }
    }
    base += nt;
}
__device__ __forceinline__ void zero_fill(bf16_t* dst, int rows, int cols8, int ld) {
    const size_t n = (size_t)rows * cols8;
    for (size_t i = (size_t)opaque_bid() * NTHR + opaque_tid(); i < n; i += (size_t)gridDim.x * NTHR) { const size_t r = i / cols8, c = i - r * cols8; *(u32x4*)(dst + r * ld + c * 8) = (u32x4){0u, 0u, 0u, 0u}; }
}
__device__ void prep_weights(const Params& p, LAS unsigned char* lds) {
    LAS float* tile = (LAS float*)lds;
    unsigned char* ws = p.ws;
    const float* attn_norm = (const float*)p.in[2]; const float* mlp_norm = (const float*)p.in[3];
    int base = 0;
    for (int a = 0; a < 2; ++a) {
        cvt_job((const float*)p.in[4] + (size_t)a * 1024 * 448, 1024, 448, attn_norm + a * 1024, (bf16_t*)(ws + WS_WIN) + (size_t)a * 512 * 1024, 1024, base, tile);
        cvt_job((const float*)p.in[7] + (size_t)a * 256 * 3072, 256, 3072, (const float*)p.in[5] + a * 256, (bf16_t*)(ws + WS_WQB) + (size_t)a * 3072 * 256, 256, base, tile);
        cvt_job((const float*)p.in[8] + (size_t)a * 128 * 4096, 128, 4096, (const float*)p.in[6] + a * 128, (bf16_t*)(ws + WS_WKVB) + (size_t)a * 4096 * 128, 128, base, tile);
        cvt_job((const float*)p.in[11] + (size_t)a * 2048 * 1024, 2048, 1024, nullptr, (bf16_t*)(ws + WS_WO) + (size_t)a * 1024 * 2048, 2048, base, tile);
        cvt_job((const float*)p.in[17] + (size_t)a * 1024 * 1024, 1024, 1024, nullptr, (bf16_t*)(ws + WS_WOB) + (size_t)a * 1024 * 1024, 1024, base, tile);
        zero_fill((bf16_t*)(ws + WS_WIN) + (size_t)a * 512 * 1024 + (size_t)448 * 1024, 64, 128, 1024);
    }
    cvt_job((const float*)p.in[13], 1024, 6144, (const float*)p.in[12], (bf16_t*)(ws + WS_WKVQ), 1024, base, tile);
    cvt_job((const float*)p.in[15], 1024, 3072, attn_norm + 2 * 1024, (bf16_t*)(ws + WS_WKVQ) + (size_t)6144 * 1024, 1024, base, tile);
    cvt_job((const float*)p.in[15] + (size_t)1024 * 3072, 1024, 3072, attn_norm + 3 * 1024, (bf16_t*)(ws + WS_WQ1), 1024, base, tile);
    for (int l = 0; l < 4; ++l) {
        cvt_job((const float*)p.in[18] + (size_t)l * 1024 * 4096, 1024, 4096, mlp_norm + l * 1024, (bf16_t*)(ws + WS_W1) + (size_t)l * 4096 * 1024, 1024, base, tile);
        cvt_job((const float*)p.in[19] + (size_t)l * 4096 * 1024, 4096, 1024, nullptr, (bf16_t*)(ws + WS_W2) + (size_t)l * 1024 * 4096, 4096, base, tile);
    }
    __syncthreads();
}
__device__ void prep_x(const float* __restrict__ x, bf16_t* __restrict__ xb, float* __restrict__ ss) {
    const int tid_ = opaque_tid(), lane = tid_ & 63, gw = opaque_bid() * 8 + (tid_ >> 6), nw = gridDim.x * 8;
    for (int r0 = gw; r0 < TH; r0 += 4 * nw) {
        f32x4 v[4][4];
#pragma unroll
        for (int q = 0; q < 4; ++q) { const int r = r0 + q * nw; if (r < TH) {
#pragma unroll
            for (int i = 0; i < 4; ++i) v[q][i] = *(const f32x4*)(x + (size_t)r * 1024 + i * 256 + lane * 4); } }
#pragma unroll
        for (int q = 0; q < 4; ++q) { const int r = r0 + q * nw; if (r < TH) { bf16_t* br = xb + (size_t)r * 1024; float s_ = 0.f;
#pragma unroll
            for (int i = 0; i < 4; ++i) { const f32x4 w = v[q][i]; s_ += w.x * w.x + w.y * w.y + w.z * w.z + w.w * w.w;
                *(u32x2*)(br + i * 256 + lane * 4) = (u32x2){cvtpk(w.x, w.y), cvtpk(w.z, w.w)}; }
#pragma unroll
            for (int o = 1; o < 64; o <<= 1) s_ += __shfl_xor(s_, o);
            if (lane < 16) ss[(size_t)r * 16 + lane] = lane == 0 ? s_ : 0.f; } }
    }
}

struct EpiBf16S {
    static constexpr bool PERM = true, AFTER_DRAIN = false, INIT_ACC = false;
    bf16_t* O; int ldc; bf16_t* O2; int ldc2; int split; const float* ss; int nsl4; float inv_n; int act; float* ssl; float* ssk; const LAS float* rs; int pm0;
    __device__ __forceinline__ void operator()(const f32x4 (&acc)[2][2][4][2], const pg8::Unit& u, int wr, int wc, int fr, int fq) const {
        const int row0 = u.pm * 256 + wr * 64 + fr; int colt = u.pn * 256; bf16_t* base = O; int ld = ldc;
        if (colt >= split) { base = O2; colt -= split; ld = ldc2; }
        const int col0 = colt + wc * 32 + 8 * fq;
#pragma unroll
        for (int ai = 0; ai < 2; ++ai)
#pragma unroll
            for (int m = 0; m < 4; ++m) { const int row = row0 + ai * 128 + m * 16; float sc = 1.0f;
                if (ss) { if (u.pm == pm0) sc = rs[(wr * 4 + wc) * 128 + ai * 64 + m * 16 + fr];
                    else { const f32x4* sp = (const f32x4*)(ss + (size_t)row * 16); f32x4 a = sp[0]; if (nsl4 == 4) a = (a + sp[1]) + (sp[2] + sp[3]); sc = rsqrtf(((a.x + a.y) + (a.z + a.w)) * inv_n + EPS); } }
                bf16_t* rowp = base + (size_t)row * ld + col0; float sa = 0.f, sb = 0.f;
#pragma unroll
                for (int bj = 0; bj < 2; ++bj) { f32x4 v0 = acc[ai][bj][m][0] * sc, v1 = acc[ai][bj][m][1] * sc;
                    if (act) {
#pragma unroll
                        for (int j = 0; j < 4; ++j) { const float a0 = fmaxf(v0[j], 0.f), a1 = fmaxf(v1[j], 0.f); v0[j] = a0 * a0; v1[j] = a1 * a1; } }
                    float sq = 0.f; if (ssl || ssk) sq = ((v0[0] * v0[0] + v0[1] * v0[1]) + (v0[2] * v0[2] + v0[3] * v0[3])) + ((v1[0] * v1[0] + v1[1] * v1[1]) + (v1[2] * v1[2] + v1[3] * v1[3]));
                    if (bj == 0) sa = sq; else sb = sq;
                    u32x4 w; w.x = cvtpk(v0[0], v0[1]); w.y = cvtpk(v0[2], v0[3]); w.z = cvtpk(v1[0], v1[1]); w.w = cvtpk(v1[2], v1[3]);
                    *(u32x4*)(rowp + bj * 128) = w; }
                if (ssk) { float sk_ = sa; sk_ += __shfl_xor(sk_, 16); sk_ += __shfl_xor(sk_, 32); if (fq == 0) ssk[((size_t)row * 16 + u.pn) * 4 + wc] = sk_; }
                if (ssl) { sa += __shfl_xor(sa, 16); sa += __shfl_xor(sa, 32); sb += __shfl_xor(sb, 16); sb += __shfl_xor(sb, 32);
                    if (fq == 0) { float* sr_ = ssl + (size_t)row * 16; if (u.pn == 0) sr_[wc] = sa + sb; else { sr_[4 + wc] = sa; sr_[8 + wc] = sb; } } } }
    }
};
struct EpiRes {
    static constexpr bool PERM = false, AFTER_DRAIN = false, INIT_ACC = true;
    const float* xin; float* xout; bf16_t* xb; float* ss;
    __device__ __forceinline__ void init_acc(f32x4 (&acc)[2][2][4][2], const pg8::Unit& u, int wr, int wc, int fr, int fq) const {
        const int row0 = u.pm * 256 + wr * 64 + fr, col0 = u.pn * 256 + wc * 32 + 4 * fq;
#pragma unroll
        for (int ai = 0; ai < 2; ++ai)
#pragma unroll
            for (int m = 0; m < 4; ++m) { const size_t off = (size_t)(row0 + ai * 128 + m * 16) * 1024 + col0;
#pragma unroll
                for (int bj = 0; bj < 2; ++bj)
#pragma unroll
                    for (int n = 0; n < 2; ++n) acc[ai][bj][m][n] = *(const f32x4*)(xin + off + bj * 128 + n * 16); }
    }
    __device__ __forceinline__ void operator()(const f32x4 (&acc)[2][2][4][2], const pg8::Unit& u, int wr, int wc, int fr, int fq) const {
        const int row0 = u.pm * 256 + wr * 64 + fr, col0 = u.pn * 256 + wc * 32 + 4 * fq;
#pragma unroll
        for (int ai = 0; ai < 2; ++ai)
#pragma unroll
            for (int m = 0; m < 4; ++m) { const int row = row0 + ai * 128 + m * 16; const size_t off = (size_t)row * 1024 + col0; float s = 0.f;
#pragma unroll
                for (int bj = 0; bj < 2; ++bj)
#pragma unroll
                    for (int n = 0; n < 2; ++n) { const int c = bj * 128 + n * 16; const f32x4 o = acc[ai][bj][m][n];
                        *(f32x4*)(xout + off + c) = o; s += (o.x * o.x + o.y * o.y) + (o.z * o.z + o.w * o.w);
                        *(u32x2*)(xb + off + c) = (u32x2){cvtpk(o.x, o.y), cvtpk(o.z, o.w)}; }
                s += __shfl_xor(s, 16); s += __shfl_xor(s, 32);
                if (fq == 0) ss[(size_t)row * 16 + u.pn * 4 + wc] = s; }
    }
};
template <class Epi> __device__ __forceinline__ void run_gemm(LAS unsigned char* lds, const bf16_t* A, int lda, const bf16_t* Bt, int N, int K, const Epi& E) {
    pg8::Gemm g{A, Bt, TH, N, K, lda}; pg8::StaticOrder S; S.init(TH, N, (int)gridDim.x, opaque_bid());
    pg8::gemm_phase<Epi, pg8::StaticOrder>(lds, g, S, E);
}
__device__ __forceinline__ void run_gemm_bf16(LAS unsigned char* lds, const bf16_t* A, int lda, const bf16_t* Bt, int N, int K, EpiBf16S E) {
    pg8::Gemm g{A, Bt, TH, N, K, lda}; pg8::StaticOrder S; S.init(TH, N, (int)gridDim.x, opaque_bid());
    E.rs = (const LAS float*)(lds + RS_OFF); E.pm0 = -1;
    pg8::Unit u0;
    if (E.ss && S.next(0, u0)) {
        const int tid = opaque_tid(), wid = tid >> 6, lane = tid & 63, wr = wid >> 2;
        LAS float* tab = (LAS float*)(lds + RS_OFF) + wid * 128;
#pragma unroll
        for (int hh = 0; hh < 2; ++hh) { const int row = u0.pm * 256 + hh * 128 + wr * 64 + lane;
            const f32x4* sp = (const f32x4*)(E.ss + (size_t)row * 16); f32x4 a = sp[0]; if (E.nsl4 == 4) a = (a + sp[1]) + (sp[2] + sp[3]);
            tab[hh * 64 + lane] = rsqrtf(((a.x + a.y) + (a.z + a.w)) * E.inv_n + EPS); }
        E.pm0 = u0.pm;
    }
    pg8::gemm_phase<EpiBf16S, pg8::StaticOrder>(lds, g, S, E);
}

__device__ void lat_prep(bf16_t* lat) {
    const int tid_ = opaque_tid(), lane = tid_ & 63, gw = opaque_bid() * 8 + (tid_ >> 6), nw = gridDim.x * 8;
    for (int t = gw; t < TH; t += nw) {
        bf16_t* p = lat + (size_t)t * 512 + lane * 8; const u32x4 w = *(const u32x4*)p; float v[8]; UNPACK8(w, v);
        float s = 0.f;
#pragma unroll
        for (int e = 0; e < 8; ++e) s += v[e] * v[e];
        s += __shfl_xor(s, 1); s += __shfl_xor(s, 2); s += __shfl_xor(s, 4); s += __shfl_xor(s, 8);
        const float s32 = s + __shfl_xor(s, 16);
        const float rstd = lane < 32 ? rsqrtf(s32 * (1.0f / 256.0f) + EPS) : rsqrtf(s * (1.0f / 128.0f) + EPS);
        if (lane < 48) {
#pragma unroll
            for (int e = 0; e < 8; ++e) v[e] *= rstd;
            *(u32x4*)p = PACK8(v); }
    }
}
__device__ void kpe_prep(const bf16_t* lat, const int* pos, const float* gk, bf16_t* kper) {
    const int tid = opaque_tid(), grp = tid >> 3, l8 = tid & 7;
    float invf[8], g[8];
#pragma unroll
    for (int e = 0; e < 8; ++e) { invf[e] = exp2f(-(float)((l8 & 3) * 8 + e) * (LOG2_THETA / 32.0f)) * 0.15915494309189535f; g[e] = gk[128 + l8 * 8 + e]; }
    for (int t = opaque_bid() * 64 + grp; t < TH; t += (int)gridDim.x * 64) {
        const float posf = (float)pos[t];
        const u32x4 w = *(const u32x4*)(lat + (size_t)t * 512 + 384 + l8 * 8); float v[8]; UNPACK8(w, v);
#pragma unroll
        for (int e = 0; e < 8; ++e) { const float y = v[e] * g[e]; const float pr = __shfl_xor(y, 4); float sn_, cs_; sincos_rev(posf, invf[e], sn_, cs_);
            v[e] = (l8 & 4) ? y * cs_ + pr * sn_ : y * cs_ - pr * sn_; }
        *(u32x4*)(kper + (size_t)t * 64 + l8 * 8) = PACK8(v);
    }
}
__device__ void head_prep(bf16_t* kbuf  , bf16_t* qbuf, const int* pos, const float* gk, const float* gq) {
    const int tid_ = opaque_tid(), lane = tid_ & 63, gw = opaque_bid() * 8 + (tid_ >> 6), nw = gridDim.x * 8;
    const float qscale = 0.08838834764831845f * LOG2E;
    const int c16 = lane & 15;
    float invf[8];
#pragma unroll
    for (int e = 0; e < 8; ++e) invf[e] = exp2f(-(float)((c16 & 7) * 8 + e) * (LOG2_THETA / 64.0f)) * 0.15915494309189535f;
    for (int t = gw; t < TH; t += nw) {
        const float posf = (float)pos[t];
        float cs[8], sn[8];
#pragma unroll
        for (int e = 0; e < 8; ++e) sincos_rev(posf, invf[e], sn[e], cs[e]);
        u32x4 wv[6];
#pragma unroll
        for (int itr = 0; itr < 6; ++itr) wv[itr] = *(const u32x4*)(kbuf + (size_t)t * 6144 + (itr * 4 + (lane >> 4)) * 128 + c16 * 8);
#pragma unroll
        for (int itr = 0; itr < 6; ++itr) { const bool isq = false;
            const int hh = (isq ? itr - 6 : itr) * 4 + (lane >> 4), g = hh >> 3;
            bf16_t* p = isq ? qbuf + (size_t)t * 3072 + hh * 128 + c16 * 8 : kbuf + (size_t)t * 6144 + hh * 128 + c16 * 8;
            const float* gn = (isq ? gq : gk) + g * 128 + c16 * 8;
            float v[8]; UNPACK8(wv[itr], v); float s = 0.f;
#pragma unroll
            for (int e = 0; e < 8; ++e) s += v[e] * v[e];
            s += __shfl_xor(s, 1); s += __shfl_xor(s, 2); s += __shfl_xor(s, 4); s += __shfl_xor(s, 8);
            const float rstd = rsqrtf(s * (1.0f / 128.0f) + EPS), osc = isq ? qscale : 1.0f;
#pragma unroll
            for (int e = 0; e < 8; ++e) { const float y = v[e] * rstd * gn[e]; const float pr = __shfl_xor(y, 8);
                v[e] = ((c16 & 8) ? y * cs[e] + pr * sn[e] : y * cs[e] - pr * sn[e]) * osc; }
            *(u32x4*)p = PACK8(v); }
    }
}

struct AttnItem { const bf16_t* o2; const float* lse2; const bf16_t* q; const bf16_t* k; const bf16_t* kpe; const bf16_t* v; bf16_t* o; float* lse; const int* pos; const float* gq; const float* gk; const float* ssk; const float* ssl; int q_ld, k_ld, kpe_ld, v_ld, o_ld, P0, ld, merge; };
__device__ __forceinline__ int v_st(int k, int c) { const int kk = (k & ~0xC) | ((k & 4) << 1) | ((k & 8) >> 1); return ((kk >> 3) * 4 + (c >> 5)) * 512 + ((kk & 7) * 32 + (c & 31)) * 2; }
__device__ __forceinline__ int v_rd_base(int lane) { return ((lane & 3) << 3) | (((lane >> 2) & 3) << 6) | (((lane >> 4) & 1) << 5) | (((lane >> 5) & 1) << 8); }
#define PK4(P, B_, OUT) do { unsigned a0_ = cvtpk(P[B_+0], P[B_+1]), a1_ = cvtpk(P[B_+2], P[B_+3]); unsigned b0_ = cvtpk(P[B_+4], P[B_+5]), b1_ = cvtpk(P[B_+6], P[B_+7]); \
        auto r0_ = __builtin_amdgcn_permlane32_swap(a0_, b0_, false, false); auto r1_ = __builtin_amdgcn_permlane32_swap(a1_, b1_, false, false); \
        u32x4 w_ = {r0_[0], r1_[0], r0_[1], r1_[1]}; OUT = w_; } while (0)
__device__ __forceinline__ bf16x8 as_bf(u32x4 w) { return *reinterpret_cast<bf16x8*>(&w); }

template <int DQK, int MODE>
__device__ __forceinline__ void attn_block(const AttnItem& it, LAS unsigned char* lds) {
    constexpr int RS = DQK * 2, SHM_K = 64 * RS, SHM_V = 16384, ND0 = DQK / 16, KCH = DQK / 8, NKC = (64 * KCH) / 512;
    const int tid = opaque_tid(), wid = __builtin_amdgcn_readfirstlane(tid >> 6), lane = tid & 63, r32 = lane & 31, hi = lane >> 5;
    const int ld = it.ld, Lm1 = (2048 >> ld) - 1, lsh = 11 - ld;
#define TOK(p) (MODE == 0 ? (p) : ((((p) & Lm1) << ld) | ((p) >> lsh)))
#define LOF(p) (MODE == 0 ? 0 : max((p) - 128, (p) & ~Lm1))
    const int q0 = it.P0 + wid * 32, qp = q0 + r32;
    const int span = qp - LOF(qp), lo_w = LOF(q0), lo_last = LOF(q0 + 31);
    LAS unsigned char* V_lds = lds; LAS unsigned char* K_lds = lds + 2 * SHM_V;
    const int j_lo = LOF(it.P0) >> 6, NT = (it.P0 >> 6) + 4 - j_lo;
    const int sr = tid >> 4, sc = (tid & 15) * 8, vst0 = v_st(sr, sc), vst1 = v_st(32 + sr, sc);
    constexpr int NSET = (MODE == 1) ? 2 : 1;
    bf16x8 sk[NSET][NKC], sv0[NSET], sv1[NSET]; f32x4 s_k4 = {0.f, 0.f, 0.f, 0.f}, s_p4 = {0.f, 0.f, 0.f, 0.f};
    constexpr int KRS_OFF = 2 * SHM_V + 2 * SHM_K;
    int offk[NKC], offv0 = sr * it.v_ld + sc, offv1 = (32 + sr) * it.v_ld + sc;
#pragma unroll
    for (int i_ = 0; i_ < NKC; ++i_) { const int c_ = tid + 512 * i_, row_ = c_ / KCH, cc_ = c_ - row_ * KCH; offk[i_] = (DQK == 192 && cc_ >= 16) ? row_ * it.kpe_ld + (cc_ - 16) * 8 : row_ * it.k_ld + cc_ * 8; }
#define SLOAD(S_, kb_) do { if (MODE == 0) { const bf16_t* kt_ = it.k + (size_t)(kb_) * it.k_ld; const bf16_t* pt_ = it.kpe + (size_t)(kb_) * it.kpe_ld; const bf16_t* vt_ = it.v + (size_t)(kb_) * it.v_ld; \
            _Pragma("unroll") for (int i_ = 0; i_ < NKC; ++i_) { const int c_ = tid + 512 * i_, row_ = c_ / KCH, cc_ = c_ - row_ * KCH; sk[S_][i_] = *(const bf16x8*)(((DQK == 192 && cc_ >= 16) ? pt_ : kt_) + offk[i_]); } \
            sv0[S_] = *(const bf16x8*)(vt_ + offv0); sv1[S_] = *(const bf16x8*)(vt_ + offv1); \
            if (tid < 64) { s_k4 = *(const f32x4*)(it.ssk + (size_t)((kb_) + tid) * 64); s_p4 = *(const f32x4*)(it.ssl + (size_t)((kb_) + tid) * 16); } } else { \
        _Pragma("unroll") for (int i_ = 0; i_ < NKC; ++i_) { const int c_ = tid + 512 * i_, row_ = c_ / KCH, cc_ = c_ - row_ * KCH; const int tk_ = TOK((kb_) + row_); \
            sk[S_][i_] = *(const bf16x8*)(it.k + (size_t)tk_ * it.k_ld + cc_ * 8); } \
        { const int t0_ = TOK((kb_) + sr), t1_ = TOK((kb_) + 32 + sr); sv0[S_] = *(const bf16x8*)(it.v + (size_t)t0_ * it.v_ld + sc); sv1[S_] = *(const bf16x8*)(it.v + (size_t)t1_ * it.v_ld + sc); } } } while (0)
#define SWRITE(S_, bf_) do { _Pragma("unroll") for (int i_ = 0; i_ < NKC; ++i_) { const int c_ = tid + 512 * i_, row_ = c_ / KCH, cc_ = c_ - row_ * KCH; const int swz_ = (((DQK == 128) ? row_ : (row_ >> 1)) & 7) << 4; \
            *(LAS bf16x8*)(K_lds + (bf_) * SHM_K + row_ * RS + ((cc_ * 16) ^ swz_)) = sk[S_][i_]; } \
        *(LAS bf16x8*)(V_lds + (bf_) * SHM_V + vst0) = sv0[S_]; *(LAS bf16x8*)(V_lds + (bf_) * SHM_V + vst1) = sv1[S_]; \
        if (MODE == 0 && tid < 64) { const f32x4 a_ = s_k4 + s_p4; *(LAS float*)(lds + KRS_OFF + (bf_) * 256 + tid * 4) = rsqrtf(((a_.x + a_.y) + (a_.z + a_.w)) * (1.0f / 192.0f) + EPS); } } while (0)
    float m_reg = -1e30f, l_reg = 0.f; f32x16 o[4];
#pragma unroll
    for (int d = 0; d < 4; ++d)
#pragma unroll
        for (int r = 0; r < 16; ++r) o[d][r] = 0.f;
    SLOAD(0, j_lo * 64); if (MODE == 1) SLOAD(NSET - 1, j_lo * 64 + 64);
    bf16x8 qr[ND0];
    {
      constexpr int NR = (MODE == 0) ? 2 : 4;
      constexpr int R0 = (MODE == 0) ? 8 : 0;
      constexpr float QS = ((MODE == 0) ? 0.07216878364870322f : 0.08838834764831845f) * LOG2E;
      constexpr float FSTEP = LOG2_THETA / ((MODE == 0) ? 32.0f : 64.0f);
      const int tq_ = TOK(qp);
      const bf16_t* qrow = it.q + (size_t)tq_ * it.q_ld + hi * 8;
      u32x4 raw[ND0]; float ssq = 0.f;
#pragma unroll
      for (int d0 = 0; d0 < ND0; ++d0) raw[d0] = *(const u32x4*)(qrow + d0 * 16);
      const float posf = (float)it.pos[tq_];
#pragma unroll
      for (int d0 = 0; d0 < ND0; ++d0) { float v[8]; UNPACK8(raw[d0], v);
#pragma unroll
          for (int e = 0; e < 8; ++e) ssq += v[e] * v[e]; }
      { auto rr = __builtin_amdgcn_permlane32_swap(__float_as_uint(ssq), __float_as_uint(ssq), false, false); ssq = __uint_as_float(rr[0]) + __uint_as_float(rr[1]); }
      const float rq = rsqrtf(ssq * (1.0f / (float)DQK) + EPS) * QS;
      const float* gp = it.gq + hi * 8;
#pragma unroll
      for (int d0 = 0; d0 < ND0; ++d0) {
          if (d0 >= R0 + NR && d0 < R0 + 2 * NR) continue;
          f32x4 g0 = *(const f32x4*)(gp + d0 * 16), g1 = *(const f32x4*)(gp + d0 * 16 + 4);
          if (MODE == 0 && d0 < 8) { g0 *= *(const f32x4*)(it.gk + hi * 8 + d0 * 16); g1 *= *(const f32x4*)(it.gk + hi * 8 + d0 * 16 + 4); }
          float v[8]; UNPACK8(raw[d0], v);
#pragma unroll
          for (int e = 0; e < 8; ++e) v[e] *= rq * (e < 4 ? g0[e & 3] : g1[e & 3]);
          if (d0 >= R0 && d0 < R0 + NR) {
              const f32x4 h0 = *(const f32x4*)(gp + (d0 + NR) * 16), h1 = *(const f32x4*)(gp + (d0 + NR) * 16 + 4);
              float w[8]; UNPACK8(raw[d0 + NR], w);
#pragma unroll
              for (int e = 0; e < 8; ++e) { w[e] *= rq * (e < 4 ? h0[e & 3] : h1[e & 3]);
                  float sn_, cs_; sincos_rev(posf, __builtin_amdgcn_exp2f(-(float)((d0 - R0) * 16 + hi * 8 + e) * FSTEP - 2.6514961294723187f), sn_, cs_);
                  const float x1 = v[e], x2 = w[e]; v[e] = x1 * cs_ - x2 * sn_; w[e] = x2 * cs_ + x1 * sn_; }
              qr[d0 + NR] = as_bf(PACK8(w)); }
          qr[d0] = as_bf(PACK8(v)); } }
    SWRITE(0, 0); __syncthreads();
    const int swzr = (((DQK == 128) ? r32 : (r32 >> 1)) & 7) << 4;
    int kro[4];
#pragma unroll
    for (int dd = 0; dd < 4; ++dd) kro[dd] = r32 * RS + ((dd * 32 + hi * 16) ^ swzr);
#pragma unroll 1
    for (int t2 = 0; t2 < NT; t2 += NSET) {
#pragma unroll
      for (int us = 0; us < NSET; ++us) { const int t = t2 + us; if (t < NT) {
        const int kb = (j_lo + t) * 64, buf = t & 1;
        if (MODE == 1) { if (t + 2 < NT) SLOAD(us, kb + 128); } else { if (t + 1 < NT) SLOAD(0, kb + 64); }
#pragma unroll 1
        for (int hf = 0; hf < 2; ++hf) {
            const int kh = kb + 32 * hf;
            const bool act = (kh <= q0 + 31) && (kh + 31 >= lo_w);
            if (act) {
                f32x16 p0;
#pragma unroll
                for (int r = 0; r < 16; ++r) p0[r] = 0.f;
                { const LAS unsigned char* kbp = K_lds + buf * SHM_K + hf * (32 * RS);
#pragma unroll
                  for (int d0 = 0; d0 < ND0; ++d0) {
                      const bf16x8 b0 = *(const LAS bf16x8*)(kbp + kro[d0 & 3] + (d0 >> 2) * 128);
                      p0 = __builtin_amdgcn_mfma_f32_32x32x16_bf16(b0, qr[d0], p0, 0, 0, 0); } }
                if (MODE == 0) { const LAS float* kr_ = (const LAS float*)(lds + KRS_OFF + buf * 256) + 32 * hf + 4 * hi;
#pragma unroll
                    for (int j4 = 0; j4 < 4; ++j4) { const f32x4 s4 = *(const LAS f32x4*)(kr_ + 8 * j4);
#pragma unroll
                        for (int e = 0; e < 4; ++e) p0[4 * j4 + e] *= s4[e]; } }
                if (!((kh + 31 <= q0) && (kh >= lo_last))) {
                    const int dq = qp - kh - 4 * hi; const float NEG = -__builtin_inff();
#pragma unroll
                    for (int r = 0; r < 16; ++r) { const int c = (r & 3) + 8 * (r >> 2); if ((unsigned)(dq - c) > (unsigned)span) p0[r] = NEG; } }
                float pmax = p0[0];
#pragma unroll
                for (int r = 1; r < 16; ++r) pmax = fmaxf(pmax, p0[r]);
                { auto rr = __builtin_amdgcn_permlane32_swap(__float_as_uint(pmax), __float_as_uint(pmax), false, false); pmax = fmaxf(__uint_as_float(rr[0]), __uint_as_float(rr[1])); }
                float mn = m_reg, alpha = 1.0f;
                const bool resc = !__all(pmax - m_reg <= 8.0f);
                if (resc) { mn = fmaxf(m_reg, pmax); alpha = __builtin_amdgcn_exp2f(m_reg - mn); m_reg = mn; }
                float ps = 0.f;
#pragma unroll
                for (int r = 0; r < 16; ++r) { p0[r] = __builtin_amdgcn_exp2f(p0[r] - mn); ps += p0[r]; }
                { auto rr = __builtin_amdgcn_permlane32_swap(__float_as_uint(ps), __float_as_uint(ps), false, false); ps = __uint_as_float(rr[0]) + __uint_as_float(rr[1]); }
                l_reg = l_reg * alpha + ps;
                u32x4 pa0, pa1; PK4(p0, 0, pa0); PK4(p0, 8, pa1);
                if (resc) {
#pragma unroll
                    for (int d = 0; d < 4; ++d)
#pragma unroll
                        for (int r = 0; r < 16; ++r) o[d][r] *= alpha; }
                const unsigned vb = (unsigned)(uintptr_t)(V_lds + buf * SHM_V + hf * 8192) + (unsigned)v_rd_base(lane);
#define TRRD(dst, off) asm volatile("ds_read_b64_tr_b16 %0, %1 offset:%2" : "=&v"(dst) : "v"(vb), "i"(off) : "memory")
#define PV_D0(d0) do { s16x4 l0, l1, h0, h1; constexpr int b_ = (d0) * 512; \
                TRRD(l0, b_); TRRD(h0, b_ + 2048); TRRD(l1, b_ + 4096); TRRD(h1, b_ + 6144); \
                asm volatile("s_waitcnt lgkmcnt(0)" ::: "memory"); __builtin_amdgcn_sched_barrier(0); \
                o[d0] = __builtin_amdgcn_mfma_f32_32x32x16_bf16((bf16x8){l0[0], l0[1], l0[2], l0[3], h0[0], h0[1], h0[2], h0[3]}, as_bf(pa0), o[d0], 0, 0, 0); \
                o[d0] = __builtin_amdgcn_mfma_f32_32x32x16_bf16((bf16x8){l1[0], l1[1], l1[2], l1[3], h1[0], h1[1], h1[2], h1[3]}, as_bf(pa1), o[d0], 0, 0, 0); } while (0)
                PV_D0(0); PV_D0(1); PV_D0(2); PV_D0(3);
#undef PV_D0
#undef TRRD
            }
        }
        if (t + 1 < NT) SWRITE((NSET - 1) - us, buf ^ 1);
        __syncthreads();
      } }
    }
    const int tq = TOK(qp);
    float a_cur = 1.0f / l_reg, a_pa = 0.f, a_pb = 0.f;
    if (MODE == 1) {
        const float lse_cur = m_reg + __builtin_amdgcn_logf(l_reg); float lse_new = lse_cur;
        if (it.merge) { const float la = it.lse[(size_t)tq * 8], lb = it.lse2[(size_t)tq * 8]; const float mx = fmaxf(fmaxf(la, lb), lse_cur);
            const float ea = __builtin_amdgcn_exp2f(la - mx), eb = __builtin_amdgcn_exp2f(lb - mx), ec = __builtin_amdgcn_exp2f(lse_cur - mx); const float inv = 1.0f / (ea + eb + ec);
            lse_new = mx + __builtin_amdgcn_logf(ea + eb + ec); a_pa = ea * inv; a_pb = eb * inv; a_cur *= ec * inv; }
        if (hi == 0) it.lse[(size_t)tq * 8] = lse_new;
    }
    bf16_t* orow = it.o + (size_t)tq * it.o_ld + hi * 8;
    const bf16_t* orow2 = (MODE == 1) ? it.o2 + (size_t)tq * it.o_ld + hi * 8 : nullptr;
    u32x4 mq0[4], mq1[4], mr0[4], mr1[4];
    if (MODE == 1 && it.merge) {
#pragma unroll
        for (int d0 = 0; d0 < 4; ++d0) { mq0[d0] = *(const u32x4*)(orow + d0 * 32); mq1[d0] = *(const u32x4*)(orow + d0 * 32 + 16); mr0[d0] = *(const u32x4*)(orow2 + d0 * 32); mr1[d0] = *(const u32x4*)(orow2 + d0 * 32 + 16); } }
#pragma unroll
    for (int d0 = 0; d0 < 4; ++d0) {
#pragma unroll
        for (int r = 0; r < 16; ++r) o[d0][r] *= a_cur;
        u32x4 w0, w1; PK4(o[d0], 0, w0); PK4(o[d0], 8, w1);
        if (MODE == 1 && it.merge) {
            const u32x4 q0w = mq0[d0], q1w = mq1[d0], r0w = mr0[d0], r1w = mr1[d0];
            float a[8], b[8], c[8];
            UNPACK8(w0, a); UNPACK8(q0w, b); UNPACK8(r0w, c);
#pragma unroll
            for (int e = 0; e < 8; ++e) a[e] += b[e] * a_pa + c[e] * a_pb;
            w0 = PACK8(a);
            UNPACK8(w1, a); UNPACK8(q1w, b); UNPACK8(r1w, c);
#pragma unroll
            for (int e = 0; e < 8; ++e) a[e] += b[e] * a_pa + c[e] * a_pb;
            w1 = PACK8(a);
        }
        *(u32x4*)(orow + d0 * 32) = w0; *(u32x4*)(orow + d0 * 32 + 16) = w1;
    }
#undef SLOAD
#undef SWRITE
#undef TOK
#undef LOF
}

__device__ void mla_attn_phase(const Params& p, LAS unsigned char* lds, const int* pos, const float* gq, const float* gk) {
    unsigned char* ws = p.ws;
    const int G_ = (int)gridDim.x, bid_ = opaque_bid(), vb_ = (G_ % 8 == 0) ? (bid_ % 8) * (G_ / 8) + bid_ / 8 : bid_;
    for (int item = vb_; item < BH * 16 * 4; item += G_) {
        const int bh = item >> 2, pr = item & 3, b = bh >> 4, h = bh & 15; const size_t tb = (size_t)b * SEQ;
        AttnItem it; it.q = (const bf16_t*)(ws + WS_Q) + tb * 3072 + h * 192; it.q_ld = 3072;
        it.k = (const bf16_t*)(ws + WS_KV) + tb * 4096 + h * 256; it.k_ld = 4096; it.kpe = (const bf16_t*)(ws + WS_KPER) + tb * 64; it.kpe_ld = 64; it.gk = gk; it.ssk = (const float*)(ws + WS_SSK) + (tb * 16 + h) * 4; it.ssl = (const float*)(ws + WS_SSL) + tb * 16 + 8;
        it.v = (const bf16_t*)(ws + WS_KV) + tb * 4096 + h * 256 + 128; it.v_ld = 4096; it.o = (bf16_t*)(ws + WS_AO) + tb * 2048 + h * 128; it.o_ld = 2048;
        it.lse = nullptr; it.o2 = nullptr; it.lse2 = nullptr; it.ld = 0; it.merge = 0; it.pos = pos + tb; it.gq = gq;
#pragma unroll 1
        for (int k2 = 0; k2 < 2; ++k2) { it.P0 = (k2 == 0 ? 7 - pr : pr) * 256; attn_block<192, 0>(it, lds); }
    }
}
__device__ void dil_attn_phase(const Params& p, LAS unsigned char* lds, int pg, const int* pos, const float* gq) {
    unsigned char* ws = p.ws;
    const int G_ = (int)gridDim.x, bid_ = opaque_bid(), vb_ = (G_ % 8 == 0) ? (bid_ % 8) * (G_ / 8) + bid_ / 8 : bid_;
    const int nitems = pg == 0 ? 2 * BH * 8 * 8 : BH * 8 * 8;
#pragma unroll 1
    for (int item = vb_; item < nitems; item += G_) {
        const int g = pg == 0 ? (item >= BH * 8 * 8 ? 1 : 0) : 2, li_ = item & (BH * 8 * 8 - 1);
        const int bh = li_ >> 3, qb = li_ & 7, b = bh >> 3, h = bh & 7, hh = g * 8 + h; const size_t tb = (size_t)b * SEQ;
        AttnItem it; it.q = (const bf16_t*)(ws + WS_QB) + tb * 3072 + hh * 128; it.q_ld = 3072;
        it.k = (const bf16_t*)(ws + WS_KVB) + tb * 6144 + hh * 128; it.k_ld = 6144; it.kpe = nullptr; it.kpe_ld = 0; it.gk = nullptr; it.ssk = nullptr; it.ssl = nullptr;
        it.v = (const bf16_t*)(ws + WS_KVB) + tb * 6144 + 3072 + hh * 128; it.v_ld = 6144; it.o_ld = 1024;
        it.o = (bf16_t*)(ws + (g == 1 ? WS_OB2 : WS_OB)) + tb * 1024 + h * 128; it.lse = (float*)(ws + (g == 1 ? WS_LSE2 : WS_LSE)) + tb * 8 + h;
        it.o2 = (const bf16_t*)(ws + WS_OB2) + tb * 1024 + h * 128; it.lse2 = (const float*)(ws + WS_LSE2) + tb * 8 + h;
        it.ld = 2 * g; it.merge = g == 2; it.P0 = qb * 256; it.pos = pos + tb; it.gq = gq + g * 128;
        attn_block<128, 1>(it, lds);
    }
}

#define XB_TMO      128
#define XB_XCNT(j)  (256  + 64 * (j))
#define XB_XSUB(j)  (1280 + 64 * (j))
#define XB_XGEN(j)  (2304 + 64 * (j))
#define XB_TOP      3328
#define XB_TOPGEN   3392
#define XCD_BAR_WORDS 3456
#define XB_SPIN_CAP (1u << 18)

__device__ __forceinline__ unsigned xb_ld(unsigned* p)              { return __hip_atomic_load(p, __ATOMIC_RELAXED, __HIP_MEMORY_SCOPE_AGENT); }
__device__ __forceinline__ unsigned xb_add(unsigned* p, unsigned v) { return __hip_atomic_fetch_add(p, v, __ATOMIC_RELAXED, __HIP_MEMORY_SCOPE_AGENT); }
__device__ __forceinline__ unsigned xb_xcc_id() { return (unsigned)__builtin_amdgcn_s_getreg((3 << 11) | 20) & 0xFu; }
#define XB_SPIN(cond, bar) do { unsigned _sp = 0; while (cond) { __builtin_amdgcn_s_sleep(1); \
    if ((++_sp & 255u) == 0u) { if (xb_ld(&(bar)[XB_TMO])) break; if (_sp > XB_SPIN_CAP) { atomicAdd(&(bar)[XB_TMO], 1u); break; } } } } while (0)

struct XcdBarrier {
    unsigned* bar; unsigned x;
    volatile LAS unsigned* st;
};

__device__ __forceinline__ XcdBarrier xcd_barrier_post(unsigned* bar, volatile LAS unsigned* st) {
    XcdBarrier b; b.bar = bar; b.x = xb_xcc_id(); b.st = st;
    if (threadIdx.x == 0) (void)xb_add(&bar[XB_XCNT(b.x)], 1u);
    return b;
}
__device__ __forceinline__ void xcd_barrier_complete(unsigned* bar, unsigned x, unsigned& nloc, unsigned& nx) {
    const unsigned G = gridDim.x * gridDim.y * gridDim.z;
    unsigned sum, cnt, mine, sp = 0u;
    for (;;) {
        sum = 0u; cnt = 0u; mine = 0u;
#pragma unroll
        for (unsigned j = 0; j < 16; ++j) { const unsigned c = xb_ld(&bar[XB_XCNT(j)]); sum += c; cnt += (c > 0u) ? 1u : 0u; mine = (j == x) ? c : mine; }
        if (sum == G) break;
        __builtin_amdgcn_s_sleep(1);
        if ((++sp & 255u) == 0u) { if (xb_ld(&bar[XB_TMO])) break; if (sp > XB_SPIN_CAP) { atomicAdd(&bar[XB_TMO], 1u); break; } }
    }
    nloc = mine > 0u ? mine : 1u; nx = cnt > 0u ? cnt : 1u;
}

__device__ __forceinline__ void xcd_barrier(const XcdBarrier& b) {
    asm volatile("s_waitcnt vmcnt(0)" ::: "memory");
    __syncthreads();
    if (threadIdx.x == 0) {
        unsigned* bar = b.bar;
        __builtin_amdgcn_s_waitcnt(0);
        unsigned nloc = b.st[0], nx = b.st[1];
        if (nloc == 0u) { xcd_barrier_complete(bar, b.x, nloc, nx); b.st[0] = nloc; b.st[1] = nx; }
        const unsigned old = xb_add(&bar[XB_XSUB(b.x)], 1u);
        const unsigned gen = old / nloc;
        if (old + 1u == (gen + 1u) * nloc) {
            __builtin_amdgcn_fence(__ATOMIC_RELEASE, "agent");
            asm volatile("s_waitcnt vmcnt(0)" ::: "memory");
            const unsigned og = xb_add(&bar[XB_TOP], 1u);
            const unsigned tg = og / nx;
            if (og + 1u == (tg + 1u) * nx) xb_add(&bar[XB_TOPGEN], 1u);
            else XB_SPIN(xb_ld(&bar[XB_TOPGEN]) == tg, bar);
            __builtin_amdgcn_fence(__ATOMIC_ACQUIRE, "agent");
            xb_add(&bar[XB_XGEN(b.x)], 1u);
            asm volatile("s_waitcnt vmcnt(0)" ::: "memory");
        } else {
            XB_SPIN(xb_ld(&bar[XB_XGEN(b.x)]) == gen, bar);
            __builtin_amdgcn_fence(__ATOMIC_ACQUIRE, "agent");
            asm volatile("s_waitcnt vmcnt(0)" ::: "memory");
        }
    }
    __syncthreads();
}

constexpr int NPH_HALF = 1 + 2 * 6 + 7 + 6;
#ifndef SKIP_MASK
#define SKIP_MASK 0
#endif
__global__ void __launch_bounds__(NTHR) mega(Params p) {
    extern __shared__ __attribute__((aligned(16))) unsigned char lds_raw[];
    LAS unsigned char* lds = (LAS unsigned char*)lds_raw;
    cg::grid_group grid = cg::this_grid();
    unsigned char* ws = p.ws;
    bf16_t* XB = (bf16_t*)(ws + WS_XB); float* SS = (float*)(ws + WS_SS); bf16_t* HB = (bf16_t*)(ws + WS_H);
    bf16_t* LAT = (bf16_t*)(ws + WS_LAT); bf16_t* Q = (bf16_t*)(ws + WS_Q); bf16_t* KV = (bf16_t*)(ws + WS_KV); bf16_t* KPE = (bf16_t*)(ws + WS_KPE); bf16_t* AO = (bf16_t*)(ws + WS_AO);
    bf16_t* KVB = (bf16_t*)(ws + WS_KVB); bf16_t* QB = (bf16_t*)(ws + WS_QB); bf16_t* OB = (bf16_t*)(ws + WS_OB);
#ifndef PROBE_MASK
#define PROBE_MASK 0
#endif
    unsigned long long probe_acc = 0ull;
    volatile LAS unsigned* bar_st = (volatile LAS unsigned*)(lds + 131072);
    if (threadIdx.x < 4) bar_st[threadIdx.x] = 0u;
    __syncthreads();
    XcdBarrier xbar = xcd_barrier_post((unsigned*)(ws + WS_BAR), bar_st);
#pragma unroll 1
    for (int ph = p.ph_lo; ph < p.ph_hi; ++ph) {
        const unsigned long long probe_t0 = PROBE_MASK ? __builtin_amdgcn_s_memrealtime() : 0ull;
        const int hb = ph >= NPH_HALF ? 1 : 0, li = hb ? ph - NPH_HALF + 1 : ph;
        const size_t toff = (size_t)hb * TH;
        const float* xin0 = (const float*)p.in[0] + toff * DM; float* xo = p.out + toff * DM; const int* pos = (const int*)p.in[1] + toff;
        int lyr = 0, j = -1;
        if (li >= 20) { lyr = 3; const int jm = li - 20; j = jm == 0 ? 0 : (jm <= 2 ? jm + 1 : jm + 2); }
        else if (li >= 13) { lyr = 2; const int jm = li - 13; j = jm <= 3 ? jm : jm + 1; }
        else if (li >= 1) { lyr = (li - 1) / 6; const int jm = (li - 1) - lyr * 6; j = jm == 0 ? 0 : jm == 1 ? 2 : jm + 2; }
        const bool mla = lyr < 2; const int ab = lyr & 1;
        int gk = 0;
        const bf16_t* A = nullptr; const bf16_t* Bt = nullptr; int lda = 0, N = 0, K = 0, nsub = 1;
        EpiBf16S E1{nullptr, 0, nullptr, 0, 1 << 30, nullptr, 4, 1.0f / 1024.0f, 0, nullptr, nullptr, nullptr, -1}; EpiRes E2{nullptr, nullptr, XB, SS};
        float* SSL = (float*)(ws + WS_SSL);
        if (li > 0) {
            if (j == 6) { gk = 1; A = XB; lda = 1024; Bt = (const bf16_t*)(ws + WS_W1) + (size_t)lyr * 4096 * 1024; N = 4096; K = 1024; E1.O = HB; E1.ldc = 4096; E1.ss = SS; E1.act = 1; }
            else if (j == 7) { gk = 2; A = HB; lda = 4096; Bt = (const bf16_t*)(ws + WS_W2) + (size_t)lyr * 1024 * 4096; N = 1024; K = 4096; E2.xin = xo; E2.xout = xo; }
            else if (j == 5) { gk = 2; N = 1024; E2.xin = lyr == 0 ? xin0 : xo; E2.xout = xo;
                if (mla) { A = AO; lda = 2048; K = 2048; Bt = (const bf16_t*)(ws + WS_WO) + (size_t)ab * 1024 * 2048; }
                else { A = OB; lda = 1024; K = 1024; Bt = (const bf16_t*)(ws + WS_WOB) + (size_t)ab * 1024 * 1024; } }
            else if (j == 0) { gk = 1; A = XB; lda = 1024; K = 1024; E1.ss = SS;
                if (hb == 1 && lyr == 0) { A = (const bf16_t*)(p.out + (size_t)TH * DM); E1.ss = (const float*)(p.out + (size_t)TH * DM) + 8 * MiB; }
                if (mla) { Bt = (const bf16_t*)(ws + WS_WIN) + (size_t)ab * 512 * 1024; N = 512; E1.O = LAT; E1.ldc = 512; E1.ssl = SSL; }
                else if (ab == 0) { Bt = (const bf16_t*)(ws + WS_WKVQ); N = 9216; E1.O = KVB; E1.ldc = 6144; E1.O2 = QB; E1.ldc2 = 3072; E1.split = 6144; }
                else { Bt = (const bf16_t*)(ws + WS_WQ1); N = 3072; E1.O = QB; E1.ldc = 3072; } }
            else if (j == 2 && mla) { gk = 1; nsub = 2; A = LAT; lda = 512; K = 256; Bt = (const bf16_t*)(ws + WS_WQB) + (size_t)ab * 3072 * 256; N = 3072; E1.O = Q; E1.ldc = 3072; E1.ss = SSL; E1.nsl4 = 1; E1.inv_n = 1.0f / 256.0f; }
        }
        if (!(SKIP_MASK & 1) && gk == 1) {
            if (nsub == 2) kpe_prep(LAT, pos, (const float*)p.in[10] + ab * 192, (bf16_t*)(ws + WS_KPER));
#pragma unroll 1
            for (int sub = 0; sub < nsub; ++sub) {
                if (sub == 1) { A = LAT + 256; Bt = (const bf16_t*)(ws + WS_WKVB) + (size_t)ab * 4096 * 128; N = 4096; K = 128; E1.O = KV; E1.ldc = 4096; E1.ss = SSL + 4; E1.inv_n = 1.0f / 128.0f; E1.ssk = (float*)(ws + WS_SSK); }
                run_gemm_bf16(lds, A, lda, Bt, N, K, E1);
            }
        } else if (!(SKIP_MASK & 2) && gk == 2) {
            run_gemm(lds, A, lda, Bt, N, K, E2);
        } else if (li == 0) {
            if (!(SKIP_MASK & 4)) { prep_weights(p, lds); prep_x(xin0, XB, SS);
                prep_x((const float*)p.in[0] + (size_t)TH * DM, (bf16_t*)(p.out + (size_t)TH * DM), p.out + (size_t)TH * DM + 8 * MiB); }
        } else if (mla) {
            if (j == 4) { if (!(SKIP_MASK & 32)) mla_attn_phase(p, lds, pos, (const float*)p.in[9] + ab * 192, (const float*)p.in[10] + ab * 192); }
        } else {
            if (j == 1) { if (!(SKIP_MASK & 64)) head_prep(ab == 0 ? KVB : nullptr, QB, pos, (const float*)p.in[14], (const float*)p.in[16] + ab * 384); }
            else if (j >= 2 && j <= 3) { if (!(SKIP_MASK & 128)) dil_attn_phase(p, lds, j - 2, pos, (const float*)p.in[16] + ab * 384); }
        }
        if (ph + 1 < p.ph_hi) { if (p.ph_hi > 4096) grid.sync(); else xcd_barrier(xbar); }
        if (PROBE_MASK) { const int cat = gk == 1 ? 1 : gk == 2 ? 2 : li == 0 ? 3 : mla ? (j == 1 ? 4 : j == 3 ? 5 : 6) : (j == 1 ? 7 : 8);
            if ((PROBE_MASK >> cat) & 1) probe_acc += __builtin_amdgcn_s_memrealtime() - probe_t0; }
    }
    if (PROBE_MASK && blockIdx.x == 0) { const unsigned long long t1 = __builtin_amdgcn_s_memrealtime(); while (__builtin_amdgcn_s_memrealtime() - t1 < probe_acc) __builtin_amdgcn_s_sleep(16); }
}
constexpr int N_PHASES = 2 * NPH_HALF - 1;

extern "C" void kernel_launch(void* const* d_in, const int* in_sizes, int n_in, void* d_out, int out_size, void* d_ws, size_t ws_size, hipStream_t stream) {
    static int grid_blocks = 0;
    if (!grid_blocks) {
        int dev = 0, cus = 0, per_cu = 0;
        (void)hipGetDevice(&dev);
        (void)hipDeviceGetAttribute(&cus, hipDeviceAttributeMultiprocessorCount, dev);
        (void)hipFuncSetAttribute((const void*)mega, hipFuncAttributeMaxDynamicSharedMemorySize, LDS_BYTES);
        (void)hipOccupancyMaxActiveBlocksPerMultiprocessor(&per_cu, (const void*)mega, NTHR, LDS_BYTES);
        (void)hipGetLastError();
        grid_blocks = cus > 0 ? cus : 256;
        if (ws_size < WS_END || n_in != 20) { fprintf(stderr, "kernel_launch: workspace %zu < %zu or n_in %d != 20\n", ws_size, (size_t)WS_END, n_in); }
    }
    (void)hipMemsetAsync((unsigned char*)d_ws + WS_BAR, 0, XCD_BAR_WORDS * sizeof(unsigned), stream);
    Params p{};
    for (int i = 0; i < 20; ++i) p.in[i] = d_in[i];
    p.out = (float*)d_out; p.ws = (unsigned char*)d_ws;
#if ONE_LAUNCH
    p.ph_lo = 0; p.ph_hi = N_PHASES;
    void* args[] = {&p};
    hipError_t e = hipLaunchCooperativeKernel((const void*)mega, dim3(grid_blocks), dim3(NTHR), args, LDS_BYTES, stream);
    if (e != hipSuccess) fprintf(stderr, "cooperative launch failed: %s (grid %d)\n", hipGetErrorString(e), grid_blocks);
#else
    for (int ph = 0; ph < N_PHASES; ++ph) { p.ph_lo = ph; p.ph_hi = ph + 1; hipLaunchKernelGGL(mega, dim3(grid_blocks), dim3(NTHR), LDS_BYTES, stream, p); }
#endif
}
```
